# Optimizing an MI355X kernel written in HIP

```python
import jax, jax.numpy as jnp
from jax import lax
import numpy as np

D_MODEL = 1024
BATCH = 8
SEQ = 2048
DEPTH = 4
DEC_BATCH = 128
DEC_SEQ = 8
PAST_LEN = 16384
PAGE_SIZE = 128

N_MIXERS = 2
EXPAND = 2
D_INNER = EXPAND * D_MODEL
HEAD_DIM = 64
N_HEADS = D_INNER // HEAD_DIM
N_GROUPS = 8
HEADS_PER_GROUP = N_HEADS // N_GROUPS
D_STATE = 128
CONV_WIDTH = 4
CONV_DIM = D_INNER + 2 * N_GROUPS * D_STATE
D_IN_PROJ = 2 * D_INNER + 2 * N_GROUPS * D_STATE + N_HEADS
CHUNK = 128
POOL_WIDTH = EXPAND * D_MODEL
POOL_WINDOWS = (2, 4, 8, 16)
N_POOL_GROUPS = len(POOL_WINDOWS)
POOL_GROUP_DIM = POOL_WIDTH // N_POOL_GROUPS
POOL_STATE = max(POOL_WINDOWS) - 1
N_SSD_LAYERS = (DEPTH + 1) // 2
N_POOL_LAYERS = DEPTH // 2
EPS = 1e-6

kernel_name = "hybrid_ssd_pool_adaln_step"


def rmsnorm(x, g):
    xf = x.astype(jnp.float32)
    return xf * lax.rsqrt(jnp.mean(xf * xf, axis=-1, keepdims=True) + EPS) * g.astype(jnp.float32)


def ssd_scan(x, dt, A, B, C, h0):
    b, L, H, P = x.shape
    T = min(CHUNK, L)
    nc = L // T
    G, R, N = N_GROUPS, HEADS_PER_GROUP, D_STATE
    x = x.reshape(b, nc, T, G, R, P)
    dt = dt.reshape(b, nc, T, G, R)
    B = B.reshape(b, nc, T, G, N)
    C = C.reshape(b, nc, T, G, N)
    acum = jnp.cumsum(dt * A.reshape(G, R), axis=2)
    seg = acum[:, :, :, None] - acum[:, :, None, :]
    mask = jnp.tril(jnp.ones((T, T), dtype=bool))[:, :, None, None]
    decay = jnp.where(mask, jnp.exp(jnp.where(mask, seg, 0.0)), 0.0)
    CB = jnp.einsum('bctgn,bcsgn->bctsg', C, B)
    xdt = x * dt[..., None]
    y_intra = jnp.einsum('bctsgr,bcsgrp->bctgrp', CB[..., None] * decay, xdt)
    decay_end = jnp.exp(acum[:, :, -1:] - acum)
    chunk_states = jnp.einsum('bctgn,bctgr,bctgrp->bcgrpn', B, decay_end, xdt)
    chunk_decay = jnp.exp(acum[:, :, -1])

    def step(h, inp):
        s, d = inp
        return d[..., None, None] * h + s, h

    h_final, h_prev = lax.scan(step, h0.reshape(b, G, R, P, N),
                               (jnp.moveaxis(chunk_states, 1, 0), jnp.moveaxis(chunk_decay, 1, 0)))
    h_prev = jnp.moveaxis(h_prev, 0, 1)
    y_inter = jnp.einsum('bctgn,bctgr,bcgrpn->bctgrp', C, jnp.exp(acum), h_prev)
    y = (y_intra + y_inter).reshape(b, L, H, P)
    return y, h_final.reshape(b, H, P, N)


def ssd_branch(h, conv_prev, ssm_prev, w_in, conv_w, conv_b, dt_bias, a_log, d_skip, norm_g, w_out):
    b, L, _ = h.shape
    zxbcdt = h @ w_in
    z = zxbcdt[..., :D_INNER]
    xbc = zxbcdt[..., D_INNER:D_INNER + CONV_DIM].astype(jnp.float32)
    dt_raw = zxbcdt[..., D_INNER + CONV_DIM:].astype(jnp.float32)
    xp = jnp.concatenate([conv_prev.astype(jnp.float32), xbc], axis=1)
    conv = conv_b.astype(jnp.float32) + sum(xp[:, k:k + L] * conv_w[k].astype(jnp.float32)
                                            for k in range(CONV_WIDTH))
    new_conv = xp[:, -(CONV_WIDTH - 1):]
    xbc_act = jax.nn.silu(conv)
    xs = xbc_act[..., :D_INNER].reshape(b, L, N_HEADS, HEAD_DIM)
    Bm = xbc_act[..., D_INNER:D_INNER + N_GROUPS * D_STATE].reshape(b, L, N_GROUPS, D_STATE)
    Cm = xbc_act[..., D_INNER + N_GROUPS * D_STATE:].reshape(b, L, N_GROUPS, D_STATE)
    dt = jax.nn.softplus(dt_raw + dt_bias.astype(jnp.float32))
    A = -jnp.exp(a_log.astype(jnp.float32))
    y, new_ssm = ssd_scan(xs, dt, A, Bm, Cm, ssm_prev.astype(jnp.float32))
    y = (y + d_skip.astype(jnp.float32)[:, None] * xs).reshape(b, L, D_INNER)
    gated = (y * jax.nn.silu(z.astype(jnp.float32))).reshape(b, L, N_GROUPS, D_INNER // N_GROUPS)
    gated = gated * lax.rsqrt(jnp.mean(gated * gated, axis=-1, keepdims=True) + EPS)
    gated = gated.reshape(b, L, D_INNER) * norm_g.astype(jnp.float32)
    return gated.astype(h.dtype) @ w_out, new_conv, new_ssm


def pool_branch(h, pool_prev, start_pos, w_in, w_group, ch_scale, w_out):
    b, L, _ = h.shape
    uz = h @ w_in
    u = uz[..., :POOL_WIDTH].astype(jnp.float32)
    z = uz[..., POOL_WIDTH:].astype(jnp.float32)
    up = jnp.concatenate([pool_prev.astype(jnp.float32), u], axis=1)
    cs = jnp.concatenate([jnp.zeros((b, 1, POOL_WIDTH), jnp.float32), jnp.cumsum(up, axis=1)], axis=1)
    off = POOL_STATE + 1
    pos = start_pos + jnp.arange(L)
    groups = []
    for g, w in enumerate(POOL_WINDOWS):
        sl = slice(g * POOL_GROUP_DIM, (g + 1) * POOL_GROUP_DIM)
        win_sum = cs[:, off:off + L, sl] - cs[:, off - w:off - w + L, sl]
        cnt = jnp.minimum(w, pos + 1).astype(jnp.float32)[None, :, None]
        groups.append(win_sum / cnt - u[..., sl])
    pooled = jnp.stack(groups, axis=2)
    mixed = jnp.einsum('blgc,gcd->blgd', pooled, w_group.astype(jnp.float32)).reshape(b, L, POOL_WIDTH)
    mixed = mixed * ch_scale.astype(jnp.float32) * jax.nn.silu(z)
    return mixed.astype(h.dtype) @ w_out, up[:, -POOL_STATE:]


def trunk(x, c, start_pos, ssm_in, conv_in, pool_in, ada_w, ada_b, norm_g,
          ssd_w_in, ssd_conv_w, ssd_conv_b, ssd_dt_bias, ssd_a_log, ssd_d, ssd_norm_g, ssd_w_out,
          pool_w_in, pool_w_group, pool_scale, pool_w_out, final_norm_g):
    new_ssm, new_conv, new_pool = [], [], []
    sc = jax.nn.silu(c.astype(jnp.float32))
    for i in range(DEPTH):
        mod = sc @ ada_w[i].astype(jnp.float32) + ada_b[i].astype(jnp.float32)
        shift, scale, gate = jnp.split(mod, 3, axis=-1)
        hn = (rmsnorm(x, norm_g[i]) * (1.0 + scale[:, None]) + shift[:, None]).astype(x.dtype)
        j = i // N_MIXERS
        if i % N_MIXERS == 0:
            out, cv, st = ssd_branch(hn, conv_in[j], ssm_in[j], ssd_w_in[j], ssd_conv_w[j], ssd_conv_b[j],
                                     ssd_dt_bias[j], ssd_a_log[j], ssd_d[j], ssd_norm_g[j], ssd_w_out[j])
            new_conv.append(cv)
            new_ssm.append(st)
        else:
            out, ps = pool_branch(hn, pool_in[j], start_pos, pool_w_in[j], pool_w_group[j],
                                  pool_scale[j], pool_w_out[j])
            new_pool.append(ps)
        x = (x.astype(jnp.float32) + (1.0 + gate[:, None]) * out.astype(jnp.float32)).astype(x.dtype)
    y = rmsnorm(x, final_norm_g).astype(x.dtype)
    return y, jnp.stack(new_ssm), jnp.stack(new_conv), jnp.stack(new_pool)


def setup_inputs(seed: int = 0) -> dict:
    key = jax.random.key(seed)
    ks = jax.random.split(key, 24)
    nrm = lambda k, shape, s: jax.random.normal(k, shape, jnp.float32) * s
    dt0 = jnp.exp(jax.random.uniform(ks[10], (N_SSD_LAYERS, N_HEADS), jnp.float32,
                                     np.log(1e-3), np.log(1e-1)))
    return {
        "x_prompt": nrm(ks[0], (BATCH, SEQ, D_MODEL), 1.0),
        "x_sample": nrm(ks[1], (DEC_BATCH, DEC_SEQ, D_MODEL), 1.0),
        "state_ssm": nrm(ks[2], (N_SSD_LAYERS, DEC_BATCH, N_HEADS, HEAD_DIM, D_STATE), 0.1),
        "state_conv": nrm(ks[3], (N_SSD_LAYERS, DEC_BATCH, CONV_WIDTH - 1, CONV_DIM), 1.0),
        "state_pool": nrm(ks[4], (N_POOL_LAYERS, DEC_BATCH, POOL_STATE, POOL_WIDTH), 1.0),
        "c_prompt": nrm(ks[5], (BATCH, D_MODEL), 1.0),
        "c_sample": nrm(ks[6], (DEC_BATCH, D_MODEL), 1.0),
        "ada_w": nrm(ks[7], (DEPTH, D_MODEL, 3 * D_MODEL), 0.1 * D_MODEL ** -0.5),
        "ada_b": nrm(ks[8], (DEPTH, 3 * D_MODEL), 0.02),
        "norm_g": 1.0 + nrm(ks[9], (DEPTH, D_MODEL), 0.02),
        "ssd_w_in": nrm(ks[11], (N_SSD_LAYERS, D_MODEL, D_IN_PROJ), D_MODEL ** -0.5),
        "ssd_conv_w": nrm(ks[12], (N_SSD_LAYERS, CONV_WIDTH, CONV_DIM), CONV_WIDTH ** -0.5),
        "ssd_conv_b": nrm(ks[13], (N_SSD_LAYERS, CONV_DIM), 0.02),
        "ssd_dt_bias": dt0 + jnp.log(-jnp.expm1(-dt0)),
        "ssd_a_log": jnp.log(jax.random.uniform(ks[14], (N_SSD_LAYERS, N_HEADS), jnp.float32, 1.0, 16.0)),
        "ssd_d": 1.0 + nrm(ks[15], (N_SSD_LAYERS, N_HEADS), 0.02),
        "ssd_norm_g": 1.0 + nrm(ks[16], (N_SSD_LAYERS, D_INNER), 0.02),
        "ssd_w_out": nrm(ks[17], (N_SSD_LAYERS, D_INNER, D_MODEL), D_INNER ** -0.5),
        "pool_w_in": nrm(ks[18], (N_POOL_LAYERS, D_MODEL, 2 * POOL_WIDTH), D_MODEL ** -0.5),
        "pool_w_group": nrm(ks[19], (N_POOL_LAYERS, N_POOL_GROUPS, POOL_GROUP_DIM, POOL_GROUP_DIM), POOL_GROUP_DIM ** -0.5),
        "pool_scale": 1.0 + nrm(ks[20], (N_POOL_LAYERS, POOL_WIDTH), 0.1),
        "pool_w_out": nrm(ks[21], (N_POOL_LAYERS, POOL_WIDTH, D_MODEL), POOL_WIDTH ** -0.5),
        "final_norm_g": 1.0 + nrm(ks[22], (D_MODEL,), 0.02),
    }


def reference(x_prompt, x_sample, state_ssm, state_conv, state_pool, c_prompt, c_sample,
              ada_w, ada_b, norm_g, ssd_w_in, ssd_conv_w, ssd_conv_b, ssd_dt_bias, ssd_a_log, ssd_d,
              ssd_norm_g, ssd_w_out, pool_w_in, pool_w_group, pool_scale, pool_w_out, final_norm_g):
    weights = (ada_w, ada_b, norm_g, ssd_w_in, ssd_conv_w, ssd_conv_b, ssd_dt_bias, ssd_a_log, ssd_d,
               ssd_norm_g, ssd_w_out, pool_w_in, pool_w_group, pool_scale, pool_w_out, final_norm_g)
    b = x_prompt.shape[0]
    ssm0 = jnp.zeros((N_SSD_LAYERS, b, N_HEADS, HEAD_DIM, D_STATE), jnp.float32)
    conv0 = jnp.zeros((N_SSD_LAYERS, b, CONV_WIDTH - 1, CONV_DIM), jnp.float32)
    pool0 = jnp.zeros((N_POOL_LAYERS, b, POOL_STATE, POOL_WIDTH), jnp.float32)
    y_prompt, ssm_p, conv_p, pool_p = trunk(x_prompt, c_prompt, 0, ssm0, conv0, pool0, *weights)
    y_sample, ssm_s, conv_s, pool_s = trunk(x_sample, c_sample, PAST_LEN, state_ssm, state_conv,
                                            state_pool, *weights)
    return (y_prompt, y_sample, ssm_p, conv_p, pool_p, ssm_s, conv_s, pool_s)
```

```cpp
#include <hip/hip_runtime.h>
#include <hip/hip_cooperative_groups.h>
#include <cstdio>
namespace cg = cooperative_groups;

#define LAS __attribute__((address_space(3)))
typedef unsigned short bf16_t;
typedef short bf16x8 __attribute__((ext_vector_type(8)));
typedef float f32x4 __attribute__((ext_vector_type(4)));
typedef float f32x16 __attribute__((ext_vector_type(16)));
typedef unsigned u32x4 __attribute__((ext_vector_type(4)));
typedef unsigned u32x2 __attribute__((ext_vector_type(2)));

constexpr int MP = 16384, MT = 17408, DM = 1024;
constexpr int ZXW = 6144;
constexpr size_t O_SSM_P = 17825792, O_CONV_P = 22020096, O_POOL_P = 22216704, O_SSM_S = 22708224, O_CONV_S = 89817088, O_POOL_S = 92962816;

constexpr size_t WS_WT_SSD_IN = 0;
constexpr size_t WS_WT_SSD_OUT = WS_WT_SSD_IN + 2ull * 6400 * 1024 * 2;
constexpr size_t WS_WT_POOL_IN = WS_WT_SSD_OUT + 2ull * 1024 * 2048 * 2;
constexpr size_t WS_WT_POOL_G = WS_WT_POOL_IN + 2ull * 4096 * 1024 * 2;
constexpr size_t WS_WT_POOL_OUT = WS_WT_POOL_G + 2ull * 2048 * 512 * 2;
constexpr size_t WS_WT_ADA = WS_WT_POOL_OUT + 2ull * 1024 * 2048 * 2;
constexpr size_t WS_AC = WS_WT_ADA + 12288ull * 1024 * 2;
constexpr size_t WS_SHIFTA = WS_AC + 256ull * 1024 * 2;
constexpr size_t WS_MOD = WS_SHIFTA + 4ull * 256 * 1024 * 2;
constexpr size_t WS_SB = WS_MOD + 136ull * 12288 * 4;
constexpr size_t WS_APRIME = WS_SB + 4ull * 136 * 6400 * 4;
constexpr size_t WS_SSQ = WS_APRIME + 17408ull * 1024 * 2;
constexpr size_t WS_XW = WS_SSQ + 17408ull * 16 * 4;
constexpr size_t WS_ZX = WS_XW + 17408ull * 1024 * 4;
constexpr size_t WS_DTRAW = WS_ZX + 17408ull * 6144 * 2;
constexpr size_t WS_YG = WS_DTRAW + 17408ull * 32 * 4;
constexpr size_t WS_A2 = WS_YG + 17408ull * 2048 * 2;
constexpr size_t WS_END = WS_A2 + 17408ull * 2048 * 2;

constexpr int LDS_BYTES = 147712;

struct WJob { const float* src; bf16_t* dst; int K, N, tiles_n, tile_begin; };
constexpr int NWJ = 20;
struct Params {
    const float* in[23];
    float* out;
    unsigned char* ws;
    WJob wj[NWJ];
    int wtiles; int pad0;
};

__device__ __forceinline__ unsigned cvt_pk_bf16(float lo, float hi) { unsigned r; asm("v_cvt_pk_bf16_f32 %0, %1, %2" : "=v"(r) : "v"(lo), "v"(hi)); return r; }
__device__ __forceinline__ float bf_lo(unsigned u) { return __uint_as_float(u << 16); }
__device__ __forceinline__ float bf_hi(unsigned u) { return __uint_as_float(u & 0xffff0000u); }
__device__ __forceinline__ float bf2f(bf16_t b) { return __uint_as_float(((unsigned)b) << 16); }
__device__ __forceinline__ float silu_f(float v) { return v * __builtin_amdgcn_rcpf(1.f + __expf(-v)); }
__device__ __forceinline__ float softplus_f(float v) { return v > 20.f ? v : log1pf(__expf(v)); }
__device__ __forceinline__ int otid() { int t = threadIdx.x; asm volatile("" : "+v"(t)); return t; }
__device__ __forceinline__ int row_b(int r) { return r < MP ? (r >> 11) : 8 + ((r - MP) >> 3); }
__device__ __forceinline__ u32x4 pack8(f32x4 a, f32x4 b) { u32x4 r; r.x = cvt_pk_bf16(a.x, a.y); r.y = cvt_pk_bf16(a.z, a.w); r.z = cvt_pk_bf16(b.x, b.y); r.w = cvt_pk_bf16(b.z, b.w); return r; }

namespace pg8 {
constexpr int BM = 256, BK = 64, HALF = 128, HTB = HALF * BK * 2, STAGE_BYTES = 8 * HTB, NXCD = 8, WGM = 8;
__device__ __forceinline__ int lds_byte(int r, int c) { const int st = (r >> 4) * 2 + (c >> 5), rr = r & 15, cc = c & 31, ob = rr * 64 + cc * 2; return st * 1024 + (ob ^ (((ob >> 9) & 1) << 5)); }
__device__ __forceinline__ void stage_rc(int b, int& R, int& C) { const int st = b / 1024, sb = b % 1024, swz = sb ^ (((sb >> 9) & 1) << 5); R = (st >> 1) * 16 + swz / 64; C = (st & 1) * 32 + (swz % 64) / 2; }
__device__ __forceinline__ int perm32(int rho) { const int n = rho >> 4, i = rho & 15; return 8 * (i >> 2) + 4 * n + (i & 3); }

struct Unit { int pm, pn, q; const char* A; const char* B; };

struct MainSched {
    int nM, nN, nwg, G, c, lda, ldb, K, gsh;
    const char* A; const char* Bt;
    __device__ void init(int M, int N, int K_, int lda_, int ldb_, const void* A_, const void* Bt_, int gsh_) {
        nM = M / BM; nN = N / BM; nwg = nM * nN; G = (int)gridDim.x; c = (int)blockIdx.x; lda = lda_; ldb = ldb_; K = K_; A = (const char*)A_; Bt = (const char*)Bt_; gsh = gsh_;
    }
    __device__ bool next(int i, Unit& u) const {
        const long L = (long)i * G + c; if (L >= nwg) return false;
        int wgid = (int)L; { const int q = nwg / NXCD, r = nwg % NXCD, xcd = wgid % NXCD, off = wgid / NXCD; wgid = (xcd < r ? xcd * (q + 1) : r * (q + 1) + (xcd - r) * q) + off; }
        const int nig = WGM * nN, gid = wgid / nig, fm = gid * WGM, gsz = (nM - fm) < WGM ? (nM - fm) : WGM;
        u.pm = fm + ((wgid % nig) % gsz); u.pn = (wgid % nig) / gsz; u.q = 0;
        u.A = A + ((size_t)u.pm * BM * lda + (size_t)(u.pn >> gsh) * 512) * 2;
        u.B = Bt + (size_t)u.pn * BM * ldb * 2;
        return true;
    }
};
struct SmallSched {
    int mode, G, c, lda, ldb, K;
    const char* A0; const char* ada; const char* ssd_in; const char* pool_in;
    __device__ bool next(int i, Unit& u) const {
        const long L = (long)i * G + c;
        u.pm = 0;
        if (mode == 0) { if (L >= 48) return false; u.pn = (int)L; u.q = 0; u.A = A0; u.B = ada + (size_t)u.pn * BM * 1024 * 2; return true; }
        if (L >= 82) return false;
        int l = (int)L, q, pn;
        if (l < 25) { q = 0; pn = l; } else if (l < 41) { q = 1; pn = l - 25; } else if (l < 66) { q = 2; pn = l - 41; } else { q = 3; pn = l - 66; }
        u.q = q; u.pn = pn; u.A = A0 + (size_t)q * 256 * 1024 * 2;
        u.B = ((q & 1) ? pool_in + (size_t)(q >> 1) * 4096 * 1024 * 2 : ssd_in + (size_t)(q >> 1) * 6400 * 1024 * 2) + (size_t)pn * BM * 1024 * 2;
        return true;
    }
};

template <class Epi, class Sched>
__device__ __forceinline__ void gemm_phase(LAS unsigned char* lds, const Sched& S, const Epi& E) {
    const int tid = otid(), wid = __builtin_amdgcn_readfirstlane(tid >> 6), lane = tid & 63, wr = wid >> 2, wc = wid & 3, fr = lane & 15, fq = lane >> 4;
    const int K = S.K, nt = K / BK;
    unsigned voffA[2], voffB[2];
#pragma unroll
    for (int i = 0; i < 2; ++i) { int R, C; stage_rc(tid * 16 + i * 8192, R, C); const int Rb = Epi::PERM ? ((R & ~31) + perm32(R & 31)) : R;
        voffA[i] = (unsigned)(R * S.lda + C) * 2u; voffB[i] = (unsigned)(Rb * S.ldb + C) * 2u; }
    const size_t kstep = (size_t)(BK * 2);
    const size_t hstepA = (size_t)HALF * S.lda * 2, hstepB = (size_t)HALF * S.ldb * 2;
    const unsigned ldsw = (unsigned)wid * 1024u;
    const int aoff = lds_byte(wr * 64 + fr, fq * 8), boff = lds_byte(wc * 32 + fr, fq * 8);
#define PG8_SA(b, h) (((b) * 2 + (h)) * HTB)
#define PG8_SB(b, h) ((4 + (b) * 2 + (h)) * HTB)
#define PG8_STAGE(bufoff, gbase, voff) do { _Pragma("unroll") for (int _i = 0; _i < 2; ++_i) \
        __builtin_amdgcn_global_load_lds((const unsigned*)((const char*)(gbase) + (voff)[_i]), (LAS unsigned*)(lds + (bufoff) + ldsw + _i * 8192), 16, 0, 0); } while (0)
#define PG8_LDA(dst, b, h) do { _Pragma("unroll") for (int m = 0; m < 4; ++m) _Pragma("unroll") for (int k = 0; k < 2; ++k) dst[m][k] = *(const LAS bf16x8*)(lds + PG8_SA(b, h) + aoff + m * 2048 + k * 1024); } while (0)
#define PG8_LDB(dst, b, h) do { _Pragma("unroll") for (int n = 0; n < 2; ++n) _Pragma("unroll") for (int k = 0; k < 2; ++k) dst[n][k] = *(const LAS bf16x8*)(lds + PG8_SB(b, h) + boff + n * 2048 + k * 1024); } while (0)
#define PG8_MMA(ai, bj, At, Bt) do { __builtin_amdgcn_s_setprio(1); _Pragma("unroll") for (int m = 0; m < 4; ++m) _Pragma("unroll") for (int n = 0; n < 2; ++n) _Pragma("unroll") for (int k = 0; k < 2; ++k) \
        acc[ai][bj][m][n] = __builtin_amdgcn_mfma_f32_16x16x32_bf16(Bt[n][k], At[m][k], acc[ai][bj][m][n], 0, 0, 0); __builtin_amdgcn_s_setprio(0); } while (0)
#define PG8_WAIT_V(n) asm volatile("s_waitcnt vmcnt(" #n ")" ::: "memory")
#define PG8_WAIT_L(n) asm volatile("s_waitcnt lgkmcnt(" #n ")" ::: "memory")
#define PG8_BAR __builtin_amdgcn_s_barrier()
#define PG8_SCHED __builtin_amdgcn_sched_barrier(0)
    Unit cur, nxt; int ui = 0;
    if (!S.next(0, cur)) return;
    f32x4 acc[2][2][4][2];
#pragma unroll
    for (int a = 0; a < 2; ++a)
#pragma unroll
        for (int b = 0; b < 2; ++b)
#pragma unroll
            for (int m = 0; m < 4; ++m)
#pragma unroll
                for (int n = 0; n < 2; ++n) acc[a][b][m][n] = (f32x4){0.f, 0.f, 0.f, 0.f};
    bf16x8 At[4][2], B0[2][2], B1[2][2];
    const char* cA = cur.A; const char* cB = cur.B;
    PG8_STAGE(PG8_SB(0, 0), cB, voffB); PG8_STAGE(PG8_SA(0, 0), cA, voffA); PG8_STAGE(PG8_SB(0, 1), cB + hstepB, voffB); PG8_STAGE(PG8_SA(0, 1), cA + hstepA, voffA);
    if (wr == 1) PG8_BAR;
    PG8_WAIT_V(4); PG8_BAR;
    PG8_STAGE(PG8_SB(1, 0), cB + kstep, voffB); PG8_STAGE(PG8_SA(1, 0), cA + kstep, voffA); PG8_STAGE(PG8_SB(1, 1), cB + hstepB + kstep, voffB);
    PG8_WAIT_V(6); PG8_BAR;
    for (;;) {
        const bool has_next = S.next(ui + 1, nxt);
        const char* nA = has_next ? nxt.A : cA; const char* nB = has_next ? nxt.B : cB;
        for (int t = 0; t < nt; t += 2) {
            const bool last = (t == nt - 2);
            const char* a1 = cA + (size_t)(t + 1) * kstep;
            const char* a2 = last ? nA : cA + (size_t)(t + 2) * kstep; const char* b2 = last ? nB : cB + (size_t)(t + 2) * kstep;
            const char* a3 = a2 + kstep; const char* b3 = b2 + kstep;
            PG8_LDB(B0, 0, 0); PG8_SCHED; PG8_LDA(At, 0, 0); PG8_STAGE(PG8_SA(1, 1), a1 + hstepA, voffA);
            PG8_WAIT_L(8); PG8_BAR; PG8_WAIT_L(0); PG8_MMA(0, 0, At, B0); PG8_BAR; PG8_SCHED;
            PG8_LDB(B1, 0, 1); PG8_STAGE(PG8_SB(0, 0), b2, voffB);
            PG8_BAR; PG8_WAIT_L(0); PG8_MMA(0, 1, At, B1); PG8_BAR;
            PG8_LDA(At, 0, 1); PG8_STAGE(PG8_SA(0, 0), a2, voffA);
            PG8_BAR; PG8_WAIT_L(0); PG8_MMA(1, 0, At, B0); PG8_BAR; PG8_SCHED;
            PG8_STAGE(PG8_SB(0, 1), b2 + hstepB, voffB);
            PG8_WAIT_V(6); PG8_BAR; PG8_MMA(1, 1, At, B1); PG8_BAR;
            PG8_LDB(B0, 1, 0); PG8_SCHED; PG8_LDA(At, 1, 0); PG8_STAGE(PG8_SA(0, 1), a2 + hstepA, voffA);
            PG8_WAIT_L(8); PG8_BAR; PG8_WAIT_L(0); PG8_MMA(0, 0, At, B0); PG8_BAR; PG8_SCHED;
            PG8_LDB(B1, 1, 1); PG8_STAGE(PG8_SB(1, 0), b3, voffB);
            PG8_BAR; PG8_WAIT_L(0); PG8_MMA(0, 1, At, B1); PG8_BAR;
            PG8_LDA(At, 1, 1); PG8_STAGE(PG8_SA(1, 0), a3, voffA);
            PG8_BAR; PG8_WAIT_L(0); PG8_MMA(1, 0, At, B0); PG8_BAR; PG8_SCHED;
            PG8_STAGE(PG8_SB(1, 1), b3 + hstepB, voffB);
            PG8_WAIT_V(6); PG8_BAR; PG8_MMA(1, 1, At, B1); PG8_BAR;
        }
        E(acc, cur, wr, wc, fr, fq);
        if (!has_next) break;
#pragma unroll
        for (int a = 0; a < 2; ++a)
#pragma unroll
            for (int b = 0; b < 2; ++b)
#pragma unroll
                for (int m = 0; m < 4; ++m)
#pragma unroll
                    for (int n = 0; n < 2; ++n) acc[a][b][m][n] = (f32x4){0.f, 0.f, 0.f, 0.f};
        cur = nxt; cA = nA; cB = nB; ++ui;
    }
    PG8_WAIT_V(0);
    if (wr == 0) PG8_BAR;
    PG8_BAR;
#undef PG8_SA
#undef PG8_SB
#undef PG8_STAGE
#undef PG8_LDA
#undef PG8_LDB
#undef PG8_MMA
#undef PG8_WAIT_V
#undef PG8_WAIT_L
#undef PG8_BAR
#undef PG8_SCHED
}
}
using pg8::Unit;

struct EpiIn {
    static constexpr bool PERM = true;
    const float* ssq; const float* sb; bf16_t* out; int ldo, nbf; float* dtraw;
    __device__ __forceinline__ void operator()(const f32x4 (&acc)[2][2][4][2], const Unit& u, int wr, int wc, int fr, int fq) const {
        asm volatile("" : "+v"(fr), "+v"(fq));
        const int row0 = u.pm * 256 + wr * 64 + fr, colt = u.pn * 256 + wc * 32 + 8 * fq;
#pragma unroll
        for (int ai = 0; ai < 2; ++ai)
#pragma unroll
            for (int m = 0; m < 4; ++m) {
                __builtin_amdgcn_sched_barrier(0);
                const int r = row0 + ai * 128 + m * 16;
                const f32x4* sp = (const f32x4*)(ssq + (size_t)r * 16);
                const f32x4 s0 = sp[0], s1 = sp[1], s2 = sp[2], s3 = sp[3];
                const f32x4 st = (s0 + s1) + (s2 + s3);
                const float rstd = rsqrtf(((st.x + st.y) + (st.z + st.w)) * (1.f / 1024.f) + 1e-6f);
                const float* sbr = sb + (size_t)row_b(r) * 6400;
#pragma unroll
                for (int bj = 0; bj < 2; ++bj) {
                    const int c = colt + bj * 128;
                    if (c < nbf) {
                        const f32x4 b0 = *(const f32x4*)(sbr + c), b1 = *(const f32x4*)(sbr + c + 4);
                        const f32x4 v0 = acc[ai][bj][m][0] * rstd + b0, v1 = acc[ai][bj][m][1] * rstd + b1;
                        *(u32x4*)(out + (size_t)r * ldo + c) = pack8(v0, v1);
                    } else if (dtraw != nullptr && c < nbf + 32) {
                        const f32x4 b0 = *(const f32x4*)(sbr + c), b1 = *(const f32x4*)(sbr + c + 4);
                        float* dp = dtraw + (size_t)r * 32 + (c - nbf);
                        *(f32x4*)dp = acc[ai][bj][m][0] * rstd + b0; *(f32x4*)(dp + 4) = acc[ai][bj][m][1] * rstd + b1;
                    }
                }
            }
    }
};
struct EpiOut {
    static constexpr bool PERM = true;
    const float* xin_p; const float* xin_s; float* xw; const float* modl; const float* ng_next; bf16_t* aprime; float* ssq;
    __device__ __forceinline__ void operator()(const f32x4 (&acc)[2][2][4][2], const Unit& u, int wr, int wc, int fr, int fq) const {
        asm volatile("" : "+v"(fr), "+v"(fq));
        const int row0 = u.pm * 256 + wr * 64 + fr, colt = u.pn * 256 + wc * 32 + 8 * fq;
#pragma unroll
        for (int ai = 0; ai < 2; ++ai)
#pragma unroll
            for (int m = 0; m < 4; ++m) {
                __builtin_amdgcn_sched_barrier(0);
                const int r = row0 + ai * 128 + m * 16;
                const float* xr = r < MP ? xin_p + (size_t)r * DM : xin_s + (size_t)(r - MP) * DM;
                const float* mb = modl + (size_t)row_b(r) * 12288;
                float ss = 0.f;
#pragma unroll
                for (int bj = 0; bj < 2; ++bj) {
                    const int c = colt + bj * 128;
                    const f32x4 g0 = *(const f32x4*)(mb + 2048 + c), g1 = *(const f32x4*)(mb + 2048 + c + 4);
                    const f32x4 x0 = *(const f32x4*)(xr + c), x1 = *(const f32x4*)(xr + c + 4);
                    const f32x4 n0 = x0 + (g0 + 1.f) * acc[ai][bj][m][0], n1 = x1 + (g1 + 1.f) * acc[ai][bj][m][1];
                    *(f32x4*)(xw + (size_t)r * DM + c) = n0; *(f32x4*)(xw + (size_t)r * DM + c + 4) = n1;
                    ss += (n0.x * n0.x + n0.y * n0.y) + (n0.z * n0.z + n0.w * n0.w) + (n1.x * n1.x + n1.y * n1.y) + (n1.z * n1.z + n1.w * n1.w);
                    if (ng_next != nullptr) {
                        const f32x4 s0 = *(const f32x4*)(mb + 3072 + 1024 + c), s1 = *(const f32x4*)(mb + 3072 + 1024 + c + 4);
                        const f32x4 w0 = *(const f32x4*)(ng_next + c), w1 = *(const f32x4*)(ng_next + c + 4);
                        *(u32x4*)(aprime + (size_t)r * DM + c) = pack8(n0 * w0 * (s0 + 1.f), n1 * w1 * (s1 + 1.f));
                    }
                }
                ss += __shfl_xor(ss, 16); ss += __shfl_xor(ss, 32);
                if (fq == 0) ssq[(size_t)r * 16 + u.pn * 4 + wc] = ss;
            }
    }
};
struct EpiGrp {
    static constexpr bool PERM = true;
    const bf16_t* uz; const float* chs; bf16_t* out;
    __device__ __forceinline__ void operator()(const f32x4 (&acc)[2][2][4][2], const Unit& u, int wr, int wc, int fr, int fq) const {
        asm volatile("" : "+v"(fr), "+v"(fq));
        const int row0 = u.pm * 256 + wr * 64 + fr, colt = u.pn * 256 + wc * 32 + 8 * fq;
#pragma unroll
        for (int ai = 0; ai < 2; ++ai)
#pragma unroll
            for (int m = 0; m < 4; ++m) {
                __builtin_amdgcn_sched_barrier(0);
                const int r = row0 + ai * 128 + m * 16;
#pragma unroll
                for (int bj = 0; bj < 2; ++bj) {
                    const int c = colt + bj * 128;
                    const u32x4 zz = *(const u32x4*)(uz + (size_t)r * 4096 + 2048 + c);
                    const f32x4 c0 = *(const f32x4*)(chs + c), c1 = *(const f32x4*)(chs + c + 4);
                    f32x4 z0, z1;
                    z0.x = silu_f(bf_lo(zz.x)); z0.y = silu_f(bf_hi(zz.x)); z0.z = silu_f(bf_lo(zz.y)); z0.w = silu_f(bf_hi(zz.y));
                    z1.x = silu_f(bf_lo(zz.z)); z1.y = silu_f(bf_hi(zz.z)); z1.z = silu_f(bf_lo(zz.w)); z1.w = silu_f(bf_hi(zz.w));
                    *(u32x4*)(out + (size_t)r * 2048 + c) = pack8(acc[ai][bj][m][0] * c0 * z0, acc[ai][bj][m][1] * c1 * z1);
                }
            }
    }
};
struct EpiSmall {
    static constexpr bool PERM = true;
    int mode; float* mod; const float* ada_b; bf16_t* shiftA; float* sb;
    __device__ __forceinline__ void operator()(const f32x4 (&acc)[2][2][4][2], const Unit& u, int wr, int wc, int fr, int fq) const {
        asm volatile("" : "+v"(fr), "+v"(fq));
        const int row0 = wr * 64 + fr, colt = u.pn * 256 + wc * 32 + 8 * fq;
#pragma unroll
        for (int ai = 0; ai < 2; ++ai)
#pragma unroll
            for (int m = 0; m < 4; ++m) {
                __builtin_amdgcn_sched_barrier(0);
                const int r = row0 + ai * 128 + m * 16;
                if (r < 136) {
#pragma unroll
                    for (int bj = 0; bj < 2; ++bj) {
                        const int c = colt + bj * 128;
                        if (mode == 0) {
                            const f32x4 v0 = acc[ai][bj][m][0] + *(const f32x4*)(ada_b + c), v1 = acc[ai][bj][m][1] + *(const f32x4*)(ada_b + c + 4);
                            *(f32x4*)(mod + (size_t)r * 12288 + c) = v0; *(f32x4*)(mod + (size_t)r * 12288 + c + 4) = v1;
                            const int li = c / 3072, cc = c - li * 3072;
                            if (cc < 1024) *(u32x4*)(shiftA + ((size_t)li * 256 + r) * 1024 + cc) = pack8(v0, v1);
                        } else {
                            float* sp = sb + ((size_t)u.q * 136 + r) * 6400 + c;
                            *(f32x4*)sp = acc[ai][bj][m][0]; *(f32x4*)(sp + 4) = acc[ai][bj][m][1];
                        }
                    }
                }
            }
    }
};

__device__ void phase_prep0(const Params& p, LAS unsigned char* lds) {
    LAS float* tl = (LAS float*)lds;
    const int tid = otid();
    for (int tile = blockIdx.x; tile < p.wtiles; tile += gridDim.x) {
        int j = 0;
#pragma unroll 1
        for (int q = 1; q < NWJ; ++q) if (tile >= p.wj[q].tile_begin) j = q;
        const WJob job = p.wj[j];
        const int lt = tile - job.tile_begin, tk = lt / job.tiles_n, tn = lt - tk * job.tiles_n, k0 = tk * 64, n0 = tn * 64;
        {
            const int kk = tid >> 3, nn = (tid & 7) * 8;
            f32x4 a = (f32x4){0.f, 0.f, 0.f, 0.f}, b = a;
            if (n0 + nn < job.N) { const float* sp = job.src + (size_t)(k0 + kk) * job.N + n0 + nn; a = *(const f32x4*)sp; b = *(const f32x4*)(sp + 4); }
            LAS float* d = tl + kk * 65 + nn;
            d[0] = a.x; d[1] = a.y; d[2] = a.z; d[3] = a.w; d[4] = b.x; d[5] = b.y; d[6] = b.z; d[7] = b.w;
        }
        __syncthreads();
        {
            const int n = tid >> 3, k8 = (tid & 7) * 8;
            const LAS float* s = tl + k8 * 65 + n;
            u32x4 o; o.x = cvt_pk_bf16(s[0], s[65]); o.y = cvt_pk_bf16(s[130], s[195]); o.z = cvt_pk_bf16(s[260], s[325]); o.w = cvt_pk_bf16(s[390], s[455]);
            *(u32x4*)(job.dst + (size_t)(n0 + n) * job.K + k0 + k8) = o;
        }
        __syncthreads();
    }
    bf16_t* ac = (bf16_t*)(p.ws + WS_AC);
    const int gt = blockIdx.x * 512 + tid, nth = gridDim.x * 512;
    for (int i = gt; i < 256 * 1024 / 8; i += nth) {
        const int r = i >> 7, c = (i & 127) * 8;
        u32x4 o = (u32x4){0u, 0u, 0u, 0u};
        if (r < 136) {
            const float* cp = r < 8 ? p.in[5] + (size_t)r * 1024 + c : p.in[6] + (size_t)(r - 8) * 1024 + c;
            const f32x4 a = *(const f32x4*)cp, b = *(const f32x4*)(cp + 4);
            o.x = cvt_pk_bf16(silu_f(a.x), silu_f(a.y)); o.y = cvt_pk_bf16(silu_f(a.z), silu_f(a.w)); o.z = cvt_pk_bf16(silu_f(b.x), silu_f(b.y)); o.w = cvt_pk_bf16(silu_f(b.z), silu_f(b.w));
        }
        *(u32x4*)(ac + (size_t)i * 8) = o;
    }
    u32x4* sh = (u32x4*)(p.ws + WS_SHIFTA);
    for (int i = gt; i < 4 * 256 * 1024 / 8; i += nth) sh[i] = (u32x4){0u, 0u, 0u, 0u};
}

__device__ void phase_xprep(const Params& p) {
    const int tid_ = otid(), lane = tid_ & 63, wv = blockIdx.x * 8 + (tid_ >> 6), nw = gridDim.x * 8;
    const float* mod = (const float*)(p.ws + WS_MOD);
    bf16_t* ap = (bf16_t*)(p.ws + WS_APRIME);
    float* ssq = (float*)(p.ws + WS_SSQ);
    const float* ng = p.in[9];
    for (int r = wv; r < MT; r += nw) {
        const float* xr = r < MP ? p.in[0] + (size_t)r * DM : p.in[1] + (size_t)(r - MP) * DM;
        const float* mb = mod + (size_t)row_b(r) * 12288 + 1024;
        float ss = 0.f;
#pragma unroll
        for (int q = 0; q < 4; ++q) {
            const int c = q * 256 + lane * 4;
            const f32x4 x = *(const f32x4*)(xr + c), s = *(const f32x4*)(mb + c), g = *(const f32x4*)(ng + c);
            ss += (x.x * x.x + x.y * x.y) + (x.z * x.z + x.w * x.w);
            const f32x4 a = x * g * (s + 1.f);
            u32x2 o; o.x = cvt_pk_bf16(a.x, a.y); o.y = cvt_pk_bf16(a.z, a.w);
            *(u32x2*)(ap + (size_t)r * DM + c) = o;
        }
#pragma unroll
        for (int o = 1; o < 64; o <<= 1) ss += __shfl_xor(ss, o);
        if (lane < 16) ssq[(size_t)r * 16 + lane] = lane == 0 ? ss : 0.f;
    }
}

__device__ void phase_final(const Params& p) {
    const int tid_ = otid(), lane = tid_ & 63, wv = blockIdx.x * 8 + (tid_ >> 6), nw = gridDim.x * 8;
    const float* xw = (const float*)(p.ws + WS_XW);
    const float* ssq = (const float*)(p.ws + WS_SSQ);
    const float* fg = p.in[22];
    for (int r = wv; r < MT; r += nw) {
        float s = lane < 16 ? ssq[(size_t)r * 16 + lane] : 0.f;
#pragma unroll
        for (int o = 1; o < 16; o <<= 1) s += __shfl_xor(s, o);
        s = __shfl(s, 0);
        const float rstd = rsqrtf(s * (1.f / 1024.f) + 1e-6f);
#pragma unroll
        for (int q = 0; q < 4; ++q) {
            const int c = q * 256 + lane * 4;
            const f32x4 x = *(const f32x4*)(xw + (size_t)r * DM + c), g = *(const f32x4*)(fg + c);
            *(f32x4*)(p.out + (size_t)r * DM + c) = x * rstd * g;
        }
    }
}

__device__ void phase_ssdnorm(const Params& p, int j) {
    const int tid_ = otid(), lane = tid_ & 63, wv = blockIdx.x * 8 + (tid_ >> 6), nw = gridDim.x * 8;
    const bf16_t* yg = (const bf16_t*)(p.ws + WS_YG);
    bf16_t* a2 = (bf16_t*)(p.ws + WS_A2);
    const float* ng = p.in[16] + (size_t)j * 2048;
    for (int r = wv; r < MT; r += nw) {
#pragma unroll
        for (int q = 0; q < 4; ++q) {
            const int c = q * 512 + lane * 8;
            const u32x4 v = *(const u32x4*)(yg + (size_t)r * 2048 + c);
            f32x4 a, b;
            a.x = bf_lo(v.x); a.y = bf_hi(v.x); a.z = bf_lo(v.y); a.w = bf_hi(v.y); b.x = bf_lo(v.z); b.y = bf_hi(v.z); b.z = bf_lo(v.w); b.w = bf_hi(v.w);
            float ss = (a.x * a.x + a.y * a.y) + (a.z * a.z + a.w * a.w) + (b.x * b.x + b.y * b.y) + (b.z * b.z + b.w * b.w);
#pragma unroll
            for (int o = 1; o < 32; o <<= 1) ss += __shfl_xor(ss, o);
            const float rstd = rsqrtf(ss * (1.f / 256.f) + 1e-6f);
            const f32x4 g0 = *(const f32x4*)(ng + c), g1 = *(const f32x4*)(ng + c + 4);
            *(u32x4*)(a2 + (size_t)r * 2048 + c) = pack8(a * rstd * g0, b * rstd * g1);
        }
    }
}

__device__ void phase_pool(const Params& p, int j) {
    const bf16_t* uz = (const bf16_t*)(p.ws + WS_ZX);
    bf16_t* pooled = (bf16_t*)(p.ws + WS_YG);
    const int gt = blockIdx.x * 512 + otid(), nth = gridDim.x * 512;
    for (int u = gt; u < 131072 + 32768; u += nth) {
        int cv, row0, t0, R; const float* prev = nullptr; bool prompt;
        if (u < 131072) { cv = u & 255; const int run = (u >> 8) & 63, b = u >> 14; row0 = b * 2048; t0 = run * 32; R = 32; prompt = true; }
        else { const int v = u - 131072; cv = v & 255; const int b = v >> 8; row0 = MP + b * 8; t0 = 0; R = 8; prompt = false; prev = p.in[4] + ((size_t)(j * 128 + b) * 15) * 2048; }
        const int c = cv * 8, w = 2 << (c >> 9);
        float s[8];
#pragma unroll
        for (int i = 0; i < 8; ++i) s[i] = 0.f;
        auto getu = [&](int tt, float (&o)[8]) {
            if (tt >= 0) {
                const u32x4 v = *(const u32x4*)(uz + (size_t)(row0 + tt) * 4096 + c);
                o[0] = bf_lo(v.x); o[1] = bf_hi(v.x); o[2] = bf_lo(v.y); o[3] = bf_hi(v.y); o[4] = bf_lo(v.z); o[5] = bf_hi(v.z); o[6] = bf_lo(v.w); o[7] = bf_hi(v.w);
            } else if (!prompt) {
                const float* pp = prev + (size_t)(15 + tt) * 2048 + c;
                const f32x4 a = *(const f32x4*)pp, b = *(const f32x4*)(pp + 4);
                o[0] = a.x; o[1] = a.y; o[2] = a.z; o[3] = a.w; o[4] = b.x; o[5] = b.y; o[6] = b.z; o[7] = b.w;
            } else {
#pragma unroll
                for (int i = 0; i < 8; ++i) o[i] = 0.f;
            }
        };
        for (int i = 1; i < w; ++i) {
            float o[8]; getu(t0 - i, o);
#pragma unroll
            for (int k = 0; k < 8; ++k) s[k] += o[k];
        }
        for (int t = t0; t < t0 + R; ++t) {
            float cur[8], old[8]; getu(t, cur); getu(t - w + 1, old);
            const float inv = 1.f / (float)(prompt ? min(w, t + 1) : w);
            f32x4 a, b;
#pragma unroll
            for (int k = 0; k < 8; ++k) s[k] += cur[k];
            a.x = s[0] * inv - cur[0]; a.y = s[1] * inv - cur[1]; a.z = s[2] * inv - cur[2]; a.w = s[3] * inv - cur[3];
            b.x = s[4] * inv - cur[4]; b.y = s[5] * inv - cur[5]; b.z = s[6] * inv - cur[6]; b.w = s[7] * inv - cur[7];
            *(u32x4*)(pooled + (size_t)(row0 + t) * 2048 + c) = pack8(a, b);
#pragma unroll
            for (int k = 0; k < 8; ++k) s[k] -= old[k];
        }
    }
    for (int i = gt; i < 8 * 15 * 2048; i += nth) {
        const int ch = i & 2047, k = (i >> 11) % 15, b = (i >> 11) / 15;
        p.out[O_POOL_P + ((size_t)(j * 8 + b) * 15 + k) * 2048 + ch] = bf2f(uz[(size_t)(b * 2048 + 2033 + k) * 4096 + ch]);
    }
    for (int i = gt; i < 128 * 15 * 2048; i += nth) {
        const int ch = i & 2047, k = (i >> 11) % 15, b = (i >> 11) / 15;
        float v;
        if (k < 7) v = p.in[4][((size_t)(j * 128 + b) * 15 + 8 + k) * 2048 + ch];
        else v = bf2f(uz[(size_t)(MP + b * 8 + k - 7) * 4096 + ch]);
        p.out[O_POOL_S + ((size_t)(j * 128 + b) * 15 + k) * 2048 + ch] = v;
    }
}

constexpr int RS = 272;
constexpr int L_XT = 0, L_BN = 17408, L_BT = 52224, L_CN = 87040, L_HB = 121856, L_SM = 139264, L_CW = 141312;
__device__ __forceinline__ int xt_addr(int pr, int t) { return L_XT + pr * RS + ((((t >> 3) ^ (pr >> 1)) & 15) << 4) + (t & 7) * 2; }
__device__ __forceinline__ int bt_addr(int n, int t) { return L_BT + n * RS + ((((t >> 3) ^ (n >> 3)) & 15) << 4) + (t & 7) * 2; }
__device__ __forceinline__ f32x16 mfma32(bf16x8 a, bf16x8 b, f32x16 c) { return __builtin_amdgcn_mfma_f32_32x32x16_bf16(a, b, c, 0, 0, 0); }

#define OPQ(x) asm volatile("" : "+v"(x))
__device__ void ssd_prompt_item(const Params& p, int j, int b, int h, LAS unsigned char* lds) {
    const int tid0 = otid(), wid = __builtin_amdgcn_readfirstlane(tid0 >> 6), g = h >> 2;
    const char* zxc = (const char*)(p.ws + WS_ZX);
    const char* dtc = (const char*)(p.ws + WS_DTRAW);
    char* ygc = (char*)(p.ws + WS_YG);
    const int rowbase = b * 2048;
    LAS float* sm_acum = (LAS float*)(lds + L_SM);
    LAS float* sm_dt = sm_acum + 128;
    LAS float* sm_w = sm_acum + 256;
    LAS float* sm_ea = sm_acum + 384;
    LAS float* cw = (LAS float*)(lds + L_CW);
    const float Ah = -__expf(p.in[14][j * 32 + h]), Dh = p.in[15][j * 32 + h], dtb = p.in[13][j * 32 + h];
    const bool roleB = wid < 4;
    const int qq = wid >> 1, tt = qq ^ (qq >> 1), pt = wid & 1, hp = wid & 1, hn = wid >> 1;

    __syncthreads();
    if (tid0 < 320) {
        const int ch = tid0 < 64 ? h * 64 + tid0 : (tid0 < 192 ? 2048 + g * 128 + (tid0 - 64) : 3072 + g * 128 + (tid0 - 192));
#pragma unroll
        for (int k = 0; k < 4; ++k) cw[k * 320 + tid0] = p.in[11][((size_t)j * 4 + k) * 4096 + ch];
        cw[4 * 320 + tid0] = p.in[12][(size_t)j * 4096 + ch];
    }
    for (int i = tid0; i < 17408 / 4; i += 512) *(LAS unsigned*)(lds + L_HB + i * 4) = 0u;

    u32x4 rawBC[11]; unsigned rawX[11]; float dtp0 = 0.f, dtp1 = 0.f;
    auto prefetch = [&](int t0) {
        int tid = tid0; OPQ(tid);
        const int bt_ = tid & 255, tqb = bt_ >> 4, cg8 = bt_ & 15, tqx = tid >> 5, cp = tid & 31, lane = tid & 63;
        const int colBC = (roleB ? 4096 : 5120) + g * 128 + cg8 * 8, colX = 2048 + h * 64 + cp * 2;
        const int rB = t0 + tqb * 8 - 3, rX = t0 + tqx * 8 - 3;
        const unsigned oB = (unsigned)((rowbase + rB) * ZXW + colBC) * 2u, oX = (unsigned)((rowbase + rX) * ZXW + colX) * 2u;
#pragma unroll
        for (int i = 0; i < 11; ++i) {
            rawBC[i] = (rB + i >= 0) ? *(const u32x4*)(zxc + (oB + (unsigned)i * 12288u)) : (u32x4){0u, 0u, 0u, 0u};
            rawX[i] = (rX + i >= 0) ? *(const unsigned*)(zxc + (oX + (unsigned)i * 12288u)) : 0u;
        }
        if (wid == 0) { const unsigned od = (unsigned)((rowbase + t0 + 2 * lane) * 32 + h) * 4u; dtp0 = *(const float*)(dtc + od); dtp1 = *(const float*)(dtc + (od + 128u)); }
    };
    prefetch(0);

    f32x16 hacc;
#pragma unroll
    for (int i = 0; i < 16; ++i) hacc[i] = 0.f;

#pragma unroll 1
    for (int c = 0; c < 16; ++c) {
        const int t0 = c * 128;
        if (wid == 0) {
            int lane = tid0 & 63; OPQ(lane);
            const float d0 = softplus_f(dtp0 + dtb), d1 = softplus_f(dtp1 + dtb);
            const float a0 = d0 * Ah, a1 = a0 + d1 * Ah;
            float sc = a1;
#pragma unroll
            for (int o = 1; o < 64; o <<= 1) { const float v = __shfl_up(sc, o); if (lane >= o) sc += v; }
            const float c1 = sc, c0 = sc - a1 + a0;
            const float last = __shfl(sc, 63);
            sm_acum[2 * lane] = c0; sm_acum[2 * lane + 1] = c1;
            sm_dt[2 * lane] = d0; sm_dt[2 * lane + 1] = d1;
            sm_w[2 * lane] = __expf(last - c0) * d0; sm_w[2 * lane + 1] = __expf(last - c1) * d1;
            sm_ea[2 * lane] = __expf(c0); sm_ea[2 * lane + 1] = __expf(c1);
        }
        __syncthreads();
        {
            int tid = tid0; OPQ(tid);
            const int bt_ = tid & 255, tqb = bt_ >> 4, cg8 = bt_ & 15;
            const int lcBC = (roleB ? 64 : 192) + cg8 * 8;
            const f32x4 wv0 = *(const LAS f32x4*)(sm_w + tqb * 8), wv1 = *(const LAS f32x4*)(sm_w + tqb * 8 + 4);
            const float wt[8] = {wv0.x, wv0.y, wv0.z, wv0.w, wv1.x, wv1.y, wv1.z, wv1.w};
            const int natbase = (roleB ? L_BN : L_CN) + (tqb * 8) * RS + cg8 * 16;
#pragma unroll
            for (int half = 0; half < 2; ++half) {
                u32x2 nat[8]; u32x4 tr[4];
#pragma unroll
                for (int ipp = 0; ipp < 2; ++ipp) {
                    const int ip = half * 2 + ipp;
                    const float k0a = cw[0 * 320 + lcBC + 2 * ip], k0b = cw[0 * 320 + lcBC + 2 * ip + 1];
                    const float k1a = cw[1 * 320 + lcBC + 2 * ip], k1b = cw[1 * 320 + lcBC + 2 * ip + 1];
                    const float k2a = cw[2 * 320 + lcBC + 2 * ip], k2b = cw[2 * 320 + lcBC + 2 * ip + 1];
                    const float k3a = cw[3 * 320 + lcBC + 2 * ip], k3b = cw[3 * 320 + lcBC + 2 * ip + 1];
                    const float bba = cw[4 * 320 + lcBC + 2 * ip], bbb = cw[4 * 320 + lcBC + 2 * ip + 1];
                    float ra[11], rb[11];
#pragma unroll
                    for (int i = 0; i < 11; ++i) { const unsigned v = rawBC[i][ip]; ra[i] = bf_lo(v); rb[i] = bf_hi(v); }
                    float va[8], vb[8];
#pragma unroll
                    for (int t = 0; t < 8; ++t) {
                        va[t] = silu_f(bba + k0a * ra[t] + k1a * ra[t + 1] + k2a * ra[t + 2] + k3a * ra[t + 3]);
                        vb[t] = silu_f(bbb + k0b * rb[t] + k1b * rb[t + 1] + k2b * rb[t + 2] + k3b * rb[t + 3]);
                        nat[t][ipp] = cvt_pk_bf16(va[t], vb[t]);
                    }
                    if (roleB) {
#pragma unroll
                        for (int tp = 0; tp < 4; ++tp) {
                            tr[2 * ipp][tp] = cvt_pk_bf16(va[2 * tp] * wt[2 * tp], va[2 * tp + 1] * wt[2 * tp + 1]);
                            tr[2 * ipp + 1][tp] = cvt_pk_bf16(vb[2 * tp] * wt[2 * tp], vb[2 * tp + 1] * wt[2 * tp + 1]);
                        }
                    }
                }
#pragma unroll
                for (int t = 0; t < 8; ++t) *(LAS u32x2*)(lds + natbase + t * RS + half * 8) = nat[t];
                if (roleB) {
#pragma unroll
                    for (int i = 0; i < 4; ++i) *(LAS u32x4*)(lds + bt_addr(cg8 * 8 + half * 4 + i, tqb * 8)) = tr[i];
                }
                __builtin_amdgcn_sched_barrier(0);
            }
        }
        {
            int tid = tid0; OPQ(tid);
            const int tqx = tid >> 5, cp = tid & 31, lcX = cp * 2;
            const float k0a = cw[0 * 320 + lcX], k0b = cw[0 * 320 + lcX + 1], k1a = cw[1 * 320 + lcX], k1b = cw[1 * 320 + lcX + 1];
            const float k2a = cw[2 * 320 + lcX], k2b = cw[2 * 320 + lcX + 1], k3a = cw[3 * 320 + lcX], k3b = cw[3 * 320 + lcX + 1];
            const float bba = cw[4 * 320 + lcX], bbb = cw[4 * 320 + lcX + 1];
            float ra[11], rb[11];
#pragma unroll
            for (int i = 0; i < 11; ++i) { ra[i] = bf_lo(rawX[i]); rb[i] = bf_hi(rawX[i]); }
            float va[8], vb[8];
#pragma unroll
            for (int t = 0; t < 8; ++t) {
                va[t] = silu_f(bba + k0a * ra[t] + k1a * ra[t + 1] + k2a * ra[t + 2] + k3a * ra[t + 3]);
                vb[t] = silu_f(bbb + k0b * rb[t] + k1b * rb[t + 1] + k2b * rb[t + 2] + k3b * rb[t + 3]);
            }
            u32x4 xa, xb;
            xa.x = cvt_pk_bf16(va[0], va[1]); xa.y = cvt_pk_bf16(va[2], va[3]); xa.z = cvt_pk_bf16(va[4], va[5]); xa.w = cvt_pk_bf16(va[6], va[7]);
            xb.x = cvt_pk_bf16(vb[0], vb[1]); xb.y = cvt_pk_bf16(vb[2], vb[3]); xb.z = cvt_pk_bf16(vb[4], vb[5]); xb.w = cvt_pk_bf16(vb[6], vb[7]);
            *(LAS u32x4*)(lds + xt_addr(cp * 2, tqx * 8)) = xa;
            *(LAS u32x4*)(lds + xt_addr(cp * 2 + 1, tqx * 8)) = xb;
        }
        if (c + 1 < 16) prefetch(t0 + 128);
        bf16_t zr[16];
        {
            int ln = tid0 & 63; OPQ(ln);
            const int l31 = ln & 31, hh = ln >> 5;
            const unsigned oz = (unsigned)((rowbase + t0 + tt * 32 + 4 * hh) * ZXW + h * 64 + pt * 32 + l31) * 2u;
#pragma unroll
            for (int rg = 0; rg < 16; ++rg) zr[rg] = *(const bf16_t*)(zxc + (oz + (unsigned)((rg & 3) + 8 * (rg >> 2)) * 12288u));
        }
        __syncthreads();
        f32x16 y;
        {
            int ln = tid0 & 63; OPQ(ln);
            const int l31 = ln & 31, hh = ln >> 5;
            const int cbase = L_CN + (tt * 32 + l31) * RS + 16 * hh, hbase = L_HB + (pt * 32 + l31) * RS + 16 * hh;
#pragma unroll
            for (int i = 0; i < 16; ++i) y[i] = 0.f;
#pragma unroll
            for (int ks = 0; ks < 8; ++ks) { const bf16x8 cfr = *(const LAS bf16x8*)(lds + cbase + ks * 32); const bf16x8 bfr = *(const LAS bf16x8*)(lds + hbase + ks * 32); y = mfma32(cfr, bfr, y); }
#pragma unroll
            for (int rq = 0; rq < 4; ++rq) { const f32x4 e = *(const LAS f32x4*)(sm_ea + tt * 32 + 8 * rq + 4 * hh); y[4 * rq] *= e.x; y[4 * rq + 1] *= e.y; y[4 * rq + 2] *= e.z; y[4 * rq + 3] *= e.w; }
            const int tidx = tt * 32 + l31;
            const float at = sm_acum[tidx];
#pragma unroll 1
            for (int st = 0; st <= tt; ++st) {
                f32x16 s;
#pragma unroll
                for (int i = 0; i < 16; ++i) s[i] = 0.f;
                const int bbase = L_BN + (st * 32 + l31) * RS + 16 * hh;
#pragma unroll
                for (int ks = 0; ks < 8; ++ks) { const bf16x8 afr = *(const LAS bf16x8*)(lds + bbase + ks * 32); const bf16x8 cfr = *(const LAS bf16x8*)(lds + cbase + ks * 32); s = mfma32(afr, cfr, s); }
#pragma unroll
                for (int rq = 0; rq < 4; ++rq) {
                    const int sb0 = st * 32 + 8 * rq + 4 * hh;
                    const f32x4 asv = *(const LAS f32x4*)(sm_acum + sb0), dsv = *(const LAS f32x4*)(sm_dt + sb0);
#pragma unroll
                    for (int i = 0; i < 4; ++i) {
                        float e = at - asv[i];
                        if (sb0 + i > tidx) e = -INFINITY;
                        s[4 * rq + i] *= __expf(e) * dsv[i];
                    }
                }
#pragma unroll
                for (int k2 = 0; k2 < 2; ++k2) {
                    u32x4 au; au.x = cvt_pk_bf16(s[8 * k2], s[8 * k2 + 1]); au.y = cvt_pk_bf16(s[8 * k2 + 2], s[8 * k2 + 3]); au.z = cvt_pk_bf16(s[8 * k2 + 4], s[8 * k2 + 5]); au.w = cvt_pk_bf16(s[8 * k2 + 6], s[8 * k2 + 7]);
                    const int sbase = st * 32 + 16 * k2 + 4 * hh;
                    const u32x2 lo = *(const LAS u32x2*)(lds + xt_addr(pt * 32 + l31, sbase)), hi = *(const LAS u32x2*)(lds + xt_addr(pt * 32 + l31, sbase + 8));
                    u32x4 bu; bu.x = lo.x; bu.y = lo.y; bu.z = hi.x; bu.w = hi.y;
                    y = mfma32(__builtin_bit_cast(bf16x8, au), __builtin_bit_cast(bf16x8, bu), y);
                }
            }
        }
        {
            int ln = tid0 & 63; OPQ(ln);
            const int l31 = ln & 31, hh = ln >> 5;
            const float dec = sm_ea[127];
#pragma unroll
            for (int i = 0; i < 16; ++i) hacc[i] *= dec;
#pragma unroll
            for (int ks = 0; ks < 8; ++ks) {
                const bf16x8 a = *(const LAS bf16x8*)(lds + xt_addr(hp * 32 + l31, ks * 16 + 8 * hh));
                const bf16x8 bb = *(const LAS bf16x8*)(lds + bt_addr(hn * 32 + l31, ks * 16 + 8 * hh));
                hacc = mfma32(a, bb, hacc);
            }
        }
        {
            int ln = tid0 & 63; OPQ(ln);
            const int l31 = ln & 31, hh = ln >> 5;
            const unsigned oy = (unsigned)((rowbase + t0 + tt * 32 + 4 * hh) * 2048 + h * 64 + pt * 32 + l31) * 2u;
#pragma unroll
            for (int rq = 0; rq < 4; ++rq) {
                const u32x2 xv = *(const LAS u32x2*)(lds + xt_addr(pt * 32 + l31, tt * 32 + 8 * rq + 4 * hh));
                const float xs[4] = {bf_lo(xv.x), bf_hi(xv.x), bf_lo(xv.y), bf_hi(xv.y)};
#pragma unroll
                for (int i = 0; i < 4; ++i) {
                    const int rg = 4 * rq + i;
                    const float yv = y[rg] + Dh * xs[i];
                    const float gv = yv * silu_f(bf2f(zr[rg]));
                    *(bf16_t*)(ygc + (oy + (unsigned)(8 * rq + i) * 4096u)) = (bf16_t)(cvt_pk_bf16(gv, 0.f) & 0xffffu);
                }
            }
        }
        __syncthreads();
        {
            int ln = tid0 & 63; OPQ(ln);
            const int l31 = ln & 31, hh = ln >> 5;
#pragma unroll
            for (int rg = 0; rg < 16; ++rg) {
                const int pr = hp * 32 + (rg & 3) + 8 * (rg >> 2) + 4 * hh;
                *(LAS bf16_t*)(lds + L_HB + pr * RS + (hn * 32 + l31) * 2) = (bf16_t)(cvt_pk_bf16(hacc[rg], 0.f) & 0xffffu);
            }
        }
    }
    {
        int ln = tid0 & 63; OPQ(ln);
        const int l31 = ln & 31, hh = ln >> 5;
        float* so = p.out + O_SSM_P + ((size_t)(j * 8 + b) * 32 + h) * 8192;
#pragma unroll
        for (int rg = 0; rg < 16; ++rg) {
            const int pr = hp * 32 + (rg & 3) + 8 * (rg >> 2) + 4 * hh;
            so[pr * 128 + hn * 32 + l31] = hacc[rg];
        }
    }
}

__device__ void ssd_sample_item(const Params& p, int j, int b, int g, LAS unsigned char* lds) {
    const int tid = otid();
    const bf16_t* zx = (const bf16_t*)(p.ws + WS_ZX);
    const float* dtraw = (const float*)(p.ws + WS_DTRAW);
    bf16_t* yg = (bf16_t*)(p.ws + WS_YG);
    LAS float* sx = (LAS float*)lds;
    LAS float* sB = sx + 2048;
    LAS float* sC = sB + 1024;
    LAS float* sdt = sC + 1024;
    LAS float* sdec = sdt + 32;
    const int pp = tid >> 3, nl = (tid & 7) * 4;
    const float* st = p.in[2] + ((size_t)(j * 128 + b) * 32 + g * 4) * 8192;
    f32x4 hs[4][4];
#pragma unroll
    for (int r = 0; r < 4; ++r)
#pragma unroll
        for (int q = 0; q < 4; ++q) hs[r][q] = *(const f32x4*)(st + r * 8192 + pp * 128 + nl + 32 * q);
    __syncthreads();
    {
        const int cc = tid < 256 ? g * 256 + tid : (tid < 384 ? 2048 + g * 128 + (tid - 256) : 3072 + g * 128 + (tid - 384));
        float raw[11];
#pragma unroll
        for (int k = 0; k < 3; ++k) raw[k] = p.in[3][((size_t)(j * 128 + b) * 3 + k) * 4096 + cc];
#pragma unroll
        for (int t = 0; t < 8; ++t) raw[3 + t] = bf2f(zx[(size_t)(MP + b * 8 + t) * ZXW + 2048 + cc]);
        const float w0 = p.in[11][((size_t)j * 4 + 0) * 4096 + cc], w1 = p.in[11][((size_t)j * 4 + 1) * 4096 + cc];
        const float w2 = p.in[11][((size_t)j * 4 + 2) * 4096 + cc], w3 = p.in[11][((size_t)j * 4 + 3) * 4096 + cc];
        const float bs = p.in[12][(size_t)j * 4096 + cc];
        LAS float* dst = tid < 256 ? sx + tid : (tid < 384 ? sB + (tid - 256) : sC + (tid - 384));
        const int dstride = tid < 256 ? 256 : 128;
#pragma unroll
        for (int t = 0; t < 8; ++t) dst[t * dstride] = silu_f(bs + w0 * raw[t] + w1 * raw[t + 1] + w2 * raw[t + 2] + w3 * raw[t + 3]);
        if (tid < 32) {
            const int t = tid >> 2, r = tid & 3, hd = g * 4 + r;
            const float dtv = softplus_f(dtraw[(size_t)(MP + b * 8 + t) * 32 + hd] + p.in[13][j * 32 + hd]);
            sdt[tid] = dtv; sdec[tid] = __expf(-dtv * __expf(p.in[14][j * 32 + hd]));
        }
    }
    __syncthreads();
    float* so = p.out + O_SSM_S + ((size_t)(j * 128 + b) * 32 + g * 4) * 8192;
#pragma unroll
    for (int r = 0; r < 4; ++r) {
        const float Dh = p.in[15][j * 32 + g * 4 + r];
        float ysel = 0.f;
#pragma unroll
        for (int t = 0; t < 8; ++t) {
            const float dtv = sdt[t * 4 + r], dec = sdec[t * 4 + r], dx = dtv * sx[t * 256 + r * 64 + pp];
            float yp = 0.f;
#pragma unroll
            for (int q = 0; q < 4; ++q) {
                const f32x4 B4 = *(const LAS f32x4*)(sB + t * 128 + nl + 32 * q), C4 = *(const LAS f32x4*)(sC + t * 128 + nl + 32 * q);
                hs[r][q] = hs[r][q] * dec + B4 * dx;
                yp += (hs[r][q].x * C4.x + hs[r][q].y * C4.y) + (hs[r][q].z * C4.z + hs[r][q].w * C4.w);
            }
            yp += __shfl_xor(yp, 1); yp += __shfl_xor(yp, 2); yp += __shfl_xor(yp, 4);
            if ((tid & 7) == t) ysel = yp;
        }
        {
            const int t = tid & 7, ch = g * 256 + r * 64 + pp;
            const size_t row = (size_t)(MP + b * 8 + t);
            const float yv = ysel + Dh * sx[t * 256 + r * 64 + pp];
            const float gv = yv * silu_f(bf2f(zx[row * ZXW + ch]));
            yg[row * 2048 + ch] = (bf16_t)(cvt_pk_bf16(gv, 0.f) & 0xffffu);
        }
#pragma unroll
        for (int q = 0; q < 4; ++q) *(f32x4*)(so + r * 8192 + pp * 128 + nl + 32 * q) = hs[r][q];
    }
}

__device__ void phase_scan(const Params& p, int j, LAS unsigned char* lds) {
    for (int item = blockIdx.x; item < 256; item += gridDim.x) {
        const int g = item & 7, k = item >> 3, b = k >> 2, r = k & 3;
#ifndef NO_PROMPT
        ssd_prompt_item(p, j, b, g * 4 + r, lds);
#endif
    }
#ifndef NO_SAMPLE
    for (int item = blockIdx.x; item < 1024; item += gridDim.x) ssd_sample_item(p, j, item >> 3, item & 7, lds);
#endif
    const bf16_t* zx = (const bf16_t*)(p.ws + WS_ZX);
    const int gt = blockIdx.x * 512 + otid(), nth = gridDim.x * 512;
    for (int i = gt; i < 136 * 3 * 4096; i += nth) {
        const int ch = i & 4095, k = (i >> 12) % 3, s = (i >> 12) / 3;
        if (s < 8) p.out[O_CONV_P + ((size_t)(j * 8 + s) * 3 + k) * 4096 + ch] = bf2f(zx[(size_t)(s * 2048 + 2045 + k) * ZXW + 2048 + ch]);
        else p.out[O_CONV_S + ((size_t)(j * 128 + (s - 8)) * 3 + k) * 4096 + ch] = bf2f(zx[(size_t)(MP + (s - 8) * 8 + 5 + k) * ZXW + 2048 + ch]);
    }
}

__global__ __launch_bounds__(512, 2) void hybrid_fwd(Params p) {
    extern __shared__ __attribute__((aligned(16))) unsigned char smem[];
    LAS unsigned char* lds = (LAS unsigned char*)smem;
    cg::grid_group grid = cg::this_grid();
    unsigned char* ws = p.ws;

#ifndef NO_PREP0
    phase_prep0(p, lds);
#endif
    grid.sync();
#pragma unroll 1
    for (int mode = 0; mode < 2; ++mode) {
        pg8::SmallSched S; S.mode = mode; S.G = (int)gridDim.x; S.c = (int)blockIdx.x; S.lda = 1024; S.ldb = 1024; S.K = 1024;
        S.A0 = (const char*)(ws + (mode == 0 ? WS_AC : WS_SHIFTA)); S.ada = (const char*)(ws + WS_WT_ADA); S.ssd_in = (const char*)(ws + WS_WT_SSD_IN); S.pool_in = (const char*)(ws + WS_WT_POOL_IN);
        EpiSmall E; E.mode = mode; E.mod = (float*)(ws + WS_MOD); E.ada_b = p.in[8]; E.shiftA = (bf16_t*)(ws + WS_SHIFTA); E.sb = (float*)(ws + WS_SB);
#ifndef NO_GSMALL
        pg8::gemm_phase<EpiSmall, pg8::SmallSched>(lds, S, E);
#endif
        if (mode == 1) phase_xprep(p);
        grid.sync();
    }
#pragma unroll 1
    for (int layer = 0; layer < 4; ++layer) {
        const int j = layer >> 1; const bool ssd = (layer & 1) == 0;
        {
            pg8::MainSched S;
            S.init(MT, ssd ? 6400 : 4096, 1024, 1024, 1024, ws + WS_APRIME, ssd ? ws + WS_WT_SSD_IN + (size_t)j * 6400 * 1024 * 2 : ws + WS_WT_POOL_IN + (size_t)j * 4096 * 1024 * 2, 30);
            EpiIn E; E.ssq = (const float*)(ws + WS_SSQ); E.sb = (const float*)(ws + WS_SB) + (size_t)layer * 136 * 6400; E.out = (bf16_t*)(ws + WS_ZX);
            E.ldo = ssd ? ZXW : 4096; E.nbf = ssd ? ZXW : 4096; E.dtraw = ssd ? (float*)(ws + WS_DTRAW) : nullptr;
#ifndef NO_GIN
            pg8::gemm_phase<EpiIn, pg8::MainSched>(lds, S, E);
#endif
        }
        grid.sync();
#ifndef NO_SCAN
        if (ssd) phase_scan(p, j, lds);
#endif
#ifndef NO_POOL
        if (!ssd) phase_pool(p, j);
#endif
        grid.sync();
        if (ssd) phase_ssdnorm(p, j);
        else {
            pg8::MainSched S; S.init(MT, 2048, 512, 2048, 512, ws + WS_YG, ws + WS_WT_POOL_G + (size_t)j * 2048 * 512 * 2, 1);
            EpiGrp E; E.uz = (const bf16_t*)(ws + WS_ZX); E.chs = p.in[20] + (size_t)j * 2048; E.out = (bf16_t*)(ws + WS_A2);
#ifndef NO_GGRP
            pg8::gemm_phase<EpiGrp, pg8::MainSched>(lds, S, E);
#endif
        }
        grid.sync();
        {
            pg8::MainSched S; S.init(MT, 1024, 2048, 2048, 2048, ws + WS_A2, ssd ? ws + WS_WT_SSD_OUT + (size_t)j * 1024 * 2048 * 2 : ws + WS_WT_POOL_OUT + (size_t)j * 1024 * 2048 * 2, 30);
            EpiOut E; float* xw = (float*)(ws + WS_XW);
            E.xin_p = layer == 0 ? p.in[0] : xw; E.xin_s = layer == 0 ? p.in[1] : xw + (size_t)MP * DM; E.xw = xw;
            E.modl = (const float*)(ws + WS_MOD) + (size_t)layer * 3072; E.ng_next = layer < 3 ? p.in[9] + (size_t)(layer + 1) * 1024 : nullptr;
            E.aprime = (bf16_t*)(ws + WS_APRIME); E.ssq = (float*)(ws + WS_SSQ);
#ifndef NO_GOUT
            pg8::gemm_phase<EpiOut, pg8::MainSched>(lds, S, E);
#endif
        }
        grid.sync();
    }
    phase_final(p);
}

extern "C" void kernel_launch(void* const* d_in, const int* in_sizes, int n_in, void* d_out, int out_size, void* d_ws, size_t ws_size, hipStream_t stream) {
    static int grid = 0;
    if (grid == 0) {
        if (n_in != 23 || ws_size < WS_END) { fprintf(stderr, "kernel_launch: unexpected n_in %d or ws_size %zu (need %zu)\n", n_in, ws_size, (size_t)WS_END); grid = -1; return; }
        int dev = 0, cus = 0, per_cu = 0;
        hipGetDevice(&dev);
        hipDeviceGetAttribute(&cus, hipDeviceAttributeMultiprocessorCount, dev);
        if (hipFuncSetAttribute((const void*)hybrid_fwd, hipFuncAttributeMaxDynamicSharedMemorySize, LDS_BYTES) != hipSuccess) { fprintf(stderr, "kernel_launch: hipFuncSetAttribute failed\n"); grid = -1; return; }
        if (hipOccupancyMaxActiveBlocksPerMultiprocessor(&per_cu, (const void*)hybrid_fwd, 512, LDS_BYTES) != hipSuccess || per_cu < 1) { fprintf(stderr, "kernel_launch: occupancy query gave %d\n", per_cu); (void)hipGetLastError(); per_cu = 1; }
        grid = cus * 1;
    }
    if (grid < 0) return;
    Params p{};
    for (int i = 0; i < 23; ++i) p.in[i] = (const float*)d_in[i];
    p.out = (float*)d_out; p.ws = (unsigned char*)d_ws;
    unsigned char* ws = (unsigned char*)d_ws;
    int nj = 0, tb = 0;
    auto add = [&](const float* src, size_t dst_off, int K, int N, int Npad) {
        WJob& w = p.wj[nj++]; w.src = src; w.dst = (bf16_t*)(ws + dst_off); w.K = K; w.N = N; w.tiles_n = Npad / 64; w.tile_begin = tb; tb += (K / 64) * (Npad / 64);
    };
    for (int i = 0; i < 4; ++i) add(p.in[7] + (size_t)i * 1024 * 3072, WS_WT_ADA + (size_t)i * 3072 * 1024 * 2, 1024, 3072, 3072);
    for (int j = 0; j < 2; ++j) add(p.in[10] + (size_t)j * 1024 * 6176, WS_WT_SSD_IN + (size_t)j * 6400 * 1024 * 2, 1024, 6176, 6400);
    for (int j = 0; j < 2; ++j) add(p.in[18] + (size_t)j * 1024 * 4096, WS_WT_POOL_IN + (size_t)j * 4096 * 1024 * 2, 1024, 4096, 4096);
    for (int j = 0; j < 2; ++j) add(p.in[17] + (size_t)j * 2048 * 1024, WS_WT_SSD_OUT + (size_t)j * 1024 * 2048 * 2, 2048, 1024, 1024);
    for (int j = 0; j < 2; ++j) add(p.in[21] + (size_t)j * 2048 * 1024, WS_WT_POOL_OUT + (size_t)j * 1024 * 2048 * 2, 2048, 1024, 1024);
    for (int q = 0; q < 8; ++q) add(p.in[19] + (size_t)q * 512 * 512, WS_WT_POOL_G + (size_t)q * 512 * 512 * 2, 512, 512, 512);
    p.wtiles = tb;
    void* args[] = {&p};
    hipError_t e = hipLaunchCooperativeKernel((const void*)hybrid_fwd, dim3(grid), dim3(512), args, LDS_BYTES, stream);
    if (e != hipSuccess) fprintf(stderr, "cooperative launch failed: %s (grid %d)\n", hipGetErrorString(e), grid);
}
```

```cpp
#include <hip/hip_runtime.h>
#include <hip/hip_cooperative_groups.h>
#include <cstdio>
namespace cg = cooperative_groups;

#define LAS __attribute__((address_space(3)))
typedef unsigned short bf16_t;
typedef short bf16x8 __attribute__((ext_vector_type(8)));
typedef float f32x4 __attribute__((ext_vector_type(4)));
typedef float f32x16 __attribute__((ext_vector_type(16)));
typedef unsigned u32x4 __attribute__((ext_vector_type(4)));
typedef unsigned u32x2 __attribute__((ext_vector_type(2)));

constexpr int MP = 16384, MT = 17408, DM = 1024;
constexpr int ZXW = 6144;
constexpr size_t O_SSM_P = 17825792, O_CONV_P = 22020096, O_POOL_P = 22216704, O_SSM_S = 22708224, O_CONV_S = 89817088, O_POOL_S = 92962816;

constexpr size_t WS_WT_SSD_IN = 0;
constexpr size_t WS_WT_SSD_OUT = WS_WT_SSD_IN + 2ull * 6400 * 1024 * 2;
constexpr size_t WS_WT_POOL_IN = WS_WT_SSD_OUT + 2ull * 1024 * 2048 * 2;
constexpr size_t WS_WT_POOL_G = WS_WT_POOL_IN + 2ull * 4096 * 1024 * 2;
constexpr size_t WS_WT_POOL_OUT = WS_WT_POOL_G + 2ull * 2048 * 512 * 2;
constexpr size_t WS_WT_ADA = WS_WT_POOL_OUT + 2ull * 1024 * 2048 * 2;
constexpr size_t WS_AC = WS_WT_ADA + 12288ull * 1024 * 2;
constexpr size_t WS_SHIFTA = WS_AC + 256ull * 1024 * 2;
constexpr size_t WS_MOD = WS_SHIFTA + 4ull * 256 * 1024 * 2;
constexpr size_t WS_SB = WS_MOD + 136ull * 12288 * 4;
constexpr size_t WS_APRIME = WS_SB + 4ull * 136 * 6400 * 4;
constexpr size_t WS_SSQ = WS_APRIME + 17408ull * 1024 * 2;
constexpr size_t WS_XW = WS_SSQ + 17408ull * 16 * 4;
constexpr size_t WS_ZX = WS_XW + 17408ull * 1024 * 4;
constexpr size_t WS_DTRAW = WS_ZX + 17408ull * 6144 * 2;
constexpr size_t WS_YG = WS_DTRAW + 17408ull * 32 * 4;
constexpr size_t WS_A2 = WS_YG + 17408ull * 2048 * 2;
constexpr size_t WS_BAR = WS_A2 + 17408ull * 2048 * 2;
constexpr size_t WS_END = WS_BAR + 16384;

constexpr int LDS_XB = 147712;
constexpr int LDS_BYTES = 147728;

struct WJob { const float* src; bf16_t* dst; int K, N, tiles_n, tile_begin; };
constexpr int NWJ = 20;
struct Params {
    const float* in[23];
    float* out;
    unsigned char* ws;
    WJob wj[NWJ];
    int wtiles; int pad0;
};

__device__ __forceinline__ unsigned cvt_pk_bf16(float lo, float hi) { unsigned r; asm("v_cvt_pk_bf16_f32 %0, %1, %2" : "=v"(r) : "v"(lo), "v"(hi)); return r; }
__device__ __forceinline__ float bf_lo(unsigned u) { return __uint_as_float(u << 16); }
__device__ __forceinline__ float bf_hi(unsigned u) { return __uint_as_float(u & 0xffff0000u); }
__device__ __forceinline__ float bf2f(bf16_t b) { return __uint_as_float(((unsigned)b) << 16); }
__device__ __forceinline__ float silu_f(float v) { return v * __builtin_amdgcn_rcpf(1.f + __expf(-v)); }
__device__ __forceinline__ float softplus_f(float v) { return v > 20.f ? v : log1pf(__expf(v)); }
__device__ __forceinline__ int otid() { int t = threadIdx.x; asm volatile("" : "+v"(t)); return t; }
__device__ __forceinline__ int row_b(int r) { return r < MP ? (r >> 11) : 8 + ((r - MP) >> 3); }
__device__ __forceinline__ u32x4 pack8(f32x4 a, f32x4 b) { u32x4 r; r.x = cvt_pk_bf16(a.x, a.y); r.y = cvt_pk_bf16(a.z, a.w); r.z = cvt_pk_bf16(b.x, b.y); r.w = cvt_pk_bf16(b.z, b.w); return r; }

namespace pg8 {
constexpr int BM = 256, BK = 64, HALF = 128, HTB = HALF * BK * 2, STAGE_BYTES = 8 * HTB, NXCD = 8, WGM = 8;
__device__ __forceinline__ int lds_byte(int r, int c) { const int st = (r >> 4) * 2 + (c >> 5), rr = r & 15, cc = c & 31, ob = rr * 64 + cc * 2; return st * 1024 + (ob ^ (((ob >> 9) & 1) << 5)); }
__device__ __forceinline__ void stage_rc(int b, int& R, int& C) { const int st = b / 1024, sb = b % 1024, swz = sb ^ (((sb >> 9) & 1) << 5); R = (st >> 1) * 16 + swz / 64; C = (st & 1) * 32 + (swz % 64) / 2; }
__device__ __forceinline__ int perm32(int rho) { const int n = rho >> 4, i = rho & 15; return 8 * (i >> 2) + 4 * n + (i & 3); }

struct Unit { int pm, pn, q; const char* A; const char* B; };

struct MainSched {
    int nM, nN, nwg, G, c, lda, ldb, K, gsh;
    const char* A; const char* Bt;
    __device__ void init(int M, int N, int K_, int lda_, int ldb_, const void* A_, const void* Bt_, int gsh_) {
        nM = M / BM; nN = N / BM; nwg = nM * nN; G = (int)gridDim.x; c = (int)blockIdx.x; lda = lda_; ldb = ldb_; K = K_; A = (const char*)A_; Bt = (const char*)Bt_; gsh = gsh_;
    }
    __device__ bool next(int i, Unit& u) const {
        const long L = (long)i * G + c; if (L >= nwg) return false;
        int wgid = (int)L; { const int q = nwg / NXCD, r = nwg % NXCD, xcd = wgid % NXCD, off = wgid / NXCD; wgid = (xcd < r ? xcd * (q + 1) : r * (q + 1) + (xcd - r) * q) + off; }
        const int nig = WGM * nN, gid = wgid / nig, fm = gid * WGM, gsz = (nM - fm) < WGM ? (nM - fm) : WGM;
        u.pm = fm + ((wgid % nig) % gsz); u.pn = (wgid % nig) / gsz; u.q = 0;
        u.A = A + ((size_t)u.pm * BM * lda + (size_t)(u.pn >> gsh) * 512) * 2;
        u.B = Bt + (size_t)u.pn * BM * ldb * 2;
        return true;
    }
};
struct SmallSched {
    int mode, G, c, lda, ldb, K;
    const char* A0; const char* ada; const char* ssd_in; const char* pool_in;
    __device__ bool next(int i, Unit& u) const {
        const long L = (long)i * G + c;
        u.pm = 0;
        if (mode == 0) { if (L >= 48) return false; u.pn = (int)L; u.q = 0; u.A = A0; u.B = ada + (size_t)u.pn * BM * 1024 * 2; return true; }
        if (L >= 82) return false;
        int l = (int)L, q, pn;
        if (l < 25) { q = 0; pn = l; } else if (l < 41) { q = 1; pn = l - 25; } else if (l < 66) { q = 2; pn = l - 41; } else { q = 3; pn = l - 66; }
        u.q = q; u.pn = pn; u.A = A0 + (size_t)q * 256 * 1024 * 2;
        u.B = ((q & 1) ? pool_in + (size_t)(q >> 1) * 4096 * 1024 * 2 : ssd_in + (size_t)(q >> 1) * 6400 * 1024 * 2) + (size_t)pn * BM * 1024 * 2;
        return true;
    }
};

template <class Epi, class Sched>
__device__ __forceinline__ void gemm_phase(LAS unsigned char* lds, const Sched& S, const Epi& E) {
    const int tid = otid(), wid = __builtin_amdgcn_readfirstlane(tid >> 6), lane = tid & 63, wr = wid >> 2, wc = wid & 3, fr = lane & 15, fq = lane >> 4;
    const int K = S.K, nt = K / BK;
    unsigned voffA[2], voffB[2];
#pragma unroll
    for (int i = 0; i < 2; ++i) { int R, C; stage_rc(tid * 16 + i * 8192, R, C); const int Rb = Epi::PERM ? ((R & ~31) + perm32(R & 31)) : R;
        voffA[i] = (unsigned)(R * S.lda + C) * 2u; voffB[i] = (unsigned)(Rb * S.ldb + C) * 2u; }
    const size_t kstep = (size_t)(BK * 2);
    const size_t hstepA = (size_t)HALF * S.lda * 2, hstepB = (size_t)HALF * S.ldb * 2;
    const unsigned ldsw = (unsigned)wid * 1024u;
    const int aoff = lds_byte(wr * 64 + fr, fq * 8), boff = lds_byte(wc * 32 + fr, fq * 8);
#define PG8_SA(b, h) (((b) * 2 + (h)) * HTB)
#define PG8_SB(b, h) ((4 + (b) * 2 + (h)) * HTB)
#define PG8_STAGE(bufoff, gbase, voff) do { _Pragma("unroll") for (int _i = 0; _i < 2; ++_i) \
        __builtin_amdgcn_global_load_lds((const unsigned*)((const char*)(gbase) + (voff)[_i]), (LAS unsigned*)(lds + (bufoff) + ldsw + _i * 8192), 16, 0, 0); } while (0)
#define PG8_LDA(dst, b, h) do { _Pragma("unroll") for (int m = 0; m < 4; ++m) _Pragma("unroll") for (int k = 0; k < 2; ++k) dst[m][k] = *(const LAS bf16x8*)(lds + PG8_SA(b, h) + aoff + m * 2048 + k * 1024); } while (0)
#define PG8_LDB(dst, b, h) do { _Pragma("unroll") for (int n = 0; n < 2; ++n) _Pragma("unroll") for (int k = 0; k < 2; ++k) dst[n][k] = *(const LAS bf16x8*)(lds + PG8_SB(b, h) + boff + n * 2048 + k * 1024); } while (0)
#define PG8_MMA(ai, bj, At, Bt) do { __builtin_amdgcn_s_setprio(1); _Pragma("unroll") for (int m = 0; m < 4; ++m) _Pragma("unroll") for (int n = 0; n < 2; ++n) _Pragma("unroll") for (int k = 0; k < 2; ++k) \
        acc[ai][bj][m][n] = __builtin_amdgcn_mfma_f32_16x16x32_bf16(Bt[n][k], At[m][k], acc[ai][bj][m][n], 0, 0, 0); __builtin_amdgcn_s_setprio(0); } while (0)
#define PG8_WAIT_V(n) asm volatile("s_waitcnt vmcnt(" #n ")" ::: "memory")
#define PG8_WAIT_L(n) asm volatile("s_waitcnt lgkmcnt(" #n ")" ::: "memory")
#define PG8_BAR __builtin_amdgcn_s_barrier()
#define PG8_SCHED __builtin_amdgcn_sched_barrier(0)
    Unit cur, nxt; int ui = 0;
    if (!S.next(0, cur)) return;
    f32x4 acc[2][2][4][2];
#pragma unroll
    for (int a = 0; a < 2; ++a)
#pragma unroll
        for (int b = 0; b < 2; ++b)
#pragma unroll
            for (int m = 0; m < 4; ++m)
#pragma unroll
                for (int n = 0; n < 2; ++n) acc[a][b][m][n] = (f32x4){0.f, 0.f, 0.f, 0.f};
    bf16x8 At[4][2], B0[2][2], B1[2][2];
    const char* cA = cur.A; const char* cB = cur.B;
    PG8_STAGE(PG8_SB(0, 0), cB, voffB); PG8_STAGE(PG8_SA(0, 0), cA, voffA); PG8_STAGE(PG8_SB(0, 1), cB + hstepB, voffB); PG8_STAGE(PG8_SA(0, 1), cA + hstepA, voffA);
    if (wr == 1) PG8_BAR;
    PG8_WAIT_V(4); PG8_BAR;
    PG8_STAGE(PG8_SB(1, 0), cB + kstep, voffB); PG8_STAGE(PG8_SA(1, 0), cA + kstep, voffA); PG8_STAGE(PG8_SB(1, 1), cB + hstepB + kstep, voffB);
    PG8_WAIT_V(6); PG8_BAR;
    for (;;) {
        const bool has_next = S.next(ui + 1, nxt);
        const char* nA = has_next ? nxt.A : cA; const char* nB = has_next ? nxt.B : cB;
        for (int t = 0; t < nt; t += 2) {
            const bool last = (t == nt - 2);
            const char* a1 = cA + (size_t)(t + 1) * kstep;
            const char* a2 = last ? nA : cA + (size_t)(t + 2) * kstep; const char* b2 = last ? nB : cB + (size_t)(t + 2) * kstep;
            const char* a3 = a2 + kstep; const char* b3 = b2 + kstep;
            PG8_LDB(B0, 0, 0); PG8_SCHED; PG8_LDA(At, 0, 0); PG8_STAGE(PG8_SA(1, 1), a1 + hstepA, voffA);
            PG8_WAIT_L(8); PG8_BAR; PG8_WAIT_L(0); PG8_MMA(0, 0, At, B0); PG8_BAR; PG8_SCHED;
            PG8_LDB(B1, 0, 1); PG8_STAGE(PG8_SB(0, 0), b2, voffB);
            PG8_BAR; PG8_WAIT_L(0); PG8_MMA(0, 1, At, B1); PG8_BAR;
            PG8_LDA(At, 0, 1); PG8_STAGE(PG8_SA(0, 0), a2, voffA);
            PG8_BAR; PG8_WAIT_L(0); PG8_MMA(1, 0, At, B0); PG8_BAR; PG8_SCHED;
            PG8_STAGE(PG8_SB(0, 1), b2 + hstepB, voffB);
            PG8_WAIT_V(6); PG8_BAR; PG8_MMA(1, 1, At, B1); PG8_BAR;
            PG8_LDB(B0, 1, 0); PG8_SCHED; PG8_LDA(At, 1, 0); PG8_STAGE(PG8_SA(0, 1), a2 + hstepA, voffA);
            PG8_WAIT_L(8); PG8_BAR; PG8_WAIT_L(0); PG8_MMA(0, 0, At, B0); PG8_BAR; PG8_SCHED;
            PG8_LDB(B1, 1, 1); PG8_STAGE(PG8_SB(1, 0), b3, voffB);
            PG8_BAR; PG8_WAIT_L(0); PG8_MMA(0, 1, At, B1); PG8_BAR;
            PG8_LDA(At, 1, 1); PG8_STAGE(PG8_SA(1, 0), a3, voffA);
            PG8_BAR; PG8_WAIT_L(0); PG8_MMA(1, 0, At, B0); PG8_BAR; PG8_SCHED;
            PG8_STAGE(PG8_SB(1, 1), b3 + hstepB, voffB);
            PG8_WAIT_V(6); PG8_BAR; PG8_MMA(1, 1, At, B1); PG8_BAR;
        }
        E(acc, cur, wr, wc, fr, fq);
        if (!has_next) break;
#pragma unroll
        for (int a = 0; a < 2; ++a)
#pragma unroll
            for (int b = 0; b < 2; ++b)
#pragma unroll
                for (int m = 0; m < 4; ++m)
#pragma unroll
                    for (int n = 0; n < 2; ++n) acc[a][b][m][n] = (f32x4){0.f, 0.f, 0.f, 0.f};
        cur = nxt; cA = nA; cB = nB; ++ui;
    }
    PG8_WAIT_V(0);
    if (wr == 0) PG8_BAR;
    PG8_BAR;
#undef PG8_SA
#undef PG8_SB
#undef PG8_STAGE
#undef PG8_LDA
#undef PG8_LDB
#undef PG8_MMA
#undef PG8_WAIT_V
#undef PG8_WAIT_L
#undef PG8_BAR
#undef PG8_SCHED
}
}
using pg8::Unit;

struct EpiIn {
    static constexpr bool PERM = true;
    const float* ssq; const float* sb; bf16_t* out; int ldo, nbf; float* dtraw;
    __device__ __forceinline__ void operator()(const f32x4 (&acc)[2][2][4][2], const Unit& u, int wr, int wc, int fr, int fq) const {
        asm volatile("" : "+v"(fr), "+v"(fq));
        const int row0 = u.pm * 256 + wr * 64 + fr, colt = u.pn * 256 + wc * 32 + 8 * fq;
#pragma unroll
        for (int ai = 0; ai < 2; ++ai)
#pragma unroll
            for (int m = 0; m < 4; ++m) {
                __builtin_amdgcn_sched_barrier(0);
                const int r = row0 + ai * 128 + m * 16;
                const f32x4* sp = (const f32x4*)(ssq + (size_t)r * 16);
                const f32x4 s0 = sp[0], s1 = sp[1], s2 = sp[2], s3 = sp[3];
                const f32x4 st = (s0 + s1) + (s2 + s3);
                const float rstd = rsqrtf(((st.x + st.y) + (st.z + st.w)) * (1.f / 1024.f) + 1e-6f);
                const float* sbr = sb + (size_t)row_b(r) * 6400;
#pragma unroll
                for (int bj = 0; bj < 2; ++bj) {
                    const int c = colt + bj * 128;
                    if (c < nbf) {
                        const f32x4 b0 = *(const f32x4*)(sbr + c), b1 = *(const f32x4*)(sbr + c + 4);
                        const f32x4 v0 = acc[ai][bj][m][0] * rstd + b0, v1 = acc[ai][bj][m][1] * rstd + b1;
                        *(u32x4*)(out + (size_t)r * ldo + c) = pack8(v0, v1);
                    } else if (dtraw != nullptr && c < nbf + 32) {
                        const f32x4 b0 = *(const f32x4*)(sbr + c), b1 = *(const f32x4*)(sbr + c + 4);
                        float* dp = dtraw + (size_t)r * 32 + (c - nbf);
                        *(f32x4*)dp = acc[ai][bj][m][0] * rstd + b0; *(f32x4*)(dp + 4) = acc[ai][bj][m][1] * rstd + b1;
                    }
                }
            }
    }
};
struct EpiOut {
    static constexpr bool PERM = true;
    const float* xin_p; const float* xin_s; float* xw; const float* modl; const float* ng_next; bf16_t* aprime; float* ssq;
    __device__ __forceinline__ void operator()(const f32x4 (&acc)[2][2][4][2], const Unit& u, int wr, int wc, int fr, int fq) const {
        asm volatile("" : "+v"(fr), "+v"(fq));
        const int row0 = u.pm * 256 + wr * 64 + fr, colt = u.pn * 256 + wc * 32 + 8 * fq;
#pragma unroll
        for (int ai = 0; ai < 2; ++ai)
#pragma unroll
            for (int m = 0; m < 4; ++m) {
                __builtin_amdgcn_sched_barrier(0);
                const int r = row0 + ai * 128 + m * 16;
                const float* xr = r < MP ? xin_p + (size_t)r * DM : xin_s + (size_t)(r - MP) * DM;
                const float* mb = modl + (size_t)row_b(r) * 12288;
                float ss = 0.f;
#pragma unroll
                for (int bj = 0; bj < 2; ++bj) {
                    const int c = colt + bj * 128;
                    const f32x4 g0 = *(const f32x4*)(mb + 2048 + c), g1 = *(const f32x4*)(mb + 2048 + c + 4);
                    const f32x4 x0 = *(const f32x4*)(xr + c), x1 = *(const f32x4*)(xr + c + 4);
                    const f32x4 n0 = x0 + (g0 + 1.f) * acc[ai][bj][m][0], n1 = x1 + (g1 + 1.f) * acc[ai][bj][m][1];
                    *(f32x4*)(xw + (size_t)r * DM + c) = n0; *(f32x4*)(xw + (size_t)r * DM + c + 4) = n1;
                    ss += (n0.x * n0.x + n0.y * n0.y) + (n0.z * n0.z + n0.w * n0.w) + (n1.x * n1.x + n1.y * n1.y) + (n1.z * n1.z + n1.w * n1.w);
                    if (ng_next != nullptr) {
                        const f32x4 s0 = *(const f32x4*)(mb + 3072 + 1024 + c), s1 = *(const f32x4*)(mb + 3072 + 1024 + c + 4);
                        const f32x4 w0 = *(const f32x4*)(ng_next + c), w1 = *(const f32x4*)(ng_next + c + 4);
                        *(u32x4*)(aprime + (size_t)r * DM + c) = pack8(n0 * w0 * (s0 + 1.f), n1 * w1 * (s1 + 1.f));
                    }
                }
                ss += __shfl_xor(ss, 16); ss += __shfl_xor(ss, 32);
                if (fq == 0) ssq[(size_t)r * 16 + u.pn * 4 + wc] = ss;
            }
    }
};
struct EpiGrp {
    static constexpr bool PERM = true;
    const bf16_t* uz; const float* chs; bf16_t* out;
    __device__ __forceinline__ void operator()(const f32x4 (&acc)[2][2][4][2], const Unit& u, int wr, int wc, int fr, int fq) const {
        asm volatile("" : "+v"(fr), "+v"(fq));
        const int row0 = u.pm * 256 + wr * 64 + fr, colt = u.pn * 256 + wc * 32 + 8 * fq;
#pragma unroll
        for (int ai = 0; ai < 2; ++ai)
#pragma unroll
            for (int m = 0; m < 4; ++m) {
                __builtin_amdgcn_sched_barrier(0);
                const int r = row0 + ai * 128 + m * 16;
#pragma unroll
                for (int bj = 0; bj < 2; ++bj) {
                    const int c = colt + bj * 128;
                    const u32x4 zz = *(const u32x4*)(uz + (size_t)r * 4096 + 2048 + c);
                    const f32x4 c0 = *(const f32x4*)(chs + c), c1 = *(const f32x4*)(chs + c + 4);
                    f32x4 z0, z1;
                    z0.x = silu_f(bf_lo(zz.x)); z0.y = silu_f(bf_hi(zz.x)); z0.z = silu_f(bf_lo(zz.y)); z0.w = silu_f(bf_hi(zz.y));
                    z1.x = silu_f(bf_lo(zz.z)); z1.y = silu_f(bf_hi(zz.z)); z1.z = silu_f(bf_lo(zz.w)); z1.w = silu_f(bf_hi(zz.w));
                    *(u32x4*)(out + (size_t)r * 2048 + c) = pack8(acc[ai][bj][m][0] * c0 * z0, acc[ai][bj][m][1] * c1 * z1);
                }
            }
    }
};
struct EpiSmall {
    static constexpr bool PERM = true;
    int mode; float* mod; const float* ada_b; bf16_t* shiftA; float* sb;
    __device__ __forceinline__ void operator()(const f32x4 (&acc)[2][2][4][2], const Unit& u, int wr, int wc, int fr, int fq) const {
        asm volatile("" : "+v"(fr), "+v"(fq));
        const int row0 = wr * 64 + fr, colt = u.pn * 256 + wc * 32 + 8 * fq;
#pragma unroll
        for (int ai = 0; ai < 2; ++ai)
#pragma unroll
            for (int m = 0; m < 4; ++m) {
                __builtin_amdgcn_sched_barrier(0);
                const int r = row0 + ai * 128 + m * 16;
                if (r < 136) {
#pragma unroll
                    for (int bj = 0; bj < 2; ++bj) {
                        const int c = colt + bj * 128;
                        if (mode == 0) {
                            const f32x4 v0 = acc[ai][bj][m][0] + *(const f32x4*)(ada_b + c), v1 = acc[ai][bj][m][1] + *(const f32x4*)(ada_b + c + 4);
                            *(f32x4*)(mod + (size_t)r * 12288 + c) = v0; *(f32x4*)(mod + (size_t)r * 12288 + c + 4) = v1;
                            const int li = c / 3072, cc = c - li * 3072;
                            if (cc < 1024) *(u32x4*)(shiftA + ((size_t)li * 256 + r) * 1024 + cc) = pack8(v0, v1);
                        } else {
                            float* sp = sb + ((size_t)u.q * 136 + r) * 6400 + c;
                            *(f32x4*)sp = acc[ai][bj][m][0]; *(f32x4*)(sp + 4) = acc[ai][bj][m][1];
                        }
                    }
                }
            }
    }
};

__device__ void phase_prep0(const Params& p, LAS unsigned char* lds) {
    LAS float* tl = (LAS float*)lds;
    const int tid = otid();
    for (int tile = blockIdx.x; tile < p.wtiles; tile += gridDim.x) {
        int j = 0;
#pragma unroll 1
        for (int q = 1; q < NWJ; ++q) if (tile >= p.wj[q].tile_begin) j = q;
        const WJob job = p.wj[j];
        const int lt = tile - job.tile_begin, tk = lt / job.tiles_n, tn = lt - tk * job.tiles_n, k0 = tk * 64, n0 = tn * 64;
        {
            const int kk = tid >> 3, nn = (tid & 7) * 8;
            f32x4 a = (f32x4){0.f, 0.f, 0.f, 0.f}, b = a;
            if (n0 + nn < job.N) { const float* sp = job.src + (size_t)(k0 + kk) * job.N + n0 + nn; a = *(const f32x4*)sp; b = *(const f32x4*)(sp + 4); }
            LAS float* d = tl + kk * 65 + nn;
            d[0] = a.x; d[1] = a.y; d[2] = a.z; d[3] = a.w; d[4] = b.x; d[5] = b.y; d[6] = b.z; d[7] = b.w;
        }
        __syncthreads();
        {
            const int n = tid >> 3, k8 = (tid & 7) * 8;
            const LAS float* s = tl + k8 * 65 + n;
            u32x4 o; o.x = cvt_pk_bf16(s[0], s[65]); o.y = cvt_pk_bf16(s[130], s[195]); o.z = cvt_pk_bf16(s[260], s[325]); o.w = cvt_pk_bf16(s[390], s[455]);
            *(u32x4*)(job.dst + (size_t)(n0 + n) * job.K + k0 + k8) = o;
        }
        __syncthreads();
    }
    bf16_t* ac = (bf16_t*)(p.ws + WS_AC);
    const int gt = blockIdx.x * 512 + tid, nth = gridDim.x * 512;
    for (int i = gt; i < 256 * 1024 / 8; i += nth) {
        const int r = i >> 7, c = (i & 127) * 8;
        u32x4 o = (u32x4){0u, 0u, 0u, 0u};
        if (r < 136) {
            const float* cp = r < 8 ? p.in[5] + (size_t)r * 1024 + c : p.in[6] + (size_t)(r - 8) * 1024 + c;
            const f32x4 a = *(const f32x4*)cp, b = *(const f32x4*)(cp + 4);
            o.x = cvt_pk_bf16(silu_f(a.x), silu_f(a.y)); o.y = cvt_pk_bf16(silu_f(a.z), silu_f(a.w)); o.z = cvt_pk_bf16(silu_f(b.x), silu_f(b.y)); o.w = cvt_pk_bf16(silu_f(b.z), silu_f(b.w));
        }
        *(u32x4*)(ac + (size_t)i * 8) = o;
    }
    u32x4* sh = (u32x4*)(p.ws + WS_SHIFTA);
    for (int i = gt; i < 4 * 256 * 1024 / 8; i += nth) sh[i] = (u32x4){0u, 0u, 0u, 0u};
}

__device__ void phase_xprep(const Params& p) {
    const int tid_ = otid(), lane = tid_ & 63, wv = blockIdx.x * 8 + (tid_ >> 6), nw = gridDim.x * 8;
    const float* mod = (const float*)(p.ws + WS_MOD);
    bf16_t* ap = (bf16_t*)(p.ws + WS_APRIME);
    float* ssq = (float*)(p.ws + WS_SSQ);
    const float* ng = p.in[9];
    for (int r = wv; r < MT; r += nw) {
        const float* xr = r < MP ? p.in[0] + (size_t)r * DM : p.in[1] + (size_t)(r - MP) * DM;
        const float* mb = mod + (size_t)row_b(r) * 12288 + 1024;
        float ss = 0.f;
#pragma unroll
        for (int q = 0; q < 4; ++q) {
            const int c = q * 256 + lane * 4;
            const f32x4 x = *(const f32x4*)(xr + c), s = *(const f32x4*)(mb + c), g = *(const f32x4*)(ng + c);
            ss += (x.x * x.x + x.y * x.y) + (x.z * x.z + x.w * x.w);
            const f32x4 a = x * g * (s + 1.f);
            u32x2 o; o.x = cvt_pk_bf16(a.x, a.y); o.y = cvt_pk_bf16(a.z, a.w);
            *(u32x2*)(ap + (size_t)r * DM + c) = o;
        }
#pragma unroll
        for (int o = 1; o < 64; o <<= 1) ss += __shfl_xor(ss, o);
        if (lane < 16) ssq[(size_t)r * 16 + lane] = lane == 0 ? ss : 0.f;
    }
}

__device__ void phase_final(const Params& p) {
    const int tid_ = otid(), lane = tid_ & 63, wv = blockIdx.x * 8 + (tid_ >> 6), nw = gridDim.x * 8;
    const float* xw = (const float*)(p.ws + WS_XW);
    const float* ssq = (const float*)(p.ws + WS_SSQ);
    const float* fg = p.in[22];
    for (int r = wv; r < MT; r += nw) {
        float s = lane < 16 ? ssq[(size_t)r * 16 + lane] : 0.f;
#pragma unroll
        for (int o = 1; o < 16; o <<= 1) s += __shfl_xor(s, o);
        s = __shfl(s, 0);
        const float rstd = rsqrtf(s * (1.f / 1024.f) + 1e-6f);
#pragma unroll
        for (int q = 0; q < 4; ++q) {
            const int c = q * 256 + lane * 4;
            const f32x4 x = *(const f32x4*)(xw + (size_t)r * DM + c), g = *(const f32x4*)(fg + c);
            *(f32x4*)(p.out + (size_t)r * DM + c) = x * rstd * g;
        }
    }
}

__device__ void phase_ssdnorm(const Params& p, int j) {
    const int tid_ = otid(), lane = tid_ & 63, wv = blockIdx.x * 8 + (tid_ >> 6), nw = gridDim.x * 8;
    const bf16_t* yg = (const bf16_t*)(p.ws + WS_YG);
    bf16_t* a2 = (bf16_t*)(p.ws + WS_A2);
    const float* ng = p.in[16] + (size_t)j * 2048;
    for (int r = wv; r < MT; r += nw) {
#pragma unroll
        for (int q = 0; q < 4; ++q) {
            const int c = q * 512 + lane * 8;
            const u32x4 v = *(const u32x4*)(yg + (size_t)r * 2048 + c);
            f32x4 a, b;
            a.x = bf_lo(v.x); a.y = bf_hi(v.x); a.z = bf_lo(v.y); a.w = bf_hi(v.y); b.x = bf_lo(v.z); b.y = bf_hi(v.z); b.z = bf_lo(v.w); b.w = bf_hi(v.w);
            float ss = (a.x * a.x + a.y * a.y) + (a.z * a.z + a.w * a.w) + (b.x * b.x + b.y * b.y) + (b.z * b.z + b.w * b.w);
#pragma unroll
            for (int o = 1; o < 32; o <<= 1) ss += __shfl_xor(ss, o);
            const float rstd = rsqrtf(ss * (1.f / 256.f) + 1e-6f);
            const f32x4 g0 = *(const f32x4*)(ng + c), g1 = *(const f32x4*)(ng + c + 4);
            *(u32x4*)(a2 + (size_t)r * 2048 + c) = pack8(a * rstd * g0, b * rstd * g1);
        }
    }
}

__device__ void phase_pool(const Params& p, int j) {
    const bf16_t* uz = (const bf16_t*)(p.ws + WS_ZX);
    bf16_t* pooled = (bf16_t*)(p.ws + WS_YG);
    const int gt = blockIdx.x * 512 + otid(), nth = gridDim.x * 512;
    for (int u = gt; u < 131072 + 32768; u += nth) {
        int cv, row0, t0, R; const float* prev = nullptr; bool prompt;
        if (u < 131072) { cv = u & 255; const int run = (u >> 8) & 63, b = u >> 14; row0 = b * 2048; t0 = run * 32; R = 32; prompt = true; }
        else { const int v = u - 131072; cv = v & 255; const int b = v >> 8; row0 = MP + b * 8; t0 = 0; R = 8; prompt = false; prev = p.in[4] + ((size_t)(j * 128 + b) * 15) * 2048; }
        const int c = cv * 8, w = 2 << (c >> 9);
        float s[8];
#pragma unroll
        for (int i = 0; i < 8; ++i) s[i] = 0.f;
        auto getu = [&](int tt, float (&o)[8]) {
            if (tt >= 0) {
                const u32x4 v = *(const u32x4*)(uz + (size_t)(row0 + tt) * 4096 + c);
                o[0] = bf_lo(v.x); o[1] = bf_hi(v.x); o[2] = bf_lo(v.y); o[3] = bf_hi(v.y); o[4] = bf_lo(v.z); o[5] = bf_hi(v.z); o[6] = bf_lo(v.w); o[7] = bf_hi(v.w);
            } else if (!prompt) {
                const float* pp = prev + (size_t)(15 + tt) * 2048 + c;
                const f32x4 a = *(const f32x4*)pp, b = *(const f32x4*)(pp + 4);
                o[0] = a.x; o[1] = a.y; o[2] = a.z; o[3] = a.w; o[4] = b.x; o[5] = b.y; o[6] = b.z; o[7] = b.w;
            } else {
#pragma unroll
                for (int i = 0; i < 8; ++i) o[i] = 0.f;
            }
        };
        for (int i = 1; i < w; ++i) {
            float o[8]; getu(t0 - i, o);
#pragma unroll
            for (int k = 0; k < 8; ++k) s[k] += o[k];
        }
        for (int t = t0; t < t0 + R; ++t) {
            float cur[8], old[8]; getu(t, cur); getu(t - w + 1, old);
            const float inv = 1.f / (float)(prompt ? min(w, t + 1) : w);
            f32x4 a, b;
#pragma unroll
            for (int k = 0; k < 8; ++k) s[k] += cur[k];
            a.x = s[0] * inv - cur[0]; a.y = s[1] * inv - cur[1]; a.z = s[2] * inv - cur[2]; a.w = s[3] * inv - cur[3];
            b.x = s[4] * inv - cur[4]; b.y = s[5] * inv - cur[5]; b.z = s[6] * inv - cur[6]; b.w = s[7] * inv - cur[7];
            *(u32x4*)(pooled + (size_t)(row0 + t) * 2048 + c) = pack8(a, b);
#pragma unroll
            for (int k = 0; k < 8; ++k) s[k] -= old[k];
        }
    }
    for (int i = gt; i < 8 * 15 * 2048; i += nth) {
        const int ch = i & 2047, k = (i >> 11) % 15, b = (i >> 11) / 15;
        p.out[O_POOL_P + ((size_t)(j * 8 + b) * 15 + k) * 2048 + ch] = bf2f(uz[(size_t)(b * 2048 + 2033 + k) * 4096 + ch]);
    }
    for (int i = gt; i < 128 * 15 * 2048; i += nth) {
        const int ch = i & 2047, k = (i >> 11) % 15, b = (i >> 11) / 15;
        float v;
        if (k < 7) v = p.in[4][((size_t)(j * 128 + b) * 15 + 8 + k) * 2048 + ch];
        else v = bf2f(uz[(size_t)(MP + b * 8 + k - 7) * 4096 + ch]);
        p.out[O_POOL_S + ((size_t)(j * 128 + b) * 15 + k) * 2048 + ch] = v;
    }
}

constexpr int RS = 272;
constexpr int L_XT = 0, L_BN = 17408, L_BT = 52224, L_CN = 87040, L_HB = 121856, L_SM = 139264, L_CW = 141312;
__device__ __forceinline__ int xt_addr(int pr, int t) { return L_XT + pr * RS + ((((t >> 3) ^ (pr >> 1)) & 15) << 4) + (t & 7) * 2; }
__device__ __forceinline__ int bt_addr(int n, int t) { return L_BT + n * RS + ((((t >> 3) ^ (n >> 3)) & 15) << 4) + (t & 7) * 2; }
__device__ __forceinline__ f32x16 mfma32(bf16x8 a, bf16x8 b, f32x16 c) { return __builtin_amdgcn_mfma_f32_32x32x16_bf16(a, b, c, 0, 0, 0); }

#define OPQ(x) asm volatile("" : "+v"(x))
__device__ void ssd_prompt_item(const Params& p, int j, int b, int h, LAS unsigned char* lds) {
    const int tid0 = otid(), wid = __builtin_amdgcn_readfirstlane(tid0 >> 6), g = h >> 2;
    const char* zxc = (const char*)(p.ws + WS_ZX);
    const char* dtc = (const char*)(p.ws + WS_DTRAW);
    char* ygc = (char*)(p.ws + WS_YG);
    const int rowbase = b * 2048;
    LAS float* sm_acum = (LAS float*)(lds + L_SM);
    LAS float* sm_dt = sm_acum + 128;
    LAS float* sm_w = sm_acum + 256;
    LAS float* sm_ea = sm_acum + 384;
    LAS float* cw = (LAS float*)(lds + L_CW);
    const float Ah = -__expf(p.in[14][j * 32 + h]), Dh = p.in[15][j * 32 + h], dtb = p.in[13][j * 32 + h];
    const bool roleB = wid < 4;
    const int qq = wid >> 1, tt = qq ^ (qq >> 1), pt = wid & 1, hp = wid & 1, hn = wid >> 1;

    __syncthreads();
    if (tid0 < 320) {
        const int ch = tid0 < 64 ? h * 64 + tid0 : (tid0 < 192 ? 2048 + g * 128 + (tid0 - 64) : 3072 + g * 128 + (tid0 - 192));
#pragma unroll
        for (int k = 0; k < 4; ++k) cw[k * 320 + tid0] = p.in[11][((size_t)j * 4 + k) * 4096 + ch];
        cw[4 * 320 + tid0] = p.in[12][(size_t)j * 4096 + ch];
    }
    for (int i = tid0; i < 17408 / 4; i += 512) *(LAS unsigned*)(lds + L_HB + i * 4) = 0u;

    u32x4 rawBC[11]; unsigned rawX[11]; float dtp0 = 0.f, dtp1 = 0.f;
    auto prefetch = [&](int t0) {
        int tid = tid0; OPQ(tid);
        const int bt_ = tid & 255, tqb = bt_ >> 4, cg8 = bt_ & 15, tqx = tid >> 5, cp = tid & 31, lane = tid & 63;
        const int colBC = (roleB ? 4096 : 5120) + g * 128 + cg8 * 8, colX = 2048 + h * 64 + cp * 2;
        const int rB = t0 + tqb * 8 - 3, rX = t0 + tqx * 8 - 3;
        const unsigned oB = (unsigned)((rowbase + rB) * ZXW + colBC) * 2u, oX = (unsigned)((rowbase + rX) * ZXW + colX) * 2u;
#pragma unroll
        for (int i = 0; i < 11; ++i) {
            rawBC[i] = (rB + i >= 0) ? *(const u32x4*)(zxc + (oB + (unsigned)i * 12288u)) : (u32x4){0u, 0u, 0u, 0u};
            rawX[i] = (rX + i >= 0) ? *(const unsigned*)(zxc + (oX + (unsigned)i * 12288u)) : 0u;
        }
        if (wid == 0) { const unsigned od = (unsigned)((rowbase + t0 + 2 * lane) * 32 + h) * 4u; dtp0 = *(const float*)(dtc + od); dtp1 = *(const float*)(dtc + (od + 128u)); }
    };
    prefetch(0);

    f32x16 hacc;
#pragma unroll
    for (int i = 0; i < 16; ++i) hacc[i] = 0.f;

#pragma unroll 1
    for (int c = 0; c < 16; ++c) {
        const int t0 = c * 128;
        if (wid == 0) {
            int lane = tid0 & 63; OPQ(lane);
            const float d0 = softplus_f(dtp0 + dtb), d1 = softplus_f(dtp1 + dtb);
            const float a0 = d0 * Ah, a1 = a0 + d1 * Ah;
            float sc = a1;
#pragma unroll
            for (int o = 1; o < 64; o <<= 1) { const float v = __shfl_up(sc, o); if (lane >= o) sc += v; }
            const float c1 = sc, c0 = sc - a1 + a0;
            const float last = __shfl(sc, 63);
            sm_acum[2 * lane] = c0; sm_acum[2 * lane + 1] = c1;
            sm_dt[2 * lane] = d0; sm_dt[2 * lane + 1] = d1;
            sm_w[2 * lane] = __expf(last - c0) * d0; sm_w[2 * lane + 1] = __expf(last - c1) * d1;
            sm_ea[2 * lane] = __expf(c0); sm_ea[2 * lane + 1] = __expf(c1);
        }
        __syncthreads();
        {
            int tid = tid0; OPQ(tid);
            const int bt_ = tid & 255, tqb = bt_ >> 4, cg8 = bt_ & 15;
            const int lcBC = (roleB ? 64 : 192) + cg8 * 8;
            const f32x4 wv0 = *(const LAS f32x4*)(sm_w + tqb * 8), wv1 = *(const LAS f32x4*)(sm_w + tqb * 8 + 4);
            const float wt[8] = {wv0.x, wv0.y, wv0.z, wv0.w, wv1.x, wv1.y, wv1.z, wv1.w};
            const int natbase = (roleB ? L_BN : L_CN) + (tqb * 8) * RS + cg8 * 16;
#pragma unroll
            for (int half = 0; half < 2; ++half) {
                u32x2 nat[8]; u32x4 tr[4];
#pragma unroll
                for (int ipp = 0; ipp < 2; ++ipp) {
                    const int ip = half * 2 + ipp;
                    const float k0a = cw[0 * 320 + lcBC + 2 * ip], k0b = cw[0 * 320 + lcBC + 2 * ip + 1];
                    const float k1a = cw[1 * 320 + lcBC + 2 * ip], k1b = cw[1 * 320 + lcBC + 2 * ip + 1];
                    const float k2a = cw[2 * 320 + lcBC + 2 * ip], k2b = cw[2 * 320 + lcBC + 2 * ip + 1];
                    const float k3a = cw[3 * 320 + lcBC + 2 * ip], k3b = cw[3 * 320 + lcBC + 2 * ip + 1];
                    const float bba = cw[4 * 320 + lcBC + 2 * ip], bbb = cw[4 * 320 + lcBC + 2 * ip + 1];
                    float ra[11], rb[11];
#pragma unroll
                    for (int i = 0; i < 11; ++i) { const unsigned v = rawBC[i][ip]; ra[i] = bf_lo(v); rb[i] = bf_hi(v); }
                    float va[8], vb[8];
#pragma unroll
                    for (int t = 0; t < 8; ++t) {
                        va[t] = silu_f(bba + k0a * ra[t] + k1a * ra[t + 1] + k2a * ra[t + 2] + k3a * ra[t + 3]);
                        vb[t] = silu_f(bbb + k0b * rb[t] + k1b * rb[t + 1] + k2b * rb[t + 2] + k3b * rb[t + 3]);
                        nat[t][ipp] = cvt_pk_bf16(va[t], vb[t]);
                    }
                    if (roleB) {
#pragma unroll
                        for (int tp = 0; tp < 4; ++tp) {
                            tr[2 * ipp][tp] = cvt_pk_bf16(va[2 * tp] * wt[2 * tp], va[2 * tp + 1] * wt[2 * tp + 1]);
                            tr[2 * ipp + 1][tp] = cvt_pk_bf16(vb[2 * tp] * wt[2 * tp], vb[2 * tp + 1] * wt[2 * tp + 1]);
                        }
                    }
                }
#pragma unroll
                for (int t = 0; t < 8; ++t) *(LAS u32x2*)(lds + natbase + t * RS + half * 8) = nat[t];
                if (roleB) {
#pragma unroll
                    for (int i = 0; i < 4; ++i) *(LAS u32x4*)(lds + bt_addr(cg8 * 8 + half * 4 + i, tqb * 8)) = tr[i];
                }
                __builtin_amdgcn_sched_barrier(0);
            }
        }
        {
            int tid = tid0; OPQ(tid);
            const int tqx = tid >> 5, cp = tid & 31, lcX = cp * 2;
            const float k0a = cw[0 * 320 + lcX], k0b = cw[0 * 320 + lcX + 1], k1a = cw[1 * 320 + lcX], k1b = cw[1 * 320 + lcX + 1];
            const float k2a = cw[2 * 320 + lcX], k2b = cw[2 * 320 + lcX + 1], k3a = cw[3 * 320 + lcX], k3b = cw[3 * 320 + lcX + 1];
            const float bba = cw[4 * 320 + lcX], bbb = cw[4 * 320 + lcX + 1];
            float ra[11], rb[11];
#pragma unroll
            for (int i = 0; i < 11; ++i) { ra[i] = bf_lo(rawX[i]); rb[i] = bf_hi(rawX[i]); }
            float va[8], vb[8];
#pragma unroll
            for (int t = 0; t < 8; ++t) {
                va[t] = silu_f(bba + k0a * ra[t] + k1a * ra[t + 1] + k2a * ra[t + 2] + k3a * ra[t + 3]);
                vb[t] = silu_f(bbb + k0b * rb[t] + k1b * rb[t + 1] + k2b * rb[t + 2] + k3b * rb[t + 3]);
            }
            u32x4 xa, xb;
            xa.x = cvt_pk_bf16(va[0], va[1]); xa.y = cvt_pk_bf16(va[2], va[3]); xa.z = cvt_pk_bf16(va[4], va[5]); xa.w = cvt_pk_bf16(va[6], va[7]);
            xb.x = cvt_pk_bf16(vb[0], vb[1]); xb.y = cvt_pk_bf16(vb[2], vb[3]); xb.z = cvt_pk_bf16(vb[4], vb[5]); xb.w = cvt_pk_bf16(vb[6], vb[7]);
            *(LAS u32x4*)(lds + xt_addr(cp * 2, tqx * 8)) = xa;
            *(LAS u32x4*)(lds + xt_addr(cp * 2 + 1, tqx * 8)) = xb;
        }
        if (c + 1 < 16) prefetch(t0 + 128);
        bf16_t zr[16];
        {
            int ln = tid0 & 63; OPQ(ln);
            const int l31 = ln & 31, hh = ln >> 5;
            const unsigned oz = (unsigned)((rowbase + t0 + tt * 32 + 4 * hh) * ZXW + h * 64 + pt * 32 + l31) * 2u;
#pragma unroll
            for (int rg = 0; rg < 16; ++rg) zr[rg] = *(const bf16_t*)(zxc + (oz + (unsigned)((rg & 3) + 8 * (rg >> 2)) * 12288u));
        }
        __syncthreads();
        f32x16 y;
        {
            int ln = tid0 & 63; OPQ(ln);
            const int l31 = ln & 31, hh = ln >> 5;
            const int cbase = L_CN + (tt * 32 + l31) * RS + 16 * hh, hbase = L_HB + (pt * 32 + l31) * RS + 16 * hh;
#pragma unroll
            for (int i = 0; i < 16; ++i) y[i] = 0.f;
#pragma unroll
            for (int ks = 0; ks < 8; ++ks) { const bf16x8 cfr = *(const LAS bf16x8*)(lds + cbase + ks * 32); const bf16x8 bfr = *(const LAS bf16x8*)(lds + hbase + ks * 32); y = mfma32(cfr, bfr, y); }
#pragma unroll
            for (int rq = 0; rq < 4; ++rq) { const f32x4 e = *(const LAS f32x4*)(sm_ea + tt * 32 + 8 * rq + 4 * hh); y[4 * rq] *= e.x; y[4 * rq + 1] *= e.y; y[4 * rq + 2] *= e.z; y[4 * rq + 3] *= e.w; }
            const int tidx = tt * 32 + l31;
            const float at = sm_acum[tidx];
#pragma unroll 1
            for (int st = 0; st <= tt; ++st) {
                f32x16 s;
#pragma unroll
                for (int i = 0; i < 16; ++i) s[i] = 0.f;
                const int bbase = L_BN + (st * 32 + l31) * RS + 16 * hh;
#pragma unroll
                for (int ks = 0; ks < 8; ++ks) { const bf16x8 afr = *(const LAS bf16x8*)(lds + bbase + ks * 32); const bf16x8 cfr = *(const LAS bf16x8*)(lds + cbase + ks * 32); s = mfma32(afr, cfr, s); }
#pragma unroll
                for (int rq = 0; rq < 4; ++rq) {
                    const int sb0 = st * 32 + 8 * rq + 4 * hh;
                    const f32x4 asv = *(const LAS f32x4*)(sm_acum + sb0), dsv = *(const LAS f32x4*)(sm_dt + sb0);
#pragma unroll
                    for (int i = 0; i < 4; ++i) {
                        float e = at - asv[i];
                        if (sb0 + i > tidx) e = -INFINITY;
                        s[4 * rq + i] *= __expf(e) * dsv[i];
                    }
                }
#pragma unroll
                for (int k2 = 0; k2 < 2; ++k2) {
                    u32x4 au; au.x = cvt_pk_bf16(s[8 * k2], s[8 * k2 + 1]); au.y = cvt_pk_bf16(s[8 * k2 + 2], s[8 * k2 + 3]); au.z = cvt_pk_bf16(s[8 * k2 + 4], s[8 * k2 + 5]); au.w = cvt_pk_bf16(s[8 * k2 + 6], s[8 * k2 + 7]);
                    const int sbase = st * 32 + 16 * k2 + 4 * hh;
                    const u32x2 lo = *(const LAS u32x2*)(lds + xt_addr(pt * 32 + l31, sbase)), hi = *(const LAS u32x2*)(lds + xt_addr(pt * 32 + l31, sbase + 8));
                    u32x4 bu; bu.x = lo.x; bu.y = lo.y; bu.z = hi.x; bu.w = hi.y;
                    y = mfma32(__builtin_bit_cast(bf16x8, au), __builtin_bit_cast(bf16x8, bu), y);
                }
            }
        }
        {
            int ln = tid0 & 63; OPQ(ln);
            const int l31 = ln & 31, hh = ln >> 5;
            const float dec = sm_ea[127];
#pragma unroll
            for (int i = 0; i < 16; ++i) hacc[i] *= dec;
#pragma unroll
            for (int ks = 0; ks < 8; ++ks) {
                const bf16x8 a = *(const LAS bf16x8*)(lds + xt_addr(hp * 32 + l31, ks * 16 + 8 * hh));
                const bf16x8 bb = *(const LAS bf16x8*)(lds + bt_addr(hn * 32 + l31, ks * 16 + 8 * hh));
                hacc = mfma32(a, bb, hacc);
            }
        }
        {
            int ln = tid0 & 63; OPQ(ln);
            const int l31 = ln & 31, hh = ln >> 5;
            const unsigned oy = (unsigned)((rowbase + t0 + tt * 32 + 4 * hh) * 2048 + h * 64 + pt * 32 + l31) * 2u;
#pragma unroll
            for (int rq = 0; rq < 4; ++rq) {
                const u32x2 xv = *(const LAS u32x2*)(lds + xt_addr(pt * 32 + l31, tt * 32 + 8 * rq + 4 * hh));
                const float xs[4] = {bf_lo(xv.x), bf_hi(xv.x), bf_lo(xv.y), bf_hi(xv.y)};
#pragma unroll
                for (int i = 0; i < 4; ++i) {
                    const int rg = 4 * rq + i;
                    const float yv = y[rg] + Dh * xs[i];
                    const float gv = yv * silu_f(bf2f(zr[rg]));
                    *(bf16_t*)(ygc + (oy + (unsigned)(8 * rq + i) * 4096u)) = (bf16_t)(cvt_pk_bf16(gv, 0.f) & 0xffffu);
                }
            }
        }
        __syncthreads();
        {
            int ln = tid0 & 63; OPQ(ln);
            const int l31 = ln & 31, hh = ln >> 5;
#pragma unroll
            for (int rg = 0; rg < 16; ++rg) {
                const int pr = hp * 32 + (rg & 3) + 8 * (rg >> 2) + 4 * hh;
                *(LAS bf16_t*)(lds + L_HB + pr * RS + (hn * 32 + l31) * 2) = (bf16_t)(cvt_pk_bf16(hacc[rg], 0.f) & 0xffffu);
            }
        }
    }
    {
        int ln = tid0 & 63; OPQ(ln);
        const int l31 = ln & 31, hh = ln >> 5;
        float* so = p.out + O_SSM_P + ((size_t)(j * 8 + b) * 32 + h) * 8192;
#pragma unroll
        for (int rg = 0; rg < 16; ++rg) {
            const int pr = hp * 32 + (rg & 3) + 8 * (rg >> 2) + 4 * hh;
            so[pr * 128 + hn * 32 + l31] = hacc[rg];
        }
    }
}

__device__ void ssd_sample_item(const Params& p, int j, int b, int g, LAS unsigned char* lds) {
    const int tid = otid();
    const bf16_t* zx = (const bf16_t*)(p.ws + WS_ZX);
    const float* dtraw = (const float*)(p.ws + WS_DTRAW);
    bf16_t* yg = (bf16_t*)(p.ws + WS_YG);
    LAS float* sx = (LAS float*)lds;
    LAS float* sB = sx + 2048;
    LAS float* sC = sB + 1024;
    LAS float* sdt = sC + 1024;
    LAS float* sdec = sdt + 32;
    const int pp = tid >> 3, nl = (tid & 7) * 4;
    const float* st = p.in[2] + ((size_t)(j * 128 + b) * 32 + g * 4) * 8192;
    f32x4 hs[4][4];
#pragma unroll
    for (int r = 0; r < 4; ++r)
#pragma unroll
        for (int q = 0; q < 4; ++q) hs[r][q] = *(const f32x4*)(st + r * 8192 + pp * 128 + nl + 32 * q);
    __syncthreads();
    {
        const int cc = tid < 256 ? g * 256 + tid : (tid < 384 ? 2048 + g * 128 + (tid - 256) : 3072 + g * 128 + (tid - 384));
        float raw[11];
#pragma unroll
        for (int k = 0; k < 3; ++k) raw[k] = p.in[3][((size_t)(j * 128 + b) * 3 + k) * 4096 + cc];
#pragma unroll
        for (int t = 0; t < 8; ++t) raw[3 + t] = bf2f(zx[(size_t)(MP + b * 8 + t) * ZXW + 2048 + cc]);
        const float w0 = p.in[11][((size_t)j * 4 + 0) * 4096 + cc], w1 = p.in[11][((size_t)j * 4 + 1) * 4096 + cc];
        const float w2 = p.in[11][((size_t)j * 4 + 2) * 4096 + cc], w3 = p.in[11][((size_t)j * 4 + 3) * 4096 + cc];
        const float bs = p.in[12][(size_t)j * 4096 + cc];
        LAS float* dst = tid < 256 ? sx + tid : (tid < 384 ? sB + (tid - 256) : sC + (tid - 384));
        const int dstride = tid < 256 ? 256 : 128;
#pragma unroll
        for (int t = 0; t < 8; ++t) dst[t * dstride] = silu_f(bs + w0 * raw[t] + w1 * raw[t + 1] + w2 * raw[t + 2] + w3 * raw[t + 3]);
        if (tid < 32) {
            const int t = tid >> 2, r = tid & 3, hd = g * 4 + r;
            const float dtv = softplus_f(dtraw[(size_t)(MP + b * 8 + t) * 32 + hd] + p.in[13][j * 32 + hd]);
            sdt[tid] = dtv; sdec[tid] = __expf(-dtv * __expf(p.in[14][j * 32 + hd]));
        }
    }
    __syncthreads();
    float* so = p.out + O_SSM_S + ((size_t)(j * 128 + b) * 32 + g * 4) * 8192;
#pragma unroll
    for (int r = 0; r < 4; ++r) {
        const float Dh = p.in[15][j * 32 + g * 4 + r];
        float ysel = 0.f;
#pragma unroll
        for (int t = 0; t < 8; ++t) {
            const float dtv = sdt[t * 4 + r], dec = sdec[t * 4 + r], dx = dtv * sx[t * 256 + r * 64 + pp];
            float yp = 0.f;
#pragma unroll
            for (int q = 0; q < 4; ++q) {
                const f32x4 B4 = *(const LAS f32x4*)(sB + t * 128 + nl + 32 * q), C4 = *(const LAS f32x4*)(sC + t * 128 + nl + 32 * q);
                hs[r][q] = hs[r][q] * dec + B4 * dx;
                yp += (hs[r][q].x * C4.x + hs[r][q].y * C4.y) + (hs[r][q].z * C4.z + hs[r][q].w * C4.w);
            }
            yp += __shfl_xor(yp, 1); yp += __shfl_xor(yp, 2); yp += __shfl_xor(yp, 4);
            if ((tid & 7) == t) ysel = yp;
        }
        {
            const int t = tid & 7, ch = g * 256 + r * 64 + pp;
            const size_t row = (size_t)(MP + b * 8 + t);
            const float yv = ysel + Dh * sx[t * 256 + r * 64 + pp];
            const float gv = yv * silu_f(bf2f(zx[row * ZXW + ch]));
            yg[row * 2048 + ch] = (bf16_t)(cvt_pk_bf16(gv, 0.f) & 0xffffu);
        }
#pragma unroll
        for (int q = 0; q < 4; ++q) *(f32x4*)(so + r * 8192 + pp * 128 + nl + 32 * q) = hs[r][q];
    }
}

__device__ void phase_scan(const Params& p, int j, LAS unsigned char* lds) {
    for (int item = blockIdx.x; item < 256; item += gridDim.x) {
        const int g = item & 7, k = item >> 3, b = k >> 2, r = k & 3;
#ifndef NO_PROMPT
        ssd_prompt_item(p, j, b, g * 4 + r, lds);
#endif
    }
#ifndef NO_SAMPLE
    for (int item = blockIdx.x; item < 1024; item += gridDim.x) ssd_sample_item(p, j, item >> 3, item & 7, lds);
#endif
    const bf16_t* zx = (const bf16_t*)(p.ws + WS_ZX);
    const int gt = blockIdx.x * 512 + otid(), nth = gridDim.x * 512;
    for (int i = gt; i < 136 * 3 * 4096; i += nth) {
        const int ch = i & 4095, k = (i >> 12) % 3, s = (i >> 12) / 3;
        if (s < 8) p.out[O_CONV_P + ((size_t)(j * 8 + s) * 3 + k) * 4096 + ch] = bf2f(zx[(size_t)(s * 2048 + 2045 + k) * ZXW + 2048 + ch]);
        else p.out[O_CONV_S + ((size_t)(j * 128 + (s - 8)) * 3 + k) * 4096 + ch] = bf2f(zx[(size_t)(MP + (s - 8) * 8 + 5 + k) * ZXW + 2048 + ch]);
    }
}

#define XB_TMO      128
#define XB_XCNT(j)  (256  + 64 * (j))
#define XB_XSUB(j)  (1280 + 64 * (j))
#define XB_XGEN(j)  (2304 + 64 * (j))
#define XB_TOP      3328
#define XB_TOPGEN   3392
#define XCD_BAR_WORDS 3456
#define XB_SPIN_CAP (1u << 22)
__device__ __forceinline__ unsigned xb_ld(unsigned* p)              { return __hip_atomic_load(p, __ATOMIC_RELAXED, __HIP_MEMORY_SCOPE_AGENT); }
__device__ __forceinline__ unsigned xb_add(unsigned* p, unsigned v) { return __hip_atomic_fetch_add(p, v, __ATOMIC_RELAXED, __HIP_MEMORY_SCOPE_AGENT); }
__device__ __forceinline__ unsigned xb_xcc_id() { return (unsigned)__builtin_amdgcn_s_getreg((3 << 11) | 20) & 0xFu; }
#define XB_SPIN(cond, bar) do { unsigned _sp = 0; while (cond) { __builtin_amdgcn_s_sleep(1); \
    if ((++_sp & 255u) == 0u) { if (xb_ld(&(bar)[XB_TMO])) break; if (_sp > XB_SPIN_CAP) { atomicAdd(&(bar)[XB_TMO], 1u); break; } } } } while (0)
struct XcdBarrier { unsigned* bar; unsigned x; volatile LAS unsigned* st; };
__device__ __forceinline__ XcdBarrier xcd_barrier_post(unsigned* bar, volatile LAS unsigned* st) {
    XcdBarrier b; b.bar = bar; b.x = xb_xcc_id(); b.st = st;
    if (threadIdx.x == 0) (void)xb_add(&bar[XB_XCNT(b.x)], 1u);
    return b;
}
__device__ __forceinline__ void xcd_barrier_complete(unsigned* bar, unsigned x, unsigned& nloc, unsigned& nx) {
    const unsigned G = gridDim.x * gridDim.y * gridDim.z;
    unsigned sum, cnt, mine, sp = 0u;
    for (;;) {
        sum = 0u; cnt = 0u; mine = 0u;
#pragma unroll
        for (unsigned j = 0; j < 16; ++j) { const unsigned c = xb_ld(&bar[XB_XCNT(j)]); sum += c; cnt += (c > 0u) ? 1u : 0u; mine = (j == x) ? c : mine; }
        if (sum == G) break;
        __builtin_amdgcn_s_sleep(1);
        if ((++sp & 255u) == 0u) { if (xb_ld(&bar[XB_TMO])) break; if (sp > XB_SPIN_CAP) { atomicAdd(&bar[XB_TMO], 1u); break; } }
    }
    nloc = mine > 0u ? mine : 1u; nx = cnt > 0u ? cnt : 1u;
}
__device__ __forceinline__ void xcd_barrier(const XcdBarrier& b) {
    asm volatile("s_waitcnt vmcnt(0)" ::: "memory");
    __syncthreads();
    if (threadIdx.x == 0) {
        unsigned* bar = b.bar;
        __builtin_amdgcn_s_waitcnt(0);
        unsigned nloc = b.st[0], nx = b.st[1];
        if (nloc == 0u) { xcd_barrier_complete(bar, b.x, nloc, nx); b.st[0] = nloc; b.st[1] = nx; }
        const unsigned old = xb_add(&bar[XB_XSUB(b.x)], 1u);
        const unsigned gen = old / nloc;
        if (old + 1u == (gen + 1u) * nloc) {
            __builtin_amdgcn_fence(__ATOMIC_RELEASE, "agent");
            asm volatile("s_waitcnt vmcnt(0)" ::: "memory");
            const unsigned og = xb_add(&bar[XB_TOP], 1u);
            const unsigned tg = og / nx;
            if (og + 1u == (tg + 1u) * nx) xb_add(&bar[XB_TOPGEN], 1u);
            else XB_SPIN(xb_ld(&bar[XB_TOPGEN]) == tg, bar);
            __builtin_amdgcn_fence(__ATOMIC_ACQUIRE, "agent");
            xb_add(&bar[XB_XGEN(b.x)], 1u);
            asm volatile("s_waitcnt vmcnt(0)" ::: "memory");
        } else {
            XB_SPIN(xb_ld(&bar[XB_XGEN(b.x)]) == gen, bar);
            __builtin_amdgcn_fence(__ATOMIC_ACQUIRE, "agent");
            asm volatile("s_waitcnt vmcnt(0)" ::: "memory");
        }
    }
    __syncthreads();
}

#ifndef REP_SYNC
#define REP_SYNC 1
#endif
#ifndef REP_SCAN
#define REP_SCAN 1
#endif
#ifndef REP_GIN
#define REP_GIN 1
#endif
#ifndef REP_GOUT
#define REP_GOUT 1
#endif
#ifndef REP_ELEM
#define REP_ELEM 1
#endif
#define GSYNC() do { for (int _r = 0; _r < REP_SYNC; ++_r) xcd_barrier(xb); } while (0)
__global__ __launch_bounds__(512, 2) void hybrid_fwd(Params p) {
    extern __shared__ __attribute__((aligned(16))) unsigned char smem[];
    LAS unsigned char* lds = (LAS unsigned char*)smem;
    cg::grid_group grid = cg::this_grid();
    unsigned char* ws = p.ws;
    volatile LAS unsigned* xst = (volatile LAS unsigned*)(lds + LDS_XB);
    if (threadIdx.x == 0) { xst[0] = 0u; xst[1] = 0u; }
    __syncthreads();
    const XcdBarrier xb = xcd_barrier_post((unsigned*)(ws + WS_BAR), xst);

#ifndef NO_PREP0
    phase_prep0(p, lds);
#endif
    grid.sync();
#pragma unroll 1
    for (int mode = 0; mode < 2; ++mode) {
        pg8::SmallSched S; S.mode = mode; S.G = (int)gridDim.x; S.c = (int)blockIdx.x; S.lda = 1024; S.ldb = 1024; S.K = 1024;
        S.A0 = (const char*)(ws + (mode == 0 ? WS_AC : WS_SHIFTA)); S.ada = (const char*)(ws + WS_WT_ADA); S.ssd_in = (const char*)(ws + WS_WT_SSD_IN); S.pool_in = (const char*)(ws + WS_WT_POOL_IN);
        EpiSmall E; E.mode = mode; E.mod = (float*)(ws + WS_MOD); E.ada_b = p.in[8]; E.shiftA = (bf16_t*)(ws + WS_SHIFTA); E.sb = (float*)(ws + WS_SB);
#ifndef NO_GSMALL
        pg8::gemm_phase<EpiSmall, pg8::SmallSched>(lds, S, E);
#endif
        if (mode == 1) phase_xprep(p);
        GSYNC();
    }
#pragma unroll 1
    for (int layer = 0; layer < 4; ++layer) {
        const int j = layer >> 1; const bool ssd = (layer & 1) == 0;
        {
            pg8::MainSched S;
            S.init(MT, ssd ? 6400 : 4096, 1024, 1024, 1024, ws + WS_APRIME, ssd ? ws + WS_WT_SSD_IN + (size_t)j * 6400 * 1024 * 2 : ws + WS_WT_POOL_IN + (size_t)j * 4096 * 1024 * 2, 30);
            EpiIn E; E.ssq = (const float*)(ws + WS_SSQ); E.sb = (const float*)(ws + WS_SB) + (size_t)layer * 136 * 6400; E.out = (bf16_t*)(ws + WS_ZX);
            E.ldo = ssd ? ZXW : 4096; E.nbf = ssd ? ZXW : 4096; E.dtraw = ssd ? (float*)(ws + WS_DTRAW) : nullptr;
            for (int rep = 0; rep < REP_GIN; ++rep) pg8::gemm_phase<EpiIn, pg8::MainSched>(lds, S, E);
        }
        GSYNC();
        if (ssd) { for (int rep = 0; rep < REP_SCAN; ++rep) phase_scan(p, j, lds); } else { for (int rep = 0; rep < REP_ELEM; ++rep) phase_pool(p, j); }
        GSYNC();
        if (ssd) { for (int rep = 0; rep < REP_ELEM; ++rep) phase_ssdnorm(p, j); }
        else {
            pg8::MainSched S; S.init(MT, 2048, 512, 2048, 512, ws + WS_YG, ws + WS_WT_POOL_G + (size_t)j * 2048 * 512 * 2, 1);
            EpiGrp E; E.uz = (const bf16_t*)(ws + WS_ZX); E.chs = p.in[20] + (size_t)j * 2048; E.out = (bf16_t*)(ws + WS_A2);
#ifndef NO_GGRP
            pg8::gemm_phase<EpiGrp, pg8::MainSched>(lds, S, E);
#endif
        }
        GSYNC();
        {
            pg8::MainSched S; S.init(MT, 1024, 2048, 2048, 2048, ws + WS_A2, ssd ? ws + WS_WT_SSD_OUT + (size_t)j * 1024 * 2048 * 2 : ws + WS_WT_POOL_OUT + (size_t)j * 1024 * 2048 * 2, 30);
            EpiOut E; float* xw = (float*)(ws + WS_XW);
            E.xin_p = layer == 0 ? p.in[0] : xw; E.xin_s = layer == 0 ? p.in[1] : xw + (size_t)MP * DM; E.xw = xw;
            E.modl = (const float*)(ws + WS_MOD) + (size_t)layer * 3072; E.ng_next = layer < 3 ? p.in[9] + (size_t)(layer + 1) * 1024 : nullptr;
            E.aprime = (bf16_t*)(ws + WS_APRIME); E.ssq = (float*)(ws + WS_SSQ);
            for (int rep = 1; rep < REP_GOUT; ++rep) { EpiOut E2 = E; E2.xw = (float*)(ws + WS_YG); E2.aprime = (bf16_t*)(ws + WS_ZX); E2.ssq = (float*)(ws + WS_ZX + 40000000); pg8::gemm_phase<EpiOut, pg8::MainSched>(lds, S, E2); }
            pg8::gemm_phase<EpiOut, pg8::MainSched>(lds, S, E);
        }
        GSYNC();
    }
    for (int rep = 0; rep < REP_ELEM; ++rep) phase_final(p);
}

extern "C" void kernel_launch(void* const* d_in, const int* in_sizes, int n_in, void* d_out, int out_size, void* d_ws, size_t ws_size, hipStream_t stream) {
    static int grid = 0;
    if (grid == 0) {
        if (n_in != 23 || ws_size < WS_END) { fprintf(stderr, "kernel_launch: unexpected n_in %d or ws_size %zu (need %zu)\n", n_in, ws_size, (size_t)WS_END); grid = -1; return; }
        int dev = 0, cus = 0, per_cu = 0;
        hipGetDevice(&dev);
        hipDeviceGetAttribute(&cus, hipDeviceAttributeMultiprocessorCount, dev);
        if (hipFuncSetAttribute((const void*)hybrid_fwd, hipFuncAttributeMaxDynamicSharedMemorySize, LDS_BYTES) != hipSuccess) { fprintf(stderr, "kernel_launch: hipFuncSetAttribute failed\n"); grid = -1; return; }
        if (hipOccupancyMaxActiveBlocksPerMultiprocessor(&per_cu, (const void*)hybrid_fwd, 512, LDS_BYTES) != hipSuccess || per_cu < 1) { fprintf(stderr, "kernel_launch: occupancy query gave %d\n", per_cu); (void)hipGetLastError(); per_cu = 1; }
        grid = cus * 1;
    }
    if (grid < 0) return;
    Params p{};
    for (int i = 0; i < 23; ++i) p.in[i] = (const float*)d_in[i];
    p.out = (float*)d_out; p.ws = (unsigned char*)d_ws;
    unsigned char* ws = (unsigned char*)d_ws;
    int nj = 0, tb = 0;
    auto add = [&](const float* src, size_t dst_off, int K, int N, int Npad) {
        WJob& w = p.wj[nj++]; w.src = src; w.dst = (bf16_t*)(ws + dst_off); w.K = K; w.N = N; w.tiles_n = Npad / 64; w.tile_begin = tb; tb += (K / 64) * (Npad / 64);
    };
    for (int i = 0; i < 4; ++i) add(p.in[7] + (size_t)i * 1024 * 3072, WS_WT_ADA + (size_t)i * 3072 * 1024 * 2, 1024, 3072, 3072);
    for (int j = 0; j < 2; ++j) add(p.in[10] + (size_t)j * 1024 * 6176, WS_WT_SSD_IN + (size_t)j * 6400 * 1024 * 2, 1024, 6176, 6400);
    for (int j = 0; j < 2; ++j) add(p.in[18] + (size_t)j * 1024 * 4096, WS_WT_POOL_IN + (size_t)j * 4096 * 1024 * 2, 1024, 4096, 4096);
    for (int j = 0; j < 2; ++j) add(p.in[17] + (size_t)j * 2048 * 1024, WS_WT_SSD_OUT + (size_t)j * 1024 * 2048 * 2, 2048, 1024, 1024);
    for (int j = 0; j < 2; ++j) add(p.in[21] + (size_t)j * 2048 * 1024, WS_WT_POOL_OUT + (size_t)j * 1024 * 2048 * 2, 2048, 1024, 1024);
    for (int q = 0; q < 8; ++q) add(p.in[19] + (size_t)q * 512 * 512, WS_WT_POOL_G + (size_t)q * 512 * 512 * 2, 512, 512, 512);
    p.wtiles = tb;
    if (hipMemsetAsync(ws + WS_BAR, 0, XCD_BAR_WORDS * 4, stream) != hipSuccess) { fprintf(stderr, "kernel_launch: memset of the barrier words failed\n"); return; }
    void* args[] = {&p};
    hipError_t e = hipLaunchCooperativeKernel((const void*)hybrid_fwd, dim3(grid), dim3(512), args, LDS_BYTES, stream);
    if (e != hipSuccess) fprintf(stderr, "cooperative launch failed: %s (grid %d)\n", hipGetErrorString(e), grid);
}
```

```cpp
#include <hip/hip_runtime.h>
#include <hip/hip_cooperative_groups.h>
#include <cstdio>
namespace cg = cooperative_groups;

#ifndef REP_PROMPT
#define REP_PROMPT 1
#endif
#define LAS __attribute__((address_space(3)))
typedef unsigned short bf16_t;
typedef short bf16x8 __attribute__((ext_vector_type(8)));
typedef float f32x4 __attribute__((ext_vector_type(4)));
typedef float f32x16 __attribute__((ext_vector_type(16)));
typedef unsigned u32x4 __attribute__((ext_vector_type(4)));
typedef unsigned u32x2 __attribute__((ext_vector_type(2)));

constexpr int MP = 16384, MT = 17408, DM = 1024;
constexpr int ZXW = 6144;
constexpr size_t O_SSM_P = 17825792, O_CONV_P = 22020096, O_POOL_P = 22216704, O_SSM_S = 22708224, O_CONV_S = 89817088, O_POOL_S = 92962816;

constexpr size_t WS_WT_SSD_IN = 0;
constexpr size_t WS_WT_SSD_OUT = WS_WT_SSD_IN + 2ull * 6400 * 1024 * 2;
constexpr size_t WS_WT_POOL_IN = WS_WT_SSD_OUT + 2ull * 1024 * 2048 * 2;
constexpr size_t WS_WT_POOL_G = WS_WT_POOL_IN + 2ull * 4096 * 1024 * 2;
constexpr size_t WS_WT_POOL_OUT = WS_WT_POOL_G + 2ull * 2048 * 512 * 2;
constexpr size_t WS_WT_ADA = WS_WT_POOL_OUT + 2ull * 1024 * 2048 * 2;
constexpr size_t WS_AC = WS_WT_ADA + 12288ull * 1024 * 2;
constexpr size_t WS_SHIFTA = WS_AC + 256ull * 1024 * 2;
constexpr size_t WS_MOD = WS_SHIFTA + 4ull * 256 * 1024 * 2;
constexpr size_t WS_SB = WS_MOD + 136ull * 12288 * 4;
constexpr size_t WS_APRIME = WS_SB + 4ull * 136 * 6400 * 4;
constexpr size_t WS_SSQ = WS_APRIME + 17408ull * 1024 * 2;
constexpr size_t WS_XW = WS_SSQ + 17408ull * 16 * 4;
constexpr size_t WS_ZX = WS_XW + 17408ull * 1024 * 4;
constexpr size_t WS_DTRAW = WS_ZX + 17408ull * 6144 * 2;
constexpr size_t WS_YG = WS_DTRAW + 17408ull * 32 * 4;
constexpr size_t WS_A2 = WS_YG + 17408ull * 2048 * 2;
constexpr size_t WS_BAR = WS_A2 + 17408ull * 2048 * 2;
constexpr size_t WS_END = WS_BAR + 16384;

constexpr int LDS_XB = 147712;
constexpr int LDS_BYTES = 147728;

struct WJob { const float* src; bf16_t* dst; int K, N, tiles_n, tile_begin; };
constexpr int NWJ = 20;
struct Params {
    const float* in[23];
    float* out;
    unsigned char* ws;
    WJob wj[NWJ];
    int wtiles; int pad0;
};

__device__ __forceinline__ unsigned cvt_pk_bf16(float lo, float hi) { unsigned r; asm("v_cvt_pk_bf16_f32 %0, %1, %2" : "=v"(r) : "v"(lo), "v"(hi)); return r; }
__device__ __forceinline__ float bf_lo(unsigned u) { return __uint_as_float(u << 16); }
__device__ __forceinline__ float bf_hi(unsigned u) { return __uint_as_float(u & 0xffff0000u); }
__device__ __forceinline__ float bf2f(bf16_t b) { return __uint_as_float(((unsigned)b) << 16); }
__device__ __forceinline__ float silu_f(float v) { return v * __builtin_amdgcn_rcpf(1.f + __expf(-v)); }
__device__ __forceinline__ float softplus_f(float v) { return v > 20.f ? v : log1pf(__expf(v)); }
__device__ __forceinline__ int otid() { int t = threadIdx.x; asm volatile("" : "+v"(t)); return t; }
__device__ __forceinline__ int row_b(int r) { return r < MP ? (r >> 11) : 8 + ((r - MP) >> 3); }
__device__ __forceinline__ u32x4 pack8(f32x4 a, f32x4 b) { u32x4 r; r.x = cvt_pk_bf16(a.x, a.y); r.y = cvt_pk_bf16(a.z, a.w); r.z = cvt_pk_bf16(b.x, b.y); r.w = cvt_pk_bf16(b.z, b.w); return r; }

namespace pg8 {
constexpr int BM = 256, BK = 64, HALF = 128, HTB = HALF * BK * 2, STAGE_BYTES = 8 * HTB, NXCD = 8, WGM = 8;
__device__ __forceinline__ int lds_byte(int r, int c) { const int st = (r >> 4) * 2 + (c >> 5), rr = r & 15, cc = c & 31, ob = rr * 64 + cc * 2; return st * 1024 + (ob ^ (((ob >> 9) & 1) << 5)); }
__device__ __forceinline__ void stage_rc(int b, int& R, int& C) { const int st = b / 1024, sb = b % 1024, swz = sb ^ (((sb >> 9) & 1) << 5); R = (st >> 1) * 16 + swz / 64; C = (st & 1) * 32 + (swz % 64) / 2; }
__device__ __forceinline__ int perm32(int rho) { const int n = rho >> 4, i = rho & 15; return 8 * (i >> 2) + 4 * n + (i & 3); }

struct Unit { int pm, pn, q; const char* A; const char* B; };

__device__ __forceinline__ void static_unit(int L, int nM, int nN, int& pm, int& pn) {
    const int nwg = nM * nN;
    int wgid = L; { const int q = nwg / NXCD, r = nwg % NXCD, xcd = wgid % NXCD, off = wgid / NXCD; wgid = (xcd < r ? xcd * (q + 1) : r * (q + 1) + (xcd - r) * q) + off; }
    const int nig = WGM * nN, gid = wgid / nig, fm = gid * WGM, gsz = (nM - fm) < WGM ? (nM - fm) : WGM;
    pm = fm + ((wgid % nig) % gsz); pn = (wgid % nig) / gsz;
}
struct MainSched {
    int nM, nN, nwg, G, c, lda, ldb, K, gsh, single;
    const char* A; const char* Bt;
    __device__ void init(int M, int N, int K_, int lda_, int ldb_, const void* A_, const void* Bt_, int gsh_, int single_ = 0) {
        nM = M / BM; nN = N / BM; nwg = nM * nN; G = (int)gridDim.x; c = (int)blockIdx.x; lda = lda_; ldb = ldb_; K = K_; A = (const char*)A_; Bt = (const char*)Bt_; gsh = gsh_; single = single_;
    }
    __device__ bool next(int i, Unit& u) const {
        if (single) { if (i > 0 || c >= 16) return false; u.pm = 64 + (c >> 2); u.pn = c & 3; }
        else { const long L = (long)i * G + c; if (L >= nwg) return false; static_unit((int)L, nM, nN, u.pm, u.pn); }
        u.q = 0;
        u.A = A + ((size_t)u.pm * BM * lda + (size_t)(u.pn >> gsh) * 512) * 2;
        u.B = Bt + (size_t)u.pn * BM * ldb * 2;
        return true;
    }
    __device__ __forceinline__ void a_ready(const Unit&) const {}
};
struct InSched {
    int nN, nP, E, nskip, c, r0, cnt, lda, ldb, K;
    const char* A; const char* Bt; unsigned* tail; unsigned* tmo;
    __device__ void init(int N, const void* A_, const void* Bt_, unsigned* tail_, unsigned* tmo_) {
        nN = N / BM; nP = 64 * nN; c = (int)blockIdx.x; lda = 1024; ldb = 1024; K = 1024; A = (const char*)A_; Bt = (const char*)Bt_; tail = tail_; tmo = tmo_;
        nskip = tail_ != nullptr ? 32 : 0; E = nskip + 4 * nN; r0 = (tail_ != nullptr && c < 16) ? 2 : 0;
        const int tot = (nP - c + 255) / 256; cnt = tot - r0 > 0 ? tot - r0 : 0;
    }
    __device__ bool next(int i, Unit& u) const {
        if (i < cnt) static_unit((i + r0) * 256 + c, 64, nN, u.pm, u.pn);
        else {
            if (c < 16) return false;
            const int e = 255 - c + 240 * (i - cnt); if (e >= E) return false;
            if (e < nskip) static_unit(e < 16 ? e : 256 + (e - 16), 64, nN, u.pm, u.pn);
            else { const int sidx = e - nskip; u.pm = 64 + sidx / nN; u.pn = sidx - (sidx / nN) * nN; }
        }
        u.q = 0;
        u.A = A + (size_t)u.pm * BM * 1024 * 2; u.B = Bt + (size_t)u.pn * BM * 1024 * 2;
        return true;
    }
    __device__ __forceinline__ void a_ready(const Unit& u) const {
        if (tail == nullptr || u.pm < 64) return;
        if (threadIdx.x < 64) {
            unsigned polls = 0;
            while ((unsigned)__builtin_amdgcn_readfirstlane(__hip_atomic_load(tail, __ATOMIC_RELAXED, __HIP_MEMORY_SCOPE_AGENT)) < 16u) {
                __builtin_amdgcn_s_sleep(2);
                if ((++polls & 255u) == 0u) { if (__builtin_amdgcn_readfirstlane(__hip_atomic_load(tmo, __ATOMIC_RELAXED, __HIP_MEMORY_SCOPE_AGENT)) != 0u) break; if (polls > (1u << 22)) { if (threadIdx.x == 0) atomicAdd(tmo, 1u); break; } }
            }
            __builtin_amdgcn_fence(__ATOMIC_ACQUIRE, "agent");
            asm volatile("s_waitcnt vmcnt(0)" ::: "memory");
        }
        asm volatile("" ::: "memory"); __builtin_amdgcn_s_barrier(); asm volatile("" ::: "memory");
    }
};
struct SmallSched {
    int mode, G, c, lda, ldb, K;
    const char* A0; const char* ada; const char* ssd_in; const char* pool_in;
    __device__ bool next(int i, Unit& u) const {
        const long L = (long)i * G + c;
        u.pm = 0;
        if (mode == 0) { if (L >= 48) return false; u.pn = (int)L; u.q = 0; u.A = A0; u.B = ada + (size_t)u.pn * BM * 1024 * 2; return true; }
        if (L >= 82) return false;
        int l = (int)L, q, pn;
        if (l < 25) { q = 0; pn = l; } else if (l < 41) { q = 1; pn = l - 25; } else if (l < 66) { q = 2; pn = l - 41; } else { q = 3; pn = l - 66; }
        u.q = q; u.pn = pn; u.A = A0 + (size_t)q * 256 * 1024 * 2;
        u.B = ((q & 1) ? pool_in + (size_t)(q >> 1) * 4096 * 1024 * 2 : ssd_in + (size_t)(q >> 1) * 6400 * 1024 * 2) + (size_t)pn * BM * 1024 * 2;
        return true;
    }
    __device__ __forceinline__ void a_ready(const Unit&) const {}
};

template <class Epi, class Sched>
__device__ __forceinline__ void gemm_phase(LAS unsigned char* lds, const Sched& S, const Epi& E) {
    const int tid = otid(), wid = __builtin_amdgcn_readfirstlane(tid >> 6), lane = tid & 63, wr = wid >> 2, wc = wid & 3, fr = lane & 15, fq = lane >> 4;
    const int K = S.K, nt = K / BK;
    unsigned voffA[2], voffB[2];
#pragma unroll
    for (int i = 0; i < 2; ++i) { int R, C; stage_rc(tid * 16 + i * 8192, R, C); const int Rb = Epi::PERM ? ((R & ~31) + perm32(R & 31)) : R;
        voffA[i] = (unsigned)(R * S.lda + C) * 2u; voffB[i] = (unsigned)(Rb * S.ldb + C) * 2u; }
    const size_t kstep = (size_t)(BK * 2);
    const size_t hstepA = (size_t)HALF * S.lda * 2, hstepB = (size_t)HALF * S.ldb * 2;
    const unsigned ldsw = (unsigned)wid * 1024u;
    const int aoff = lds_byte(wr * 64 + fr, fq * 8), boff = lds_byte(wc * 32 + fr, fq * 8);
#define PG8_SA(b, h) (((b) * 2 + (h)) * HTB)
#define PG8_SB(b, h) ((4 + (b) * 2 + (h)) * HTB)
#define PG8_STAGE(bufoff, gbase, voff) do { _Pragma("unroll") for (int _i = 0; _i < 2; ++_i) \
        __builtin_amdgcn_global_load_lds((const unsigned*)((const char*)(gbase) + (voff)[_i]), (LAS unsigned*)(lds + (bufoff) + ldsw + _i * 8192), 16, 0, 0); } while (0)
#define PG8_LDA(dst, b, h) do { _Pragma("unroll") for (int m = 0; m < 4; ++m) _Pragma("unroll") for (int k = 0; k < 2; ++k) dst[m][k] = *(const LAS bf16x8*)(lds + PG8_SA(b, h) + aoff + m * 2048 + k * 1024); } while (0)
#define PG8_LDB(dst, b, h) do { _Pragma("unroll") for (int n = 0; n < 2; ++n) _Pragma("unroll") for (int k = 0; k < 2; ++k) dst[n][k] = *(const LAS bf16x8*)(lds + PG8_SB(b, h) + boff + n * 2048 + k * 1024); } while (0)
#define PG8_MMA(ai, bj, At, Bt) do { __builtin_amdgcn_s_setprio(1); _Pragma("unroll") for (int m = 0; m < 4; ++m) _Pragma("unroll") for (int n = 0; n < 2; ++n) _Pragma("unroll") for (int k = 0; k < 2; ++k) \
        acc[ai][bj][m][n] = __builtin_amdgcn_mfma_f32_16x16x32_bf16(Bt[n][k], At[m][k], acc[ai][bj][m][n], 0, 0, 0); __builtin_amdgcn_s_setprio(0); } while (0)
#define PG8_WAIT_V(n) asm volatile("s_waitcnt vmcnt(" #n ")" ::: "memory")
#define PG8_WAIT_L(n) asm volatile("s_waitcnt lgkmcnt(" #n ")" ::: "memory")
#define PG8_BAR __builtin_amdgcn_s_barrier()
#define PG8_SCHED __builtin_amdgcn_sched_barrier(0)
    Unit cur, nxt; int ui = 0;
    if (!S.next(0, cur)) return;
    f32x4 acc[2][2][4][2];
#pragma unroll
    for (int a = 0; a < 2; ++a)
#pragma unroll
        for (int b = 0; b < 2; ++b)
#pragma unroll
            for (int m = 0; m < 4; ++m)
#pragma unroll
                for (int n = 0; n < 2; ++n) acc[a][b][m][n] = (f32x4){0.f, 0.f, 0.f, 0.f};
    bf16x8 At[4][2], B0[2][2], B1[2][2];
    const char* cA = cur.A; const char* cB = cur.B;
    S.a_ready(cur);
    PG8_STAGE(PG8_SB(0, 0), cB, voffB); PG8_STAGE(PG8_SA(0, 0), cA, voffA); PG8_STAGE(PG8_SB(0, 1), cB + hstepB, voffB); PG8_STAGE(PG8_SA(0, 1), cA + hstepA, voffA);
    if (wr == 1) PG8_BAR;
    PG8_WAIT_V(4); PG8_BAR;
    PG8_STAGE(PG8_SB(1, 0), cB + kstep, voffB); PG8_STAGE(PG8_SA(1, 0), cA + kstep, voffA); PG8_STAGE(PG8_SB(1, 1), cB + hstepB + kstep, voffB);
    PG8_WAIT_V(6); PG8_BAR;
    for (;;) {
        const bool has_next = S.next(ui + 1, nxt);
        const char* nA = has_next ? nxt.A : cA; const char* nB = has_next ? nxt.B : cB;
        for (int t = 0; t < nt; t += 2) {
            const bool last = (t == nt - 2);
            const char* a1 = cA + (size_t)(t + 1) * kstep;
            const char* a2 = last ? nA : cA + (size_t)(t + 2) * kstep; const char* b2 = last ? nB : cB + (size_t)(t + 2) * kstep;
            const char* a3 = a2 + kstep; const char* b3 = b2 + kstep;
            if (last && has_next) S.a_ready(nxt);
            PG8_LDB(B0, 0, 0); PG8_SCHED; PG8_LDA(At, 0, 0); PG8_STAGE(PG8_SA(1, 1), a1 + hstepA, voffA);
            PG8_WAIT_L(8); PG8_BAR; PG8_WAIT_L(0); PG8_MMA(0, 0, At, B0); PG8_BAR; PG8_SCHED;
            PG8_LDB(B1, 0, 1); PG8_STAGE(PG8_SB(0, 0), b2, voffB);
            PG8_BAR; PG8_WAIT_L(0); PG8_MMA(0, 1, At, B1); PG8_BAR;
            PG8_LDA(At, 0, 1); PG8_STAGE(PG8_SA(0, 0), a2, voffA);
            PG8_BAR; PG8_WAIT_L(0); PG8_MMA(1, 0, At, B0); PG8_BAR; PG8_SCHED;
            PG8_STAGE(PG8_SB(0, 1), b2 + hstepB, voffB);
            PG8_WAIT_V(6); PG8_BAR; PG8_MMA(1, 1, At, B1); PG8_BAR;
            PG8_LDB(B0, 1, 0); PG8_SCHED; PG8_LDA(At, 1, 0); PG8_STAGE(PG8_SA(0, 1), a2 + hstepA, voffA);
            PG8_WAIT_L(8); PG8_BAR; PG8_WAIT_L(0); PG8_MMA(0, 0, At, B0); PG8_BAR; PG8_SCHED;
            PG8_LDB(B1, 1, 1); PG8_STAGE(PG8_SB(1, 0), b3, voffB);
            PG8_BAR; PG8_WAIT_L(0); PG8_MMA(0, 1, At, B1); PG8_BAR;
            PG8_LDA(At, 1, 1); PG8_STAGE(PG8_SA(1, 0), a3, voffA);
            PG8_BAR; PG8_WAIT_L(0); PG8_MMA(1, 0, At, B0); PG8_BAR; PG8_SCHED;
            PG8_STAGE(PG8_SB(1, 1), b3 + hstepB, voffB);
            PG8_WAIT_V(6); PG8_BAR; PG8_MMA(1, 1, At, B1); PG8_BAR;
        }
        E(acc, cur, wr, wc, fr, fq);
        if (!has_next) break;
#pragma unroll
        for (int a = 0; a < 2; ++a)
#pragma unroll
            for (int b = 0; b < 2; ++b)
#pragma unroll
                for (int m = 0; m < 4; ++m)
#pragma unroll
                    for (int n = 0; n < 2; ++n) acc[a][b][m][n] = (f32x4){0.f, 0.f, 0.f, 0.f};
        cur = nxt; cA = nA; cB = nB; ++ui;
    }
    PG8_WAIT_V(0);
    if (wr == 0) PG8_BAR;
    PG8_BAR;
#undef PG8_SA
#undef PG8_SB
#undef PG8_STAGE
#undef PG8_LDA
#undef PG8_LDB
#undef PG8_MMA
#undef PG8_WAIT_V
#undef PG8_WAIT_L
#undef PG8_BAR
#undef PG8_SCHED
}
}
using pg8::Unit;

struct EpiIn {
    static constexpr bool PERM = true;
    const float* ssq; const float* sb; bf16_t* out; int ldo, nbf; float* dtraw;
    template <bool UNI>
    __device__ __forceinline__ void body(const f32x4 (&acc)[2][2][4][2], const Unit& u, int wr, int wc, int fr, int fq) const {
        const int row0 = u.pm * 256 + wr * 64 + fr, colt = u.pn * 256 + wc * 32 + 8 * fq;
        f32x4 ub[2][2];
        if (UNI) {
            const float* sbr = sb + (size_t)(u.pm >> 3) * 6400;
#pragma unroll
            for (int bj = 0; bj < 2; ++bj) { const int c = colt + bj * 128; if (c < nbf + 32) { ub[bj][0] = *(const f32x4*)(sbr + c); ub[bj][1] = *(const f32x4*)(sbr + c + 4); } }
        }
#pragma unroll
        for (int ai = 0; ai < 2; ++ai)
#pragma unroll
            for (int m = 0; m < 4; ++m) {
                const int r = row0 + ai * 128 + m * 16;
                const float rstd = rsqrtf(ssq[r] * (1.f / 1024.f) + 1e-6f);
                const float* sbr = sb + (size_t)row_b(r) * 6400;
#pragma unroll
                for (int bj = 0; bj < 2; ++bj) {
                    const int c = colt + bj * 128;
                    if (c < nbf + 32) {
                        f32x4 b0, b1;
                        if (UNI) { b0 = ub[bj][0]; b1 = ub[bj][1]; } else { b0 = *(const f32x4*)(sbr + c); b1 = *(const f32x4*)(sbr + c + 4); }
                        const f32x4 v0 = acc[ai][bj][m][0] * rstd + b0, v1 = acc[ai][bj][m][1] * rstd + b1;
                        if (c < nbf) *(u32x4*)(out + (size_t)r * ldo + c) = pack8(v0, v1);
                        else if (dtraw != nullptr) { float* dp = dtraw + (size_t)r * 32 + (c - nbf); *(f32x4*)dp = v0; *(f32x4*)(dp + 4) = v1; }
                    }
                }
            }
    }
    __device__ __forceinline__ void operator()(const f32x4 (&acc)[2][2][4][2], const Unit& u, int wr, int wc, int fr, int fq) const {
        asm volatile("" : "+v"(fr), "+v"(fq));
        if (u.pm < 64) body<true>(acc, u, wr, wc, fr, fq); else body<false>(acc, u, wr, wc, fr, fq);
    }
};
struct EpiOut {
    static constexpr bool PERM = true;
    const float* xin_p; const float* xin_s; float* xw; const float* modl; const float* ng_next; bf16_t* aprime; float* ssq;
    template <bool UNI>
    __device__ __forceinline__ void body(const f32x4 (&acc)[2][2][4][2], const Unit& u, int wr, int wc, int fr, int fq) const {
        const int row0 = u.pm * 256 + wr * 64 + fr, colt = u.pn * 256 + wc * 32 + 8 * fq;
        const bool has_next = ng_next != nullptr;
        f32x4 ug[2][2], us[2][2], uw[2][2];
#pragma unroll
        for (int bj = 0; bj < 2; ++bj) {
            const int c = colt + bj * 128;
            if (has_next) { uw[bj][0] = *(const f32x4*)(ng_next + c); uw[bj][1] = *(const f32x4*)(ng_next + c + 4); }
            if (UNI) {
                const float* mb = modl + (size_t)(u.pm >> 3) * 12288;
                ug[bj][0] = *(const f32x4*)(mb + 2048 + c) + 1.f; ug[bj][1] = *(const f32x4*)(mb + 2048 + c + 4) + 1.f;
                if (has_next) { us[bj][0] = (*(const f32x4*)(mb + 4096 + c) + 1.f) * uw[bj][0]; us[bj][1] = (*(const f32x4*)(mb + 4096 + c + 4) + 1.f) * uw[bj][1]; }
            }
        }
#pragma unroll
        for (int ai = 0; ai < 2; ++ai)
#pragma unroll
            for (int m = 0; m < 4; ++m) {
                const int r = row0 + ai * 128 + m * 16;
                const float* xr = r < MP ? xin_p + (size_t)r * DM : xin_s + (size_t)(r - MP) * DM;
                const float* mb = modl + (size_t)row_b(r) * 12288;
                float ss = 0.f;
#pragma unroll
                for (int bj = 0; bj < 2; ++bj) {
                    const int c = colt + bj * 128;
                    f32x4 g0, g1;
                    if (UNI) { g0 = ug[bj][0]; g1 = ug[bj][1]; } else { g0 = *(const f32x4*)(mb + 2048 + c) + 1.f; g1 = *(const f32x4*)(mb + 2048 + c + 4) + 1.f; }
                    const f32x4 x0 = *(const f32x4*)(xr + c), x1 = *(const f32x4*)(xr + c + 4);
                    const f32x4 n0 = x0 + g0 * acc[ai][bj][m][0], n1 = x1 + g1 * acc[ai][bj][m][1];
                    *(f32x4*)(xw + (size_t)r * DM + c) = n0; *(f32x4*)(xw + (size_t)r * DM + c + 4) = n1;
                    ss += (n0.x * n0.x + n0.y * n0.y) + (n0.z * n0.z + n0.w * n0.w) + (n1.x * n1.x + n1.y * n1.y) + (n1.z * n1.z + n1.w * n1.w);
                    if (has_next) {
                        f32x4 s0, s1;
                        if (UNI) { s0 = us[bj][0]; s1 = us[bj][1]; } else { s0 = (*(const f32x4*)(mb + 4096 + c) + 1.f) * uw[bj][0]; s1 = (*(const f32x4*)(mb + 4096 + c + 4) + 1.f) * uw[bj][1]; }
                        *(u32x4*)(aprime + (size_t)r * DM + c) = pack8(n0 * s0, n1 * s1);
                    }
                }
                ss += __shfl_xor(ss, 16); ss += __shfl_xor(ss, 32);
                if (fq == 0) atomicAdd(ssq + r, ss);
            }
    }
    __device__ __forceinline__ void operator()(const f32x4 (&acc)[2][2][4][2], const Unit& u, int wr, int wc, int fr, int fq) const {
        asm volatile("" : "+v"(fr), "+v"(fq));
        if (u.pm < 64) body<true>(acc, u, wr, wc, fr, fq); else body<false>(acc, u, wr, wc, fr, fq);
    }
};
struct EpiGrp {
    static constexpr bool PERM = true;
    const bf16_t* uz; const float* chs; bf16_t* out;
    __device__ __forceinline__ void operator()(const f32x4 (&acc)[2][2][4][2], const Unit& u, int wr, int wc, int fr, int fq) const {
        asm volatile("" : "+v"(fr), "+v"(fq));
        const int row0 = u.pm * 256 + wr * 64 + fr, colt = u.pn * 256 + wc * 32 + 8 * fq;
#pragma unroll
        for (int ai = 0; ai < 2; ++ai)
#pragma unroll
            for (int m = 0; m < 4; ++m) {
                const int r = row0 + ai * 128 + m * 16;
#pragma unroll
                for (int bj = 0; bj < 2; ++bj) {
                    const int c = colt + bj * 128;
                    const u32x4 zz = *(const u32x4*)(uz + (size_t)r * 4096 + 2048 + c);
                    const f32x4 c0 = *(const f32x4*)(chs + c), c1 = *(const f32x4*)(chs + c + 4);
                    f32x4 z0, z1;
                    z0.x = silu_f(bf_lo(zz.x)); z0.y = silu_f(bf_hi(zz.x)); z0.z = silu_f(bf_lo(zz.y)); z0.w = silu_f(bf_hi(zz.y));
                    z1.x = silu_f(bf_lo(zz.z)); z1.y = silu_f(bf_hi(zz.z)); z1.z = silu_f(bf_lo(zz.w)); z1.w = silu_f(bf_hi(zz.w));
                    *(u32x4*)(out + (size_t)r * 2048 + c) = pack8(acc[ai][bj][m][0] * c0 * z0, acc[ai][bj][m][1] * c1 * z1);
                }
            }
    }
};
struct EpiSmall {
    static constexpr bool PERM = true;
    int mode; float* mod; const float* ada_b; bf16_t* shiftA; float* sb;
    __device__ __forceinline__ void operator()(const f32x4 (&acc)[2][2][4][2], const Unit& u, int wr, int wc, int fr, int fq) const {
        asm volatile("" : "+v"(fr), "+v"(fq));
        const int row0 = wr * 64 + fr, colt = u.pn * 256 + wc * 32 + 8 * fq;
#pragma unroll
        for (int ai = 0; ai < 2; ++ai)
#pragma unroll
            for (int m = 0; m < 4; ++m) {
                const int r = row0 + ai * 128 + m * 16;
                if (r < 136) {
#pragma unroll
                    for (int bj = 0; bj < 2; ++bj) {
                        const int c = colt + bj * 128;
                        if (mode == 0) {
                            const f32x4 v0 = acc[ai][bj][m][0] + *(const f32x4*)(ada_b + c), v1 = acc[ai][bj][m][1] + *(const f32x4*)(ada_b + c + 4);
                            *(f32x4*)(mod + (size_t)r * 12288 + c) = v0; *(f32x4*)(mod + (size_t)r * 12288 + c + 4) = v1;
                            const int li = c / 3072, cc = c - li * 3072;
                            if (cc < 1024) *(u32x4*)(shiftA + ((size_t)li * 256 + r) * 1024 + cc) = pack8(v0, v1);
                        } else {
                            float* sp = sb + ((size_t)u.q * 136 + r) * 6400 + c;
                            *(f32x4*)sp = acc[ai][bj][m][0]; *(f32x4*)(sp + 4) = acc[ai][bj][m][1];
                        }
                    }
                }
            }
    }
};

__device__ void phase_prep0(const Params& p, LAS unsigned char* lds) {
    LAS float* tl = (LAS float*)lds;
    const int tid = otid();
    for (int tile = blockIdx.x; tile < p.wtiles; tile += gridDim.x) {
        int j = 0;
#pragma unroll 1
        for (int q = 1; q < NWJ; ++q) if (tile >= p.wj[q].tile_begin) j = q;
        const WJob job = p.wj[j];
        const int lt = tile - job.tile_begin, tk = lt / job.tiles_n, tn = lt - tk * job.tiles_n, k0 = tk * 64, n0 = tn * 64;
        {
            const int kk = tid >> 3, nn = (tid & 7) * 8;
            f32x4 a = (f32x4){0.f, 0.f, 0.f, 0.f}, b = a;
            if (n0 + nn < job.N) { const float* sp = job.src + (size_t)(k0 + kk) * job.N + n0 + nn; a = *(const f32x4*)sp; b = *(const f32x4*)(sp + 4); }
            LAS float* d = tl + kk * 65 + nn;
            d[0] = a.x; d[1] = a.y; d[2] = a.z; d[3] = a.w; d[4] = b.x; d[5] = b.y; d[6] = b.z; d[7] = b.w;
        }
        __syncthreads();
        {
            const int n = tid >> 3, k8 = (tid & 7) * 8;
            const LAS float* s = tl + k8 * 65 + n;
            u32x4 o; o.x = cvt_pk_bf16(s[0], s[65]); o.y = cvt_pk_bf16(s[130], s[195]); o.z = cvt_pk_bf16(s[260], s[325]); o.w = cvt_pk_bf16(s[390], s[455]);
            *(u32x4*)(job.dst + (size_t)(n0 + n) * job.K + k0 + k8) = o;
        }
        __syncthreads();
    }
    bf16_t* ac = (bf16_t*)(p.ws + WS_AC);
    const int gt = blockIdx.x * 512 + tid, nth = gridDim.x * 512;
    for (int i = gt; i < 256 * 1024 / 8; i += nth) {
        const int r = i >> 7, c = (i & 127) * 8;
        u32x4 o = (u32x4){0u, 0u, 0u, 0u};
        if (r < 136) {
            const float* cp = r < 8 ? p.in[5] + (size_t)r * 1024 + c : p.in[6] + (size_t)(r - 8) * 1024 + c;
            const f32x4 a = *(const f32x4*)cp, b = *(const f32x4*)(cp + 4);
            o.x = cvt_pk_bf16(silu_f(a.x), silu_f(a.y)); o.y = cvt_pk_bf16(silu_f(a.z), silu_f(a.w)); o.z = cvt_pk_bf16(silu_f(b.x), silu_f(b.y)); o.w = cvt_pk_bf16(silu_f(b.z), silu_f(b.w));
        }
        *(u32x4*)(ac + (size_t)i * 8) = o;
    }
    { u32x4* sq = (u32x4*)(p.ws + WS_SSQ + 17408ull * 4); for (int i = gt; i < 4 * 17408 / 4; i += nth) sq[i] = (u32x4){0u, 0u, 0u, 0u}; }
    u32x4* sh = (u32x4*)(p.ws + WS_SHIFTA);
    for (int i = gt; i < 4 * 256 * 1024 / 8; i += nth) sh[i] = (u32x4){0u, 0u, 0u, 0u};
}

__device__ void phase_xprep(const Params& p) {
    const int tid_ = otid(), lane = tid_ & 63, wv = blockIdx.x * 8 + (tid_ >> 6), nw = gridDim.x * 8;
    const float* mod = (const float*)(p.ws + WS_MOD);
    bf16_t* ap = (bf16_t*)(p.ws + WS_APRIME);
    float* ssq = (float*)(p.ws + WS_SSQ);
    const float* ng = p.in[9];
    for (int r = wv; r < MT; r += nw) {
        const float* xr = r < MP ? p.in[0] + (size_t)r * DM : p.in[1] + (size_t)(r - MP) * DM;
        const float* mb = mod + (size_t)row_b(r) * 12288 + 1024;
        float ss = 0.f;
#pragma unroll
        for (int q = 0; q < 4; ++q) {
            const int c = q * 256 + lane * 4;
            const f32x4 x = *(const f32x4*)(xr + c), s = *(const f32x4*)(mb + c), g = *(const f32x4*)(ng + c);
            ss += (x.x * x.x + x.y * x.y) + (x.z * x.z + x.w * x.w);
            const f32x4 a = x * g * (s + 1.f);
            u32x2 o; o.x = cvt_pk_bf16(a.x, a.y); o.y = cvt_pk_bf16(a.z, a.w);
            *(u32x2*)(ap + (size_t)r * DM + c) = o;
        }
#pragma unroll
        for (int o = 1; o < 64; o <<= 1) ss += __shfl_xor(ss, o);
        if (lane == 0) ssq[r] = ss;
    }
}

__device__ void phase_final(const Params& p, int r_begin, int r_end, int blk0) {
    if ((int)blockIdx.x < blk0) return;
    const int tid_ = otid(), lane = tid_ & 63, wv = ((int)blockIdx.x - blk0) * 8 + (tid_ >> 6), nw = ((int)gridDim.x - blk0) * 8;
    const float* xw = (const float*)(p.ws + WS_XW);
    const float* ssq = (const float*)(p.ws + WS_SSQ) + 4 * 17408;
    const float* fg = p.in[22];
    for (int r = r_begin + wv; r < r_end; r += nw) {
        const float rstd = rsqrtf(ssq[r] * (1.f / 1024.f) + 1e-6f);
#pragma unroll
        for (int q = 0; q < 4; ++q) {
            const int c = q * 256 + lane * 4;
            const f32x4 x = *(const f32x4*)(xw + (size_t)r * DM + c), g = *(const f32x4*)(fg + c);
            *(f32x4*)(p.out + (size_t)r * DM + c) = x * rstd * g;
        }
    }
}

__device__ void phase_ssdnorm(const Params& p, int j) {
    const int tid_ = otid(), lane = tid_ & 63, wv = blockIdx.x * 8 + (tid_ >> 6), nw = gridDim.x * 8;
    const bf16_t* yg = (const bf16_t*)(p.ws + WS_YG);
    bf16_t* a2 = (bf16_t*)(p.ws + WS_A2);
    const float* ng = p.in[16] + (size_t)j * 2048;
    for (int r = wv; r < MT; r += nw) {
#pragma unroll
        for (int q = 0; q < 4; ++q) {
            const int c = q * 512 + lane * 8;
            const u32x4 v = *(const u32x4*)(yg + (size_t)r * 2048 + c);
            f32x4 a, b;
            a.x = bf_lo(v.x); a.y = bf_hi(v.x); a.z = bf_lo(v.y); a.w = bf_hi(v.y); b.x = bf_lo(v.z); b.y = bf_hi(v.z); b.z = bf_lo(v.w); b.w = bf_hi(v.w);
            float ss = (a.x * a.x + a.y * a.y) + (a.z * a.z + a.w * a.w) + (b.x * b.x + b.y * b.y) + (b.z * b.z + b.w * b.w);
#pragma unroll
            for (int o = 1; o < 32; o <<= 1) ss += __shfl_xor(ss, o);
            const float rstd = rsqrtf(ss * (1.f / 256.f) + 1e-6f);
            const f32x4 g0 = *(const f32x4*)(ng + c), g1 = *(const f32x4*)(ng + c + 4);
            *(u32x4*)(a2 + (size_t)r * 2048 + c) = pack8(a * rstd * g0, b * rstd * g1);
        }
    }
}

__device__ void phase_pool(const Params& p, int j) {
    const bf16_t* uz = (const bf16_t*)(p.ws + WS_ZX);
    bf16_t* pooled = (bf16_t*)(p.ws + WS_YG);
    const int gt = blockIdx.x * 512 + otid(), nth = gridDim.x * 512;
    for (int u = gt; u < 131072 + 32768; u += nth) {
        int cv, row0, t0, R; const float* prev = nullptr; bool prompt;
        if (u < 131072) { cv = u & 255; const int run = (u >> 8) & 63, b = u >> 14; row0 = b * 2048; t0 = run * 32; R = 32; prompt = true; }
        else { const int v = u - 131072; cv = v & 255; const int b = v >> 8; row0 = MP + b * 8; t0 = 0; R = 8; prompt = false; prev = p.in[4] + ((size_t)(j * 128 + b) * 15) * 2048; }
        const int c = cv * 8, w = 2 << (c >> 9);
        float s[8];
#pragma unroll
        for (int i = 0; i < 8; ++i) s[i] = 0.f;
        auto getu = [&](int tt, float (&o)[8]) {
            if (tt >= 0) {
                const u32x4 v = *(const u32x4*)(uz + (size_t)(row0 + tt) * 4096 + c);
                o[0] = bf_lo(v.x); o[1] = bf_hi(v.x); o[2] = bf_lo(v.y); o[3] = bf_hi(v.y); o[4] = bf_lo(v.z); o[5] = bf_hi(v.z); o[6] = bf_lo(v.w); o[7] = bf_hi(v.w);
            } else if (!prompt) {
                const float* pp = prev + (size_t)(15 + tt) * 2048 + c;
                const f32x4 a = *(const f32x4*)pp, b = *(const f32x4*)(pp + 4);
                o[0] = a.x; o[1] = a.y; o[2] = a.z; o[3] = a.w; o[4] = b.x; o[5] = b.y; o[6] = b.z; o[7] = b.w;
            } else {
#pragma unroll
                for (int i = 0; i < 8; ++i) o[i] = 0.f;
            }
        };
        for (int i = 1; i < w; ++i) {
            float o[8]; getu(t0 - i, o);
#pragma unroll
            for (int k = 0; k < 8; ++k) s[k] += o[k];
        }
        for (int t = t0; t < t0 + R; ++t) {
            float cur[8], old[8]; getu(t, cur); getu(t - w + 1, old);
            const float inv = 1.f / (float)(prompt ? min(w, t + 1) : w);
            f32x4 a, b;
#pragma unroll
            for (int k = 0; k < 8; ++k) s[k] += cur[k];
            a.x = s[0] * inv - cur[0]; a.y = s[1] * inv - cur[1]; a.z = s[2] * inv - cur[2]; a.w = s[3] * inv - cur[3];
            b.x = s[4] * inv - cur[4]; b.y = s[5] * inv - cur[5]; b.z = s[6] * inv - cur[6]; b.w = s[7] * inv - cur[7];
            *(u32x4*)(pooled + (size_t)(row0 + t) * 2048 + c) = pack8(a, b);
#pragma unroll
            for (int k = 0; k < 8; ++k) s[k] -= old[k];
        }
    }
    for (int i = gt; i < 8 * 15 * 2048; i += nth) {
        const int ch = i & 2047, k = (i >> 11) % 15, b = (i >> 11) / 15;
        p.out[O_POOL_P + ((size_t)(j * 8 + b) * 15 + k) * 2048 + ch] = bf2f(uz[(size_t)(b * 2048 + 2033 + k) * 4096 + ch]);
    }
    for (int i = gt; i < 128 * 15 * 2048; i += nth) {
        const int ch = i & 2047, k = (i >> 11) % 15, b = (i >> 11) / 15;
        float v;
        if (k < 7) v = p.in[4][((size_t)(j * 128 + b) * 15 + 8 + k) * 2048 + ch];
        else v = bf2f(uz[(size_t)(MP + b * 8 + k - 7) * 4096 + ch]);
        p.out[O_POOL_S + ((size_t)(j * 128 + b) * 15 + k) * 2048 + ch] = v;
    }
}

constexpr int RS = 272;
constexpr int L_XT = 0, L_BN = 17408, L_BT = 52224, L_CN = 87040, L_HB = 121856, L_SM = 139264, L_CW = 141312;
__device__ __forceinline__ int xt_addr(int pr, int t) { return L_XT + pr * RS + ((((t >> 3) ^ (pr >> 1)) & 15) << 4) + (t & 7) * 2; }
__device__ __forceinline__ int bt_addr(int n, int t) { return L_BT + n * RS + ((((t >> 3) ^ (n >> 3)) & 15) << 4) + (t & 7) * 2; }
__device__ __forceinline__ f32x16 mfma32(bf16x8 a, bf16x8 b, f32x16 c) { return __builtin_amdgcn_mfma_f32_32x32x16_bf16(a, b, c, 0, 0, 0); }

#define OPQ(x) asm volatile("" : "+v"(x))
__device__ void ssd_prompt_item(const Params& p, int j, int b, int h, LAS unsigned char* lds) {
    const int tid0 = otid(), wid = __builtin_amdgcn_readfirstlane(tid0 >> 6), g = h >> 2;
    const char* zxc = (const char*)(p.ws + WS_ZX);
    const char* dtc = (const char*)(p.ws + WS_DTRAW);
    char* ygc = (char*)(p.ws + WS_YG);
    const int rowbase = b * 2048;
    LAS float* sm_acum = (LAS float*)(lds + L_SM);
    LAS float* sm_dt = sm_acum + 128;
    LAS float* sm_w = sm_acum + 256;
    LAS float* sm_ea = sm_acum + 384;
    LAS float* cw = (LAS float*)(lds + L_CW);
    const float Ah = -__expf(p.in[14][j * 32 + h]), Dh = p.in[15][j * 32 + h], dtb = p.in[13][j * 32 + h];
    const bool roleB = wid < 4;
    const int qq = wid >> 1, tt = qq ^ (qq >> 1), pt = wid & 1, hp = wid & 1, hn = wid >> 1;

    __syncthreads();
    if (tid0 < 320) {
        const int ch = tid0 < 64 ? h * 64 + tid0 : (tid0 < 192 ? 2048 + g * 128 + (tid0 - 64) : 3072 + g * 128 + (tid0 - 192));
#pragma unroll
        for (int k = 0; k < 4; ++k) cw[k * 320 + tid0] = p.in[11][((size_t)j * 4 + k) * 4096 + ch];
        cw[4 * 320 + tid0] = p.in[12][(size_t)j * 4096 + ch];
    }
    for (int i = tid0; i < 17408 / 4; i += 512) *(LAS unsigned*)(lds + L_HB + i * 4) = 0u;

    u32x4 rawBC[11]; unsigned rawX[11]; float dtp0 = 0.f, dtp1 = 0.f;
    auto prefetch = [&](int t0) {
        int tid = tid0; OPQ(tid);
        const int bt_ = tid & 255, tqb = bt_ >> 4, cg8 = bt_ & 15, tqx = tid >> 5, cp = tid & 31, lane = tid & 63;
        const int colBC = (roleB ? 4096 : 5120) + g * 128 + cg8 * 8, colX = 2048 + h * 64 + cp * 2;
        const int rB = t0 + tqb * 8 - 3, rX = t0 + tqx * 8 - 3;
        const unsigned oB = (unsigned)((rowbase + rB) * ZXW + colBC) * 2u, oX = (unsigned)((rowbase + rX) * ZXW + colX) * 2u;
#pragma unroll
        for (int i = 0; i < 11; ++i) {
            rawBC[i] = (rB + i >= 0) ? *(const u32x4*)(zxc + (oB + (unsigned)i * 12288u)) : (u32x4){0u, 0u, 0u, 0u};
            rawX[i] = (rX + i >= 0) ? *(const unsigned*)(zxc + (oX + (unsigned)i * 12288u)) : 0u;
        }
        if (wid == 0) { const unsigned od = (unsigned)((rowbase + t0 + 2 * lane) * 32 + h) * 4u; dtp0 = *(const float*)(dtc + od); dtp1 = *(const float*)(dtc + (od + 128u)); }
    };
    prefetch(0);

    f32x16 hacc;
#pragma unroll
    for (int i = 0; i < 16; ++i) hacc[i] = 0.f;

#pragma unroll 1
    for (int c = 0; c < 16; ++c) {
        const int t0 = c * 128;
        if (wid == 0) {
            int lane = tid0 & 63; OPQ(lane);
            const float d0 = softplus_f(dtp0 + dtb), d1 = softplus_f(dtp1 + dtb);
            const float a0 = d0 * Ah, a1 = a0 + d1 * Ah;
            float sc = a1;
#pragma unroll
            for (int o = 1; o < 64; o <<= 1) { const float v = __shfl_up(sc, o); if (lane >= o) sc += v; }
            const float c1 = sc, c0 = sc - a1 + a0;
            const float last = __shfl(sc, 63);
            sm_acum[2 * lane] = c0; sm_acum[2 * lane + 1] = c1;
            sm_dt[2 * lane] = d0; sm_dt[2 * lane + 1] = d1;
            sm_w[2 * lane] = __expf(last - c0) * d0; sm_w[2 * lane + 1] = __expf(last - c1) * d1;
            sm_ea[2 * lane] = __expf(c0); sm_ea[2 * lane + 1] = __expf(c1);
        }
        __syncthreads();
        {
            int tid = tid0; OPQ(tid);
            const int bt_ = tid & 255, tqb = bt_ >> 4, cg8 = bt_ & 15;
            const int lcBC = (roleB ? 64 : 192) + cg8 * 8;
            const f32x4 wv0 = *(const LAS f32x4*)(sm_w + tqb * 8), wv1 = *(const LAS f32x4*)(sm_w + tqb * 8 + 4);
            const float wt[8] = {wv0.x, wv0.y, wv0.z, wv0.w, wv1.x, wv1.y, wv1.z, wv1.w};
            const int natbase = (roleB ? L_BN : L_CN) + (tqb * 8) * RS + cg8 * 16;
#pragma unroll
            for (int half = 0; half < 2; ++half) {
                u32x2 nat[8]; u32x4 tr[4];
#pragma unroll
                for (int ipp = 0; ipp < 2; ++ipp) {
                    const int ip = half * 2 + ipp;
                    const float k0a = cw[0 * 320 + lcBC + 2 * ip], k0b = cw[0 * 320 + lcBC + 2 * ip + 1];
                    const float k1a = cw[1 * 320 + lcBC + 2 * ip], k1b = cw[1 * 320 + lcBC + 2 * ip + 1];
                    const float k2a = cw[2 * 320 + lcBC + 2 * ip], k2b = cw[2 * 320 + lcBC + 2 * ip + 1];
                    const float k3a = cw[3 * 320 + lcBC + 2 * ip], k3b = cw[3 * 320 + lcBC + 2 * ip + 1];
                    const float bba = cw[4 * 320 + lcBC + 2 * ip], bbb = cw[4 * 320 + lcBC + 2 * ip + 1];
                    float ra[11], rb[11];
#pragma unroll
                    for (int i = 0; i < 11; ++i) { const unsigned v = rawBC[i][ip]; ra[i] = bf_lo(v); rb[i] = bf_hi(v); }
                    float va[8], vb[8];
#pragma unroll
                    for (int t = 0; t < 8; ++t) {
                        va[t] = silu_f(bba + k0a * ra[t] + k1a * ra[t + 1] + k2a * ra[t + 2] + k3a * ra[t + 3]);
                        vb[t] = silu_f(bbb + k0b * rb[t] + k1b * rb[t + 1] + k2b * rb[t + 2] + k3b * rb[t + 3]);
                        nat[t][ipp] = cvt_pk_bf16(va[t], vb[t]);
                    }
                    if (roleB) {
#pragma unroll
                        for (int tp = 0; tp < 4; ++tp) {
                            tr[2 * ipp][tp] = cvt_pk_bf16(va[2 * tp] * wt[2 * tp], va[2 * tp + 1] * wt[2 * tp + 1]);
                            tr[2 * ipp + 1][tp] = cvt_pk_bf16(vb[2 * tp] * wt[2 * tp], vb[2 * tp + 1] * wt[2 * tp + 1]);
                        }
                    }
                }
#pragma unroll
                for (int t = 0; t < 8; ++t) *(LAS u32x2*)(lds + natbase + t * RS + half * 8) = nat[t];
                if (roleB) {
#pragma unroll
                    for (int i = 0; i < 4; ++i) *(LAS u32x4*)(lds + bt_addr(cg8 * 8 + half * 4 + i, tqb * 8)) = tr[i];
                }
                __builtin_amdgcn_sched_barrier(0);
            }
        }
        {
            int tid = tid0; OPQ(tid);
            const int tqx = tid >> 5, cp = tid & 31, lcX = cp * 2;
            const float k0a = cw[0 * 320 + lcX], k0b = cw[0 * 320 + lcX + 1], k1a = cw[1 * 320 + lcX], k1b = cw[1 * 320 + lcX + 1];
            const float k2a = cw[2 * 320 + lcX], k2b = cw[2 * 320 + lcX + 1], k3a = cw[3 * 320 + lcX], k3b = cw[3 * 320 + lcX + 1];
            const float bba = cw[4 * 320 + lcX], bbb = cw[4 * 320 + lcX + 1];
            float ra[11], rb[11];
#pragma unroll
            for (int i = 0; i < 11; ++i) { ra[i] = bf_lo(rawX[i]); rb[i] = bf_hi(rawX[i]); }
            float va[8], vb[8];
#pragma unroll
            for (int t = 0; t < 8; ++t) {
                va[t] = silu_f(bba + k0a * ra[t] + k1a * ra[t + 1] + k2a * ra[t + 2] + k3a * ra[t + 3]);
                vb[t] = silu_f(bbb + k0b * rb[t] + k1b * rb[t + 1] + k2b * rb[t + 2] + k3b * rb[t + 3]);
            }
            u32x4 xa, xb;
            xa.x = cvt_pk_bf16(va[0], va[1]); xa.y = cvt_pk_bf16(va[2], va[3]); xa.z = cvt_pk_bf16(va[4], va[5]); xa.w = cvt_pk_bf16(va[6], va[7]);
            xb.x = cvt_pk_bf16(vb[0], vb[1]); xb.y = cvt_pk_bf16(vb[2], vb[3]); xb.z = cvt_pk_bf16(vb[4], vb[5]); xb.w = cvt_pk_bf16(vb[6], vb[7]);
            *(LAS u32x4*)(lds + xt_addr(cp * 2, tqx * 8)) = xa;
            *(LAS u32x4*)(lds + xt_addr(cp * 2 + 1, tqx * 8)) = xb;
        }
        if (c + 1 < 16) prefetch(t0 + 128);
        bf16_t zr[16];
        {
            int ln = tid0 & 63; OPQ(ln);
            const int l31 = ln & 31, hh = ln >> 5;
            const unsigned oz = (unsigned)((rowbase + t0 + tt * 32 + 4 * hh) * ZXW + h * 64 + pt * 32 + l31) * 2u;
#pragma unroll
            for (int rg = 0; rg < 16; ++rg) zr[rg] = *(const bf16_t*)(zxc + (oz + (unsigned)((rg & 3) + 8 * (rg >> 2)) * 12288u));
        }
        __syncthreads();
        f32x16 y;
        {
            int ln = tid0 & 63; OPQ(ln);
            const int l31 = ln & 31, hh = ln >> 5;
            const int cbase = L_CN + (tt * 32 + l31) * RS + 16 * hh, hbase = L_HB + (pt * 32 + l31) * RS + 16 * hh;
#pragma unroll
            for (int i = 0; i < 16; ++i) y[i] = 0.f;
#pragma unroll
            for (int ks = 0; ks < 8; ++ks) { const bf16x8 cfr = *(const LAS bf16x8*)(lds + cbase + ks * 32); const bf16x8 bfr = *(const LAS bf16x8*)(lds + hbase + ks * 32); y = mfma32(cfr, bfr, y); }
#pragma unroll
            for (int rq = 0; rq < 4; ++rq) { const f32x4 e = *(const LAS f32x4*)(sm_ea + tt * 32 + 8 * rq + 4 * hh); y[4 * rq] *= e.x; y[4 * rq + 1] *= e.y; y[4 * rq + 2] *= e.z; y[4 * rq + 3] *= e.w; }
            const int tidx = tt * 32 + l31;
            const float at = sm_acum[tidx];
#pragma unroll 1
            for (int st = 0; st <= tt; ++st) {
                f32x16 s;
#pragma unroll
                for (int i = 0; i < 16; ++i) s[i] = 0.f;
                const int bbase = L_BN + (st * 32 + l31) * RS + 16 * hh;
#pragma unroll
                for (int ks = 0; ks < 8; ++ks) { const bf16x8 afr = *(const LAS bf16x8*)(lds + bbase + ks * 32); const bf16x8 cfr = *(const LAS bf16x8*)(lds + cbase + ks * 32); s = mfma32(afr, cfr, s); }
#pragma unroll
                for (int rq = 0; rq < 4; ++rq) {
                    const int sb0 = st * 32 + 8 * rq + 4 * hh;
                    const f32x4 asv = *(const LAS f32x4*)(sm_acum + sb0), dsv = *(const LAS f32x4*)(sm_dt + sb0);
#pragma unroll
                    for (int i = 0; i < 4; ++i) {
                        float e = at - asv[i];
                        if (sb0 + i > tidx) e = -INFINITY;
                        s[4 * rq + i] *= __expf(e) * dsv[i];
                    }
                }
#pragma unroll
                for (int k2 = 0; k2 < 2; ++k2) {
                    u32x4 au; au.x = cvt_pk_bf16(s[8 * k2], s[8 * k2 + 1]); au.y = cvt_pk_bf16(s[8 * k2 + 2], s[8 * k2 + 3]); au.z = cvt_pk_bf16(s[8 * k2 + 4], s[8 * k2 + 5]); au.w = cvt_pk_bf16(s[8 * k2 + 6], s[8 * k2 + 7]);
                    const int sbase = st * 32 + 16 * k2 + 4 * hh;
                    const u32x2 lo = *(const LAS u32x2*)(lds + xt_addr(pt * 32 + l31, sbase)), hi = *(const LAS u32x2*)(lds + xt_addr(pt * 32 + l31, sbase + 8));
                    u32x4 bu; bu.x = lo.x; bu.y = lo.y; bu.z = hi.x; bu.w = hi.y;
                    y = mfma32(__builtin_bit_cast(bf16x8, au), __builtin_bit_cast(bf16x8, bu), y);
                }
            }
        }
        {
            int ln = tid0 & 63; OPQ(ln);
            const int l31 = ln & 31, hh = ln >> 5;
            const float dec = sm_ea[127];
#pragma unroll
            for (int i = 0; i < 16; ++i) hacc[i] *= dec;
#pragma unroll
            for (int ks = 0; ks < 8; ++ks) {
                const bf16x8 a = *(const LAS bf16x8*)(lds + xt_addr(hp * 32 + l31, ks * 16 + 8 * hh));
                const bf16x8 bb = *(const LAS bf16x8*)(lds + bt_addr(hn * 32 + l31, ks * 16 + 8 * hh));
                hacc = mfma32(a, bb, hacc);
            }
        }
        {
            int ln = tid0 & 63; OPQ(ln);
            const int l31 = ln & 31, hh = ln >> 5;
            const unsigned oy = (unsigned)((rowbase + t0 + tt * 32 + 4 * hh) * 2048 + h * 64 + pt * 32 + l31) * 2u;
#pragma unroll
            for (int rq = 0; rq < 4; ++rq) {
                const u32x2 xv = *(const LAS u32x2*)(lds + xt_addr(pt * 32 + l31, tt * 32 + 8 * rq + 4 * hh));
                const float xs[4] = {bf_lo(xv.x), bf_hi(xv.x), bf_lo(xv.y), bf_hi(xv.y)};
#pragma unroll
                for (int i = 0; i < 4; ++i) {
                    const int rg = 4 * rq + i;
                    const float yv = y[rg] + Dh * xs[i];
                    const float gv = yv * silu_f(bf2f(zr[rg]));
                    *(bf16_t*)(ygc + (oy + (unsigned)(8 * rq + i) * 4096u)) = (bf16_t)(cvt_pk_bf16(gv, 0.f) & 0xffffu);
                }
            }
        }
        __syncthreads();
        {
            int ln = tid0 & 63; OPQ(ln);
            const int l31 = ln & 31, hh = ln >> 5;
#pragma unroll
            for (int rg = 0; rg < 16; ++rg) {
                const int pr = hp * 32 + (rg & 3) + 8 * (rg >> 2) + 4 * hh;
                *(LAS bf16_t*)(lds + L_HB + pr * RS + (hn * 32 + l31) * 2) = (bf16_t)(cvt_pk_bf16(hacc[rg], 0.f) & 0xffffu);
            }
        }
    }
    {
        int ln = tid0 & 63; OPQ(ln);
        const int l31 = ln & 31, hh = ln >> 5;
        float* so = p.out + O_SSM_P + ((size_t)(j * 8 + b) * 32 + h) * 8192;
#pragma unroll
        for (int rg = 0; rg < 16; ++rg) {
            const int pr = hp * 32 + (rg & 3) + 8 * (rg >> 2) + 4 * hh;
            so[pr * 128 + hn * 32 + l31] = hacc[rg];
        }
    }
}

__device__ void ssd_sample_item(const Params& p, int j, int b, int g, LAS unsigned char* lds) {
    const int tid = otid();
    const bf16_t* zx = (const bf16_t*)(p.ws + WS_ZX);
    const float* dtraw = (const float*)(p.ws + WS_DTRAW);
    bf16_t* yg = (bf16_t*)(p.ws + WS_YG);
    LAS float* sx = (LAS float*)lds;
    LAS float* sB = sx + 2048;
    LAS float* sC = sB + 1024;
    LAS float* sdt = sC + 1024;
    LAS float* sdec = sdt + 32;
    const int pp = tid >> 3, nl = (tid & 7) * 4;
    const float* st = p.in[2] + ((size_t)(j * 128 + b) * 32 + g * 4) * 8192;
    f32x4 hs[4][4];
#pragma unroll
    for (int r = 0; r < 4; ++r)
#pragma unroll
        for (int q = 0; q < 4; ++q) hs[r][q] = *(const f32x4*)(st + r * 8192 + pp * 128 + nl + 32 * q);
    __syncthreads();
    {
        const int cc = tid < 256 ? g * 256 + tid : (tid < 384 ? 2048 + g * 128 + (tid - 256) : 3072 + g * 128 + (tid - 384));
        float raw[11];
#pragma unroll
        for (int k = 0; k < 3; ++k) raw[k] = p.in[3][((size_t)(j * 128 + b) * 3 + k) * 4096 + cc];
#pragma unroll
        for (int t = 0; t < 8; ++t) raw[3 + t] = bf2f(zx[(size_t)(MP + b * 8 + t) * ZXW + 2048 + cc]);
        const float w0 = p.in[11][((size_t)j * 4 + 0) * 4096 + cc], w1 = p.in[11][((size_t)j * 4 + 1) * 4096 + cc];
        const float w2 = p.in[11][((size_t)j * 4 + 2) * 4096 + cc], w3 = p.in[11][((size_t)j * 4 + 3) * 4096 + cc];
        const float bs = p.in[12][(size_t)j * 4096 + cc];
        LAS float* dst = tid < 256 ? sx + tid : (tid < 384 ? sB + (tid - 256) : sC + (tid - 384));
        const int dstride = tid < 256 ? 256 : 128;
#pragma unroll
        for (int t = 0; t < 8; ++t) dst[t * dstride] = silu_f(bs + w0 * raw[t] + w1 * raw[t + 1] + w2 * raw[t + 2] + w3 * raw[t + 3]);
        if (tid < 32) {
            const int t = tid >> 2, r = tid & 3, hd = g * 4 + r;
            const float dtv = softplus_f(dtraw[(size_t)(MP + b * 8 + t) * 32 + hd] + p.in[13][j * 32 + hd]);
            sdt[tid] = dtv; sdec[tid] = __expf(-dtv * __expf(p.in[14][j * 32 + hd]));
        }
    }
    __syncthreads();
    float* so = p.out + O_SSM_S + ((size_t)(j * 128 + b) * 32 + g * 4) * 8192;
#pragma unroll
    for (int r = 0; r < 4; ++r) {
        const float Dh = p.in[15][j * 32 + g * 4 + r];
        float ysel = 0.f;
#pragma unroll
        for (int t = 0; t < 8; ++t) {
            const float dtv = sdt[t * 4 + r], dec = sdec[t * 4 + r], dx = dtv * sx[t * 256 + r * 64 + pp];
            float yp = 0.f;
#pragma unroll
            for (int q = 0; q < 4; ++q) {
                const f32x4 B4 = *(const LAS f32x4*)(sB + t * 128 + nl + 32 * q), C4 = *(const LAS f32x4*)(sC + t * 128 + nl + 32 * q);
                hs[r][q] = hs[r][q] * dec + B4 * dx;
                yp += (hs[r][q].x * C4.x + hs[r][q].y * C4.y) + (hs[r][q].z * C4.z + hs[r][q].w * C4.w);
            }
            yp += __shfl_xor(yp, 1); yp += __shfl_xor(yp, 2); yp += __shfl_xor(yp, 4);
            if ((tid & 7) == t) ysel = yp;
        }
        {
            const int t = tid & 7, ch = g * 256 + r * 64 + pp;
            const size_t row = (size_t)(MP + b * 8 + t);
            const float yv = ysel + Dh * sx[t * 256 + r * 64 + pp];
            const float gv = yv * silu_f(bf2f(zx[row * ZXW + ch]));
            yg[row * 2048 + ch] = (bf16_t)(cvt_pk_bf16(gv, 0.f) & 0xffffu);
        }
#pragma unroll
        for (int q = 0; q < 4; ++q) *(f32x4*)(so + r * 8192 + pp * 128 + nl + 32 * q) = hs[r][q];
    }
}

__device__ void phase_scan(const Params& p, int j, LAS unsigned char* lds) {
    for (int item = blockIdx.x; item < 256; item += gridDim.x) {
        const int g = item & 7, k = item >> 3, b = k >> 2, r = k & 3;
        for (int rep = 0; rep < REP_PROMPT; ++rep) ssd_prompt_item(p, j, b, g * 4 + r, lds);
    }
#ifndef NO_SAMPLE
    for (int item = blockIdx.x; item < 1024; item += gridDim.x) ssd_sample_item(p, j, item >> 3, item & 7, lds);
#endif
    const bf16_t* zx = (const bf16_t*)(p.ws + WS_ZX);
    const int gt = blockIdx.x * 512 + otid(), nth = gridDim.x * 512;
    for (int i = gt; i < 136 * 3 * 4096; i += nth) {
        const int ch = i & 4095, k = (i >> 12) % 3, s = (i >> 12) / 3;
        if (s < 8) p.out[O_CONV_P + ((size_t)(j * 8 + s) * 3 + k) * 4096 + ch] = bf2f(zx[(size_t)(s * 2048 + 2045 + k) * ZXW + 2048 + ch]);
        else p.out[O_CONV_S + ((size_t)(j * 128 + (s - 8)) * 3 + k) * 4096 + ch] = bf2f(zx[(size_t)(MP + (s - 8) * 8 + 5 + k) * ZXW + 2048 + ch]);
    }
}

#define XB_TMO      128
#define XB_XCNT(j)  (256  + 64 * (j))
#define XB_XSUB(j)  (1280 + 64 * (j))
#define XB_XGEN(j)  (2304 + 64 * (j))
#define XB_TOP      3328
#define XB_TOPGEN   3392
#define XCD_BAR_WORDS 3456
#define XB_SPIN_CAP (1u << 22)
__device__ __forceinline__ unsigned xb_ld(unsigned* p)              { return __hip_atomic_load(p, __ATOMIC_RELAXED, __HIP_MEMORY_SCOPE_AGENT); }
__device__ __forceinline__ unsigned xb_add(unsigned* p, unsigned v) { return __hip_atomic_fetch_add(p, v, __ATOMIC_RELAXED, __HIP_MEMORY_SCOPE_AGENT); }
__device__ __forceinline__ unsigned xb_xcc_id() { return (unsigned)__builtin_amdgcn_s_getreg((3 << 11) | 20) & 0xFu; }
#define XB_SPIN(cond, bar) do { unsigned _sp = 0; while (cond) { __builtin_amdgcn_s_sleep(1); \
    if ((++_sp & 255u) == 0u) { if (xb_ld(&(bar)[XB_TMO])) break; if (_sp > XB_SPIN_CAP) { atomicAdd(&(bar)[XB_TMO], 1u); break; } } } } while (0)
struct XcdBarrier { unsigned* bar; unsigned x; volatile LAS unsigned* st; };
__device__ __forceinline__ XcdBarrier xcd_barrier_post(unsigned* bar, volatile LAS unsigned* st) {
    XcdBarrier b; b.bar = bar; b.x = xb_xcc_id(); b.st = st;
    if (threadIdx.x == 0) (void)xb_add(&bar[XB_XCNT(b.x)], 1u);
    return b;
}
__device__ __forceinline__ void xcd_barrier_complete(unsigned* bar, unsigned x, unsigned& nloc, unsigned& nx) {
    const unsigned G = gridDim.x * gridDim.y * gridDim.z;
    unsigned sum, cnt, mine, sp = 0u;
    for (;;) {
        sum = 0u; cnt = 0u; mine = 0u;
#pragma unroll
        for (unsigned j = 0; j < 16; ++j) { const unsigned c = xb_ld(&bar[XB_XCNT(j)]); sum += c; cnt += (c > 0u) ? 1u : 0u; mine = (j == x) ? c : mine; }
        if (sum == G) break;
        __builtin_amdgcn_s_sleep(1);
        if ((++sp & 255u) == 0u) { if (xb_ld(&bar[XB_TMO])) break; if (sp > XB_SPIN_CAP) { atomicAdd(&bar[XB_TMO], 1u); break; } }
    }
    nloc = mine > 0u ? mine : 1u; nx = cnt > 0u ? cnt : 1u;
}
__device__ __forceinline__ void xcd_barrier(const XcdBarrier& b) {
    asm volatile("s_waitcnt vmcnt(0)" ::: "memory");
    __syncthreads();
    if (threadIdx.x == 0) {
        unsigned* bar = b.bar;
        __builtin_amdgcn_s_waitcnt(0);
        unsigned nloc = b.st[0], nx = b.st[1];
        if (nloc == 0u) { xcd_barrier_complete(bar, b.x, nloc, nx); b.st[0] = nloc; b.st[1] = nx; }
        const unsigned old = xb_add(&bar[XB_XSUB(b.x)], 1u);
        const unsigned gen = old / nloc;
        if (old + 1u == (gen + 1u) * nloc) {
            __builtin_amdgcn_fence(__ATOMIC_RELEASE, "agent");
            asm volatile("s_waitcnt vmcnt(0)" ::: "memory");
            const unsigned og = xb_add(&bar[XB_TOP], 1u);
            const unsigned tg = og / nx;
            if (og + 1u == (tg + 1u) * nx) xb_add(&bar[XB_TOPGEN], 1u);
            else XB_SPIN(xb_ld(&bar[XB_TOPGEN]) == tg, bar);
            __builtin_amdgcn_fence(__ATOMIC_ACQUIRE, "agent");
            xb_add(&bar[XB_XGEN(b.x)], 1u);
            asm volatile("s_waitcnt vmcnt(0)" ::: "memory");
        } else {
            XB_SPIN(xb_ld(&bar[XB_XGEN(b.x)]) == gen, bar);
            __builtin_amdgcn_fence(__ATOMIC_ACQUIRE, "agent");
            asm volatile("s_waitcnt vmcnt(0)" ::: "memory");
        }
    }
    __syncthreads();
}

#ifndef REP_SYNC
#define REP_SYNC 1
#endif
#ifndef REP_SCAN
#define REP_SCAN 1
#endif
#ifndef REP_GIN
#define REP_GIN 1
#endif
#ifndef REP_GOUT
#define REP_GOUT 1
#endif
#ifndef REP_ELEM
#define REP_ELEM 1
#endif
#define GSYNC() do { for (int _r = 0; _r < REP_SYNC; ++_r) xcd_barrier(xb); } while (0)
__global__ __launch_bounds__(512, 2) void hybrid_fwd(Params p) {
    extern __shared__ __attribute__((aligned(16))) unsigned char smem[];
    LAS unsigned char* lds = (LAS unsigned char*)smem;
    cg::grid_group grid = cg::this_grid();
    unsigned char* ws = p.ws;
    volatile LAS unsigned* xst = (volatile LAS unsigned*)(lds + LDS_XB);
    if (threadIdx.x == 0) { xst[0] = 0u; xst[1] = 0u; }
    __syncthreads();
    const XcdBarrier xb = xcd_barrier_post((unsigned*)(ws + WS_BAR), xst);

#ifndef NO_PREP0
    phase_prep0(p, lds);
#endif
    grid.sync();
#pragma unroll 1
    for (int mode = 0; mode < 2; ++mode) {
        pg8::SmallSched S; S.mode = mode; S.G = (int)gridDim.x; S.c = (int)blockIdx.x; S.lda = 1024; S.ldb = 1024; S.K = 1024;
        S.A0 = (const char*)(ws + (mode == 0 ? WS_AC : WS_SHIFTA)); S.ada = (const char*)(ws + WS_WT_ADA); S.ssd_in = (const char*)(ws + WS_WT_SSD_IN); S.pool_in = (const char*)(ws + WS_WT_POOL_IN);
        EpiSmall E; E.mode = mode; E.mod = (float*)(ws + WS_MOD); E.ada_b = p.in[8]; E.shiftA = (bf16_t*)(ws + WS_SHIFTA); E.sb = (float*)(ws + WS_SB);
#ifndef NO_GSMALL
        pg8::gemm_phase<EpiSmall, pg8::SmallSched>(lds, S, E);
#endif
        if (mode == 1) phase_xprep(p);
        GSYNC();
    }
    unsigned* tailw = (unsigned*)(ws + WS_BAR) + 3584;
    unsigned* tmow = (unsigned*)(ws + WS_BAR) + XB_TMO;
#pragma unroll 1
    for (int layer = 0; layer < 4; ++layer) {
        const int j = layer >> 1; const bool ssd = (layer & 1) == 0;
        {
            pg8::InSched S;
            S.init(ssd ? 6400 : 4096, ws + WS_APRIME, ssd ? ws + WS_WT_SSD_IN + (size_t)j * 6400 * 1024 * 2 : ws + WS_WT_POOL_IN + (size_t)j * 4096 * 1024 * 2, layer > 0 ? tailw + 64 * (layer - 1) : nullptr, tmow);
            EpiIn E; E.ssq = (const float*)(ws + WS_SSQ) + (size_t)layer * 17408; E.sb = (const float*)(ws + WS_SB) + (size_t)layer * 136 * 6400; E.out = (bf16_t*)(ws + WS_ZX);
            E.ldo = ssd ? ZXW : 4096; E.nbf = ssd ? ZXW : 4096; E.dtraw = ssd ? (float*)(ws + WS_DTRAW) : nullptr;
            for (int rep = 0; rep < REP_GIN; ++rep) pg8::gemm_phase<EpiIn, pg8::InSched>(lds, S, E);
        }
        GSYNC();
        if (ssd) { for (int rep = 0; rep < REP_SCAN; ++rep) phase_scan(p, j, lds); } else { for (int rep = 0; rep < REP_ELEM; ++rep) phase_pool(p, j); }
        GSYNC();
        if (ssd) { for (int rep = 0; rep < REP_ELEM; ++rep) phase_ssdnorm(p, j); }
        else {
            pg8::MainSched S; S.init(MT, 2048, 512, 2048, 512, ws + WS_YG, ws + WS_WT_POOL_G + (size_t)j * 2048 * 512 * 2, 1);
            EpiGrp E; E.uz = (const bf16_t*)(ws + WS_ZX); E.chs = p.in[20] + (size_t)j * 2048; E.out = (bf16_t*)(ws + WS_A2);
#ifndef NO_GGRP
            pg8::gemm_phase<EpiGrp, pg8::MainSched>(lds, S, E);
#endif
        }
        GSYNC();
#pragma unroll 1
        for (int part = 0; part < 2; ++part) {
            pg8::MainSched S; S.init(part == 0 ? MP : MT, 1024, 2048, 2048, 2048, ws + WS_A2, ssd ? ws + WS_WT_SSD_OUT + (size_t)j * 1024 * 2048 * 2 : ws + WS_WT_POOL_OUT + (size_t)j * 1024 * 2048 * 2, 30, part);
            EpiOut E; float* xw = (float*)(ws + WS_XW);
            E.xin_p = layer == 0 ? p.in[0] : xw; E.xin_s = layer == 0 ? p.in[1] : xw + (size_t)MP * DM; E.xw = xw;
            E.modl = (const float*)(ws + WS_MOD) + (size_t)layer * 3072; E.ng_next = layer < 3 ? p.in[9] + (size_t)(layer + 1) * 1024 : nullptr;
            E.aprime = (bf16_t*)(ws + WS_APRIME); E.ssq = (float*)(ws + WS_SSQ) + (size_t)(layer + 1) * 17408;
            pg8::gemm_phase<EpiOut, pg8::MainSched>(lds, S, E);
            if (part == 0) GSYNC();
        }
        if (blockIdx.x < 16) {
            asm volatile("s_waitcnt vmcnt(0)" ::: "memory");
            __syncthreads();
            if (threadIdx.x == 0) { __builtin_amdgcn_fence(__ATOMIC_RELEASE, "agent"); asm volatile("s_waitcnt vmcnt(0)" ::: "memory"); __hip_atomic_fetch_add(tailw + 64 * layer, 1u, __ATOMIC_RELAXED, __HIP_MEMORY_SCOPE_AGENT); }
        }
    }
    phase_final(p, 0, MP, 16);
    GSYNC();
    phase_final(p, MP, MT, 0);
}

extern "C" void kernel_launch(void* const* d_in, const int* in_sizes, int n_in, void* d_out, int out_size, void* d_ws, size_t ws_size, hipStream_t stream) {
    static int grid = 0;
    if (grid == 0) {
        if (n_in != 23 || ws_size < WS_END) { fprintf(stderr, "kernel_launch: unexpected n_in %d or ws_size %zu (need %zu)\n", n_in, ws_size, (size_t)WS_END); grid = -1; return; }
        int dev = 0, cus = 0, per_cu = 0;
        hipGetDevice(&dev);
        hipDeviceGetAttribute(&cus, hipDeviceAttributeMultiprocessorCount, dev);
        if (hipFuncSetAttribute((const void*)hybrid_fwd, hipFuncAttributeMaxDynamicSharedMemorySize, LDS_BYTES) != hipSuccess) { fprintf(stderr, "kernel_launch: hipFuncSetAttribute failed\n"); grid = -1; return; }
        if (hipOccupancyMaxActiveBlocksPerMultiprocessor(&per_cu, (const void*)hybrid_fwd, 512, LDS_BYTES) != hipSuccess || per_cu < 1) { fprintf(stderr, "kernel_launch: occupancy query gave %d\n", per_cu); (void)hipGetLastError(); per_cu = 1; }
        grid = cus * 1;
    }
    if (grid < 0) return;
    Params p{};
    for (int i = 0; i < 23; ++i) p.in[i] = (const float*)d_in[i];
    p.out = (float*)d_out; p.ws = (unsigned char*)d_ws;
    unsigned char* ws = (unsigned char*)d_ws;
    int nj = 0, tb = 0;
    auto add = [&](const float* src, size_t dst_off, int K, int N, int Npad) {
        WJob& w = p.wj[nj++]; w.src = src; w.dst = (bf16_t*)(ws + dst_off); w.K = K; w.N = N; w.tiles_n = Npad / 64; w.tile_begin = tb; tb += (K / 64) * (Npad / 64);
    };
    for (int i = 0; i < 4; ++i) add(p.in[7] + (size_t)i * 1024 * 3072, WS_WT_ADA + (size_t)i * 3072 * 1024 * 2, 1024, 3072, 3072);
    for (int j = 0; j < 2; ++j) add(p.in[10] + (size_t)j * 1024 * 6176, WS_WT_SSD_IN + (size_t)j * 6400 * 1024 * 2, 1024, 6176, 6400);
    for (int j = 0; j < 2; ++j) add(p.in[18] + (size_t)j * 1024 * 4096, WS_WT_POOL_IN + (size_t)j * 4096 * 1024 * 2, 1024, 4096, 4096);
    for (int j = 0; j < 2; ++j) add(p.in[17] + (size_t)j * 2048 * 1024, WS_WT_SSD_OUT + (size_t)j * 1024 * 2048 * 2, 2048, 1024, 1024);
    for (int j = 0; j < 2; ++j) add(p.in[21] + (size_t)j * 2048 * 1024, WS_WT_POOL_OUT + (size_t)j * 1024 * 2048 * 2, 2048, 1024, 1024);
    for (int q = 0; q < 8; ++q) add(p.in[19] + (size_t)q * 512 * 512, WS_WT_POOL_G + (size_t)q * 512 * 512 * 2, 512, 512, 512);
    p.wtiles = tb;
    if (hipMemsetAsync(ws + WS_BAR, 0, 16384, stream) != hipSuccess) { fprintf(stderr, "kernel_launch: memset of the barrier words failed\n"); return; }
    void* args[] = {&p};
    hipError_t e = hipLaunchCooperativeKernel((const void*)hybrid_fwd, dim3(grid), dim3(512), args, LDS_BYTES, stream);
    if (e != hipSuccess) fprintf(stderr, "cooperative launch failed: %s (grid %d)\n", hipGetErrorString(e), grid);
}
```

```cpp
#include <hip/hip_runtime.h>
#include <hip/hip_cooperative_groups.h>
#include <cstdio>
namespace cg = cooperative_groups;

#ifndef REP_PROMPT
#define REP_PROMPT 1
#endif
#define LAS __attribute__((address_space(3)))
typedef unsigned short bf16_t;
typedef short bf16x8 __attribute__((ext_vector_type(8)));
typedef float f32x4 __attribute__((ext_vector_type(4)));
typedef float f32x16 __attribute__((ext_vector_type(16)));
typedef unsigned u32x4 __attribute__((ext_vector_type(4)));
typedef unsigned u32x2 __attribute__((ext_vector_type(2)));
typedef float f32x2 __attribute__((ext_vector_type(2)));

constexpr int MP = 16384, MT = 17408, DM = 1024;
constexpr int ZXW = 6144;
constexpr size_t O_SSM_P = 17825792, O_CONV_P = 22020096, O_POOL_P = 22216704, O_SSM_S = 22708224, O_CONV_S = 89817088, O_POOL_S = 92962816;

constexpr size_t WS_WT_SSD_IN = 0;
constexpr size_t WS_WT_SSD_OUT = WS_WT_SSD_IN + 2ull * 6400 * 1024 * 2;
constexpr size_t WS_WT_POOL_IN = WS_WT_SSD_OUT + 2ull * 1024 * 2048 * 2;
constexpr size_t WS_WT_POOL_G = WS_WT_POOL_IN + 2ull * 4096 * 1024 * 2;
constexpr size_t WS_WT_POOL_OUT = WS_WT_POOL_G + 2ull * 2048 * 512 * 2;
constexpr size_t WS_WT_ADA = WS_WT_POOL_OUT + 2ull * 1024 * 2048 * 2;
constexpr size_t WS_AC = WS_WT_ADA + 12288ull * 1024 * 2;
constexpr size_t WS_SHIFTA = WS_AC + 256ull * 1024 * 2;
constexpr size_t WS_MOD = WS_SHIFTA + 4ull * 256 * 1024 * 2;
constexpr size_t WS_SB = WS_MOD + 136ull * 12288 * 4;
constexpr size_t WS_APRIME = WS_SB + 4ull * 136 * 6400 * 4;
constexpr size_t WS_SSQ = WS_APRIME + 17408ull * 1024 * 2;
constexpr size_t WS_XW = WS_SSQ + 17408ull * 16 * 4;
constexpr size_t WS_ZX = WS_XW + 17408ull * 1024 * 4;
constexpr size_t WS_DTRAW = WS_ZX + 17408ull * 6144 * 2;
constexpr size_t WS_YG = WS_DTRAW + 17408ull * 32 * 4;
constexpr size_t WS_A2 = WS_YG + 17408ull * 2048 * 2;
constexpr size_t WS_BAR = WS_A2 + 17408ull * 2048 * 2;
constexpr size_t WS_END = WS_BAR + 16384;

constexpr int LDS_XB = 147712;
constexpr int LDS_BYTES = 147728;

struct WJob { const float* src; bf16_t* dst; int K, N, tiles_n, tile_begin; };
constexpr int NWJ = 20;
struct Params {
    const float* in[23];
    float* out;
    unsigned char* ws;
    WJob wj[NWJ];
    int wtiles; int pad0;
};

__device__ __forceinline__ unsigned cvt_pk_bf16(float lo, float hi) { unsigned r; asm("v_cvt_pk_bf16_f32 %0, %1, %2" : "=v"(r) : "v"(lo), "v"(hi)); return r; }
__device__ __forceinline__ float bf_lo(unsigned u) { return __uint_as_float(u << 16); }
__device__ __forceinline__ float bf_hi(unsigned u) { return __uint_as_float(u & 0xffff0000u); }
__device__ __forceinline__ float bf2f(bf16_t b) { return __uint_as_float(((unsigned)b) << 16); }
__device__ __forceinline__ float silu_f(float v) { return v * __builtin_amdgcn_rcpf(1.f + __expf(-v)); }
__device__ __forceinline__ f32x2 silu2(f32x2 v) { const f32x2 e = v * (-1.44269504f); f32x2 d; d.x = __builtin_amdgcn_exp2f(e.x); d.y = __builtin_amdgcn_exp2f(e.y); d = d + 1.f; f32x2 r; r.x = __builtin_amdgcn_rcpf(d.x); r.y = __builtin_amdgcn_rcpf(d.y); return v * r; }
__device__ __forceinline__ float softplus_f(float v) { return v > 20.f ? v : log1pf(__expf(v)); }
__device__ __forceinline__ int otid() { int t = threadIdx.x; asm volatile("" : "+v"(t)); return t; }
__device__ __forceinline__ int row_b(int r) { return r < MP ? (r >> 11) : 8 + ((r - MP) >> 3); }
__device__ __forceinline__ u32x4 pack8(f32x4 a, f32x4 b) { u32x4 r; r.x = cvt_pk_bf16(a.x, a.y); r.y = cvt_pk_bf16(a.z, a.w); r.z = cvt_pk_bf16(b.x, b.y); r.w = cvt_pk_bf16(b.z, b.w); return r; }

namespace pg8 {
constexpr int BM = 256, BK = 64, HALF = 128, HTB = HALF * BK * 2, STAGE_BYTES = 8 * HTB, NXCD = 8, WGM = 8;
__device__ __forceinline__ int lds_byte(int r, int c) { const int st = (r >> 4) * 2 + (c >> 5), rr = r & 15, cc = c & 31, ob = rr * 64 + cc * 2; return st * 1024 + (ob ^ (((ob >> 9) & 1) << 5)); }
__device__ __forceinline__ void stage_rc(int b, int& R, int& C) { const int st = b / 1024, sb = b % 1024, swz = sb ^ (((sb >> 9) & 1) << 5); R = (st >> 1) * 16 + swz / 64; C = (st & 1) * 32 + (swz % 64) / 2; }
__device__ __forceinline__ int perm32(int rho) { const int n = rho >> 4, i = rho & 15; return 8 * (i >> 2) + 4 * n + (i & 3); }

struct Unit { int pm, pn, q; const char* A; const char* B; };

__device__ __forceinline__ void static_unit(int L, int nM, int nN, int& pm, int& pn) {
    const int nwg = nM * nN;
    int wgid = L; { const int q = nwg / NXCD, r = nwg % NXCD, xcd = wgid % NXCD, off = wgid / NXCD; wgid = (xcd < r ? xcd * (q + 1) : r * (q + 1) + (xcd - r) * q) + off; }
    const int nig = WGM * nN, gid = wgid / nig, fm = gid * WGM, gsz = (nM - fm) < WGM ? (nM - fm) : WGM;
    pm = fm + ((wgid % nig) % gsz); pn = (wgid % nig) / gsz;
}
struct MainSched {
    int nM, nN, nwg, G, c, lda, ldb, K, gsh, single;
    const char* A; const char* Bt;
    __device__ void init(int M, int N, int K_, int lda_, int ldb_, const void* A_, const void* Bt_, int gsh_, int single_ = 0) {
        nM = M / BM; nN = N / BM; nwg = nM * nN; G = (int)gridDim.x; c = (int)blockIdx.x; lda = lda_; ldb = ldb_; K = K_; A = (const char*)A_; Bt = (const char*)Bt_; gsh = gsh_; single = single_;
    }
    __device__ bool next(int i, Unit& u) const {
        if (single) { if (i > 0 || c >= 16) return false; u.pm = 64 + (c >> 2); u.pn = c & 3; }
        else { const long L = (long)i * G + c; if (L >= nwg) return false; static_unit((int)L, nM, nN, u.pm, u.pn); }
        u.q = 0;
        u.A = A + ((size_t)u.pm * BM * lda + (size_t)(u.pn >> gsh) * 512) * 2;
        u.B = Bt + (size_t)u.pn * BM * ldb * 2;
        return true;
    }
    __device__ __forceinline__ void a_ready(const Unit&) const {}
};
struct InSched {
    int nN, nP, E, nskip, c, r0, cnt, lda, ldb, K;
    const char* A; const char* Bt; unsigned* tail; unsigned* tmo;
    __device__ void init(int N, const void* A_, const void* Bt_, unsigned* tail_, unsigned* tmo_) {
        nN = N / BM; nP = 64 * nN; c = (int)blockIdx.x; lda = 1024; ldb = 1024; K = 1024; A = (const char*)A_; Bt = (const char*)Bt_; tail = tail_; tmo = tmo_;
        nskip = tail_ != nullptr ? 32 : 0; E = nskip + 4 * nN; r0 = (tail_ != nullptr && c < 16) ? 2 : 0;
        const int tot = (nP - c + 255) / 256; cnt = tot - r0 > 0 ? tot - r0 : 0;
    }
    __device__ bool next(int i, Unit& u) const {
        if (i < cnt) static_unit((i + r0) * 256 + c, 64, nN, u.pm, u.pn);
        else {
            if (c < 16) return false;
            const int e = 255 - c + 240 * (i - cnt); if (e >= E) return false;
            if (e < nskip) static_unit(e < 16 ? e : 256 + (e - 16), 64, nN, u.pm, u.pn);
            else { const int sidx = e - nskip; u.pm = 64 + sidx / nN; u.pn = sidx - (sidx / nN) * nN; }
        }
        u.q = 0;
        u.A = A + (size_t)u.pm * BM * 1024 * 2; u.B = Bt + (size_t)u.pn * BM * 1024 * 2;
        return true;
    }
    __device__ __forceinline__ void a_ready(const Unit& u) const {
        if (tail == nullptr || u.pm < 64) return;
        if (threadIdx.x < 64) {
            unsigned polls = 0;
            while ((unsigned)__builtin_amdgcn_readfirstlane(__hip_atomic_load(tail, __ATOMIC_RELAXED, __HIP_MEMORY_SCOPE_AGENT)) < 16u) {
                __builtin_amdgcn_s_sleep(2);
                if ((++polls & 255u) == 0u) { if (__builtin_amdgcn_readfirstlane(__hip_atomic_load(tmo, __ATOMIC_RELAXED, __HIP_MEMORY_SCOPE_AGENT)) != 0u) break; if (polls > (1u << 22)) { if (threadIdx.x == 0) atomicAdd(tmo, 1u); break; } }
            }
            __builtin_amdgcn_fence(__ATOMIC_ACQUIRE, "agent");
            asm volatile("s_waitcnt vmcnt(0)" ::: "memory");
        }
        asm volatile("" ::: "memory"); __builtin_amdgcn_s_barrier(); asm volatile("" ::: "memory");
    }
};
struct SmallSched {
    int mode, G, c, lda, ldb, K;
    const char* A0; const char* ada; const char* ssd_in; const char* pool_in;
    __device__ bool next(int i, Unit& u) const {
        const long L = (long)i * G + c;
        u.pm = 0;
        if (mode == 0) { if (L >= 48) return false; u.pn = (int)L; u.q = 0; u.A = A0; u.B = ada + (size_t)u.pn * BM * 1024 * 2; return true; }
        if (L >= 82) return false;
        int l = (int)L, q, pn;
        if (l < 25) { q = 0; pn = l; } else if (l < 41) { q = 1; pn = l - 25; } else if (l < 66) { q = 2; pn = l - 41; } else { q = 3; pn = l - 66; }
        u.q = q; u.pn = pn; u.A = A0 + (size_t)q * 256 * 1024 * 2;
        u.B = ((q & 1) ? pool_in + (size_t)(q >> 1) * 4096 * 1024 * 2 : ssd_in + (size_t)(q >> 1) * 6400 * 1024 * 2) + (size_t)pn * BM * 1024 * 2;
        return true;
    }
    __device__ __forceinline__ void a_ready(const Unit&) const {}
};

template <class Epi, class Sched>
__device__ __forceinline__ void gemm_phase(LAS unsigned char* lds, const Sched& S, const Epi& E) {
    const int tid = otid(), wid = __builtin_amdgcn_readfirstlane(tid >> 6), lane = tid & 63, wr = wid >> 2, wc = wid & 3, fr = lane & 15, fq = lane >> 4;
    const int K = S.K, nt = K / BK;
    unsigned voffA[2], voffB[2];
#pragma unroll
    for (int i = 0; i < 2; ++i) { int R, C; stage_rc(tid * 16 + i * 8192, R, C); const int Rb = Epi::PERM ? ((R & ~31) + perm32(R & 31)) : R;
        voffA[i] = (unsigned)(R * S.lda + C) * 2u; voffB[i] = (unsigned)(Rb * S.ldb + C) * 2u; }
    const size_t kstep = (size_t)(BK * 2);
    const size_t hstepA = (size_t)HALF * S.lda * 2, hstepB = (size_t)HALF * S.ldb * 2;
    const unsigned ldsw = (unsigned)wid * 1024u;
    const int aoff = lds_byte(wr * 64 + fr, fq * 8), boff = lds_byte(wc * 32 + fr, fq * 8);
#define PG8_SA(b, h) (((b) * 2 + (h)) * HTB)
#define PG8_SB(b, h) ((4 + (b) * 2 + (h)) * HTB)
#define PG8_STAGE(bufoff, gbase, voff) do { _Pragma("unroll") for (int _i = 0; _i < 2; ++_i) \
        __builtin_amdgcn_global_load_lds((const unsigned*)((const char*)(gbase) + (voff)[_i]), (LAS unsigned*)(lds + (bufoff) + ldsw + _i * 8192), 16, 0, 0); } while (0)
#define PG8_LDA(dst, b, h) do { _Pragma("unroll") for (int m = 0; m < 4; ++m) _Pragma("unroll") for (int k = 0; k < 2; ++k) dst[m][k] = *(const LAS bf16x8*)(lds + PG8_SA(b, h) + aoff + m * 2048 + k * 1024); } while (0)
#define PG8_LDB(dst, b, h) do { _Pragma("unroll") for (int n = 0; n < 2; ++n) _Pragma("unroll") for (int k = 0; k < 2; ++k) dst[n][k] = *(const LAS bf16x8*)(lds + PG8_SB(b, h) + boff + n * 2048 + k * 1024); } while (0)
#define PG8_MMA(ai, bj, At, Bt) do { __builtin_amdgcn_s_setprio(1); _Pragma("unroll") for (int m = 0; m < 4; ++m) _Pragma("unroll") for (int n = 0; n < 2; ++n) _Pragma("unroll") for (int k = 0; k < 2; ++k) \
        acc[ai][bj][m][n] = __builtin_amdgcn_mfma_f32_16x16x32_bf16(Bt[n][k], At[m][k], acc[ai][bj][m][n], 0, 0, 0); __builtin_amdgcn_s_setprio(0); } while (0)
#define PG8_WAIT_V(n) asm volatile("s_waitcnt vmcnt(" #n ")" ::: "memory")
#define PG8_WAIT_L(n) asm volatile("s_waitcnt lgkmcnt(" #n ")" ::: "memory")
#define PG8_BAR __builtin_amdgcn_s_barrier()
#define PG8_SCHED __builtin_amdgcn_sched_barrier(0)
    Unit cur, nxt; int ui = 0;
    if (!S.next(0, cur)) return;
    f32x4 acc[2][2][4][2];
#pragma unroll
    for (int a = 0; a < 2; ++a)
#pragma unroll
        for (int b = 0; b < 2; ++b)
#pragma unroll
            for (int m = 0; m < 4; ++m)
#pragma unroll
                for (int n = 0; n < 2; ++n) acc[a][b][m][n] = (f32x4){0.f, 0.f, 0.f, 0.f};
    bf16x8 At[4][2], B0[2][2], B1[2][2];
    const char* cA = cur.A; const char* cB = cur.B;
    S.a_ready(cur);
    PG8_STAGE(PG8_SB(0, 0), cB, voffB); PG8_STAGE(PG8_SA(0, 0), cA, voffA); PG8_STAGE(PG8_SB(0, 1), cB + hstepB, voffB); PG8_STAGE(PG8_SA(0, 1), cA + hstepA, voffA);
    if (wr == 1) PG8_BAR;
    PG8_WAIT_V(4); PG8_BAR;
    PG8_STAGE(PG8_SB(1, 0), cB + kstep, voffB); PG8_STAGE(PG8_SA(1, 0), cA + kstep, voffA); PG8_STAGE(PG8_SB(1, 1), cB + hstepB + kstep, voffB);
    PG8_WAIT_V(6); PG8_BAR;
    for (;;) {
        const bool has_next = S.next(ui + 1, nxt);
        const char* nA = has_next ? nxt.A : cA; const char* nB = has_next ? nxt.B : cB;
        for (int t = 0; t < nt; t += 2) {
            const bool last = (t == nt - 2);
            const char* a1 = cA + (size_t)(t + 1) * kstep;
            const char* a2 = last ? nA : cA + (size_t)(t + 2) * kstep; const char* b2 = last ? nB : cB + (size_t)(t + 2) * kstep;
            const char* a3 = a2 + kstep; const char* b3 = b2 + kstep;
            if (last && has_next) S.a_ready(nxt);
            PG8_LDB(B0, 0, 0); PG8_SCHED; PG8_LDA(At, 0, 0); PG8_STAGE(PG8_SA(1, 1), a1 + hstepA, voffA);
            PG8_WAIT_L(8); PG8_BAR; PG8_WAIT_L(0); PG8_MMA(0, 0, At, B0); PG8_BAR; PG8_SCHED;
            PG8_LDB(B1, 0, 1); PG8_STAGE(PG8_SB(0, 0), b2, voffB);
            PG8_BAR; PG8_WAIT_L(0); PG8_MMA(0, 1, At, B1); PG8_BAR;
            PG8_LDA(At, 0, 1); PG8_STAGE(PG8_SA(0, 0), a2, voffA);
            PG8_BAR; PG8_WAIT_L(0); PG8_MMA(1, 0, At, B0); PG8_BAR; PG8_SCHED;
            PG8_STAGE(PG8_SB(0, 1), b2 + hstepB, voffB);
            PG8_WAIT_V(6); PG8_BAR; PG8_MMA(1, 1, At, B1); PG8_BAR;
            PG8_LDB(B0, 1, 0); PG8_SCHED; PG8_LDA(At, 1, 0); PG8_STAGE(PG8_SA(0, 1), a2 + hstepA, voffA);
            PG8_WAIT_L(8); PG8_BAR; PG8_WAIT_L(0); PG8_MMA(0, 0, At, B0); PG8_BAR; PG8_SCHED;
            PG8_LDB(B1, 1, 1); PG8_STAGE(PG8_SB(1, 0), b3, voffB);
            PG8_BAR; PG8_WAIT_L(0); PG8_MMA(0, 1, At, B1); PG8_BAR;
            PG8_LDA(At, 1, 1); PG8_STAGE(PG8_SA(1, 0), a3, voffA);
            PG8_BAR; PG8_WAIT_L(0); PG8_MMA(1, 0, At, B0); PG8_BAR; PG8_SCHED;
            PG8_STAGE(PG8_SB(1, 1), b3 + hstepB, voffB);
            PG8_WAIT_V(6); PG8_BAR; PG8_MMA(1, 1, At, B1); PG8_BAR;
        }
        E(acc, cur, wr, wc, fr, fq);
        if (!has_next) break;
#pragma unroll
        for (int a = 0; a < 2; ++a)
#pragma unroll
            for (int b = 0; b < 2; ++b)
#pragma unroll
                for (int m = 0; m < 4; ++m)
#pragma unroll
                    for (int n = 0; n < 2; ++n) acc[a][b][m][n] = (f32x4){0.f, 0.f, 0.f, 0.f};
        cur = nxt; cA = nA; cB = nB; ++ui;
    }
    PG8_WAIT_V(0);
    if (wr == 0) PG8_BAR;
    PG8_BAR;
#undef PG8_SA
#undef PG8_SB
#undef PG8_STAGE
#undef PG8_LDA
#undef PG8_LDB
#undef PG8_MMA
#undef PG8_WAIT_V
#undef PG8_WAIT_L
#undef PG8_BAR
#undef PG8_SCHED
}
}
using pg8::Unit;

struct EpiIn {
    static constexpr bool PERM = true;
    const float* ssq; const float* sb; bf16_t* out; int ldo, nbf; float* dtraw;
    template <bool UNI>
    __device__ __forceinline__ void body(const f32x4 (&acc)[2][2][4][2], const Unit& u, int wr, int wc, int fr, int fq) const {
        const int row0 = u.pm * 256 + wr * 64 + fr, colt = u.pn * 256 + wc * 32 + 8 * fq;
        f32x4 ub[2][2];
        if (UNI) {
            const float* sbr = sb + (size_t)(u.pm >> 3) * 6400;
#pragma unroll
            for (int bj = 0; bj < 2; ++bj) { const int c = colt + bj * 128; if (c < nbf + 32) { ub[bj][0] = *(const f32x4*)(sbr + c); ub[bj][1] = *(const f32x4*)(sbr + c + 4); } }
        }
        float rsv[2][4];
#pragma unroll
        for (int ai = 0; ai < 2; ++ai)
#pragma unroll
            for (int m = 0; m < 4; ++m) rsv[ai][m] = ssq[row0 + ai * 128 + m * 16];
#pragma unroll
        for (int ai = 0; ai < 2; ++ai) {
            f32x4 nb[4][2][2];
            if (!UNI) {
#pragma unroll
                for (int m = 0; m < 4; ++m) {
                    const float* sbr = sb + (size_t)row_b(row0 + ai * 128 + m * 16) * 6400;
#pragma unroll
                    for (int bj = 0; bj < 2; ++bj) { const int c = colt + bj * 128; if (c < nbf + 32) { nb[m][bj][0] = *(const f32x4*)(sbr + c); nb[m][bj][1] = *(const f32x4*)(sbr + c + 4); } }
                }
            }
#pragma unroll
            for (int m = 0; m < 4; ++m) {
                const int r = row0 + ai * 128 + m * 16;
                const float rstd = rsqrtf(rsv[ai][m] * (1.f / 1024.f) + 1e-6f);
#pragma unroll
                for (int bj = 0; bj < 2; ++bj) {
                    const int c = colt + bj * 128;
                    if (c < nbf + 32) {
                        f32x4 b0, b1;
                        if (UNI) { b0 = ub[bj][0]; b1 = ub[bj][1]; } else { b0 = nb[m][bj][0]; b1 = nb[m][bj][1]; }
                        const f32x4 v0 = acc[ai][bj][m][0] * rstd + b0, v1 = acc[ai][bj][m][1] * rstd + b1;
                        if (c < nbf) *(u32x4*)(out + (size_t)r * ldo + c) = pack8(v0, v1);
                        else if (dtraw != nullptr) { float* dp = dtraw + (size_t)r * 32 + (c - nbf); *(f32x4*)dp = v0; *(f32x4*)(dp + 4) = v1; }
                    }
                }
            }
        }
    }
    __device__ __forceinline__ void operator()(const f32x4 (&acc)[2][2][4][2], const Unit& u, int wr, int wc, int fr, int fq) const {
        asm volatile("" : "+v"(fr), "+v"(fq));
        if (u.pm < 64) body<true>(acc, u, wr, wc, fr, fq); else body<false>(acc, u, wr, wc, fr, fq);
    }
};
struct EpiOut {
    static constexpr bool PERM = true;
    const float* xin_p; const float* xin_s; float* xw; const float* modl; const float* ng_next; bf16_t* aprime; float* ssq;
    template <bool UNI>
    __device__ __forceinline__ void body(const f32x4 (&acc)[2][2][4][2], const Unit& u, int wr, int wc, int fr, int fq) const {
        const int row0 = u.pm * 256 + wr * 64 + fr, colt = u.pn * 256 + wc * 32 + 8 * fq;
        const bool has_next = ng_next != nullptr;
        f32x4 ug[2][2], us[2][2], uw[2][2];
#pragma unroll
        for (int bj = 0; bj < 2; ++bj) {
            const int c = colt + bj * 128;
            if (has_next) { uw[bj][0] = *(const f32x4*)(ng_next + c); uw[bj][1] = *(const f32x4*)(ng_next + c + 4); }
            if (UNI) {
                const float* mb = modl + (size_t)(u.pm >> 3) * 12288;
                ug[bj][0] = *(const f32x4*)(mb + 2048 + c) + 1.f; ug[bj][1] = *(const f32x4*)(mb + 2048 + c + 4) + 1.f;
                if (has_next) { us[bj][0] = (*(const f32x4*)(mb + 4096 + c) + 1.f) * uw[bj][0]; us[bj][1] = (*(const f32x4*)(mb + 4096 + c + 4) + 1.f) * uw[bj][1]; }
            }
        }
#pragma unroll
        for (int ai = 0; ai < 2; ++ai)
#pragma unroll
            for (int mp = 0; mp < 2; ++mp) {
                f32x4 xv[2][2][2];
#pragma unroll
                for (int mm = 0; mm < 2; ++mm) {
                    const int r = row0 + ai * 128 + (mp * 2 + mm) * 16;
                    const float* xr = r < MP ? xin_p + (size_t)r * DM : xin_s + (size_t)(r - MP) * DM;
#pragma unroll
                    for (int bj = 0; bj < 2; ++bj) { xv[mm][bj][0] = *(const f32x4*)(xr + colt + bj * 128); xv[mm][bj][1] = *(const f32x4*)(xr + colt + bj * 128 + 4); }
                }
#pragma unroll
                for (int mm = 0; mm < 2; ++mm) {
                    const int m = mp * 2 + mm;
                    const int r = row0 + ai * 128 + m * 16;
                    const float* mb = modl + (size_t)row_b(r) * 12288;
                    float ss = 0.f;
#pragma unroll
                    for (int bj = 0; bj < 2; ++bj) {
                        const int c = colt + bj * 128;
                        f32x4 g0, g1;
                        if (UNI) { g0 = ug[bj][0]; g1 = ug[bj][1]; } else { g0 = *(const f32x4*)(mb + 2048 + c) + 1.f; g1 = *(const f32x4*)(mb + 2048 + c + 4) + 1.f; }
                        const f32x4 n0 = xv[mm][bj][0] + g0 * acc[ai][bj][m][0], n1 = xv[mm][bj][1] + g1 * acc[ai][bj][m][1];
                        *(f32x4*)(xw + (size_t)r * DM + c) = n0; *(f32x4*)(xw + (size_t)r * DM + c + 4) = n1;
                        ss += (n0.x * n0.x + n0.y * n0.y) + (n0.z * n0.z + n0.w * n0.w) + (n1.x * n1.x + n1.y * n1.y) + (n1.z * n1.z + n1.w * n1.w);
                        if (has_next) {
                            f32x4 s0, s1;
                            if (UNI) { s0 = us[bj][0]; s1 = us[bj][1]; } else { s0 = (*(const f32x4*)(mb + 4096 + c) + 1.f) * uw[bj][0]; s1 = (*(const f32x4*)(mb + 4096 + c + 4) + 1.f) * uw[bj][1]; }
                            *(u32x4*)(aprime + (size_t)r * DM + c) = pack8(n0 * s0, n1 * s1);
                        }
                    }
                    ss += __shfl_xor(ss, 16); ss += __shfl_xor(ss, 32);
                    if (fq == 0) atomicAdd(ssq + r, ss);
                }
            }
    }
    __device__ __forceinline__ void operator()(const f32x4 (&acc)[2][2][4][2], const Unit& u, int wr, int wc, int fr, int fq) const {
        asm volatile("" : "+v"(fr), "+v"(fq));
        if (u.pm < 64) body<true>(acc, u, wr, wc, fr, fq); else body<false>(acc, u, wr, wc, fr, fq);
    }
};
struct EpiGrp {
    static constexpr bool PERM = true;
    const bf16_t* uz; const float* chs; bf16_t* out;
    __device__ __forceinline__ void operator()(const f32x4 (&acc)[2][2][4][2], const Unit& u, int wr, int wc, int fr, int fq) const {
        asm volatile("" : "+v"(fr), "+v"(fq));
        const int row0 = u.pm * 256 + wr * 64 + fr, colt = u.pn * 256 + wc * 32 + 8 * fq;
        f32x4 cs[2][2];
#pragma unroll
        for (int bj = 0; bj < 2; ++bj) { cs[bj][0] = *(const f32x4*)(chs + colt + bj * 128); cs[bj][1] = *(const f32x4*)(chs + colt + bj * 128 + 4); }
#pragma unroll
        for (int ai = 0; ai < 2; ++ai) {
            u32x4 zz[4][2];
#pragma unroll
            for (int m = 0; m < 4; ++m)
#pragma unroll
                for (int bj = 0; bj < 2; ++bj) zz[m][bj] = *(const u32x4*)(uz + (size_t)(row0 + ai * 128 + m * 16) * 4096 + 2048 + colt + bj * 128);
#pragma unroll
            for (int m = 0; m < 4; ++m) {
                const int r = row0 + ai * 128 + m * 16;
#pragma unroll
                for (int bj = 0; bj < 2; ++bj) {
                    const int c = colt + bj * 128;
                    const u32x4 z = zz[m][bj];
                    const f32x2 a = silu2((f32x2){bf_lo(z.x), bf_hi(z.x)}), b = silu2((f32x2){bf_lo(z.y), bf_hi(z.y)}), cc = silu2((f32x2){bf_lo(z.z), bf_hi(z.z)}), d = silu2((f32x2){bf_lo(z.w), bf_hi(z.w)});
                    const f32x4 z0 = {a.x, a.y, b.x, b.y}, z1 = {cc.x, cc.y, d.x, d.y};
                    *(u32x4*)(out + (size_t)r * 2048 + c) = pack8(acc[ai][bj][m][0] * cs[bj][0] * z0, acc[ai][bj][m][1] * cs[bj][1] * z1);
                }
            }
        }
    }
};
struct EpiSmall {
    static constexpr bool PERM = true;
    int mode; float* mod; const float* ada_b; bf16_t* shiftA; float* sb;
    __device__ __forceinline__ void operator()(const f32x4 (&acc)[2][2][4][2], const Unit& u, int wr, int wc, int fr, int fq) const {
        asm volatile("" : "+v"(fr), "+v"(fq));
        const int row0 = wr * 64 + fr, colt = u.pn * 256 + wc * 32 + 8 * fq;
#pragma unroll
        for (int ai = 0; ai < 2; ++ai)
#pragma unroll
            for (int m = 0; m < 4; ++m) {
                const int r = row0 + ai * 128 + m * 16;
                if (r < 136) {
#pragma unroll
                    for (int bj = 0; bj < 2; ++bj) {
                        const int c = colt + bj * 128;
                        if (mode == 0) {
                            const f32x4 v0 = acc[ai][bj][m][0] + *(const f32x4*)(ada_b + c), v1 = acc[ai][bj][m][1] + *(const f32x4*)(ada_b + c + 4);
                            *(f32x4*)(mod + (size_t)r * 12288 + c) = v0; *(f32x4*)(mod + (size_t)r * 12288 + c + 4) = v1;
                            const int li = c / 3072, cc = c - li * 3072;
                            if (cc < 1024) *(u32x4*)(shiftA + ((size_t)li * 256 + r) * 1024 + cc) = pack8(v0, v1);
                        } else {
                            float* sp = sb + ((size_t)u.q * 136 + r) * 6400 + c;
                            *(f32x4*)sp = acc[ai][bj][m][0]; *(f32x4*)(sp + 4) = acc[ai][bj][m][1];
                        }
                    }
                }
            }
    }
};

__device__ void phase_prep0(const Params& p, LAS unsigned char* lds) {
    LAS float* tl = (LAS float*)lds;
    const int tid = otid();
    for (int tile = blockIdx.x; tile < p.wtiles; tile += gridDim.x) {
        int j = 0;
#pragma unroll 1
        for (int q = 1; q < NWJ; ++q) if (tile >= p.wj[q].tile_begin) j = q;
        const WJob job = p.wj[j];
        const int lt = tile - job.tile_begin, tk = lt / job.tiles_n, tn = lt - tk * job.tiles_n, k0 = tk * 64, n0 = tn * 64;
        {
            const int kk = tid >> 3, nn = (tid & 7) * 8;
            f32x4 a = (f32x4){0.f, 0.f, 0.f, 0.f}, b = a;
            if (n0 + nn < job.N) { const float* sp = job.src + (size_t)(k0 + kk) * job.N + n0 + nn; a = *(const f32x4*)sp; b = *(const f32x4*)(sp + 4); }
            LAS float* d = tl + kk * 65 + nn;
            d[0] = a.x; d[1] = a.y; d[2] = a.z; d[3] = a.w; d[4] = b.x; d[5] = b.y; d[6] = b.z; d[7] = b.w;
        }
        __syncthreads();
        {
            const int n = tid >> 3, k8 = (tid & 7) * 8;
            const LAS float* s = tl + k8 * 65 + n;
            u32x4 o; o.x = cvt_pk_bf16(s[0], s[65]); o.y = cvt_pk_bf16(s[130], s[195]); o.z = cvt_pk_bf16(s[260], s[325]); o.w = cvt_pk_bf16(s[390], s[455]);
            *(u32x4*)(job.dst + (size_t)(n0 + n) * job.K + k0 + k8) = o;
        }
        __syncthreads();
    }
    bf16_t* ac = (bf16_t*)(p.ws + WS_AC);
    const int gt = blockIdx.x * 512 + tid, nth = gridDim.x * 512;
    for (int i = gt; i < 256 * 1024 / 8; i += nth) {
        const int r = i >> 7, c = (i & 127) * 8;
        u32x4 o = (u32x4){0u, 0u, 0u, 0u};
        if (r < 136) {
            const float* cp = r < 8 ? p.in[5] + (size_t)r * 1024 + c : p.in[6] + (size_t)(r - 8) * 1024 + c;
            const f32x4 a = *(const f32x4*)cp, b = *(const f32x4*)(cp + 4);
            o.x = cvt_pk_bf16(silu_f(a.x), silu_f(a.y)); o.y = cvt_pk_bf16(silu_f(a.z), silu_f(a.w)); o.z = cvt_pk_bf16(silu_f(b.x), silu_f(b.y)); o.w = cvt_pk_bf16(silu_f(b.z), silu_f(b.w));
        }
        *(u32x4*)(ac + (size_t)i * 8) = o;
    }
    { u32x4* sq = (u32x4*)(p.ws + WS_SSQ + 17408ull * 4); for (int i = gt; i < 4 * 17408 / 4; i += nth) sq[i] = (u32x4){0u, 0u, 0u, 0u}; }
    u32x4* sh = (u32x4*)(p.ws + WS_SHIFTA);
    for (int i = gt; i < 4 * 256 * 1024 / 8; i += nth) sh[i] = (u32x4){0u, 0u, 0u, 0u};
}

__device__ void phase_xprep(const Params& p) {
    const int tid_ = otid(), lane = tid_ & 63, wv = blockIdx.x * 8 + (tid_ >> 6), nw = gridDim.x * 8;
    const float* mod = (const float*)(p.ws + WS_MOD);
    bf16_t* ap = (bf16_t*)(p.ws + WS_APRIME);
    float* ssq = (float*)(p.ws + WS_SSQ);
    const float* ng = p.in[9];
    for (int r0 = wv * 2; r0 < MT; r0 += nw * 2) {
        f32x4 x[2][4];
#pragma unroll
        for (int h = 0; h < 2; ++h) {
            const int r = r0 + h;
            const float* xr = r < MP ? p.in[0] + (size_t)r * DM : p.in[1] + (size_t)(r - MP) * DM;
#pragma unroll
            for (int q = 0; q < 4; ++q) x[h][q] = *(const f32x4*)(xr + q * 256 + lane * 4);
        }
#pragma unroll
        for (int h = 0; h < 2; ++h) {
            const int r = r0 + h;
            const float* mb = mod + (size_t)row_b(r) * 12288 + 1024;
            float ss = 0.f;
#pragma unroll
            for (int q = 0; q < 4; ++q) {
                const int c = q * 256 + lane * 4;
                const f32x4 xv = x[h][q], sv = *(const f32x4*)(mb + c), g = *(const f32x4*)(ng + c);
                ss += (xv.x * xv.x + xv.y * xv.y) + (xv.z * xv.z + xv.w * xv.w);
                const f32x4 a = xv * g * (sv + 1.f);
                u32x2 o; o.x = cvt_pk_bf16(a.x, a.y); o.y = cvt_pk_bf16(a.z, a.w);
                *(u32x2*)(ap + (size_t)r * DM + c) = o;
            }
#pragma unroll
            for (int o = 1; o < 64; o <<= 1) ss += __shfl_xor(ss, o);
            if (lane == 0) ssq[r] = ss;
        }
    }
}

__device__ void phase_final(const Params& p, int r_begin, int r_end, int blk0) {
    if ((int)blockIdx.x < blk0) return;
    const int tid_ = otid(), lane = tid_ & 63, wv = ((int)blockIdx.x - blk0) * 8 + (tid_ >> 6), nw = ((int)gridDim.x - blk0) * 8;
    const float* xw = (const float*)(p.ws + WS_XW);
    const float* ssq = (const float*)(p.ws + WS_SSQ) + 4 * 17408;
    const float* fg = p.in[22];
    for (int r0 = r_begin + wv * 2; r0 < r_end; r0 += nw * 2) {
        f32x4 x[2][4];
#pragma unroll
        for (int h = 0; h < 2; ++h)
#pragma unroll
            for (int q = 0; q < 4; ++q) x[h][q] = *(const f32x4*)(xw + (size_t)(r0 + h) * DM + q * 256 + lane * 4);
#pragma unroll
        for (int h = 0; h < 2; ++h) {
            const int r = r0 + h;
            const float rstd = rsqrtf(ssq[r] * (1.f / 1024.f) + 1e-6f);
#pragma unroll
            for (int q = 0; q < 4; ++q) {
                const int c = q * 256 + lane * 4;
                const f32x4 g = *(const f32x4*)(fg + c);
                *(f32x4*)(p.out + (size_t)r * DM + c) = x[h][q] * rstd * g;
            }
        }
    }
}

__device__ void phase_ssdnorm(const Params& p, int j) {
    const int tid_ = otid(), lane = tid_ & 63, wv = blockIdx.x * 8 + (tid_ >> 6), nw = gridDim.x * 8;
    const bf16_t* yg = (const bf16_t*)(p.ws + WS_YG);
    bf16_t* a2 = (bf16_t*)(p.ws + WS_A2);
    const float* ng = p.in[16] + (size_t)j * 2048;
    for (int r0 = wv * 2; r0 < MT; r0 += nw * 2) {
        u32x4 vv[2][4];
#pragma unroll
        for (int h = 0; h < 2; ++h)
#pragma unroll
            for (int q = 0; q < 4; ++q) vv[h][q] = *(const u32x4*)(yg + (size_t)(r0 + h) * 2048 + q * 512 + lane * 8);
#pragma unroll
        for (int h = 0; h < 2; ++h)
#pragma unroll
            for (int q = 0; q < 4; ++q) {
                const int c = q * 512 + lane * 8;
                const u32x4 v = vv[h][q];
                f32x4 a, b;
                a.x = bf_lo(v.x); a.y = bf_hi(v.x); a.z = bf_lo(v.y); a.w = bf_hi(v.y); b.x = bf_lo(v.z); b.y = bf_hi(v.z); b.z = bf_lo(v.w); b.w = bf_hi(v.w);
                float ss = (a.x * a.x + a.y * a.y) + (a.z * a.z + a.w * a.w) + (b.x * b.x + b.y * b.y) + (b.z * b.z + b.w * b.w);
#pragma unroll
                for (int o = 1; o < 32; o <<= 1) ss += __shfl_xor(ss, o);
                const float rstd = rsqrtf(ss * (1.f / 256.f) + 1e-6f);
                const f32x4 g0 = *(const f32x4*)(ng + c), g1 = *(const f32x4*)(ng + c + 4);
                *(u32x4*)(a2 + (size_t)(r0 + h) * 2048 + c) = pack8(a * rstd * g0, b * rstd * g1);
            }
    }
}

__device__ void phase_pool(const Params& p, int j) {
    const bf16_t* uz = (const bf16_t*)(p.ws + WS_ZX);
    bf16_t* pooled = (bf16_t*)(p.ws + WS_YG);
    const int gt = blockIdx.x * 512 + otid(), nth = gridDim.x * 512;
    for (int u = gt; u < 131072 + 32768; u += nth) {
        int cv, row0, t0, R; const float* prev = nullptr; bool prompt;
        if (u < 131072) { cv = u & 255; const int run = (u >> 8) & 63, b = u >> 14; row0 = b * 2048; t0 = run * 32; R = 32; prompt = true; }
        else { const int v = u - 131072; cv = v & 255; const int b = v >> 8; row0 = MP + b * 8; t0 = 0; R = 8; prompt = false; prev = p.in[4] + ((size_t)(j * 128 + b) * 15) * 2048; }
        const int c = cv * 8, w = 2 << (c >> 9);
        float s[8];
#pragma unroll
        for (int i = 0; i < 8; ++i) s[i] = 0.f;
        auto getu = [&](int tt, float (&o)[8]) {
            if (tt >= 0) {
                const u32x4 v = *(const u32x4*)(uz + (size_t)(row0 + tt) * 4096 + c);
                o[0] = bf_lo(v.x); o[1] = bf_hi(v.x); o[2] = bf_lo(v.y); o[3] = bf_hi(v.y); o[4] = bf_lo(v.z); o[5] = bf_hi(v.z); o[6] = bf_lo(v.w); o[7] = bf_hi(v.w);
            } else if (!prompt) {
                const float* pp = prev + (size_t)(15 + tt) * 2048 + c;
                const f32x4 a = *(const f32x4*)pp, b = *(const f32x4*)(pp + 4);
                o[0] = a.x; o[1] = a.y; o[2] = a.z; o[3] = a.w; o[4] = b.x; o[5] = b.y; o[6] = b.z; o[7] = b.w;
            } else {
#pragma unroll
                for (int i = 0; i < 8; ++i) o[i] = 0.f;
            }
        };
        for (int i = 1; i < w; ++i) {
            float o[8]; getu(t0 - i, o);
#pragma unroll
            for (int k = 0; k < 8; ++k) s[k] += o[k];
        }
        for (int tb = t0; tb < t0 + R; tb += 4) {
            float cur[4][8], old[4][8];
#pragma unroll
            for (int k = 0; k < 4; ++k) { getu(tb + k, cur[k]); getu(tb + k - w + 1, old[k]); }
#pragma unroll
            for (int k = 0; k < 4; ++k) {
                const int t = tb + k;
                const float inv = 1.f / (float)(prompt ? min(w, t + 1) : w);
                f32x4 a, b;
#pragma unroll
                for (int i = 0; i < 8; ++i) s[i] += cur[k][i];
                a.x = s[0] * inv - cur[k][0]; a.y = s[1] * inv - cur[k][1]; a.z = s[2] * inv - cur[k][2]; a.w = s[3] * inv - cur[k][3];
                b.x = s[4] * inv - cur[k][4]; b.y = s[5] * inv - cur[k][5]; b.z = s[6] * inv - cur[k][6]; b.w = s[7] * inv - cur[k][7];
                *(u32x4*)(pooled + (size_t)(row0 + t) * 2048 + c) = pack8(a, b);
#pragma unroll
                for (int i = 0; i < 8; ++i) s[i] -= old[k][i];
            }
        }
    }
    for (int i = gt; i < 8 * 15 * 2048; i += nth) {
        const int ch = i & 2047, k = (i >> 11) % 15, b = (i >> 11) / 15;
        p.out[O_POOL_P + ((size_t)(j * 8 + b) * 15 + k) * 2048 + ch] = bf2f(uz[(size_t)(b * 2048 + 2033 + k) * 4096 + ch]);
    }
    for (int i = gt; i < 128 * 15 * 2048; i += nth) {
        const int ch = i & 2047, k = (i >> 11) % 15, b = (i >> 11) / 15;
        float v;
        if (k < 7) v = p.in[4][((size_t)(j * 128 + b) * 15 + 8 + k) * 2048 + ch];
        else v = bf2f(uz[(size_t)(MP + b * 8 + k - 7) * 4096 + ch]);
        p.out[O_POOL_S + ((size_t)(j * 128 + b) * 15 + k) * 2048 + ch] = v;
    }
}

constexpr int RS = 272;
constexpr int L_XT = 0, L_BN = 17408, L_BT = 52224, L_CN = 87040, L_HB = 121856, L_SM = 139264, L_CW = 141312;
__device__ __forceinline__ int xt_addr(int pr, int t) { return L_XT + pr * RS + ((((t >> 3) ^ (pr >> 1)) & 15) << 4) + (t & 7) * 2; }
__device__ __forceinline__ int bt_addr(int n, int t) { return L_BT + n * RS + ((((t >> 3) ^ (n >> 3)) & 15) << 4) + (t & 7) * 2; }
__device__ __forceinline__ f32x16 mfma32(bf16x8 a, bf16x8 b, f32x16 c) { return __builtin_amdgcn_mfma_f32_32x32x16_bf16(a, b, c, 0, 0, 0); }

#define OPQ(x) asm volatile("" : "+v"(x))
__device__ void ssd_prompt_item(const Params& p, int j, int b, int h, LAS unsigned char* lds) {
    const int tid0 = otid(), wid = __builtin_amdgcn_readfirstlane(tid0 >> 6), g = h >> 2;
    const char* zxc = (const char*)(p.ws + WS_ZX);
    const char* dtc = (const char*)(p.ws + WS_DTRAW);
    char* ygc = (char*)(p.ws + WS_YG);
    const int rowbase = b * 2048;
    LAS float* sm_acum = (LAS float*)(lds + L_SM);
    LAS float* sm_dt = sm_acum + 128;
    LAS float* sm_w = sm_acum + 256;
    LAS float* sm_ea = sm_acum + 384;
    LAS float* cw = (LAS float*)(lds + L_CW);
    const float Ah = -__expf(p.in[14][j * 32 + h]), Dh = p.in[15][j * 32 + h], dtb = p.in[13][j * 32 + h];
    const bool roleB = wid < 4;
    const int qq = wid >> 1, tt = qq ^ (qq >> 1), pt = wid & 1, hp = wid & 1, hn = wid >> 1;

    __syncthreads();
    if (tid0 < 320) {
        const int ch = tid0 < 64 ? h * 64 + tid0 : (tid0 < 192 ? 2048 + g * 128 + (tid0 - 64) : 3072 + g * 128 + (tid0 - 192));
#pragma unroll
        for (int k = 0; k < 4; ++k) cw[k * 320 + tid0] = p.in[11][((size_t)j * 4 + k) * 4096 + ch];
        cw[4 * 320 + tid0] = p.in[12][(size_t)j * 4096 + ch];
    }
    for (int i = tid0; i < 17408 / 4; i += 512) *(LAS unsigned*)(lds + L_HB + i * 4) = 0u;

    u32x4 rawBC[11]; unsigned rawX[11]; float dtp0 = 0.f, dtp1 = 0.f;
    auto prefetch = [&](int t0) {
        int tid = tid0; OPQ(tid);
        const int bt_ = tid & 255, tqb = bt_ >> 4, cg8 = bt_ & 15, tqx = tid >> 5, cp = tid & 31, lane = tid & 63;
        const int colBC = (roleB ? 4096 : 5120) + g * 128 + cg8 * 8, colX = 2048 + h * 64 + cp * 2;
        const int rB = t0 + tqb * 8 - 3, rX = t0 + tqx * 8 - 3;
        const unsigned oB = (unsigned)((rowbase + rB) * ZXW + colBC) * 2u, oX = (unsigned)((rowbase + rX) * ZXW + colX) * 2u;
#pragma unroll
        for (int i = 0; i < 11; ++i) {
            rawBC[i] = (rB + i >= 0) ? *(const u32x4*)(zxc + (oB + (unsigned)i * 12288u)) : (u32x4){0u, 0u, 0u, 0u};
            rawX[i] = (rX + i >= 0) ? *(const unsigned*)(zxc + (oX + (unsigned)i * 12288u)) : 0u;
        }
        if (wid == 0) { const unsigned od = (unsigned)((rowbase + t0 + 2 * lane) * 32 + h) * 4u; dtp0 = *(const float*)(dtc + od); dtp1 = *(const float*)(dtc + (od + 128u)); }
    };
    prefetch(0);

    f32x16 hacc;
#pragma unroll
    for (int i = 0; i < 16; ++i) hacc[i] = 0.f;

#pragma unroll 1
    for (int c = 0; c < 16; ++c) {
        const int t0 = c * 128;
        if (wid == 0) {
            int lane = tid0 & 63; OPQ(lane);
            const float d0 = softplus_f(dtp0 + dtb), d1 = softplus_f(dtp1 + dtb);
            const float a0 = d0 * Ah, a1 = a0 + d1 * Ah;
            float sc = a1;
#pragma unroll
            for (int o = 1; o < 64; o <<= 1) { const float v = __shfl_up(sc, o); if (lane >= o) sc += v; }
            const float c1 = sc, c0 = sc - a1 + a0;
            const float last = __shfl(sc, 63);
            sm_acum[2 * lane] = c0; sm_acum[2 * lane + 1] = c1;
            sm_dt[2 * lane] = d0; sm_dt[2 * lane + 1] = d1;
            sm_w[2 * lane] = __expf(last - c0) * d0; sm_w[2 * lane + 1] = __expf(last - c1) * d1;
            sm_ea[2 * lane] = __expf(c0); sm_ea[2 * lane + 1] = __expf(c1);
        }
        __syncthreads();
        {
            int tid = tid0; OPQ(tid);
            const int bt_ = tid & 255, tqb = bt_ >> 4, cg8 = bt_ & 15;
            const int lcBC = (roleB ? 64 : 192) + cg8 * 8;
            const f32x4 wv0 = *(const LAS f32x4*)(sm_w + tqb * 8), wv1 = *(const LAS f32x4*)(sm_w + tqb * 8 + 4);
            const float wt[8] = {wv0.x, wv0.y, wv0.z, wv0.w, wv1.x, wv1.y, wv1.z, wv1.w};
            const int natbase = (roleB ? L_BN : L_CN) + (tqb * 8) * RS + cg8 * 16;
#pragma unroll
            for (int half = 0; half < 2; ++half) {
                u32x2 nat[8]; u32x4 tr[4];
#pragma unroll
                for (int ipp = 0; ipp < 2; ++ipp) {
                    const int ip = half * 2 + ipp;
                    const float k0a = cw[0 * 320 + lcBC + 2 * ip], k0b = cw[0 * 320 + lcBC + 2 * ip + 1];
                    const float k1a = cw[1 * 320 + lcBC + 2 * ip], k1b = cw[1 * 320 + lcBC + 2 * ip + 1];
                    const float k2a = cw[2 * 320 + lcBC + 2 * ip], k2b = cw[2 * 320 + lcBC + 2 * ip + 1];
                    const float k3a = cw[3 * 320 + lcBC + 2 * ip], k3b = cw[3 * 320 + lcBC + 2 * ip + 1];
                    const float bba = cw[4 * 320 + lcBC + 2 * ip], bbb = cw[4 * 320 + lcBC + 2 * ip + 1];
                    f32x2 rr[11];
#pragma unroll
                    for (int i = 0; i < 11; ++i) { const unsigned v = rawBC[i][ip]; rr[i] = (f32x2){bf_lo(v), bf_hi(v)}; }
                    const f32x2 K0 = {k0a, k0b}, K1 = {k1a, k1b}, K2 = {k2a, k2b}, K3 = {k3a, k3b}, BB = {bba, bbb};
                    float va[8], vb[8];
#pragma unroll
                    for (int t = 0; t < 8; ++t) {
                        const f32x2 v = silu2(BB + K0 * rr[t] + K1 * rr[t + 1] + K2 * rr[t + 2] + K3 * rr[t + 3]);
                        va[t] = v.x; vb[t] = v.y;
                        nat[t][ipp] = cvt_pk_bf16(v.x, v.y);
                    }
                    if (roleB) {
#pragma unroll
                        for (int tp = 0; tp < 4; ++tp) {
                            tr[2 * ipp][tp] = cvt_pk_bf16(va[2 * tp] * wt[2 * tp], va[2 * tp + 1] * wt[2 * tp + 1]);
                            tr[2 * ipp + 1][tp] = cvt_pk_bf16(vb[2 * tp] * wt[2 * tp], vb[2 * tp + 1] * wt[2 * tp + 1]);
                        }
                    }
                }
#pragma unroll
                for (int t = 0; t < 8; ++t) *(LAS u32x2*)(lds + natbase + t * RS + half * 8) = nat[t];
                if (roleB) {
#pragma unroll
                    for (int i = 0; i < 4; ++i) *(LAS u32x4*)(lds + bt_addr(cg8 * 8 + half * 4 + i, tqb * 8)) = tr[i];
                }
                __builtin_amdgcn_sched_barrier(0);
            }
        }
        {
            int tid = tid0; OPQ(tid);
            const int tqx = tid >> 5, cp = tid & 31, lcX = cp * 2;
            const float k0a = cw[0 * 320 + lcX], k0b = cw[0 * 320 + lcX + 1], k1a = cw[1 * 320 + lcX], k1b = cw[1 * 320 + lcX + 1];
            const float k2a = cw[2 * 320 + lcX], k2b = cw[2 * 320 + lcX + 1], k3a = cw[3 * 320 + lcX], k3b = cw[3 * 320 + lcX + 1];
            const float bba = cw[4 * 320 + lcX], bbb = cw[4 * 320 + lcX + 1];
            f32x2 rr[11];
#pragma unroll
            for (int i = 0; i < 11; ++i) rr[i] = (f32x2){bf_lo(rawX[i]), bf_hi(rawX[i])};
            const f32x2 K0 = {k0a, k0b}, K1 = {k1a, k1b}, K2 = {k2a, k2b}, K3 = {k3a, k3b}, BB = {bba, bbb};
            float va[8], vb[8];
#pragma unroll
            for (int t = 0; t < 8; ++t) { const f32x2 v = silu2(BB + K0 * rr[t] + K1 * rr[t + 1] + K2 * rr[t + 2] + K3 * rr[t + 3]); va[t] = v.x; vb[t] = v.y; }
            u32x4 xa, xb;
            xa.x = cvt_pk_bf16(va[0], va[1]); xa.y = cvt_pk_bf16(va[2], va[3]); xa.z = cvt_pk_bf16(va[4], va[5]); xa.w = cvt_pk_bf16(va[6], va[7]);
            xb.x = cvt_pk_bf16(vb[0], vb[1]); xb.y = cvt_pk_bf16(vb[2], vb[3]); xb.z = cvt_pk_bf16(vb[4], vb[5]); xb.w = cvt_pk_bf16(vb[6], vb[7]);
            *(LAS u32x4*)(lds + xt_addr(cp * 2, tqx * 8)) = xa;
            *(LAS u32x4*)(lds + xt_addr(cp * 2 + 1, tqx * 8)) = xb;
        }
        if (c + 1 < 16) prefetch(t0 + 128);
        bf16_t zr[16];
        {
            int ln = tid0 & 63; OPQ(ln);
            const int l31 = ln & 31, hh = ln >> 5;
            const unsigned oz = (unsigned)((rowbase + t0 + tt * 32 + 4 * hh) * ZXW + h * 64 + pt * 32 + l31) * 2u;
#pragma unroll
            for (int rg = 0; rg < 16; ++rg) zr[rg] = *(const bf16_t*)(zxc + (oz + (unsigned)((rg & 3) + 8 * (rg >> 2)) * 12288u));
        }
        __syncthreads();
        f32x16 y;
        {
            int ln = tid0 & 63; OPQ(ln);
            const int l31 = ln & 31, hh = ln >> 5;
            const int cbase = L_CN + (tt * 32 + l31) * RS + 16 * hh, hbase = L_HB + (pt * 32 + l31) * RS + 16 * hh;
#pragma unroll
            for (int i = 0; i < 16; ++i) y[i] = 0.f;
#pragma unroll
            for (int ks = 0; ks < 8; ++ks) { const bf16x8 cfr = *(const LAS bf16x8*)(lds + cbase + ks * 32); const bf16x8 bfr = *(const LAS bf16x8*)(lds + hbase + ks * 32); y = mfma32(cfr, bfr, y); }
#pragma unroll
            for (int rq = 0; rq < 4; ++rq) { const f32x4 e = *(const LAS f32x4*)(sm_ea + tt * 32 + 8 * rq + 4 * hh); y[4 * rq] *= e.x; y[4 * rq + 1] *= e.y; y[4 * rq + 2] *= e.z; y[4 * rq + 3] *= e.w; }
            const int tidx = tt * 32 + l31;
            const float at = sm_acum[tidx];
#pragma unroll 1
            for (int st = 0; st <= tt; ++st) {
                f32x16 s;
#pragma unroll
                for (int i = 0; i < 16; ++i) s[i] = 0.f;
                const int bbase = L_BN + (st * 32 + l31) * RS + 16 * hh;
#pragma unroll
                for (int ks = 0; ks < 8; ++ks) { const bf16x8 afr = *(const LAS bf16x8*)(lds + bbase + ks * 32); const bf16x8 cfr = *(const LAS bf16x8*)(lds + cbase + ks * 32); s = mfma32(afr, cfr, s); }
#pragma unroll
                for (int rq = 0; rq < 4; ++rq) {
                    const int sb0 = st * 32 + 8 * rq + 4 * hh;
                    const f32x4 asv = *(const LAS f32x4*)(sm_acum + sb0), dsv = *(const LAS f32x4*)(sm_dt + sb0);
#pragma unroll
                    for (int i = 0; i < 4; ++i) {
                        float e = at - asv[i];
                        if (sb0 + i > tidx) e = -INFINITY;
                        s[4 * rq + i] *= __expf(e) * dsv[i];
                    }
                }
#pragma unroll
                for (int k2 = 0; k2 < 2; ++k2) {
                    u32x4 au; au.x = cvt_pk_bf16(s[8 * k2], s[8 * k2 + 1]); au.y = cvt_pk_bf16(s[8 * k2 + 2], s[8 * k2 + 3]); au.z = cvt_pk_bf16(s[8 * k2 + 4], s[8 * k2 + 5]); au.w = cvt_pk_bf16(s[8 * k2 + 6], s[8 * k2 + 7]);
                    const int sbase = st * 32 + 16 * k2 + 4 * hh;
                    const u32x2 lo = *(const LAS u32x2*)(lds + xt_addr(pt * 32 + l31, sbase)), hi = *(const LAS u32x2*)(lds + xt_addr(pt * 32 + l31, sbase + 8));
                    u32x4 bu; bu.x = lo.x; bu.y = lo.y; bu.z = hi.x; bu.w = hi.y;
                    y = mfma32(__builtin_bit_cast(bf16x8, au), __builtin_bit_cast(bf16x8, bu), y);
                }
            }
        }
        {
            int ln = tid0 & 63; OPQ(ln);
            const int l31 = ln & 31, hh = ln >> 5;
            const float dec = sm_ea[127];
#pragma unroll
            for (int i = 0; i < 16; ++i) hacc[i] *= dec;
#pragma unroll
            for (int ks = 0; ks < 8; ++ks) {
                const bf16x8 a = *(const LAS bf16x8*)(lds + xt_addr(hp * 32 + l31, ks * 16 + 8 * hh));
                const bf16x8 bb = *(const LAS bf16x8*)(lds + bt_addr(hn * 32 + l31, ks * 16 + 8 * hh));
                hacc = mfma32(a, bb, hacc);
            }
        }
        {
            int ln = tid0 & 63; OPQ(ln);
            const int l31 = ln & 31, hh = ln >> 5;
            const unsigned oy = (unsigned)((rowbase + t0 + tt * 32 + 4 * hh) * 2048 + h * 64 + pt * 32 + l31) * 2u;
#pragma unroll
            for (int rq = 0; rq < 4; ++rq) {
                const u32x2 xv = *(const LAS u32x2*)(lds + xt_addr(pt * 32 + l31, tt * 32 + 8 * rq + 4 * hh));
                const float xs[4] = {bf_lo(xv.x), bf_hi(xv.x), bf_lo(xv.y), bf_hi(xv.y)};
#pragma unroll
                for (int i = 0; i < 4; ++i) {
                    const int rg = 4 * rq + i;
                    const float yv = y[rg] + Dh * xs[i];
                    const float gv = yv * silu_f(bf2f(zr[rg]));
                    *(bf16_t*)(ygc + (oy + (unsigned)(8 * rq + i) * 4096u)) = (bf16_t)(cvt_pk_bf16(gv, 0.f) & 0xffffu);
                }
            }
        }
        __syncthreads();
        {
            int ln = tid0 & 63; OPQ(ln);
            const int l31 = ln & 31, hh = ln >> 5;
#pragma unroll
            for (int rg = 0; rg < 16; ++rg) {
                const int pr = hp * 32 + (rg & 3) + 8 * (rg >> 2) + 4 * hh;
                *(LAS bf16_t*)(lds + L_HB + pr * RS + (hn * 32 + l31) * 2) = (bf16_t)(cvt_pk_bf16(hacc[rg], 0.f) & 0xffffu);
            }
        }
    }
    {
        int ln = tid0 & 63; OPQ(ln);
        const int l31 = ln & 31, hh = ln >> 5;
        float* so = p.out + O_SSM_P + ((size_t)(j * 8 + b) * 32 + h) * 8192;
#pragma unroll
        for (int rg = 0; rg < 16; ++rg) {
            const int pr = hp * 32 + (rg & 3) + 8 * (rg >> 2) + 4 * hh;
            so[pr * 128 + hn * 32 + l31] = hacc[rg];
        }
    }
}

__device__ void ssd_sample_item(const Params& p, int j, int b, int g, LAS unsigned char* lds) {
    const int tid = otid();
    const bf16_t* zx = (const bf16_t*)(p.ws + WS_ZX);
    const float* dtraw = (const float*)(p.ws + WS_DTRAW);
    bf16_t* yg = (bf16_t*)(p.ws + WS_YG);
    LAS float* sx = (LAS float*)lds;
    LAS float* sB = sx + 2048;
    LAS float* sC = sB + 1024;
    LAS float* sdt = sC + 1024;
    LAS float* sdec = sdt + 32;
    const int pp = tid >> 3, nl = (tid & 7) * 4;
    const float* st = p.in[2] + ((size_t)(j * 128 + b) * 32 + g * 4) * 8192;
    f32x4 hs[4][4];
#pragma unroll
    for (int r = 0; r < 4; ++r)
#pragma unroll
        for (int q = 0; q < 4; ++q) hs[r][q] = *(const f32x4*)(st + r * 8192 + pp * 128 + nl + 32 * q);
    __syncthreads();
    {
        const int cc = tid < 256 ? g * 256 + tid : (tid < 384 ? 2048 + g * 128 + (tid - 256) : 3072 + g * 128 + (tid - 384));
        float raw[11];
#pragma unroll
        for (int k = 0; k < 3; ++k) raw[k] = p.in[3][((size_t)(j * 128 + b) * 3 + k) * 4096 + cc];
#pragma unroll
        for (int t = 0; t < 8; ++t) raw[3 + t] = bf2f(zx[(size_t)(MP + b * 8 + t) * ZXW + 2048 + cc]);
        const float w0 = p.in[11][((size_t)j * 4 + 0) * 4096 + cc], w1 = p.in[11][((size_t)j * 4 + 1) * 4096 + cc];
        const float w2 = p.in[11][((size_t)j * 4 + 2) * 4096 + cc], w3 = p.in[11][((size_t)j * 4 + 3) * 4096 + cc];
        const float bs = p.in[12][(size_t)j * 4096 + cc];
        LAS float* dst = tid < 256 ? sx + tid : (tid < 384 ? sB + (tid - 256) : sC + (tid - 384));
        const int dstride = tid < 256 ? 256 : 128;
#pragma unroll
        for (int t = 0; t < 8; ++t) dst[t * dstride] = silu_f(bs + w0 * raw[t] + w1 * raw[t + 1] + w2 * raw[t + 2] + w3 * raw[t + 3]);
        if (tid < 32) {
            const int t = tid >> 2, r = tid & 3, hd = g * 4 + r;
            const float dtv = softplus_f(dtraw[(size_t)(MP + b * 8 + t) * 32 + hd] + p.in[13][j * 32 + hd]);
            sdt[tid] = dtv; sdec[tid] = __expf(-dtv * __expf(p.in[14][j * 32 + hd]));
        }
    }
    __syncthreads();
    float* so = p.out + O_SSM_S + ((size_t)(j * 128 + b) * 32 + g * 4) * 8192;
#pragma unroll
    for (int r = 0; r < 4; ++r) {
        const float Dh = p.in[15][j * 32 + g * 4 + r];
        float ysel = 0.f;
#pragma unroll
        for (int t = 0; t < 8; ++t) {
            const float dtv = sdt[t * 4 + r], dec = sdec[t * 4 + r], dx = dtv * sx[t * 256 + r * 64 + pp];
            float yp = 0.f;
#pragma unroll
            for (int q = 0; q < 4; ++q) {
                const f32x4 B4 = *(const LAS f32x4*)(sB + t * 128 + nl + 32 * q), C4 = *(const LAS f32x4*)(sC + t * 128 + nl + 32 * q);
                hs[r][q] = hs[r][q] * dec + B4 * dx;
                yp += (hs[r][q].x * C4.x + hs[r][q].y * C4.y) + (hs[r][q].z * C4.z + hs[r][q].w * C4.w);
            }
            yp += __shfl_xor(yp, 1); yp += __shfl_xor(yp, 2); yp += __shfl_xor(yp, 4);
            if ((tid & 7) == t) ysel = yp;
        }
        {
            const int t = tid & 7, ch = g * 256 + r * 64 + pp;
            const size_t row = (size_t)(MP + b * 8 + t);
            const float yv = ysel + Dh * sx[t * 256 + r * 64 + pp];
            const float gv = yv * silu_f(bf2f(zx[row * ZXW + ch]));
            yg[row * 2048 + ch] = (bf16_t)(cvt_pk_bf16(gv, 0.f) & 0xffffu);
        }
#pragma unroll
        for (int q = 0; q < 4; ++q) *(f32x4*)(so + r * 8192 + pp * 128 + nl + 32 * q) = hs[r][q];
    }
}

__device__ void phase_scan(const Params& p, int j, LAS unsigned char* lds) {
    for (int item = blockIdx.x; item < 256; item += gridDim.x) {
        const int g = item & 7, k = item >> 3, b = k >> 2, r = k & 3;
        for (int rep = 0; rep < REP_PROMPT; ++rep) ssd_prompt_item(p, j, b, g * 4 + r, lds);
    }
#ifndef NO_SAMPLE
    for (int item = blockIdx.x; item < 1024; item += gridDim.x) ssd_sample_item(p, j, item >> 3, item & 7, lds);
#endif
    const bf16_t* zx = (const bf16_t*)(p.ws + WS_ZX);
    const int gt = blockIdx.x * 512 + otid(), nth = gridDim.x * 512;
    for (int i = gt; i < 136 * 3 * 4096; i += nth) {
        const int ch = i & 4095, k = (i >> 12) % 3, s = (i >> 12) / 3;
        if (s < 8) p.out[O_CONV_P + ((size_t)(j * 8 + s) * 3 + k) * 4096 + ch] = bf2f(zx[(size_t)(s * 2048 + 2045 + k) * ZXW + 2048 + ch]);
        else p.out[O_CONV_S + ((size_t)(j * 128 + (s - 8)) * 3 + k) * 4096 + ch] = bf2f(zx[(size_t)(MP + (s - 8) * 8 + 5 + k) * ZXW + 2048 + ch]);
    }
}

#define XB_TMO      128
#define XB_XCNT(j)  (256  + 64 * (j))
#define XB_XSUB(j)  (1280 + 64 * (j))
#define XB_XGEN(j)  (2304 + 64 * (j))
#define XB_TOP      3328
#define XB_TOPGEN   3392
#define XCD_BAR_WORDS 3456
#define XB_SPIN_CAP (1u << 22)
__device__ __forceinline__ unsigned xb_ld(unsigned* p)              { return __hip_atomic_load(p, __ATOMIC_RELAXED, __HIP_MEMORY_SCOPE_AGENT); }
__device__ __forceinline__ unsigned xb_add(unsigned* p, unsigned v) { return __hip_atomic_fetch_add(p, v, __ATOMIC_RELAXED, __HIP_MEMORY_SCOPE_AGENT); }
__device__ __forceinline__ unsigned xb_xcc_id() { return (unsigned)__builtin_amdgcn_s_getreg((3 << 11) | 20) & 0xFu; }
#define XB_SPIN(cond, bar) do { unsigned _sp = 0; while (cond) { __builtin_amdgcn_s_sleep(1); \
    if ((++_sp & 255u) == 0u) { if (xb_ld(&(bar)[XB_TMO])) break; if (_sp > XB_SPIN_CAP) { atomicAdd(&(bar)[XB_TMO], 1u); break; } } } } while (0)
struct XcdBarrier { unsigned* bar; unsigned x; volatile LAS unsigned* st; };
__device__ __forceinline__ XcdBarrier xcd_barrier_post(unsigned* bar, volatile LAS unsigned* st) {
    XcdBarrier b; b.bar = bar; b.x = xb_xcc_id(); b.st = st;
    if (threadIdx.x == 0) (void)xb_add(&bar[XB_XCNT(b.x)], 1u);
    return b;
}
__device__ __forceinline__ void xcd_barrier_complete(unsigned* bar, unsigned x, unsigned& nloc, unsigned& nx) {
    const unsigned G = gridDim.x * gridDim.y * gridDim.z;
    unsigned sum, cnt, mine, sp = 0u;
    for (;;) {
        sum = 0u; cnt = 0u; mine = 0u;
#pragma unroll
        for (unsigned j = 0; j < 16; ++j) { const unsigned c = xb_ld(&bar[XB_XCNT(j)]); sum += c; cnt += (c > 0u) ? 1u : 0u; mine = (j == x) ? c : mine; }
        if (sum == G) break;
        __builtin_amdgcn_s_sleep(1);
        if ((++sp & 255u) == 0u) { if (xb_ld(&bar[XB_TMO])) break; if (sp > XB_SPIN_CAP) { atomicAdd(&bar[XB_TMO], 1u); break; } }
    }
    nloc = mine > 0u ? mine : 1u; nx = cnt > 0u ? cnt : 1u;
}
__device__ __forceinline__ void xcd_barrier(const XcdBarrier& b) {
    asm volatile("s_waitcnt vmcnt(0)" ::: "memory");
    __syncthreads();
    if (threadIdx.x == 0) {
        unsigned* bar = b.bar;
        __builtin_amdgcn_s_waitcnt(0);
        unsigned nloc = b.st[0], nx = b.st[1];
        if (nloc == 0u) { xcd_barrier_complete(bar, b.x, nloc, nx); b.st[0] = nloc; b.st[1] = nx; }
        const unsigned old = xb_add(&bar[XB_XSUB(b.x)], 1u);
        const unsigned gen = old / nloc;
        if (old + 1u == (gen + 1u) * nloc) {
            __builtin_amdgcn_fence(__ATOMIC_RELEASE, "agent");
            asm volatile("s_waitcnt vmcnt(0)" ::: "memory");
            const unsigned og = xb_add(&bar[XB_TOP], 1u);
            const unsigned tg = og / nx;
            if (og + 1u == (tg + 1u) * nx) xb_add(&bar[XB_TOPGEN], 1u);
            else XB_SPIN(xb_ld(&bar[XB_TOPGEN]) == tg, bar);
            __builtin_amdgcn_fence(__ATOMIC_ACQUIRE, "agent");
            xb_add(&bar[XB_XGEN(b.x)], 1u);
            asm volatile("s_waitcnt vmcnt(0)" ::: "memory");
        } else {
            XB_SPIN(xb_ld(&bar[XB_XGEN(b.x)]) == gen, bar);
            __builtin_amdgcn_fence(__ATOMIC_ACQUIRE, "agent");
            asm volatile("s_waitcnt vmcnt(0)" ::: "memory");
        }
    }
    __syncthreads();
}

#ifndef REP_PREP0
#define REP_PREP0 1
#endif
#ifndef REP_SMALL
#define REP_SMALL 1
#endif
#ifndef REP_GGRP
#define REP_GGRP 1
#endif
#ifndef REP_GGRP
#define REP_GGRP 1
#endif
#ifndef REP_SYNC
#define REP_SYNC 1
#endif
#ifndef REP_SCAN
#define REP_SCAN 1
#endif
#ifndef REP_GIN
#define REP_GIN 1
#endif
#ifndef REP_GOUT
#define REP_GOUT 1
#endif
#ifndef REP_ELEM
#define REP_ELEM 1
#endif
#define GSYNC() do { for (int _r = 0; _r < REP_SYNC; ++_r) xcd_barrier(xb); } while (0)
__global__ __launch_bounds__(512, 2) void hybrid_fwd(Params p) {
    extern __shared__ __attribute__((aligned(16))) unsigned char smem[];
    LAS unsigned char* lds = (LAS unsigned char*)smem;
    cg::grid_group grid = cg::this_grid();
    unsigned char* ws = p.ws;
    volatile LAS unsigned* xst = (volatile LAS unsigned*)(lds + LDS_XB);
    if (threadIdx.x == 0) { xst[0] = 0u; xst[1] = 0u; }
    __syncthreads();
    const XcdBarrier xb = xcd_barrier_post((unsigned*)(ws + WS_BAR), xst);

    for (int rep = 0; rep < REP_PREP0; ++rep) phase_prep0(p, lds);
    grid.sync();
#pragma unroll 1
    for (int mode_ = 0; mode_ < 2 * REP_SMALL; ++mode_) {
        const int mode = mode_ % 2;
        pg8::SmallSched S; S.mode = mode; S.G = (int)gridDim.x; S.c = (int)blockIdx.x; S.lda = 1024; S.ldb = 1024; S.K = 1024;
        S.A0 = (const char*)(ws + (mode == 0 ? WS_AC : WS_SHIFTA)); S.ada = (const char*)(ws + WS_WT_ADA); S.ssd_in = (const char*)(ws + WS_WT_SSD_IN); S.pool_in = (const char*)(ws + WS_WT_POOL_IN);
        EpiSmall E; E.mode = mode; E.mod = (float*)(ws + WS_MOD); E.ada_b = p.in[8]; E.shiftA = (bf16_t*)(ws + WS_SHIFTA); E.sb = (float*)(ws + WS_SB);
#ifndef NO_GSMALL
        pg8::gemm_phase<EpiSmall, pg8::SmallSched>(lds, S, E);
#endif
        if (mode == 1) phase_xprep(p);
        GSYNC();
    }
    unsigned* tailw = (unsigned*)(ws + WS_BAR) + 3584;
    unsigned* tmow = (unsigned*)(ws + WS_BAR) + XB_TMO;
#pragma unroll 1
    for (int layer = 0; layer < 4; ++layer) {
        const int j = layer >> 1; const bool ssd = (layer & 1) == 0;
        {
            pg8::InSched S;
            S.init(ssd ? 6400 : 4096, ws + WS_APRIME, ssd ? ws + WS_WT_SSD_IN + (size_t)j * 6400 * 1024 * 2 : ws + WS_WT_POOL_IN + (size_t)j * 4096 * 1024 * 2, layer > 0 ? tailw + 64 * (layer - 1) : nullptr, tmow);
            EpiIn E; E.ssq = (const float*)(ws + WS_SSQ) + (size_t)layer * 17408; E.sb = (const float*)(ws + WS_SB) + (size_t)layer * 136 * 6400; E.out = (bf16_t*)(ws + WS_ZX);
            E.ldo = ssd ? ZXW : 4096; E.nbf = ssd ? ZXW : 4096; E.dtraw = ssd ? (float*)(ws + WS_DTRAW) : nullptr;
            for (int rep = 0; rep < REP_GIN; ++rep) pg8::gemm_phase<EpiIn, pg8::InSched>(lds, S, E);
        }
        GSYNC();
        if (ssd) { for (int rep = 0; rep < REP_SCAN; ++rep) phase_scan(p, j, lds); } else { for (int rep = 0; rep < REP_ELEM; ++rep) phase_pool(p, j); }
        GSYNC();
        if (ssd) { for (int rep = 0; rep < REP_ELEM; ++rep) phase_ssdnorm(p, j); }
        else {
            pg8::MainSched S; S.init(MT, 2048, 512, 2048, 512, ws + WS_YG, ws + WS_WT_POOL_G + (size_t)j * 2048 * 512 * 2, 1);
            EpiGrp E; E.uz = (const bf16_t*)(ws + WS_ZX); E.chs = p.in[20] + (size_t)j * 2048; E.out = (bf16_t*)(ws + WS_A2);
            for (int rep = 0; rep < REP_GGRP; ++rep) pg8::gemm_phase<EpiGrp, pg8::MainSched>(lds, S, E);
        }
        GSYNC();
#pragma unroll 1
        for (int part = 0; part < 2; ++part) {
            pg8::MainSched S; S.init(part == 0 ? MP : MT, 1024, 2048, 2048, 2048, ws + WS_A2, ssd ? ws + WS_WT_SSD_OUT + (size_t)j * 1024 * 2048 * 2 : ws + WS_WT_POOL_OUT + (size_t)j * 1024 * 2048 * 2, 30, part);
            EpiOut E; float* xw = (float*)(ws + WS_XW);
            E.xin_p = layer == 0 ? p.in[0] : xw; E.xin_s = layer == 0 ? p.in[1] : xw + (size_t)MP * DM; E.xw = xw;
            E.modl = (const float*)(ws + WS_MOD) + (size_t)layer * 3072; E.ng_next = layer < 3 ? p.in[9] + (size_t)(layer + 1) * 1024 : nullptr;
            E.aprime = (bf16_t*)(ws + WS_APRIME); E.ssq = (float*)(ws + WS_SSQ) + (size_t)(layer + 1) * 17408;
            pg8::gemm_phase<EpiOut, pg8::MainSched>(lds, S, E);
            if (part == 0) GSYNC();
        }
        if (blockIdx.x < 16) {
            asm volatile("s_waitcnt vmcnt(0)" ::: "memory");
            __syncthreads();
            if (threadIdx.x == 0) { __builtin_amdgcn_fence(__ATOMIC_RELEASE, "agent"); asm volatile("s_waitcnt vmcnt(0)" ::: "memory"); __hip_atomic_fetch_add(tailw + 64 * layer, 1u, __ATOMIC_RELAXED, __HIP_MEMORY_SCOPE_AGENT); }
        }
    }
    phase_final(p, 0, MP, 16);
    GSYNC();
    phase_final(p, MP, MT, 0);
}

extern "C" void kernel_launch(void* const* d_in, const int* in_sizes, int n_in, void* d_out, int out_size, void* d_ws, size_t ws_size, hipStream_t stream) {
    static int grid = 0;
    if (grid == 0) {
        if (n_in != 23 || ws_size < WS_END) { fprintf(stderr, "kernel_launch: unexpected n_in %d or ws_size %zu (need %zu)\n", n_in, ws_size, (size_t)WS_END); grid = -1; return; }
        int dev = 0, cus = 0, per_cu = 0;
        hipGetDevice(&dev);
        hipDeviceGetAttribute(&cus, hipDeviceAttributeMultiprocessorCount, dev);
        if (hipFuncSetAttribute((const void*)hybrid_fwd, hipFuncAttributeMaxDynamicSharedMemorySize, LDS_BYTES) != hipSuccess) { fprintf(stderr, "kernel_launch: hipFuncSetAttribute failed\n"); grid = -1; return; }
        if (hipOccupancyMaxActiveBlocksPerMultiprocessor(&per_cu, (const void*)hybrid_fwd, 512, LDS_BYTES) != hipSuccess || per_cu < 1) { fprintf(stderr, "kernel_launch: occupancy query gave %d\n", per_cu); (void)hipGetLastError(); per_cu = 1; }
        grid = cus * 1;
    }
    if (grid < 0) return;
    Params p{};
    for (int i = 0; i < 23; ++i) p.in[i] = (const float*)d_in[i];
    p.out = (float*)d_out; p.ws = (unsigned char*)d_ws;
    unsigned char* ws = (unsigned char*)d_ws;
    int nj = 0, tb = 0;
    auto add = [&](const float* src, size_t dst_off, int K, int N, int Npad) {
        WJob& w = p.wj[nj++]; w.src = src; w.dst = (bf16_t*)(ws + dst_off); w.K = K; w.N = N; w.tiles_n = Npad / 64; w.tile_begin = tb; tb += (K / 64) * (Npad / 64);
    };
    for (int i = 0; i < 4; ++i) add(p.in[7] + (size_t)i * 1024 * 3072, WS_WT_ADA + (size_t)i * 3072 * 1024 * 2, 1024, 3072, 3072);
    for (int j = 0; j < 2; ++j) add(p.in[10] + (size_t)j * 1024 * 6176, WS_WT_SSD_IN + (size_t)j * 6400 * 1024 * 2, 1024, 6176, 6400);
    for (int j = 0; j < 2; ++j) add(p.in[18] + (size_t)j * 1024 * 4096, WS_WT_POOL_IN + (size_t)j * 4096 * 1024 * 2, 1024, 4096, 4096);
    for (int j = 0; j < 2; ++j) add(p.in[17] + (size_t)j * 2048 * 1024, WS_WT_SSD_OUT + (size_t)j * 1024 * 2048 * 2, 2048, 1024, 1024);
    for (int j = 0; j < 2; ++j) add(p.in[21] + (size_t)j * 2048 * 1024, WS_WT_POOL_OUT + (size_t)j * 1024 * 2048 * 2, 2048, 1024, 1024);
    for (int q = 0; q < 8; ++q) add(p.in[19] + (size_t)q * 512 * 512, WS_WT_POOL_G + (size_t)q * 512 * 512 * 2, 512, 512, 512);
    p.wtiles = tb;
    if (hipMemsetAsync(ws + WS_BAR, 0, 16384, stream) != hipSuccess) { fprintf(stderr, "kernel_launch: memset of the barrier words failed\n"); return; }
    void* args[] = {&p};
    hipError_t e = hipLaunchCooperativeKernel((const void*)hybrid_fwd, dim3(grid), dim3(512), args, LDS_BYTES, stream);
    if (e != hipSuccess) fprintf(stderr, "cooperative launch failed: %s (grid %d)\n", hipGetErrorString(e), grid);
}
```

```cpp
#include <hip/hip_runtime.h>
#include <hip/hip_cooperative_groups.h>
#include <cstdio>
namespace cg = cooperative_groups;

#ifndef REP_PROMPT
#define REP_PROMPT 1
#endif
#define LAS __attribute__((address_space(3)))
typedef unsigned short bf16_t;
typedef short bf16x8 __attribute__((ext_vector_type(8)));
typedef float f32x4 __attribute__((ext_vector_type(4)));
typedef float f32x16 __attribute__((ext_vector_type(16)));
typedef unsigned u32x4 __attribute__((ext_vector_type(4)));
typedef unsigned u32x2 __attribute__((ext_vector_type(2)));
typedef float f32x2 __attribute__((ext_vector_type(2)));

constexpr int MP = 16384, MT = 17408, DM = 1024;
constexpr int ZXW = 6144;
constexpr size_t O_SSM_P = 17825792, O_CONV_P = 22020096, O_POOL_P = 22216704, O_SSM_S = 22708224, O_CONV_S = 89817088, O_POOL_S = 92962816;

constexpr size_t WS_WT_SSD_IN = 0;
constexpr size_t WS_WT_SSD_OUT = WS_WT_SSD_IN + 2ull * 6400 * 1024 * 2;
constexpr size_t WS_WT_POOL_IN = WS_WT_SSD_OUT + 2ull * 1024 * 2048 * 2;
constexpr size_t WS_WT_POOL_G = WS_WT_POOL_IN + 2ull * 4096 * 1024 * 2;
constexpr size_t WS_WT_POOL_OUT = WS_WT_POOL_G + 2ull * 2048 * 512 * 2;
constexpr size_t WS_WT_ADA = WS_WT_POOL_OUT + 2ull * 1024 * 2048 * 2;
constexpr size_t WS_AC = WS_WT_ADA + 12288ull * 1024 * 2;
constexpr size_t WS_SHIFTA = WS_AC + 256ull * 1024 * 2;
constexpr size_t WS_MOD = WS_SHIFTA + 4ull * 256 * 1024 * 2;
constexpr size_t WS_SB = WS_MOD + 136ull * 12288 * 4;
constexpr size_t WS_APRIME = WS_SB + 4ull * 136 * 6400 * 4;
constexpr size_t WS_SSQ = WS_APRIME + 17408ull * 1024 * 2;
constexpr size_t WS_XW = WS_SSQ + 17408ull * 16 * 4;
constexpr size_t WS_ZX = WS_XW + 17408ull * 1024 * 4;
constexpr size_t WS_DTRAW = WS_ZX + 17408ull * 6144 * 2;
constexpr size_t WS_YG = WS_DTRAW + 17408ull * 32 * 4;
constexpr size_t WS_A2 = WS_YG + 17408ull * 2048 * 2;
constexpr size_t WS_BAR = WS_A2 + 17408ull * 2048 * 2;
constexpr size_t WS_END = WS_BAR + 16384;

constexpr int LDS_XB = 147712;
constexpr int LDS_BYTES = 147728;

struct WJob { const float* src; long long doff; int K, N, tiles_n, tile_begin; };
struct WTab { WJob wj[20]; int wtiles; int pad0; };
constexpr int NWJ = 20;
struct Params {
    const float* in[23];
    float* out;
    unsigned char* ws;
};

__device__ __forceinline__ unsigned cvt_pk_bf16(float lo, float hi) { unsigned r; asm("v_cvt_pk_bf16_f32 %0, %1, %2" : "=v"(r) : "v"(lo), "v"(hi)); return r; }
__device__ __forceinline__ float bf_lo(unsigned u) { return __uint_as_float(u << 16); }
__device__ __forceinline__ float bf_hi(unsigned u) { return __uint_as_float(u & 0xffff0000u); }
__device__ __forceinline__ float bf2f(bf16_t b) { return __uint_as_float(((unsigned)b) << 16); }
__device__ __forceinline__ float silu_f(float v) { return v * __builtin_amdgcn_rcpf(1.f + __expf(-v)); }
__device__ __forceinline__ f32x2 silu2(f32x2 v) { const f32x2 e = v * (-1.44269504f); f32x2 d; d.x = __builtin_amdgcn_exp2f(e.x); d.y = __builtin_amdgcn_exp2f(e.y); d = d + 1.f; f32x2 r; r.x = __builtin_amdgcn_rcpf(d.x); r.y = __builtin_amdgcn_rcpf(d.y); return v * r; }
__device__ __forceinline__ float softplus_f(float v) { return v > 20.f ? v : log1pf(__expf(v)); }
__device__ __forceinline__ int otid() { int t = threadIdx.x; asm volatile("" : "+v"(t)); return t; }
__device__ __forceinline__ int row_b(int r) { return r < MP ? (r >> 11) : 8 + ((r - MP) >> 3); }
__device__ __forceinline__ u32x4 pack8(f32x4 a, f32x4 b) { u32x4 r; r.x = cvt_pk_bf16(a.x, a.y); r.y = cvt_pk_bf16(a.z, a.w); r.z = cvt_pk_bf16(b.x, b.y); r.w = cvt_pk_bf16(b.z, b.w); return r; }

namespace pg8 {
constexpr int BM = 256, BK = 64, HALF = 128, HTB = HALF * BK * 2, STAGE_BYTES = 8 * HTB, NXCD = 8, WGM = 8;
__device__ __forceinline__ int lds_byte(int r, int c) { const int st = (r >> 4) * 2 + (c >> 5), rr = r & 15, cc = c & 31, ob = rr * 64 + cc * 2; return st * 1024 + (ob ^ (((ob >> 9) & 1) << 5)); }
__device__ __forceinline__ void stage_rc(int b, int& R, int& C) { const int st = b / 1024, sb = b % 1024, swz = sb ^ (((sb >> 9) & 1) << 5); R = (st >> 1) * 16 + swz / 64; C = (st & 1) * 32 + (swz % 64) / 2; }
__device__ __forceinline__ int perm32(int rho) { const int n = rho >> 4, i = rho & 15; return 8 * (i >> 2) + 4 * n + (i & 3); }

struct Unit { int pm, pn, q; const char* A; const char* B; };

__device__ __forceinline__ void static_unit(int L, int nM, int nN, int& pm, int& pn) {
    const int nwg = nM * nN;
    int wgid = L; { const int q = nwg / NXCD, r = nwg % NXCD, xcd = wgid % NXCD, off = wgid / NXCD; wgid = (xcd < r ? xcd * (q + 1) : r * (q + 1) + (xcd - r) * q) + off; }
    const int nig = WGM * nN, gid = wgid / nig, fm = gid * WGM, gsz = (nM - fm) < WGM ? (nM - fm) : WGM;
    pm = fm + ((wgid % nig) % gsz); pn = (wgid % nig) / gsz;
}
struct MainSched {
    int nM, nN, nwg, G, c, lda, ldb, K, gsh, single;
    const char* A; const char* Bt;
    __device__ void init(int M, int N, int K_, int lda_, int ldb_, const void* A_, const void* Bt_, int gsh_, int single_ = 0) {
        nM = M / BM; nN = N / BM; nwg = nM * nN; G = (int)gridDim.x; c = (int)blockIdx.x; lda = lda_; ldb = ldb_; K = K_; A = (const char*)A_; Bt = (const char*)Bt_; gsh = gsh_; single = single_;
    }
    __device__ bool next(int i, Unit& u) const {
        if (single) { if (i > 0 || c >= 16) return false; u.pm = 64 + (c >> 2); u.pn = c & 3; }
        else { const long L = (long)i * G + c; if (L >= nwg) return false; static_unit((int)L, nM, nN, u.pm, u.pn); }
        u.q = 0;
        u.A = A + ((size_t)u.pm * BM * lda + (size_t)(u.pn >> gsh) * 512) * 2;
        u.B = Bt + (size_t)u.pn * BM * ldb * 2;
        return true;
    }
    __device__ __forceinline__ void a_ready(const Unit&) const {}
};
struct InSched {
    int nN, nP, E, nskip, c, r0, cnt, lda, ldb, K;
    const char* A; const char* Bt; unsigned* tail; unsigned* tmo;
    __device__ void init(int N, const void* A_, const void* Bt_, unsigned* tail_, unsigned* tmo_) {
        nN = N / BM; nP = 64 * nN; c = (int)blockIdx.x; lda = 1024; ldb = 1024; K = 1024; A = (const char*)A_; Bt = (const char*)Bt_; tail = tail_; tmo = tmo_;
        nskip = tail_ != nullptr ? 32 : 0; E = nskip + 4 * nN; r0 = (tail_ != nullptr && c < 16) ? 2 : 0;
        const int tot = (nP - c + 255) / 256; cnt = tot - r0 > 0 ? tot - r0 : 0;
    }
    __device__ bool next(int i, Unit& u) const {
        if (i < cnt) static_unit((i + r0) * 256 + c, 64, nN, u.pm, u.pn);
        else {
            if (c < 16) return false;
            const int e = 255 - c + 240 * (i - cnt); if (e >= E) return false;
            if (e < nskip) static_unit(e < 16 ? e : 256 + (e - 16), 64, nN, u.pm, u.pn);
            else { const int sidx = e - nskip; u.pm = 64 + sidx / nN; u.pn = sidx - (sidx / nN) * nN; }
        }
        u.q = 0;
        u.A = A + (size_t)u.pm * BM * 1024 * 2; u.B = Bt + (size_t)u.pn * BM * 1024 * 2;
        return true;
    }
    __device__ __forceinline__ void a_ready(const Unit& u) const {
        if (tail == nullptr || u.pm < 64) return;
        if (threadIdx.x < 64) {
            unsigned polls = 0;
            while ((unsigned)__builtin_amdgcn_readfirstlane(__hip_atomic_load(tail, __ATOMIC_RELAXED, __HIP_MEMORY_SCOPE_AGENT)) < 16u) {
                __builtin_amdgcn_s_sleep(2);
                if ((++polls & 255u) == 0u) { if (__builtin_amdgcn_readfirstlane(__hip_atomic_load(tmo, __ATOMIC_RELAXED, __HIP_MEMORY_SCOPE_AGENT)) != 0u) break; if (polls > (1u << 22)) { if (threadIdx.x == 0) atomicAdd(tmo, 1u); break; } }
            }
            __builtin_amdgcn_fence(__ATOMIC_ACQUIRE, "agent");
            asm volatile("s_waitcnt vmcnt(0)" ::: "memory");
        }
        asm volatile("" ::: "memory"); __builtin_amdgcn_s_barrier(); asm volatile("" ::: "memory");
    }
};
struct SmallSched {
    int mode, G, c, lda, ldb, K;
    const char* A0; const char* ada; const char* ssd_in; const char* pool_in;
    __device__ bool next(int i, Unit& u) const {
        const long L = (long)i * G + c;
        u.pm = 0;
        if (mode == 0) { if (L >= 48) return false; u.pn = (int)L; u.q = 0; u.A = A0; u.B = ada + (size_t)u.pn * BM * 1024 * 2; return true; }
        if (L >= 82) return false;
        int l = (int)L, q, pn;
        if (l < 25) { q = 0; pn = l; } else if (l < 41) { q = 1; pn = l - 25; } else if (l < 66) { q = 2; pn = l - 41; } else { q = 3; pn = l - 66; }
        u.q = q; u.pn = pn; u.A = A0 + (size_t)q * 256 * 1024 * 2;
        u.B = ((q & 1) ? pool_in + (size_t)(q >> 1) * 4096 * 1024 * 2 : ssd_in + (size_t)(q >> 1) * 6400 * 1024 * 2) + (size_t)pn * BM * 1024 * 2;
        return true;
    }
    __device__ __forceinline__ void a_ready(const Unit&) const {}
};

template <class Epi, class Sched>
__device__ __forceinline__ void gemm_phase(LAS unsigned char* lds, const Sched& S, const Epi& E) {
    const int tid = otid(), wid = __builtin_amdgcn_readfirstlane(tid >> 6), lane = tid & 63, wr = wid >> 2, wc = wid & 3, fr = lane & 15, fq = lane >> 4;
    const int K = S.K, nt = K / BK;
    unsigned voffA[2], voffB[2];
#pragma unroll
    for (int i = 0; i < 2; ++i) { int R, C; stage_rc(tid * 16 + i * 8192, R, C); const int Rb = Epi::PERM ? ((R & ~31) + perm32(R & 31)) : R;
        voffA[i] = (unsigned)(R * S.lda + C) * 2u; voffB[i] = (unsigned)(Rb * S.ldb + C) * 2u; }
    const size_t kstep = (size_t)(BK * 2);
    const size_t hstepA = (size_t)HALF * S.lda * 2, hstepB = (size_t)HALF * S.ldb * 2;
    const unsigned ldsw = (unsigned)wid * 1024u;
    const int aoff = lds_byte(wr * 64 + fr, fq * 8), boff = lds_byte(wc * 32 + fr, fq * 8);
#define PG8_SA(b, h) (((b) * 2 + (h)) * HTB)
#define PG8_SB(b, h) ((4 + (b) * 2 + (h)) * HTB)
#define PG8_STAGE(bufoff, gbase, voff) do { _Pragma("unroll") for (int _i = 0; _i < 2; ++_i) \
        __builtin_amdgcn_global_load_lds((const unsigned*)((const char*)(gbase) + (voff)[_i]), (LAS unsigned*)(lds + (bufoff) + ldsw + _i * 8192), 16, 0, 0); } while (0)
#define PG8_LDA(dst, b, h) do { _Pragma("unroll") for (int m = 0; m < 4; ++m) _Pragma("unroll") for (int k = 0; k < 2; ++k) dst[m][k] = *(const LAS bf16x8*)(lds + PG8_SA(b, h) + aoff + m * 2048 + k * 1024); } while (0)
#define PG8_LDB(dst, b, h) do { _Pragma("unroll") for (int n = 0; n < 2; ++n) _Pragma("unroll") for (int k = 0; k < 2; ++k) dst[n][k] = *(const LAS bf16x8*)(lds + PG8_SB(b, h) + boff + n * 2048 + k * 1024); } while (0)
#define PG8_MMA(ai, bj, At, Bt) do { __builtin_amdgcn_s_setprio(1); _Pragma("unroll") for (int m = 0; m < 4; ++m) _Pragma("unroll") for (int n = 0; n < 2; ++n) _Pragma("unroll") for (int k = 0; k < 2; ++k) \
        acc[ai][bj][m][n] = __builtin_amdgcn_mfma_f32_16x16x32_bf16(Bt[n][k], At[m][k], acc[ai][bj][m][n], 0, 0, 0); __builtin_amdgcn_s_setprio(0); } while (0)
#define PG8_WAIT_V(n) asm volatile("s_waitcnt vmcnt(" #n ")" ::: "memory")
#define PG8_WAIT_L(n) asm volatile("s_waitcnt lgkmcnt(" #n ")" ::: "memory")
#define PG8_BAR __builtin_amdgcn_s_barrier()
#define PG8_SCHED __builtin_amdgcn_sched_barrier(0)
    Unit cur, nxt; int ui = 0;
    if (!S.next(0, cur)) return;
    f32x4 acc[2][2][4][2];
#pragma unroll
    for (int a = 0; a < 2; ++a)
#pragma unroll
        for (int b = 0; b < 2; ++b)
#pragma unroll
            for (int m = 0; m < 4; ++m)
#pragma unroll
                for (int n = 0; n < 2; ++n) acc[a][b][m][n] = (f32x4){0.f, 0.f, 0.f, 0.f};
    bf16x8 At[4][2], B0[2][2], B1[2][2];
    const char* cA = cur.A; const char* cB = cur.B;
    S.a_ready(cur);
    PG8_STAGE(PG8_SB(0, 0), cB, voffB); PG8_STAGE(PG8_SA(0, 0), cA, voffA); PG8_STAGE(PG8_SB(0, 1), cB + hstepB, voffB); PG8_STAGE(PG8_SA(0, 1), cA + hstepA, voffA);
    if (wr == 1) PG8_BAR;
    PG8_WAIT_V(4); PG8_BAR;
    PG8_STAGE(PG8_SB(1, 0), cB + kstep, voffB); PG8_STAGE(PG8_SA(1, 0), cA + kstep, voffA); PG8_STAGE(PG8_SB(1, 1), cB + hstepB + kstep, voffB);
    PG8_WAIT_V(6); PG8_BAR;
    for (;;) {
        const bool has_next = S.next(ui + 1, nxt);
        const char* nA = has_next ? nxt.A : cA; const char* nB = has_next ? nxt.B : cB;
        for (int t = 0; t < nt; t += 2) {
            const bool last = (t == nt - 2);
            const char* a1 = cA + (size_t)(t + 1) * kstep;
            const char* a2 = last ? nA : cA + (size_t)(t + 2) * kstep; const char* b2 = last ? nB : cB + (size_t)(t + 2) * kstep;
            const char* a3 = a2 + kstep; const char* b3 = b2 + kstep;
            if (last && has_next) S.a_ready(nxt);
            PG8_LDB(B0, 0, 0); PG8_SCHED; PG8_LDA(At, 0, 0); PG8_STAGE(PG8_SA(1, 1), a1 + hstepA, voffA);
            PG8_WAIT_L(8); PG8_BAR; PG8_WAIT_L(0); PG8_MMA(0, 0, At, B0); PG8_BAR; PG8_SCHED;
            PG8_LDB(B1, 0, 1); PG8_STAGE(PG8_SB(0, 0), b2, voffB);
            PG8_BAR; PG8_WAIT_L(0); PG8_MMA(0, 1, At, B1); PG8_BAR;
            PG8_LDA(At, 0, 1); PG8_STAGE(PG8_SA(0, 0), a2, voffA);
            PG8_BAR; PG8_WAIT_L(0); PG8_MMA(1, 0, At, B0); PG8_BAR; PG8_SCHED;
            PG8_STAGE(PG8_SB(0, 1), b2 + hstepB, voffB);
            PG8_WAIT_V(6); PG8_BAR; PG8_MMA(1, 1, At, B1); PG8_BAR;
            PG8_LDB(B0, 1, 0); PG8_SCHED; PG8_LDA(At, 1, 0); PG8_STAGE(PG8_SA(0, 1), a2 + hstepA, voffA);
            PG8_WAIT_L(8); PG8_BAR; PG8_WAIT_L(0); PG8_MMA(0, 0, At, B0); PG8_BAR; PG8_SCHED;
            PG8_LDB(B1, 1, 1); PG8_STAGE(PG8_SB(1, 0), b3, voffB);
            PG8_BAR; PG8_WAIT_L(0); PG8_MMA(0, 1, At, B1); PG8_BAR;
            PG8_LDA(At, 1, 1); PG8_STAGE(PG8_SA(1, 0), a3, voffA);
            PG8_BAR; PG8_WAIT_L(0); PG8_MMA(1, 0, At, B0); PG8_BAR; PG8_SCHED;
            PG8_STAGE(PG8_SB(1, 1), b3 + hstepB, voffB);
            PG8_WAIT_V(6); PG8_BAR; PG8_MMA(1, 1, At, B1); PG8_BAR;
        }
        E(acc, cur, wr, wc, fr, fq);
        if (!has_next) break;
#pragma unroll
        for (int a = 0; a < 2; ++a)
#pragma unroll
            for (int b = 0; b < 2; ++b)
#pragma unroll
                for (int m = 0; m < 4; ++m)
#pragma unroll
                    for (int n = 0; n < 2; ++n) acc[a][b][m][n] = (f32x4){0.f, 0.f, 0.f, 0.f};
        cur = nxt; cA = nA; cB = nB; ++ui;
    }
    PG8_WAIT_V(0);
    if (wr == 0) PG8_BAR;
    PG8_BAR;
#undef PG8_SA
#undef PG8_SB
#undef PG8_STAGE
#undef PG8_LDA
#undef PG8_LDB
#undef PG8_MMA
#undef PG8_WAIT_V
#undef PG8_WAIT_L
#undef PG8_BAR
#undef PG8_SCHED
}
}
using pg8::Unit;

struct EpiIn {
    static constexpr bool PERM = true;
    const float* ssq; const float* sb; bf16_t* out; int ldo, nbf; float* dtraw;
    template <bool UNI>
    __device__ __forceinline__ void body(const f32x4 (&acc)[2][2][4][2], const Unit& u, int wr, int wc, int fr, int fq) const {
        const int row0 = u.pm * 256 + wr * 64 + fr, colt = u.pn * 256 + wc * 32 + 8 * fq;
        f32x4 ub[2][2];
        if (UNI) {
            const float* sbr = sb + (size_t)(u.pm >> 3) * 6400;
#pragma unroll
            for (int bj = 0; bj < 2; ++bj) { const int c = colt + bj * 128; if (c < nbf + 32) { ub[bj][0] = *(const f32x4*)(sbr + c); ub[bj][1] = *(const f32x4*)(sbr + c + 4); } }
        }
        float rsv[2][4];
#pragma unroll
        for (int ai = 0; ai < 2; ++ai)
#pragma unroll
            for (int m = 0; m < 4; ++m) rsv[ai][m] = ssq[row0 + ai * 128 + m * 16];
#pragma unroll
        for (int ai = 0; ai < 2; ++ai) {
            f32x4 nb[4][2][2];
            if (!UNI) {
#pragma unroll
                for (int m = 0; m < 4; ++m) {
                    const float* sbr = sb + (size_t)row_b(row0 + ai * 128 + m * 16) * 6400;
#pragma unroll
                    for (int bj = 0; bj < 2; ++bj) { const int c = colt + bj * 128; if (c < nbf + 32) { nb[m][bj][0] = *(const f32x4*)(sbr + c); nb[m][bj][1] = *(const f32x4*)(sbr + c + 4); } }
                }
            }
#pragma unroll
            for (int m = 0; m < 4; ++m) {
                const int r = row0 + ai * 128 + m * 16;
                const float rstd = rsqrtf(rsv[ai][m] * (1.f / 1024.f) + 1e-6f);
#pragma unroll
                for (int bj = 0; bj < 2; ++bj) {
                    const int c = colt + bj * 128;
                    if (c < nbf + 32) {
                        f32x4 b0, b1;
                        if (UNI) { b0 = ub[bj][0]; b1 = ub[bj][1]; } else { b0 = nb[m][bj][0]; b1 = nb[m][bj][1]; }
                        const f32x4 v0 = acc[ai][bj][m][0] * rstd + b0, v1 = acc[ai][bj][m][1] * rstd + b1;
                        if (c < nbf) *(u32x4*)(out + (size_t)r * ldo + c) = pack8(v0, v1);
                        else if (dtraw != nullptr) { float* dp = dtraw + (size_t)r * 32 + (c - nbf); *(f32x4*)dp = v0; *(f32x4*)(dp + 4) = v1; }
                    }
                }
            }
        }
    }
    __device__ __forceinline__ void operator()(const f32x4 (&acc)[2][2][4][2], const Unit& u, int wr, int wc, int fr, int fq) const {
        asm volatile("" : "+v"(fr), "+v"(fq));
        if (u.pm < 64) body<true>(acc, u, wr, wc, fr, fq); else body<false>(acc, u, wr, wc, fr, fq);
    }
};
struct EpiOut {
    static constexpr bool PERM = true;
    const float* xin_p; const float* xin_s; float* xw; const float* modl; const float* ng_next; bf16_t* aprime; float* ssq;
    template <bool UNI>
    __device__ __forceinline__ void body(const f32x4 (&acc)[2][2][4][2], const Unit& u, int wr, int wc, int fr, int fq) const {
        const int row0 = u.pm * 256 + wr * 64 + fr, colt = u.pn * 256 + wc * 32 + 8 * fq;
        const bool has_next = ng_next != nullptr;
        f32x4 ug[2][2], us[2][2], uw[2][2];
#pragma unroll
        for (int bj = 0; bj < 2; ++bj) {
            const int c = colt + bj * 128;
            if (has_next) { uw[bj][0] = *(const f32x4*)(ng_next + c); uw[bj][1] = *(const f32x4*)(ng_next + c + 4); }
            if (UNI) {
                const float* mb = modl + (size_t)(u.pm >> 3) * 12288;
                ug[bj][0] = *(const f32x4*)(mb + 2048 + c) + 1.f; ug[bj][1] = *(const f32x4*)(mb + 2048 + c + 4) + 1.f;
                if (has_next) { us[bj][0] = (*(const f32x4*)(mb + 4096 + c) + 1.f) * uw[bj][0]; us[bj][1] = (*(const f32x4*)(mb + 4096 + c + 4) + 1.f) * uw[bj][1]; }
            }
        }
#pragma unroll
        for (int ai = 0; ai < 2; ++ai)
#pragma unroll
            for (int mp = 0; mp < 2; ++mp) {
                f32x4 xv[2][2][2];
#pragma unroll
                for (int mm = 0; mm < 2; ++mm) {
                    const int r = row0 + ai * 128 + (mp * 2 + mm) * 16;
                    const float* xr = r < MP ? xin_p + (size_t)r * DM : xin_s + (size_t)(r - MP) * DM;
#pragma unroll
                    for (int bj = 0; bj < 2; ++bj) { xv[mm][bj][0] = *(const f32x4*)(xr + colt + bj * 128); xv[mm][bj][1] = *(const f32x4*)(xr + colt + bj * 128 + 4); }
                }
#pragma unroll
                for (int mm = 0; mm < 2; ++mm) {
                    const int m = mp * 2 + mm;
                    const int r = row0 + ai * 128 + m * 16;
                    const float* mb = modl + (size_t)row_b(r) * 12288;
                    float ss = 0.f;
#pragma unroll
                    for (int bj = 0; bj < 2; ++bj) {
                        const int c = colt + bj * 128;
                        f32x4 g0, g1;
                        if (UNI) { g0 = ug[bj][0]; g1 = ug[bj][1]; } else { g0 = *(const f32x4*)(mb + 2048 + c) + 1.f; g1 = *(const f32x4*)(mb + 2048 + c + 4) + 1.f; }
                        const f32x4 n0 = xv[mm][bj][0] + g0 * acc[ai][bj][m][0], n1 = xv[mm][bj][1] + g1 * acc[ai][bj][m][1];
                        *(f32x4*)(xw + (size_t)r * DM + c) = n0; *(f32x4*)(xw + (size_t)r * DM + c + 4) = n1;
                        ss += (n0.x * n0.x + n0.y * n0.y) + (n0.z * n0.z + n0.w * n0.w) + (n1.x * n1.x + n1.y * n1.y) + (n1.z * n1.z + n1.w * n1.w);
                        if (has_next) {
                            f32x4 s0, s1;
                            if (UNI) { s0 = us[bj][0]; s1 = us[bj][1]; } else { s0 = (*(const f32x4*)(mb + 4096 + c) + 1.f) * uw[bj][0]; s1 = (*(const f32x4*)(mb + 4096 + c + 4) + 1.f) * uw[bj][1]; }
                            *(u32x4*)(aprime + (size_t)r * DM + c) = pack8(n0 * s0, n1 * s1);
                        }
                    }
                    ss += __shfl_xor(ss, 16); ss += __shfl_xor(ss, 32);
                    if (fq == 0) atomicAdd(ssq + r, ss);
                }
            }
    }
    __device__ __forceinline__ void operator()(const f32x4 (&acc)[2][2][4][2], const Unit& u, int wr, int wc, int fr, int fq) const {
        asm volatile("" : "+v"(fr), "+v"(fq));
        if (u.pm < 64) body<true>(acc, u, wr, wc, fr, fq); else body<false>(acc, u, wr, wc, fr, fq);
    }
};
struct EpiGrp {
    static constexpr bool PERM = true;
    const bf16_t* uz; const float* chs; bf16_t* out;
    __device__ __forceinline__ void operator()(const f32x4 (&acc)[2][2][4][2], const Unit& u, int wr, int wc, int fr, int fq) const {
        asm volatile("" : "+v"(fr), "+v"(fq));
        const int row0 = u.pm * 256 + wr * 64 + fr, colt = u.pn * 256 + wc * 32 + 8 * fq;
        f32x4 cs[2][2];
#pragma unroll
        for (int bj = 0; bj < 2; ++bj) { cs[bj][0] = *(const f32x4*)(chs + colt + bj * 128); cs[bj][1] = *(const f32x4*)(chs + colt + bj * 128 + 4); }
#pragma unroll
        for (int ai = 0; ai < 2; ++ai) {
            u32x4 zz[4][2];
#pragma unroll
            for (int m = 0; m < 4; ++m)
#pragma unroll
                for (int bj = 0; bj < 2; ++bj) zz[m][bj] = *(const u32x4*)(uz + (size_t)(row0 + ai * 128 + m * 16) * 4096 + 2048 + colt + bj * 128);
#pragma unroll
            for (int m = 0; m < 4; ++m) {
                const int r = row0 + ai * 128 + m * 16;
#pragma unroll
                for (int bj = 0; bj < 2; ++bj) {
                    const int c = colt + bj * 128;
                    const u32x4 z = zz[m][bj];
                    const f32x2 a = silu2((f32x2){bf_lo(z.x), bf_hi(z.x)}), b = silu2((f32x2){bf_lo(z.y), bf_hi(z.y)}), cc = silu2((f32x2){bf_lo(z.z), bf_hi(z.z)}), d = silu2((f32x2){bf_lo(z.w), bf_hi(z.w)});
                    const f32x4 z0 = {a.x, a.y, b.x, b.y}, z1 = {cc.x, cc.y, d.x, d.y};
                    *(u32x4*)(out + (size_t)r * 2048 + c) = pack8(acc[ai][bj][m][0] * cs[bj][0] * z0, acc[ai][bj][m][1] * cs[bj][1] * z1);
                }
            }
        }
    }
};
struct EpiSmall {
    static constexpr bool PERM = true;
    int mode; float* mod; const float* ada_b; bf16_t* shiftA; float* sb;
    __device__ __forceinline__ void operator()(const f32x4 (&acc)[2][2][4][2], const Unit& u, int wr, int wc, int fr, int fq) const {
        asm volatile("" : "+v"(fr), "+v"(fq));
        const int row0 = wr * 64 + fr, colt = u.pn * 256 + wc * 32 + 8 * fq;
#pragma unroll
        for (int ai = 0; ai < 2; ++ai)
#pragma unroll
            for (int m = 0; m < 4; ++m) {
                const int r = row0 + ai * 128 + m * 16;
                if (r < 136) {
#pragma unroll
                    for (int bj = 0; bj < 2; ++bj) {
                        const int c = colt + bj * 128;
                        if (mode == 0) {
                            const f32x4 v0 = acc[ai][bj][m][0] + *(const f32x4*)(ada_b + c), v1 = acc[ai][bj][m][1] + *(const f32x4*)(ada_b + c + 4);
                            *(f32x4*)(mod + (size_t)r * 12288 + c) = v0; *(f32x4*)(mod + (size_t)r * 12288 + c + 4) = v1;
                            const int li = c / 3072, cc = c - li * 3072;
                            if (cc < 1024) *(u32x4*)(shiftA + ((size_t)li * 256 + r) * 1024 + cc) = pack8(v0, v1);
                        } else {
                            float* sp = sb + ((size_t)u.q * 136 + r) * 6400 + c;
                            *(f32x4*)sp = acc[ai][bj][m][0]; *(f32x4*)(sp + 4) = acc[ai][bj][m][1];
                        }
                    }
                }
            }
    }
};

__device__ void phase_prep0(const Params& p, const WTab& wt, LAS unsigned char* lds) {
    LAS float* tl = (LAS float*)lds;
    const int tid = otid();
    for (int tile = blockIdx.x; tile < wt.wtiles; tile += gridDim.x) {
        int j = 0;
#pragma unroll 1
        for (int q = 1; q < NWJ; ++q) if (tile >= wt.wj[q].tile_begin) j = q;
        const WJob job = wt.wj[j];
        bf16_t* jdst = (bf16_t*)(p.ws + job.doff);
        const int lt = tile - job.tile_begin, tk = lt / job.tiles_n, tn = lt - tk * job.tiles_n, k0 = tk * 64, n0 = tn * 64;
        {
            const int kk = tid >> 3, nn = (tid & 7) * 8;
            f32x4 a = (f32x4){0.f, 0.f, 0.f, 0.f}, b = a;
            if (n0 + nn < job.N) { const __attribute__((address_space(1))) f32x4* sp = (const __attribute__((address_space(1))) f32x4*)(job.src + (size_t)(k0 + kk) * job.N + n0 + nn); a = sp[0]; b = sp[1]; }
            LAS float* d = tl + kk * 65 + nn;
            d[0] = a.x; d[1] = a.y; d[2] = a.z; d[3] = a.w; d[4] = b.x; d[5] = b.y; d[6] = b.z; d[7] = b.w;
        }
        __syncthreads();
        {
            const int n = tid >> 3, k8 = (tid & 7) * 8;
            const LAS float* s = tl + k8 * 65 + n;
            u32x4 o; o.x = cvt_pk_bf16(s[0], s[65]); o.y = cvt_pk_bf16(s[130], s[195]); o.z = cvt_pk_bf16(s[260], s[325]); o.w = cvt_pk_bf16(s[390], s[455]);
            *(u32x4*)(jdst + (size_t)(n0 + n) * job.K + k0 + k8) = o;
        }
        __syncthreads();
    }
    bf16_t* ac = (bf16_t*)(p.ws + WS_AC);
    const int gt = blockIdx.x * 512 + tid, nth = gridDim.x * 512;
    for (int i = gt; i < 256 * 1024 / 8; i += nth) {
        const int r = i >> 7, c = (i & 127) * 8;
        u32x4 o = (u32x4){0u, 0u, 0u, 0u};
        if (r < 136) {
            const float* cp = r < 8 ? p.in[5] + (size_t)r * 1024 + c : p.in[6] + (size_t)(r - 8) * 1024 + c;
            const f32x4 a = *(const f32x4*)cp, b = *(const f32x4*)(cp + 4);
            o.x = cvt_pk_bf16(silu_f(a.x), silu_f(a.y)); o.y = cvt_pk_bf16(silu_f(a.z), silu_f(a.w)); o.z = cvt_pk_bf16(silu_f(b.x), silu_f(b.y)); o.w = cvt_pk_bf16(silu_f(b.z), silu_f(b.w));
        }
        *(u32x4*)(ac + (size_t)i * 8) = o;
    }
    { u32x4* sq = (u32x4*)(p.ws + WS_SSQ + 17408ull * 4); for (int i = gt; i < 4 * 17408 / 4; i += nth) sq[i] = (u32x4){0u, 0u, 0u, 0u}; }
    u32x4* sh = (u32x4*)(p.ws + WS_SHIFTA);
    for (int i = gt; i < 4 * 256 * 1024 / 8; i += nth) sh[i] = (u32x4){0u, 0u, 0u, 0u};
}

__device__ void phase_xprep(const Params& p) {
    const int tid_ = otid(), lane = tid_ & 63, wv = blockIdx.x * 8 + (tid_ >> 6), nw = gridDim.x * 8;
    const float* mod = (const float*)(p.ws + WS_MOD);
    bf16_t* ap = (bf16_t*)(p.ws + WS_APRIME);
    float* ssq = (float*)(p.ws + WS_SSQ);
    const float* ng = p.in[9];
    for (int r0 = wv * 2; r0 < MT; r0 += nw * 2) {
        f32x4 x[2][4];
#pragma unroll
        for (int h = 0; h < 2; ++h) {
            const int r = r0 + h;
            const float* xr = r < MP ? p.in[0] + (size_t)r * DM : p.in[1] + (size_t)(r - MP) * DM;
#pragma unroll
            for (int q = 0; q < 4; ++q) x[h][q] = *(const f32x4*)(xr + q * 256 + lane * 4);
        }
#pragma unroll
        for (int h = 0; h < 2; ++h) {
            const int r = r0 + h;
            const float* mb = mod + (size_t)row_b(r) * 12288 + 1024;
            float ss = 0.f;
#pragma unroll
            for (int q = 0; q < 4; ++q) {
                const int c = q * 256 + lane * 4;
                const f32x4 xv = x[h][q], sv = *(const f32x4*)(mb + c), g = *(const f32x4*)(ng + c);
                ss += (xv.x * xv.x + xv.y * xv.y) + (xv.z * xv.z + xv.w * xv.w);
                const f32x4 a = xv * g * (sv + 1.f);
                u32x2 o; o.x = cvt_pk_bf16(a.x, a.y); o.y = cvt_pk_bf16(a.z, a.w);
                *(u32x2*)(ap + (size_t)r * DM + c) = o;
            }
#pragma unroll
            for (int o = 1; o < 64; o <<= 1) ss += __shfl_xor(ss, o);
            if (lane == 0) ssq[r] = ss;
        }
    }
}

__device__ void phase_final(const Params& p, int r_begin, int r_end, int blk0) {
    if ((int)blockIdx.x < blk0) return;
    const int tid_ = otid(), lane = tid_ & 63, wv = ((int)blockIdx.x - blk0) * 8 + (tid_ >> 6), nw = ((int)gridDim.x - blk0) * 8;
    const float* xw = (const float*)(p.ws + WS_XW);
    const float* ssq = (const float*)(p.ws + WS_SSQ) + 4 * 17408;
    const float* fg = p.in[22];
    for (int r0 = r_begin + wv * 2; r0 < r_end; r0 += nw * 2) {
        f32x4 x[2][4];
#pragma unroll
        for (int h = 0; h < 2; ++h)
#pragma unroll
            for (int q = 0; q < 4; ++q) x[h][q] = *(const f32x4*)(xw + (size_t)(r0 + h) * DM + q * 256 + lane * 4);
#pragma unroll
        for (int h = 0; h < 2; ++h) {
            const int r = r0 + h;
            const float rstd = rsqrtf(ssq[r] * (1.f / 1024.f) + 1e-6f);
#pragma unroll
            for (int q = 0; q < 4; ++q) {
                const int c = q * 256 + lane * 4;
                const f32x4 g = *(const f32x4*)(fg + c);
                *(f32x4*)(p.out + (size_t)r * DM + c) = x[h][q] * rstd * g;
            }
        }
    }
}

__device__ void phase_ssdnorm(const Params& p, int j) {
    const int tid_ = otid(), lane = tid_ & 63, wv = blockIdx.x * 8 + (tid_ >> 6), nw = gridDim.x * 8;
    const bf16_t* yg = (const bf16_t*)(p.ws + WS_YG);
    bf16_t* a2 = (bf16_t*)(p.ws + WS_A2);
    const float* ng = p.in[16] + (size_t)j * 2048;
    for (int r0 = wv * 2; r0 < MT; r0 += nw * 2) {
        u32x4 vv[2][4];
#pragma unroll
        for (int h = 0; h < 2; ++h)
#pragma unroll
            for (int q = 0; q < 4; ++q) vv[h][q] = *(const u32x4*)(yg + (size_t)(r0 + h) * 2048 + q * 512 + lane * 8);
#pragma unroll
        for (int h = 0; h < 2; ++h)
#pragma unroll
            for (int q = 0; q < 4; ++q) {
                const int c = q * 512 + lane * 8;
                const u32x4 v = vv[h][q];
                f32x4 a, b;
                a.x = bf_lo(v.x); a.y = bf_hi(v.x); a.z = bf_lo(v.y); a.w = bf_hi(v.y); b.x = bf_lo(v.z); b.y = bf_hi(v.z); b.z = bf_lo(v.w); b.w = bf_hi(v.w);
                float ss = (a.x * a.x + a.y * a.y) + (a.z * a.z + a.w * a.w) + (b.x * b.x + b.y * b.y) + (b.z * b.z + b.w * b.w);
#pragma unroll
                for (int o = 1; o < 32; o <<= 1) ss += __shfl_xor(ss, o);
                const float rstd = rsqrtf(ss * (1.f / 256.f) + 1e-6f);
                const f32x4 g0 = *(const f32x4*)(ng + c), g1 = *(const f32x4*)(ng + c + 4);
                *(u32x4*)(a2 + (size_t)(r0 + h) * 2048 + c) = pack8(a * rstd * g0, b * rstd * g1);
            }
    }
}

__device__ void phase_pool(const Params& p, int j) {
    const bf16_t* uz = (const bf16_t*)(p.ws + WS_ZX);
    bf16_t* pooled = (bf16_t*)(p.ws + WS_YG);
    const int gt = blockIdx.x * 512 + otid(), nth = gridDim.x * 512;
    for (int u = gt; u < 131072 + 32768; u += nth) {
        int cv, row0, t0, R; const float* prev = nullptr; bool prompt;
        if (u < 131072) { cv = u & 255; const int run = (u >> 8) & 63, b = u >> 14; row0 = b * 2048; t0 = run * 32; R = 32; prompt = true; }
        else { const int v = u - 131072; cv = v & 255; const int b = v >> 8; row0 = MP + b * 8; t0 = 0; R = 8; prompt = false; prev = p.in[4] + ((size_t)(j * 128 + b) * 15) * 2048; }
        const int c = cv * 8, w = 2 << (c >> 9);
        float s[8];
#pragma unroll
        for (int i = 0; i < 8; ++i) s[i] = 0.f;
        auto getu = [&](int tt, float (&o)[8]) {
            if (tt >= 0) {
                const u32x4 v = *(const u32x4*)(uz + (size_t)(row0 + tt) * 4096 + c);
                o[0] = bf_lo(v.x); o[1] = bf_hi(v.x); o[2] = bf_lo(v.y); o[3] = bf_hi(v.y); o[4] = bf_lo(v.z); o[5] = bf_hi(v.z); o[6] = bf_lo(v.w); o[7] = bf_hi(v.w);
            } else if (!prompt) {
                const float* pp = prev + (size_t)(15 + tt) * 2048 + c;
                const f32x4 a = *(const f32x4*)pp, b = *(const f32x4*)(pp + 4);
                o[0] = a.x; o[1] = a.y; o[2] = a.z; o[3] = a.w; o[4] = b.x; o[5] = b.y; o[6] = b.z; o[7] = b.w;
            } else {
#pragma unroll
                for (int i = 0; i < 8; ++i) o[i] = 0.f;
            }
        };
        for (int i = 1; i < w; ++i) {
            float o[8]; getu(t0 - i, o);
#pragma unroll
            for (int k = 0; k < 8; ++k) s[k] += o[k];
        }
        for (int tb = t0; tb < t0 + R; tb += 4) {
            float cur[4][8], old[4][8];
#pragma unroll
            for (int k = 0; k < 4; ++k) { getu(tb + k, cur[k]); getu(tb + k - w + 1, old[k]); }
#pragma unroll
            for (int k = 0; k < 4; ++k) {
                const int t = tb + k;
                const float inv = 1.f / (float)(prompt ? min(w, t + 1) : w);
                f32x4 a, b;
#pragma unroll
                for (int i = 0; i < 8; ++i) s[i] += cur[k][i];
                a.x = s[0] * inv - cur[k][0]; a.y = s[1] * inv - cur[k][1]; a.z = s[2] * inv - cur[k][2]; a.w = s[3] * inv - cur[k][3];
                b.x = s[4] * inv - cur[k][4]; b.y = s[5] * inv - cur[k][5]; b.z = s[6] * inv - cur[k][6]; b.w = s[7] * inv - cur[k][7];
                *(u32x4*)(pooled + (size_t)(row0 + t) * 2048 + c) = pack8(a, b);
#pragma unroll
                for (int i = 0; i < 8; ++i) s[i] -= old[k][i];
            }
        }
    }
    for (int i = gt; i < (8 + 128) * 15 * 256; i += nth) {
        const int cv = i & 255, k = (i >> 8) % 15, sq = (i >> 8) / 15, ch = cv * 8;
        f32x4 a, b2;
        float* dst;
        bool from_state = false; size_t urow = 0;
        if (sq < 8) { urow = (size_t)(sq * 2048 + 2033 + k); dst = p.out + O_POOL_P + ((size_t)(j * 8 + sq) * 15 + k) * 2048 + ch; }
        else { const int bb = sq - 8; dst = p.out + O_POOL_S + ((size_t)(j * 128 + bb) * 15 + k) * 2048 + ch; if (k < 7) from_state = true; else urow = (size_t)(MP + bb * 8 + k - 7); }
        if (from_state) { const float* sp = p.in[4] + ((size_t)(j * 128 + (sq - 8)) * 15 + 8 + k) * 2048 + ch; a = *(const f32x4*)sp; b2 = *(const f32x4*)(sp + 4); }
        else { const u32x4 v = *(const u32x4*)(uz + urow * 4096 + ch); a = (f32x4){bf_lo(v.x), bf_hi(v.x), bf_lo(v.y), bf_hi(v.y)}; b2 = (f32x4){bf_lo(v.z), bf_hi(v.z), bf_lo(v.w), bf_hi(v.w)}; }
        *(f32x4*)dst = a; *(f32x4*)(dst + 4) = b2;
    }
}

constexpr int RS = 272;
constexpr int L_XT = 0, L_BN = 17408, L_BT = 52224, L_CN = 87040, L_HB = 121856, L_SM = 139264, L_CW = 141312;
__device__ __forceinline__ int xt_addr(int pr, int t) { return L_XT + pr * RS + ((((t >> 3) ^ (pr >> 1)) & 15) << 4) + (t & 7) * 2; }
__device__ __forceinline__ int bt_addr(int n, int t) { return L_BT + n * RS + ((((t >> 3) ^ (n >> 3)) & 15) << 4) + (t & 7) * 2; }
__device__ __forceinline__ f32x16 mfma32(bf16x8 a, bf16x8 b, f32x16 c) { return __builtin_amdgcn_mfma_f32_32x32x16_bf16(a, b, c, 0, 0, 0); }

#define OPQ(x) asm volatile("" : "+v"(x))
__device__ void ssd_prompt_item(const Params& p, int j, int b, int h, LAS unsigned char* lds) {
    const int tid0 = otid(), wid = __builtin_amdgcn_readfirstlane(tid0 >> 6), g = h >> 2;
    const char* zxc = (const char*)(p.ws + WS_ZX);
    const char* dtc = (const char*)(p.ws + WS_DTRAW);
    char* ygc = (char*)(p.ws + WS_YG);
    const int rowbase = b * 2048;
    LAS float* sm_acum = (LAS float*)(lds + L_SM);
    LAS float* sm_dt = sm_acum + 128;
    LAS float* sm_w = sm_acum + 256;
    LAS float* sm_ea = sm_acum + 384;
    LAS float* cw = (LAS float*)(lds + L_CW);
    const float Ah = -__expf(p.in[14][j * 32 + h]), Dh = p.in[15][j * 32 + h], dtb = p.in[13][j * 32 + h];
    const bool roleB = wid < 4;
    const int qq = wid >> 1, tt = qq ^ (qq >> 1), pt = wid & 1, hp = wid & 1, hn = wid >> 1;

    __syncthreads();
    if (tid0 < 320) {
        const int ch = tid0 < 64 ? h * 64 + tid0 : (tid0 < 192 ? 2048 + g * 128 + (tid0 - 64) : 3072 + g * 128 + (tid0 - 192));
#pragma unroll
        for (int k = 0; k < 4; ++k) cw[k * 320 + tid0] = p.in[11][((size_t)j * 4 + k) * 4096 + ch];
        cw[4 * 320 + tid0] = p.in[12][(size_t)j * 4096 + ch];
    }
    for (int i = tid0; i < 17408 / 4; i += 512) *(LAS unsigned*)(lds + L_HB + i * 4) = 0u;

    u32x4 rawBC[11]; unsigned rawX[11]; float dtp0 = 0.f, dtp1 = 0.f;
    auto prefetch = [&](int t0) {
        int tid = tid0; OPQ(tid);
        const int bt_ = tid & 255, tqb = bt_ >> 4, cg8 = bt_ & 15, tqx = tid >> 5, cp = tid & 31, lane = tid & 63;
        const int colBC = (roleB ? 4096 : 5120) + g * 128 + cg8 * 8, colX = 2048 + h * 64 + cp * 2;
        const int rB = t0 + tqb * 8 - 3, rX = t0 + tqx * 8 - 3;
        const unsigned oB = (unsigned)((rowbase + rB) * ZXW + colBC) * 2u, oX = (unsigned)((rowbase + rX) * ZXW + colX) * 2u;
#pragma unroll
        for (int i = 0; i < 11; ++i) {
            rawBC[i] = (rB + i >= 0) ? *(const u32x4*)(zxc + (oB + (unsigned)i * 12288u)) : (u32x4){0u, 0u, 0u, 0u};
            rawX[i] = (rX + i >= 0) ? *(const unsigned*)(zxc + (oX + (unsigned)i * 12288u)) : 0u;
        }
        if (wid == 0) { const unsigned od = (unsigned)((rowbase + t0 + 2 * lane) * 32 + h) * 4u; dtp0 = *(const float*)(dtc + od); dtp1 = *(const float*)(dtc + (od + 128u)); }
    };
    prefetch(0);

    f32x16 hacc;
#pragma unroll
    for (int i = 0; i < 16; ++i) hacc[i] = 0.f;

#pragma unroll 1
    for (int c = 0; c < 16; ++c) {
        const int t0 = c * 128;
        if (wid == 0) {
            int lane = tid0 & 63; OPQ(lane);
            const float d0 = softplus_f(dtp0 + dtb), d1 = softplus_f(dtp1 + dtb);
            const float a0 = d0 * Ah, a1 = a0 + d1 * Ah;
            float sc = a1;
#pragma unroll
            for (int o = 1; o < 64; o <<= 1) { const float v = __shfl_up(sc, o); if (lane >= o) sc += v; }
            const float c1 = sc, c0 = sc - a1 + a0;
            const float last = __shfl(sc, 63);
            sm_acum[2 * lane] = c0; sm_acum[2 * lane + 1] = c1;
            sm_dt[2 * lane] = d0; sm_dt[2 * lane + 1] = d1;
            sm_w[2 * lane] = __expf(last - c0) * d0; sm_w[2 * lane + 1] = __expf(last - c1) * d1;
            sm_ea[2 * lane] = __expf(c0); sm_ea[2 * lane + 1] = __expf(c1);
        }
        __syncthreads();
        {
            int tid = tid0; OPQ(tid);
            const int bt_ = tid & 255, tqb = bt_ >> 4, cg8 = bt_ & 15;
            const int lcBC = (roleB ? 64 : 192) + cg8 * 8;
            const f32x4 wv0 = *(const LAS f32x4*)(sm_w + tqb * 8), wv1 = *(const LAS f32x4*)(sm_w + tqb * 8 + 4);
            const float wt[8] = {wv0.x, wv0.y, wv0.z, wv0.w, wv1.x, wv1.y, wv1.z, wv1.w};
            const int natbase = (roleB ? L_BN : L_CN) + (tqb * 8) * RS + cg8 * 16;
#pragma unroll
            for (int half = 0; half < 2; ++half) {
                u32x2 nat[8]; u32x4 tr[4];
#pragma unroll
                for (int ipp = 0; ipp < 2; ++ipp) {
                    const int ip = half * 2 + ipp;
                    const float k0a = cw[0 * 320 + lcBC + 2 * ip], k0b = cw[0 * 320 + lcBC + 2 * ip + 1];
                    const float k1a = cw[1 * 320 + lcBC + 2 * ip], k1b = cw[1 * 320 + lcBC + 2 * ip + 1];
                    const float k2a = cw[2 * 320 + lcBC + 2 * ip], k2b = cw[2 * 320 + lcBC + 2 * ip + 1];
                    const float k3a = cw[3 * 320 + lcBC + 2 * ip], k3b = cw[3 * 320 + lcBC + 2 * ip + 1];
                    const float bba = cw[4 * 320 + lcBC + 2 * ip], bbb = cw[4 * 320 + lcBC + 2 * ip + 1];
                    f32x2 rr[11];
#pragma unroll
                    for (int i = 0; i < 11; ++i) { const unsigned v = rawBC[i][ip]; rr[i] = (f32x2){bf_lo(v), bf_hi(v)}; }
                    const f32x2 K0 = {k0a, k0b}, K1 = {k1a, k1b}, K2 = {k2a, k2b}, K3 = {k3a, k3b}, BB = {bba, bbb};
                    float va[8], vb[8];
#pragma unroll
                    for (int t = 0; t < 8; ++t) {
                        const f32x2 v = silu2(BB + K0 * rr[t] + K1 * rr[t + 1] + K2 * rr[t + 2] + K3 * rr[t + 3]);
                        va[t] = v.x; vb[t] = v.y;
                        nat[t][ipp] = cvt_pk_bf16(v.x, v.y);
                    }
                    if (roleB) {
#pragma unroll
                        for (int tp = 0; tp < 4; ++tp) {
                            tr[2 * ipp][tp] = cvt_pk_bf16(va[2 * tp] * wt[2 * tp], va[2 * tp + 1] * wt[2 * tp + 1]);
                            tr[2 * ipp + 1][tp] = cvt_pk_bf16(vb[2 * tp] * wt[2 * tp], vb[2 * tp + 1] * wt[2 * tp + 1]);
                        }
                    }
                }
#pragma unroll
                for (int t = 0; t < 8; ++t) *(LAS u32x2*)(lds + natbase + t * RS + half * 8) = nat[t];
                if (roleB) {
#pragma unroll
                    for (int i = 0; i < 4; ++i) *(LAS u32x4*)(lds + bt_addr(cg8 * 8 + half * 4 + i, tqb * 8)) = tr[i];
                }
                __builtin_amdgcn_sched_barrier(0);
            }
        }
        {
            int tid = tid0; OPQ(tid);
            const int tqx = tid >> 5, cp = tid & 31, lcX = cp * 2;
            const float k0a = cw[0 * 320 + lcX], k0b = cw[0 * 320 + lcX + 1], k1a = cw[1 * 320 + lcX], k1b = cw[1 * 320 + lcX + 1];
            const float k2a = cw[2 * 320 + lcX], k2b = cw[2 * 320 + lcX + 1], k3a = cw[3 * 320 + lcX], k3b = cw[3 * 320 + lcX + 1];
            const float bba = cw[4 * 320 + lcX], bbb = cw[4 * 320 + lcX + 1];
            f32x2 rr[11];
#pragma unroll
            for (int i = 0; i < 11; ++i) rr[i] = (f32x2){bf_lo(rawX[i]), bf_hi(rawX[i])};
            const f32x2 K0 = {k0a, k0b}, K1 = {k1a, k1b}, K2 = {k2a, k2b}, K3 = {k3a, k3b}, BB = {bba, bbb};
            float va[8], vb[8];
#pragma unroll
            for (int t = 0; t < 8; ++t) { const f32x2 v = silu2(BB + K0 * rr[t] + K1 * rr[t + 1] + K2 * rr[t + 2] + K3 * rr[t + 3]); va[t] = v.x; vb[t] = v.y; }
            u32x4 xa, xb;
            xa.x = cvt_pk_bf16(va[0], va[1]); xa.y = cvt_pk_bf16(va[2], va[3]); xa.z = cvt_pk_bf16(va[4], va[5]); xa.w = cvt_pk_bf16(va[6], va[7]);
            xb.x = cvt_pk_bf16(vb[0], vb[1]); xb.y = cvt_pk_bf16(vb[2], vb[3]); xb.z = cvt_pk_bf16(vb[4], vb[5]); xb.w = cvt_pk_bf16(vb[6], vb[7]);
            *(LAS u32x4*)(lds + xt_addr(cp * 2, tqx * 8)) = xa;
            *(LAS u32x4*)(lds + xt_addr(cp * 2 + 1, tqx * 8)) = xb;
        }
        if (c + 1 < 16) prefetch(t0 + 128);
        bf16_t zr[16];
        {
            int ln = tid0 & 63; OPQ(ln);
            const int l31 = ln & 31, hh = ln >> 5;
            const unsigned oz = (unsigned)((rowbase + t0 + tt * 32 + 4 * hh) * ZXW + h * 64 + pt * 32 + l31) * 2u;
#pragma unroll
            for (int rg = 0; rg < 16; ++rg) zr[rg] = *(const bf16_t*)(zxc + (oz + (unsigned)((rg & 3) + 8 * (rg >> 2)) * 12288u));
        }
        __syncthreads();
        f32x16 y;
        {
            int ln = tid0 & 63; OPQ(ln);
            const int l31 = ln & 31, hh = ln >> 5;
            const int cbase = L_CN + (tt * 32 + l31) * RS + 16 * hh, hbase = L_HB + (pt * 32 + l31) * RS + 16 * hh;
#pragma unroll
            for (int i = 0; i < 16; ++i) y[i] = 0.f;
#pragma unroll
            for (int ks = 0; ks < 8; ++ks) { const bf16x8 cfr = *(const LAS bf16x8*)(lds + cbase + ks * 32); const bf16x8 bfr = *(const LAS bf16x8*)(lds + hbase + ks * 32); y = mfma32(cfr, bfr, y); }
#pragma unroll
            for (int rq = 0; rq < 4; ++rq) { const f32x4 e = *(const LAS f32x4*)(sm_ea + tt * 32 + 8 * rq + 4 * hh); y[4 * rq] *= e.x; y[4 * rq + 1] *= e.y; y[4 * rq + 2] *= e.z; y[4 * rq + 3] *= e.w; }
            const int tidx = tt * 32 + l31;
            const float at = sm_acum[tidx];
#pragma unroll 1
            for (int st = 0; st <= tt; ++st) {
                f32x16 s;
#pragma unroll
                for (int i = 0; i < 16; ++i) s[i] = 0.f;
                const int bbase = L_BN + (st * 32 + l31) * RS + 16 * hh;
#pragma unroll
                for (int ks = 0; ks < 8; ++ks) { const bf16x8 afr = *(const LAS bf16x8*)(lds + bbase + ks * 32); const bf16x8 cfr = *(const LAS bf16x8*)(lds + cbase + ks * 32); s = mfma32(afr, cfr, s); }
#pragma unroll
                for (int rq = 0; rq < 4; ++rq) {
                    const int sb0 = st * 32 + 8 * rq + 4 * hh;
                    const f32x4 asv = *(const LAS f32x4*)(sm_acum + sb0), dsv = *(const LAS f32x4*)(sm_dt + sb0);
#pragma unroll
                    for (int i = 0; i < 4; ++i) {
                        float e = at - asv[i];
                        if (sb0 + i > tidx) e = -INFINITY;
                        s[4 * rq + i] *= __expf(e) * dsv[i];
                    }
                }
#pragma unroll
                for (int k2 = 0; k2 < 2; ++k2) {
                    u32x4 au; au.x = cvt_pk_bf16(s[8 * k2], s[8 * k2 + 1]); au.y = cvt_pk_bf16(s[8 * k2 + 2], s[8 * k2 + 3]); au.z = cvt_pk_bf16(s[8 * k2 + 4], s[8 * k2 + 5]); au.w = cvt_pk_bf16(s[8 * k2 + 6], s[8 * k2 + 7]);
                    const int sbase = st * 32 + 16 * k2 + 4 * hh;
                    const u32x2 lo = *(const LAS u32x2*)(lds + xt_addr(pt * 32 + l31, sbase)), hi = *(const LAS u32x2*)(lds + xt_addr(pt * 32 + l31, sbase + 8));
                    u32x4 bu; bu.x = lo.x; bu.y = lo.y; bu.z = hi.x; bu.w = hi.y;
                    y = mfma32(__builtin_bit_cast(bf16x8, au), __builtin_bit_cast(bf16x8, bu), y);
                }
            }
        }
        {
            int ln = tid0 & 63; OPQ(ln);
            const int l31 = ln & 31, hh = ln >> 5;
            const float dec = sm_ea[127];
#pragma unroll
            for (int i = 0; i < 16; ++i) hacc[i] *= dec;
#pragma unroll
            for (int ks = 0; ks < 8; ++ks) {
                const bf16x8 a = *(const LAS bf16x8*)(lds + xt_addr(hp * 32 + l31, ks * 16 + 8 * hh));
                const bf16x8 bb = *(const LAS bf16x8*)(lds + bt_addr(hn * 32 + l31, ks * 16 + 8 * hh));
                hacc = mfma32(a, bb, hacc);
            }
        }
        {
            int ln = tid0 & 63; OPQ(ln);
            const int l31 = ln & 31, hh = ln >> 5;
            const unsigned oy = (unsigned)((rowbase + t0 + tt * 32 + 4 * hh) * 2048 + h * 64 + pt * 32 + l31) * 2u;
#pragma unroll
            for (int rq = 0; rq < 4; ++rq) {
                const u32x2 xv = *(const LAS u32x2*)(lds + xt_addr(pt * 32 + l31, tt * 32 + 8 * rq + 4 * hh));
                const float xs[4] = {bf_lo(xv.x), bf_hi(xv.x), bf_lo(xv.y), bf_hi(xv.y)};
#pragma unroll
                for (int i = 0; i < 4; ++i) {
                    const int rg = 4 * rq + i;
                    const float yv = y[rg] + Dh * xs[i];
                    const float gv = yv * silu_f(bf2f(zr[rg]));
                    *(bf16_t*)(ygc + (oy + (unsigned)(8 * rq + i) * 4096u)) = (bf16_t)(cvt_pk_bf16(gv, 0.f) & 0xffffu);
                }
            }
        }
        __syncthreads();
        {
            int ln = tid0 & 63; OPQ(ln);
            const int l31 = ln & 31, hh = ln >> 5;
#pragma unroll
            for (int rg = 0; rg < 16; ++rg) {
                const int pr = hp * 32 + (rg & 3) + 8 * (rg >> 2) + 4 * hh;
                *(LAS bf16_t*)(lds + L_HB + pr * RS + (hn * 32 + l31) * 2) = (bf16_t)(cvt_pk_bf16(hacc[rg], 0.f) & 0xffffu);
            }
        }
    }
    {
        int ln = tid0 & 63; OPQ(ln);
        const int l31 = ln & 31, hh = ln >> 5;
        float* so = p.out + O_SSM_P + ((size_t)(j * 8 + b) * 32 + h) * 8192;
#pragma unroll
        for (int rg = 0; rg < 16; ++rg) {
            const int pr = hp * 32 + (rg & 3) + 8 * (rg >> 2) + 4 * hh;
            so[pr * 128 + hn * 32 + l31] = hacc[rg];
        }
    }
}

__device__ void ssd_sample_item(const Params& p, int j, int b, int g, LAS unsigned char* lds) {
    const int tid = otid();
    const bf16_t* zx = (const bf16_t*)(p.ws + WS_ZX);
    const float* dtraw = (const float*)(p.ws + WS_DTRAW);
    bf16_t* yg = (bf16_t*)(p.ws + WS_YG);
    LAS float* sx = (LAS float*)lds;
    LAS float* sB = sx + 2048;
    LAS float* sC = sB + 1024;
    LAS float* sdt = sC + 1024;
    LAS float* sdec = sdt + 32;
    const int pp = tid >> 3, nl = (tid & 7) * 4;
    const float* st = p.in[2] + ((size_t)(j * 128 + b) * 32 + g * 4) * 8192;
    f32x4 hs[4][4];
#pragma unroll
    for (int r = 0; r < 4; ++r)
#pragma unroll
        for (int q = 0; q < 4; ++q) hs[r][q] = *(const f32x4*)(st + r * 8192 + pp * 128 + nl + 32 * q);
    __syncthreads();
    {
        const int cc = tid < 256 ? g * 256 + tid : (tid < 384 ? 2048 + g * 128 + (tid - 256) : 3072 + g * 128 + (tid - 384));
        float raw[11];
#pragma unroll
        for (int k = 0; k < 3; ++k) raw[k] = p.in[3][((size_t)(j * 128 + b) * 3 + k) * 4096 + cc];
#pragma unroll
        for (int t = 0; t < 8; ++t) raw[3 + t] = bf2f(zx[(size_t)(MP + b * 8 + t) * ZXW + 2048 + cc]);
        const float w0 = p.in[11][((size_t)j * 4 + 0) * 4096 + cc], w1 = p.in[11][((size_t)j * 4 + 1) * 4096 + cc];
        const float w2 = p.in[11][((size_t)j * 4 + 2) * 4096 + cc], w3 = p.in[11][((size_t)j * 4 + 3) * 4096 + cc];
        const float bs = p.in[12][(size_t)j * 4096 + cc];
        LAS float* dst = tid < 256 ? sx + tid : (tid < 384 ? sB + (tid - 256) : sC + (tid - 384));
        const int dstride = tid < 256 ? 256 : 128;
#pragma unroll
        for (int t = 0; t < 8; ++t) dst[t * dstride] = silu_f(bs + w0 * raw[t] + w1 * raw[t + 1] + w2 * raw[t + 2] + w3 * raw[t + 3]);
        if (tid < 32) {
            const int t = tid >> 2, r = tid & 3, hd = g * 4 + r;
            const float dtv = softplus_f(dtraw[(size_t)(MP + b * 8 + t) * 32 + hd] + p.in[13][j * 32 + hd]);
            sdt[tid] = dtv; sdec[tid] = __expf(-dtv * __expf(p.in[14][j * 32 + hd]));
        }
    }
    __syncthreads();
    float* so = p.out + O_SSM_S + ((size_t)(j * 128 + b) * 32 + g * 4) * 8192;
#pragma unroll
    for (int r = 0; r < 4; ++r) {
        const float Dh = p.in[15][j * 32 + g * 4 + r];
        float ysel = 0.f;
#pragma unroll
        for (int t = 0; t < 8; ++t) {
            const float dtv = sdt[t * 4 + r], dec = sdec[t * 4 + r], dx = dtv * sx[t * 256 + r * 64 + pp];
            float yp = 0.f;
#pragma unroll
            for (int q = 0; q < 4; ++q) {
                const f32x4 B4 = *(const LAS f32x4*)(sB + t * 128 + nl + 32 * q), C4 = *(const LAS f32x4*)(sC + t * 128 + nl + 32 * q);
                hs[r][q] = hs[r][q] * dec + B4 * dx;
                yp += (hs[r][q].x * C4.x + hs[r][q].y * C4.y) + (hs[r][q].z * C4.z + hs[r][q].w * C4.w);
            }
            yp += __shfl_xor(yp, 1); yp += __shfl_xor(yp, 2); yp += __shfl_xor(yp, 4);
            if ((tid & 7) == t) ysel = yp;
        }
        {
            const int t = tid & 7, ch = g * 256 + r * 64 + pp;
            const size_t row = (size_t)(MP + b * 8 + t);
            const float yv = ysel + Dh * sx[t * 256 + r * 64 + pp];
            const float gv = yv * silu_f(bf2f(zx[row * ZXW + ch]));
            yg[row * 2048 + ch] = (bf16_t)(cvt_pk_bf16(gv, 0.f) & 0xffffu);
        }
#pragma unroll
        for (int q = 0; q < 4; ++q) *(f32x4*)(so + r * 8192 + pp * 128 + nl + 32 * q) = hs[r][q];
    }
}

__device__ void phase_scan(const Params& p, int j, LAS unsigned char* lds) {
    for (int item = blockIdx.x; item < 256; item += gridDim.x) {
        const int g = item & 7, k = item >> 3, b = k >> 2, r = k & 3;
        for (int rep = 0; rep < REP_PROMPT; ++rep) ssd_prompt_item(p, j, b, g * 4 + r, lds);
    }
#ifndef NO_SAMPLE
    for (int item = blockIdx.x; item < 1024; item += gridDim.x) ssd_sample_item(p, j, item >> 3, item & 7, lds);
#endif
    const bf16_t* zx = (const bf16_t*)(p.ws + WS_ZX);
    const int gt = blockIdx.x * 512 + otid(), nth = gridDim.x * 512;
    for (int i = gt; i < 136 * 3 * 512; i += nth) {
        const int ch = (i & 511) * 8, k = (i >> 9) % 3, sq = (i >> 9) / 3;
        const size_t row = sq < 8 ? (size_t)(sq * 2048 + 2045 + k) : (size_t)(MP + (sq - 8) * 8 + 5 + k);
        float* dst = sq < 8 ? p.out + O_CONV_P + ((size_t)(j * 8 + sq) * 3 + k) * 4096 + ch : p.out + O_CONV_S + ((size_t)(j * 128 + (sq - 8)) * 3 + k) * 4096 + ch;
        const u32x4 v = *(const u32x4*)(zx + row * ZXW + 2048 + ch);
        *(f32x4*)dst = (f32x4){bf_lo(v.x), bf_hi(v.x), bf_lo(v.y), bf_hi(v.y)}; *(f32x4*)(dst + 4) = (f32x4){bf_lo(v.z), bf_hi(v.z), bf_lo(v.w), bf_hi(v.w)};
    }
}

#define XB_TMO      128
#define XB_XCNT(j)  (256  + 64 * (j))
#define XB_XSUB(j)  (1280 + 64 * (j))
#define XB_XGEN(j)  (2304 + 64 * (j))
#define XB_TOP      3328
#define XB_TOPGEN   3392
#define XCD_BAR_WORDS 3456
#define XB_SPIN_CAP (1u << 22)
__device__ __forceinline__ unsigned xb_ld(unsigned* p)              { return __hip_atomic_load(p, __ATOMIC_RELAXED, __HIP_MEMORY_SCOPE_AGENT); }
__device__ __forceinline__ unsigned xb_add(unsigned* p, unsigned v) { return __hip_atomic_fetch_add(p, v, __ATOMIC_RELAXED, __HIP_MEMORY_SCOPE_AGENT); }
__device__ __forceinline__ unsigned xb_xcc_id() { return (unsigned)__builtin_amdgcn_s_getreg((3 << 11) | 20) & 0xFu; }
#define XB_SPIN(cond, bar) do { unsigned _sp = 0; while (cond) { __builtin_amdgcn_s_sleep(1); \
    if ((++_sp & 255u) == 0u) { if (xb_ld(&(bar)[XB_TMO])) break; if (_sp > XB_SPIN_CAP) { atomicAdd(&(bar)[XB_TMO], 1u); break; } } } } while (0)
struct XcdBarrier { unsigned* bar; unsigned x; volatile LAS unsigned* st; };
__device__ __forceinline__ XcdBarrier xcd_barrier_post(unsigned* bar, volatile LAS unsigned* st) {
    XcdBarrier b; b.bar = bar; b.x = xb_xcc_id(); b.st = st;
    if (threadIdx.x == 0) (void)xb_add(&bar[XB_XCNT(b.x)], 1u);
    return b;
}
__device__ __forceinline__ void xcd_barrier_complete(unsigned* bar, unsigned x, unsigned& nloc, unsigned& nx) {
    const unsigned G = gridDim.x * gridDim.y * gridDim.z;
    unsigned sum, cnt, mine, sp = 0u;
    for (;;) {
        sum = 0u; cnt = 0u; mine = 0u;
#pragma unroll
        for (unsigned j = 0; j < 16; ++j) { const unsigned c = xb_ld(&bar[XB_XCNT(j)]); sum += c; cnt += (c > 0u) ? 1u : 0u; mine = (j == x) ? c : mine; }
        if (sum == G) break;
        __builtin_amdgcn_s_sleep(1);
        if ((++sp & 255u) == 0u) { if (xb_ld(&bar[XB_TMO])) break; if (sp > XB_SPIN_CAP) { atomicAdd(&bar[XB_TMO], 1u); break; } }
    }
    nloc = mine > 0u ? mine : 1u; nx = cnt > 0u ? cnt : 1u;
}
__device__ __forceinline__ void xcd_barrier(const XcdBarrier& b) {
    asm volatile("s_waitcnt vmcnt(0)" ::: "memory");
    __syncthreads();
    if (threadIdx.x == 0) {
        unsigned* bar = b.bar;
        __builtin_amdgcn_s_waitcnt(0);
        unsigned nloc = b.st[0], nx = b.st[1];
        if (nloc == 0u) { xcd_barrier_complete(bar, b.x, nloc, nx); b.st[0] = nloc; b.st[1] = nx; }
        const unsigned old = xb_add(&bar[XB_XSUB(b.x)], 1u);
        const unsigned gen = old / nloc;
        if (old + 1u == (gen + 1u) * nloc) {
            __builtin_amdgcn_fence(__ATOMIC_RELEASE, "agent");
            asm volatile("s_waitcnt vmcnt(0)" ::: "memory");
            const unsigned og = xb_add(&bar[XB_TOP], 1u);
            const unsigned tg = og / nx;
            if (og + 1u == (tg + 1u) * nx) xb_add(&bar[XB_TOPGEN], 1u);
            else XB_SPIN(xb_ld(&bar[XB_TOPGEN]) == tg, bar);
            __builtin_amdgcn_fence(__ATOMIC_ACQUIRE, "agent");
            xb_add(&bar[XB_XGEN(b.x)], 1u);
            asm volatile("s_waitcnt vmcnt(0)" ::: "memory");
        } else {
            XB_SPIN(xb_ld(&bar[XB_XGEN(b.x)]) == gen, bar);
            __builtin_amdgcn_fence(__ATOMIC_ACQUIRE, "agent");
            asm volatile("s_waitcnt vmcnt(0)" ::: "memory");
        }
    }
    __syncthreads();
}

#ifndef REP_PREP0
#define REP_PREP0 1
#endif
#ifndef REP_SMALL
#define REP_SMALL 1
#endif
#ifndef REP_GGRP
#define REP_GGRP 1
#endif
#ifndef REP_GGRP
#define REP_GGRP 1
#endif
#ifndef REP_SYNC
#define REP_SYNC 1
#endif
#ifndef REP_SCAN
#define REP_SCAN 1
#endif
#ifndef REP_GIN
#define REP_GIN 1
#endif
#ifndef REP_GOUT
#define REP_GOUT 1
#endif
#ifndef REP_ELEM
#define REP_ELEM 1
#endif
#define GSYNC() do { for (int _r = 0; _r < REP_SYNC; ++_r) xcd_barrier(xb); } while (0)
__global__ __launch_bounds__(512, 2) void hybrid_fwd(const float* i0, const float* i1, const float* i2, const float* i3, const float* i4, const float* i5, const float* i6, const float* i7,
        const float* i8, const float* i9, const float* i10, const float* i11, const float* i12, const float* i13, const float* i14, const float* i15, const float* i16, const float* i17,
        const float* i18, const float* i19, const float* i20, const float* i21, const float* i22, float* outp, unsigned char* wsp, WTab wt) {
    Params p;
    p.in[0] = i0; p.in[1] = i1; p.in[2] = i2; p.in[3] = i3; p.in[4] = i4; p.in[5] = i5; p.in[6] = i6; p.in[7] = i7; p.in[8] = i8; p.in[9] = i9; p.in[10] = i10; p.in[11] = i11;
    p.in[12] = i12; p.in[13] = i13; p.in[14] = i14; p.in[15] = i15; p.in[16] = i16; p.in[17] = i17; p.in[18] = i18; p.in[19] = i19; p.in[20] = i20; p.in[21] = i21; p.in[22] = i22;
    p.out = outp; p.ws = wsp;
    extern __shared__ __attribute__((aligned(16))) unsigned char smem[];
    LAS unsigned char* lds = (LAS unsigned char*)smem;
    cg::grid_group grid = cg::this_grid();
    unsigned char* ws = p.ws;
    volatile LAS unsigned* xst = (volatile LAS unsigned*)(lds + LDS_XB);
    if (threadIdx.x == 0) { xst[0] = 0u; xst[1] = 0u; }
    __syncthreads();
    const XcdBarrier xb = xcd_barrier_post((unsigned*)(ws + WS_BAR), xst);

    for (int rep = 0; rep < REP_PREP0; ++rep) phase_prep0(p, wt, lds);
    grid.sync();
#pragma unroll 1
    for (int mode_ = 0; mode_ < 2 * REP_SMALL; ++mode_) {
        const int mode = mode_ % 2;
        pg8::SmallSched S; S.mode = mode; S.G = (int)gridDim.x; S.c = (int)blockIdx.x; S.lda = 1024; S.ldb = 1024; S.K = 1024;
        S.A0 = (const char*)(ws + (mode == 0 ? WS_AC : WS_SHIFTA)); S.ada = (const char*)(ws + WS_WT_ADA); S.ssd_in = (const char*)(ws + WS_WT_SSD_IN); S.pool_in = (const char*)(ws + WS_WT_POOL_IN);
        EpiSmall E; E.mode = mode; E.mod = (float*)(ws + WS_MOD); E.ada_b = p.in[8]; E.shiftA = (bf16_t*)(ws + WS_SHIFTA); E.sb = (float*)(ws + WS_SB);
#ifndef NO_GSMALL
        pg8::gemm_phase<EpiSmall, pg8::SmallSched>(lds, S, E);
#endif
        if (mode == 1) phase_xprep(p);
        GSYNC();
    }
    unsigned* tailw = (unsigned*)(ws + WS_BAR) + 3584;
    unsigned* tmow = (unsigned*)(ws + WS_BAR) + XB_TMO;
#pragma unroll 1
    for (int layer = 0; layer < 4; ++layer) {
        const int j = layer >> 1; const bool ssd = (layer & 1) == 0;
        {
            pg8::InSched S;
            S.init(ssd ? 6400 : 4096, ws + WS_APRIME, ssd ? ws + WS_WT_SSD_IN + (size_t)j * 6400 * 1024 * 2 : ws + WS_WT_POOL_IN + (size_t)j * 4096 * 1024 * 2, layer > 0 ? tailw + 64 * (layer - 1) : nullptr, tmow);
            EpiIn E; E.ssq = (const float*)(ws + WS_SSQ) + (size_t)layer * 17408; E.sb = (const float*)(ws + WS_SB) + (size_t)layer * 136 * 6400; E.out = (bf16_t*)(ws + WS_ZX);
            E.ldo = ssd ? ZXW : 4096; E.nbf = ssd ? ZXW : 4096; E.dtraw = ssd ? (float*)(ws + WS_DTRAW) : nullptr;
            for (int rep = 0; rep < REP_GIN; ++rep) pg8::gemm_phase<EpiIn, pg8::InSched>(lds, S, E);
        }
        GSYNC();
        if (ssd) { for (int rep = 0; rep < REP_SCAN; ++rep) phase_scan(p, j, lds); } else { for (int rep = 0; rep < REP_ELEM; ++rep) phase_pool(p, j); }
        GSYNC();
        if (ssd) { for (int rep = 0; rep < REP_ELEM; ++rep) phase_ssdnorm(p, j); }
        else {
            pg8::MainSched S; S.init(MT, 2048, 512, 2048, 512, ws + WS_YG, ws + WS_WT_POOL_G + (size_t)j * 2048 * 512 * 2, 1);
            EpiGrp E; E.uz = (const bf16_t*)(ws + WS_ZX); E.chs = p.in[20] + (size_t)j * 2048; E.out = (bf16_t*)(ws + WS_A2);
            for (int rep = 0; rep < REP_GGRP; ++rep) pg8::gemm_phase<EpiGrp, pg8::MainSched>(lds, S, E);
        }
        GSYNC();
#pragma unroll 1
        for (int part = 0; part < 2; ++part) {
            pg8::MainSched S; S.init(part == 0 ? MP : MT, 1024, 2048, 2048, 2048, ws + WS_A2, ssd ? ws + WS_WT_SSD_OUT + (size_t)j * 1024 * 2048 * 2 : ws + WS_WT_POOL_OUT + (size_t)j * 1024 * 2048 * 2, 30, part);
            EpiOut E; float* xw = (float*)(ws + WS_XW);
            E.xin_p = layer == 0 ? p.in[0] : xw; E.xin_s = layer == 0 ? p.in[1] : xw + (size_t)MP * DM; E.xw = xw;
            E.modl = (const float*)(ws + WS_MOD) + (size_t)layer * 3072; E.ng_next = layer < 3 ? p.in[9] + (size_t)(layer + 1) * 1024 : nullptr;
            E.aprime = (bf16_t*)(ws + WS_APRIME); E.ssq = (float*)(ws + WS_SSQ) + (size_t)(layer + 1) * 17408;
            pg8::gemm_phase<EpiOut, pg8::MainSched>(lds, S, E);
            if (part == 0) GSYNC();
        }
        if (blockIdx.x < 16) {
            asm volatile("s_waitcnt vmcnt(0)" ::: "memory");
            __syncthreads();
            if (threadIdx.x == 0) { __builtin_amdgcn_fence(__ATOMIC_RELEASE, "agent"); asm volatile("s_waitcnt vmcnt(0)" ::: "memory"); __hip_atomic_fetch_add(tailw + 64 * layer, 1u, __ATOMIC_RELAXED, __HIP_MEMORY_SCOPE_AGENT); }
        }
    }
    phase_final(p, 0, MP, 16);
    GSYNC();
    phase_final(p, MP, MT, 0);
}

extern "C" void kernel_launch(void* const* d_in, const int* in_sizes, int n_in, void* d_out, int out_size, void* d_ws, size_t ws_size, hipStream_t stream) {
    static int grid = 0;
    if (grid == 0) {
        if (n_in != 23 || ws_size < WS_END) { fprintf(stderr, "kernel_launch: unexpected n_in %d or ws_size %zu (need %zu)\n", n_in, ws_size, (size_t)WS_END); grid = -1; return; }
        int dev = 0, cus = 0, per_cu = 0;
        hipGetDevice(&dev);
        hipDeviceGetAttribute(&cus, hipDeviceAttributeMultiprocessorCount, dev);
        if (hipFuncSetAttribute((const void*)hybrid_fwd, hipFuncAttributeMaxDynamicSharedMemorySize, LDS_BYTES) != hipSuccess) { fprintf(stderr, "kernel_launch: hipFuncSetAttribute failed\n"); grid = -1; return; }
        if (hipOccupancyMaxActiveBlocksPerMultiprocessor(&per_cu, (const void*)hybrid_fwd, 512, LDS_BYTES) != hipSuccess || per_cu < 1) { fprintf(stderr, "kernel_launch: occupancy query gave %d\n", per_cu); (void)hipGetLastError(); per_cu = 1; }
        grid = cus * 1;
    }
    if (grid < 0) return;
    WTab wt{};
    unsigned char* ws = (unsigned char*)d_ws;
    int nj = 0, tb = 0;
    auto add = [&](int srci, long long soff, size_t dst_off, int K, int N, int Npad) {
        WJob& w = wt.wj[nj++]; w.src = (const float*)d_in[srci] + soff; w.doff = (long long)dst_off; w.K = K; w.N = N; w.tiles_n = Npad / 64; w.tile_begin = tb; tb += (K / 64) * (Npad / 64);
    };
    for (int i = 0; i < 4; ++i) add(7, (long long)i * 1024 * 3072, WS_WT_ADA + (size_t)i * 3072 * 1024 * 2, 1024, 3072, 3072);
    for (int j = 0; j < 2; ++j) add(10, (long long)j * 1024 * 6176, WS_WT_SSD_IN + (size_t)j * 6400 * 1024 * 2, 1024, 6176, 6400);
    for (int j = 0; j < 2; ++j) add(18, (long long)j * 1024 * 4096, WS_WT_POOL_IN + (size_t)j * 4096 * 1024 * 2, 1024, 4096, 4096);
    for (int j = 0; j < 2; ++j) add(17, (long long)j * 2048 * 1024, WS_WT_SSD_OUT + (size_t)j * 1024 * 2048 * 2, 2048, 1024, 1024);
    for (int j = 0; j < 2; ++j) add(21, (long long)j * 2048 * 1024, WS_WT_POOL_OUT + (size_t)j * 1024 * 2048 * 2, 2048, 1024, 1024);
    for (int q = 0; q < 8; ++q) add(19, (long long)q * 512 * 512, WS_WT_POOL_G + (size_t)q * 512 * 512 * 2, 512, 512, 512);
    wt.wtiles = tb;
    if (hipMemsetAsync(ws + WS_BAR, 0, 16384, stream) != hipSuccess) { fprintf(stderr, "kernel_launch: memset of the barrier words failed\n"); return; }
    const float* ip[23]; for (int i = 0; i < 23; ++i) ip[i] = (const float*)d_in[i];
    float* outp = (float*)d_out;
    void* args[26];
    for (int i = 0; i < 23; ++i) args[i] = (void*)&ip[i];
    args[23] = (void*)&outp; args[24] = (void*)&ws; args[25] = (void*)&wt;
    hipError_t e = hipLaunchCooperativeKernel((const void*)hybrid_fwd, dim3(grid), dim3(512), args, LDS_BYTES, stream);
    if (e != hipSuccess) fprintf(stderr, "cooperative launch failed: %s (grid %d)\n", hipGetErrorString(e), grid);
}
```

```cpp
#include <hip/hip_runtime.h>
#include <hip/hip_cooperative_groups.h>
#include <cstdio>
namespace cg = cooperative_groups;

#ifndef REP_PROMPT
#define REP_PROMPT 1
#endif
#define LAS __attribute__((address_space(3)))
typedef unsigned short bf16_t;
typedef short bf16x8 __attribute__((ext_vector_type(8)));
typedef float f32x4 __attribute__((ext_vector_type(4)));
typedef float f32x16 __attribute__((ext_vector_type(16)));
typedef unsigned u32x4 __attribute__((ext_vector_type(4)));
typedef unsigned u32x2 __attribute__((ext_vector_type(2)));
typedef float f32x2 __attribute__((ext_vector_type(2)));

constexpr int MP = 16384, MT = 17408, DM = 1024;
constexpr int ZXW = 6144;
constexpr size_t O_SSM_P = 17825792, O_CONV_P = 22020096, O_POOL_P = 22216704, O_SSM_S = 22708224, O_CONV_S = 89817088, O_POOL_S = 92962816;

constexpr size_t WS_WT_SSD_IN = 0;
constexpr size_t WS_WT_SSD_OUT = WS_WT_SSD_IN + 2ull * 6400 * 1024 * 2;
constexpr size_t WS_WT_POOL_IN = WS_WT_SSD_OUT + 2ull * 1024 * 2048 * 2;
constexpr size_t WS_WT_POOL_G = WS_WT_POOL_IN + 2ull * 4096 * 1024 * 2;
constexpr size_t WS_WT_POOL_OUT = WS_WT_POOL_G + 2ull * 2048 * 512 * 2;
constexpr size_t WS_WT_ADA = WS_WT_POOL_OUT + 2ull * 1024 * 2048 * 2;
constexpr size_t WS_AC = WS_WT_ADA + 12288ull * 1024 * 2;
constexpr size_t WS_SHIFTA = WS_AC + 256ull * 1024 * 2;
constexpr size_t WS_MOD = WS_SHIFTA + 4ull * 256 * 1024 * 2;
constexpr size_t WS_SB = WS_MOD + 136ull * 12288 * 4;
constexpr size_t WS_APRIME = WS_SB + 4ull * 136 * 6400 * 4;
constexpr size_t WS_SSQ = WS_APRIME + 17408ull * 1024 * 2;
constexpr size_t WS_XW = WS_SSQ + 17408ull * 16 * 4;
constexpr size_t WS_ZX = WS_XW + 17408ull * 1024 * 4;
constexpr size_t WS_DTRAW = WS_ZX + 17408ull * 6144 * 2;
constexpr size_t WS_YG = WS_DTRAW + 17408ull * 32 * 4;
constexpr size_t WS_A2 = WS_YG + 17408ull * 2048 * 2;
constexpr size_t WS_BAR = WS_A2 + 17408ull * 2048 * 2;
constexpr size_t WS_END = WS_BAR + 16384;

constexpr int LDS_XB = 147712;
constexpr int LDS_BYTES = 147728;

struct WJob { const float* src; long long doff; int K, N, tiles_n, tile_begin; };
struct WTab { WJob wj[20]; int wtiles; int pad0; };
constexpr int NWJ = 20;
struct Params {
    const float* in[23];
    float* out;
    unsigned char* ws;
};

__device__ __forceinline__ unsigned cvt_pk_bf16(float lo, float hi) { unsigned r; asm("v_cvt_pk_bf16_f32 %0, %1, %2" : "=v"(r) : "v"(lo), "v"(hi)); return r; }
__device__ __forceinline__ float bf_lo(unsigned u) { return __uint_as_float(u << 16); }
__device__ __forceinline__ float bf_hi(unsigned u) { return __uint_as_float(u & 0xffff0000u); }
__device__ __forceinline__ float bf2f(bf16_t b) { return __uint_as_float(((unsigned)b) << 16); }
__device__ __forceinline__ float silu_f(float v) { return v * __builtin_amdgcn_rcpf(1.f + __expf(-v)); }
__device__ __forceinline__ f32x2 silu2(f32x2 v) { const f32x2 e = v * (-1.44269504f); f32x2 d; d.x = __builtin_amdgcn_exp2f(e.x); d.y = __builtin_amdgcn_exp2f(e.y); d = d + 1.f; f32x2 r; r.x = __builtin_amdgcn_rcpf(d.x); r.y = __builtin_amdgcn_rcpf(d.y); return v * r; }
__device__ __forceinline__ float softplus_f(float v) { return v > 20.f ? v : log1pf(__expf(v)); }
__device__ __forceinline__ int otid() { int t = threadIdx.x; asm volatile("" : "+v"(t)); return t; }
__device__ __forceinline__ int row_b(int r) { return r < MP ? (r >> 11) : 8 + ((r - MP) >> 3); }
__device__ __forceinline__ u32x4 pack8(f32x4 a, f32x4 b) { u32x4 r; r.x = cvt_pk_bf16(a.x, a.y); r.y = cvt_pk_bf16(a.z, a.w); r.z = cvt_pk_bf16(b.x, b.y); r.w = cvt_pk_bf16(b.z, b.w); return r; }

namespace pg8 {
constexpr int BM = 256, BK = 64, HALF = 128, HTB = HALF * BK * 2, STAGE_BYTES = 8 * HTB, NXCD = 8, WGM = 8;
__device__ __forceinline__ int lds_byte(int r, int c) { const int st = (r >> 4) * 2 + (c >> 5), rr = r & 15, cc = c & 31, ob = rr * 64 + cc * 2; return st * 1024 + (ob ^ (((ob >> 9) & 1) << 5)); }
__device__ __forceinline__ void stage_rc(int b, int& R, int& C) { const int st = b / 1024, sb = b % 1024, swz = sb ^ (((sb >> 9) & 1) << 5); R = (st >> 1) * 16 + swz / 64; C = (st & 1) * 32 + (swz % 64) / 2; }
__device__ __forceinline__ int perm32(int rho) { const int n = rho >> 4, i = rho & 15; return 8 * (i >> 2) + 4 * n + (i & 3); }

struct Unit { int pm, pn, q; const char* A; const char* B; };

__device__ __forceinline__ void static_unit(int L, int nM, int nN, int& pm, int& pn) {
    const int nwg = nM * nN;
    int wgid = L; { const int q = nwg / NXCD, r = nwg % NXCD, xcd = wgid % NXCD, off = wgid / NXCD; wgid = (xcd < r ? xcd * (q + 1) : r * (q + 1) + (xcd - r) * q) + off; }
    const int nig = WGM * nN, gid = wgid / nig, fm = gid * WGM, gsz = (nM - fm) < WGM ? (nM - fm) : WGM;
    pm = fm + ((wgid % nig) % gsz); pn = (wgid % nig) / gsz;
}
struct MainSched {
    int nM, nN, nwg, G, c, lda, ldb, K, gsh, single;
    const char* A; const char* Bt;
    __device__ void init(int M, int N, int K_, int lda_, int ldb_, const void* A_, const void* Bt_, int gsh_, int single_ = 0) {
        nM = M / BM; nN = N / BM; nwg = nM * nN; G = (int)gridDim.x; c = (int)blockIdx.x; lda = lda_; ldb = ldb_; K = K_; A = (const char*)A_; Bt = (const char*)Bt_; gsh = gsh_; single = single_;
    }
    __device__ bool next(int i, Unit& u) const {
        if (single) { if (i > 0 || c >= 16) return false; u.pm = 64 + (c >> 2); u.pn = c & 3; }
        else { const long L = (long)i * G + c; if (L >= nwg) return false; static_unit((int)L, nM, nN, u.pm, u.pn); }
        u.q = 0;
        u.A = A + ((size_t)u.pm * BM * lda + (size_t)(u.pn >> gsh) * 512) * 2;
        u.B = Bt + (size_t)u.pn * BM * ldb * 2;
        return true;
    }
    __device__ __forceinline__ void a_ready(const Unit&) const {}
};
struct InSched {
    int nN, nP, E, nskip, c, r0, cnt, lda, ldb, K;
    const char* A; const char* Bt; unsigned* tail; unsigned* tmo;
    __device__ void init(int N, const void* A_, const void* Bt_, unsigned* tail_, unsigned* tmo_) {
        nN = N / BM; nP = 64 * nN; c = (int)blockIdx.x; lda = 1024; ldb = 1024; K = 1024; A = (const char*)A_; Bt = (const char*)Bt_; tail = tail_; tmo = tmo_;
        nskip = tail_ != nullptr ? 32 : 0; E = nskip + 4 * nN; r0 = (tail_ != nullptr && c < 16) ? 2 : 0;
        const int tot = (nP - c + 255) / 256; cnt = tot - r0 > 0 ? tot - r0 : 0;
    }
    __device__ bool next(int i, Unit& u) const {
        if (i < cnt) static_unit((i + r0) * 256 + c, 64, nN, u.pm, u.pn);
        else {
            if (c < 16) return false;
            const int e = 255 - c + 240 * (i - cnt); if (e >= E) return false;
            if (e < nskip) static_unit(e < 16 ? e : 256 + (e - 16), 64, nN, u.pm, u.pn);
            else { const int sidx = e - nskip; u.pm = 64 + sidx / nN; u.pn = sidx - (sidx / nN) * nN; }
        }
        u.q = 0;
        u.A = A + (size_t)u.pm * BM * 1024 * 2; u.B = Bt + (size_t)u.pn * BM * 1024 * 2;
        return true;
    }
    __device__ __forceinline__ void a_ready(const Unit& u) const {
        if (tail == nullptr || u.pm < 64) return;
        if (threadIdx.x < 64) {
            unsigned polls = 0;
            while ((unsigned)__builtin_amdgcn_readfirstlane(__hip_atomic_load(tail, __ATOMIC_RELAXED, __HIP_MEMORY_SCOPE_AGENT)) < 16u) {
                __builtin_amdgcn_s_sleep(2);
                if ((++polls & 255u) == 0u) { if (__builtin_amdgcn_readfirstlane(__hip_atomic_load(tmo, __ATOMIC_RELAXED, __HIP_MEMORY_SCOPE_AGENT)) != 0u) break; if (polls > (1u << 22)) { if (threadIdx.x == 0) atomicAdd(tmo, 1u); break; } }
            }
            __builtin_amdgcn_fence(__ATOMIC_ACQUIRE, "agent");
            asm volatile("s_waitcnt vmcnt(0)" ::: "memory");
        }
        asm volatile("" ::: "memory"); __builtin_amdgcn_s_barrier(); asm volatile("" ::: "memory");
    }
};
struct SmallSched {
    int mode, G, c, lda, ldb, K;
    const char* A0; const char* ada; const char* ssd_in; const char* pool_in;
    __device__ bool next(int i, Unit& u) const {
        const long L = (long)i * G + c;
        u.pm = 0;
        if (mode == 0) { if (L >= 48) return false; u.pn = (int)L; u.q = 0; u.A = A0; u.B = ada + (size_t)u.pn * BM * 1024 * 2; return true; }
        if (L >= 82) return false;
        int l = (int)L, q, pn;
        if (l < 25) { q = 0; pn = l; } else if (l < 41) { q = 1; pn = l - 25; } else if (l < 66) { q = 2; pn = l - 41; } else { q = 3; pn = l - 66; }
        u.q = q; u.pn = pn; u.A = A0 + (size_t)q * 256 * 1024 * 2;
        u.B = ((q & 1) ? pool_in + (size_t)(q >> 1) * 4096 * 1024 * 2 : ssd_in + (size_t)(q >> 1) * 6400 * 1024 * 2) + (size_t)pn * BM * 1024 * 2;
        return true;
    }
    __device__ __forceinline__ void a_ready(const Unit&) const {}
};

template <class Epi, class Sched>
__device__ __forceinline__ void gemm_phase(LAS unsigned char* lds, const Sched& S, const Epi& E) {
    const int tid = otid(), wid = __builtin_amdgcn_readfirstlane(tid >> 6), lane = tid & 63, wr = wid >> 2, wc = wid & 3, fr = lane & 15, fq = lane >> 4;
    const int K = S.K, nt = K / BK;
    unsigned voffA[2], voffB[2];
#pragma unroll
    for (int i = 0; i < 2; ++i) { int R, C; stage_rc(tid * 16 + i * 8192, R, C); const int Rb = Epi::PERM ? ((R & ~31) + perm32(R & 31)) : R;
        voffA[i] = (unsigned)(R * S.lda + C) * 2u; voffB[i] = (unsigned)(Rb * S.ldb + C) * 2u; }
    const size_t kstep = (size_t)(BK * 2);
    const size_t hstepA = (size_t)HALF * S.lda * 2, hstepB = (size_t)HALF * S.ldb * 2;
    const unsigned ldsw = (unsigned)wid * 1024u;
    const int aoff = lds_byte(wr * 64 + fr, fq * 8), boff = lds_byte(wc * 32 + fr, fq * 8);
#define PG8_SA(b, h) (((b) * 2 + (h)) * HTB)
#define PG8_SB(b, h) ((4 + (b) * 2 + (h)) * HTB)
#define PG8_STAGE(bufoff, gbase, voff) do { _Pragma("unroll") for (int _i = 0; _i < 2; ++_i) \
        __builtin_amdgcn_global_load_lds((const unsigned*)((const char*)(gbase) + (voff)[_i]), (LAS unsigned*)(lds + (bufoff) + ldsw + _i * 8192), 16, 0, 0); } while (0)
#define PG8_LDA(dst, b, h) do { _Pragma("unroll") for (int m = 0; m < 4; ++m) _Pragma("unroll") for (int k = 0; k < 2; ++k) dst[m][k] = *(const LAS bf16x8*)(lds + PG8_SA(b, h) + aoff + m * 2048 + k * 1024); } while (0)
#define PG8_LDB(dst, b, h) do { _Pragma("unroll") for (int n = 0; n < 2; ++n) _Pragma("unroll") for (int k = 0; k < 2; ++k) dst[n][k] = *(const LAS bf16x8*)(lds + PG8_SB(b, h) + boff + n * 2048 + k * 1024); } while (0)
#define PG8_MMA(ai, bj, At, Bt) do { __builtin_amdgcn_s_setprio(1); _Pragma("unroll") for (int m = 0; m < 4; ++m) _Pragma("unroll") for (int n = 0; n < 2; ++n) _Pragma("unroll") for (int k = 0; k < 2; ++k) \
        acc[ai][bj][m][n] = __builtin_amdgcn_mfma_f32_16x16x32_bf16(Bt[n][k], At[m][k], acc[ai][bj][m][n], 0, 0, 0); __builtin_amdgcn_s_setprio(0); } while (0)
#define PG8_WAIT_V(n) asm volatile("s_waitcnt vmcnt(" #n ")" ::: "memory")
#define PG8_WAIT_L(n) asm volatile("s_waitcnt lgkmcnt(" #n ")" ::: "memory")
#define PG8_BAR __builtin_amdgcn_s_barrier()
#define PG8_SCHED __builtin_amdgcn_sched_barrier(0)
    Unit cur, nxt; int ui = 0;
    if (!S.next(0, cur)) return;
    f32x4 acc[2][2][4][2];
#pragma unroll
    for (int a = 0; a < 2; ++a)
#pragma unroll
        for (int b = 0; b < 2; ++b)
#pragma unroll
            for (int m = 0; m < 4; ++m)
#pragma unroll
                for (int n = 0; n < 2; ++n) acc[a][b][m][n] = (f32x4){0.f, 0.f, 0.f, 0.f};
    bf16x8 At[4][2], B0[2][2], B1[2][2];
    const char* cA = cur.A; const char* cB = cur.B;
    S.a_ready(cur);
    PG8_STAGE(PG8_SB(0, 0), cB, voffB); PG8_STAGE(PG8_SA(0, 0), cA, voffA); PG8_STAGE(PG8_SB(0, 1), cB + hstepB, voffB); PG8_STAGE(PG8_SA(0, 1), cA + hstepA, voffA);
    if (wr == 1) PG8_BAR;
    PG8_WAIT_V(4); PG8_BAR;
    PG8_STAGE(PG8_SB(1, 0), cB + kstep, voffB); PG8_STAGE(PG8_SA(1, 0), cA + kstep, voffA); PG8_STAGE(PG8_SB(1, 1), cB + hstepB + kstep, voffB);
    PG8_WAIT_V(6); PG8_BAR;
    for (;;) {
        const bool has_next = S.next(ui + 1, nxt);
        const char* nA = has_next ? nxt.A : cA; const char* nB = has_next ? nxt.B : cB;
        for (int t = 0; t < nt; t += 2) {
            const bool last = (t == nt - 2);
            const char* a1 = cA + (size_t)(t + 1) * kstep;
            const char* a2 = last ? nA : cA + (size_t)(t + 2) * kstep; const char* b2 = last ? nB : cB + (size_t)(t + 2) * kstep;
            const char* a3 = a2 + kstep; const char* b3 = b2 + kstep;
            if (last && has_next) S.a_ready(nxt);
            PG8_LDB(B0, 0, 0); PG8_SCHED; PG8_LDA(At, 0, 0); PG8_STAGE(PG8_SA(1, 1), a1 + hstepA, voffA);
            PG8_WAIT_L(8); PG8_BAR; PG8_WAIT_L(0); PG8_MMA(0, 0, At, B0); PG8_BAR; PG8_SCHED;
            PG8_LDB(B1, 0, 1); PG8_STAGE(PG8_SB(0, 0), b2, voffB);
            PG8_BAR; PG8_WAIT_L(0); PG8_MMA(0, 1, At, B1); PG8_BAR;
            PG8_LDA(At, 0, 1); PG8_STAGE(PG8_SA(0, 0), a2, voffA);
            PG8_BAR; PG8_WAIT_L(0); PG8_MMA(1, 0, At, B0); PG8_BAR; PG8_SCHED;
            PG8_STAGE(PG8_SB(0, 1), b2 + hstepB, voffB);
            PG8_WAIT_V(6); PG8_BAR; PG8_MMA(1, 1, At, B1); PG8_BAR;
            PG8_LDB(B0, 1, 0); PG8_SCHED; PG8_LDA(At, 1, 0); PG8_STAGE(PG8_SA(0, 1), a2 + hstepA, voffA);
            PG8_WAIT_L(8); PG8_BAR; PG8_WAIT_L(0); PG8_MMA(0, 0, At, B0); PG8_BAR; PG8_SCHED;
            PG8_LDB(B1, 1, 1); PG8_STAGE(PG8_SB(1, 0), b3, voffB);
            PG8_BAR; PG8_WAIT_L(0); PG8_MMA(0, 1, At, B1); PG8_BAR;
            PG8_LDA(At, 1, 1); PG8_STAGE(PG8_SA(1, 0), a3, voffA);
            PG8_BAR; PG8_WAIT_L(0); PG8_MMA(1, 0, At, B0); PG8_BAR; PG8_SCHED;
            PG8_STAGE(PG8_SB(1, 1), b3 + hstepB, voffB);
            PG8_WAIT_V(6); PG8_BAR; PG8_MMA(1, 1, At, B1); PG8_BAR;
        }
        E(acc, cur, wr, wc, fr, fq);
        if (!has_next) break;
#pragma unroll
        for (int a = 0; a < 2; ++a)
#pragma unroll
            for (int b = 0; b < 2; ++b)
#pragma unroll
                for (int m = 0; m < 4; ++m)
#pragma unroll
                    for (int n = 0; n < 2; ++n) acc[a][b][m][n] = (f32x4){0.f, 0.f, 0.f, 0.f};
        cur = nxt; cA = nA; cB = nB; ++ui;
    }
    PG8_WAIT_V(0);
    if (wr == 0) PG8_BAR;
    PG8_BAR;
#undef PG8_SA
#undef PG8_SB
#undef PG8_STAGE
#undef PG8_LDA
#undef PG8_LDB
#undef PG8_MMA
#undef PG8_WAIT_V
#undef PG8_WAIT_L
#undef PG8_BAR
#undef PG8_SCHED
}
}
using pg8::Unit;

struct EpiIn {
    static constexpr bool PERM = true;
    const float* ssq; const float* sb; bf16_t* out; int ldo, nbf; float* dtraw;
    template <bool UNI>
    __device__ __forceinline__ void body(const f32x4 (&acc)[2][2][4][2], const Unit& u, int wr, int wc, int fr, int fq) const {
        const int row0 = u.pm * 256 + wr * 64 + fr, colt = u.pn * 256 + wc * 32 + 8 * fq;
        f32x4 ub[2][2];
        if (UNI) {
            const float* sbr = sb + (size_t)(u.pm >> 3) * 6400;
#pragma unroll
            for (int bj = 0; bj < 2; ++bj) { const int c = colt + bj * 128; if (c < nbf + 32) { ub[bj][0] = *(const f32x4*)(sbr + c); ub[bj][1] = *(const f32x4*)(sbr + c + 4); } }
        }
        float rsv[2][4];
#pragma unroll
        for (int ai = 0; ai < 2; ++ai)
#pragma unroll
            for (int m = 0; m < 4; ++m) rsv[ai][m] = ssq[row0 + ai * 128 + m * 16];
#pragma unroll
        for (int ai = 0; ai < 2; ++ai) {
            f32x4 nb[4][2][2];
            if (!UNI) {
#pragma unroll
                for (int m = 0; m < 4; ++m) {
                    const float* sbr = sb + (size_t)row_b(row0 + ai * 128 + m * 16) * 6400;
#pragma unroll
                    for (int bj = 0; bj < 2; ++bj) { const int c = colt + bj * 128; if (c < nbf + 32) { nb[m][bj][0] = *(const f32x4*)(sbr + c); nb[m][bj][1] = *(const f32x4*)(sbr + c + 4); } }
                }
            }
#pragma unroll
            for (int m = 0; m < 4; ++m) {
                const int r = row0 + ai * 128 + m * 16;
                const float rstd = rsqrtf(rsv[ai][m] * (1.f / 1024.f) + 1e-6f);
#pragma unroll
                for (int bj = 0; bj < 2; ++bj) {
                    const int c = colt + bj * 128;
                    if (c < nbf + 32) {
                        f32x4 b0, b1;
                        if (UNI) { b0 = ub[bj][0]; b1 = ub[bj][1]; } else { b0 = nb[m][bj][0]; b1 = nb[m][bj][1]; }
                        const f32x4 v0 = acc[ai][bj][m][0] * rstd + b0, v1 = acc[ai][bj][m][1] * rstd + b1;
                        if (c < nbf) *(u32x4*)(out + (size_t)r * ldo + c) = pack8(v0, v1);
                        else if (dtraw != nullptr) { float* dp = dtraw + (size_t)r * 32 + (c - nbf); *(f32x4*)dp = v0; *(f32x4*)(dp + 4) = v1; }
                    }
                }
            }
        }
    }
    __device__ __forceinline__ void operator()(const f32x4 (&acc)[2][2][4][2], const Unit& u, int wr, int wc, int fr, int fq) const {
        asm volatile("" : "+v"(fr), "+v"(fq));
        if (u.pm < 64) body<true>(acc, u, wr, wc, fr, fq); else body<false>(acc, u, wr, wc, fr, fq);
    }
};
struct EpiOut {
    static constexpr bool PERM = true;
    const float* xin_p; const float* xin_s; float* xw; const float* modl; const float* ng_next; bf16_t* aprime; float* ssq;
    template <bool UNI>
    __device__ __forceinline__ void body(const f32x4 (&acc)[2][2][4][2], const Unit& u, int wr, int wc, int fr, int fq) const {
        const int row0 = u.pm * 256 + wr * 64 + fr, colt = u.pn * 256 + wc * 32 + 8 * fq;
        const bool has_next = ng_next != nullptr;
        f32x4 ug[2][2], us[2][2], uw[2][2];
#pragma unroll
        for (int bj = 0; bj < 2; ++bj) {
            const int c = colt + bj * 128;
            if (has_next) { uw[bj][0] = *(const f32x4*)(ng_next + c); uw[bj][1] = *(const f32x4*)(ng_next + c + 4); }
            if (UNI) {
                const float* mb = modl + (size_t)(u.pm >> 3) * 12288;
                ug[bj][0] = *(const f32x4*)(mb + 2048 + c) + 1.f; ug[bj][1] = *(const f32x4*)(mb + 2048 + c + 4) + 1.f;
                if (has_next) { us[bj][0] = (*(const f32x4*)(mb + 4096 + c) + 1.f) * uw[bj][0]; us[bj][1] = (*(const f32x4*)(mb + 4096 + c + 4) + 1.f) * uw[bj][1]; }
            }
        }
#pragma unroll
        for (int ai = 0; ai < 2; ++ai)
#pragma unroll
            for (int mp = 0; mp < 2; ++mp) {
                f32x4 xv[2][2][2];
#pragma unroll
                for (int mm = 0; mm < 2; ++mm) {
                    const int r = row0 + ai * 128 + (mp * 2 + mm) * 16;
                    const float* xr = r < MP ? xin_p + (size_t)r * DM : xin_s + (size_t)(r - MP) * DM;
#pragma unroll
                    for (int bj = 0; bj < 2; ++bj) { xv[mm][bj][0] = *(const f32x4*)(xr + colt + bj * 128); xv[mm][bj][1] = *(const f32x4*)(xr + colt + bj * 128 + 4); }
                }
#pragma unroll
                for (int mm = 0; mm < 2; ++mm) {
                    const int m = mp * 2 + mm;
                    const int r = row0 + ai * 128 + m * 16;
                    const float* mb = modl + (size_t)row_b(r) * 12288;
                    float ss = 0.f;
#pragma unroll
                    for (int bj = 0; bj < 2; ++bj) {
                        const int c = colt + bj * 128;
                        f32x4 g0, g1;
                        if (UNI) { g0 = ug[bj][0]; g1 = ug[bj][1]; } else { g0 = *(const f32x4*)(mb + 2048 + c) + 1.f; g1 = *(const f32x4*)(mb + 2048 + c + 4) + 1.f; }
                        const f32x4 n0 = xv[mm][bj][0] + g0 * acc[ai][bj][m][0], n1 = xv[mm][bj][1] + g1 * acc[ai][bj][m][1];
                        *(f32x4*)(xw + (size_t)r * DM + c) = n0; *(f32x4*)(xw + (size_t)r * DM + c + 4) = n1;
                        ss += (n0.x * n0.x + n0.y * n0.y) + (n0.z * n0.z + n0.w * n0.w) + (n1.x * n1.x + n1.y * n1.y) + (n1.z * n1.z + n1.w * n1.w);
                        if (has_next) {
                            f32x4 s0, s1;
                            if (UNI) { s0 = us[bj][0]; s1 = us[bj][1]; } else { s0 = (*(const f32x4*)(mb + 4096 + c) + 1.f) * uw[bj][0]; s1 = (*(const f32x4*)(mb + 4096 + c + 4) + 1.f) * uw[bj][1]; }
                            *(u32x4*)(aprime + (size_t)r * DM + c) = pack8(n0 * s0, n1 * s1);
                        }
                    }
                    ss += __shfl_xor(ss, 16); ss += __shfl_xor(ss, 32);
                    if (fq == 0) atomicAdd(ssq + r, ss);
                }
            }
    }
    __device__ __forceinline__ void operator()(const f32x4 (&acc)[2][2][4][2], const Unit& u, int wr, int wc, int fr, int fq) const {
        asm volatile("" : "+v"(fr), "+v"(fq));
        if (u.pm < 64) body<true>(acc, u, wr, wc, fr, fq); else body<false>(acc, u, wr, wc, fr, fq);
    }
};
struct EpiGrp {
    static constexpr bool PERM = true;
    const bf16_t* uz; const float* chs; bf16_t* out;
    __device__ __forceinline__ void operator()(const f32x4 (&acc)[2][2][4][2], const Unit& u, int wr, int wc, int fr, int fq) const {
        asm volatile("" : "+v"(fr), "+v"(fq));
        const int row0 = u.pm * 256 + wr * 64 + fr, colt = u.pn * 256 + wc * 32 + 8 * fq;
        f32x4 cs[2][2];
#pragma unroll
        for (int bj = 0; bj < 2; ++bj) { cs[bj][0] = *(const f32x4*)(chs + colt + bj * 128); cs[bj][1] = *(const f32x4*)(chs + colt + bj * 128 + 4); }
#pragma unroll
        for (int ai = 0; ai < 2; ++ai) {
            u32x4 zz[4][2];
#pragma unroll
            for (int m = 0; m < 4; ++m)
#pragma unroll
                for (int bj = 0; bj < 2; ++bj) zz[m][bj] = *(const u32x4*)(uz + (size_t)(row0 + ai * 128 + m * 16) * 4096 + 2048 + colt + bj * 128);
#pragma unroll
            for (int m = 0; m < 4; ++m) {
                const int r = row0 + ai * 128 + m * 16;
#pragma unroll
                for (int bj = 0; bj < 2; ++bj) {
                    const int c = colt + bj * 128;
                    const u32x4 z = zz[m][bj];
                    const f32x2 a = silu2((f32x2){bf_lo(z.x), bf_hi(z.x)}), b = silu2((f32x2){bf_lo(z.y), bf_hi(z.y)}), cc = silu2((f32x2){bf_lo(z.z), bf_hi(z.z)}), d = silu2((f32x2){bf_lo(z.w), bf_hi(z.w)});
                    const f32x4 z0 = {a.x, a.y, b.x, b.y}, z1 = {cc.x, cc.y, d.x, d.y};
                    *(u32x4*)(out + (size_t)r * 2048 + c) = pack8(acc[ai][bj][m][0] * cs[bj][0] * z0, acc[ai][bj][m][1] * cs[bj][1] * z1);
                }
            }
        }
    }
};
struct EpiSmall {
    static constexpr bool PERM = true;
    int mode; float* mod; const float* ada_b; bf16_t* shiftA; float* sb;
    __device__ __forceinline__ void operator()(const f32x4 (&acc)[2][2][4][2], const Unit& u, int wr, int wc, int fr, int fq) const {
        asm volatile("" : "+v"(fr), "+v"(fq));
        const int row0 = wr * 64 + fr, colt = u.pn * 256 + wc * 32 + 8 * fq;
#pragma unroll
        for (int ai = 0; ai < 2; ++ai)
#pragma unroll
            for (int m = 0; m < 4; ++m) {
                const int r = row0 + ai * 128 + m * 16;
                if (r < 136) {
#pragma unroll
                    for (int bj = 0; bj < 2; ++bj) {
                        const int c = colt + bj * 128;
                        if (mode == 0) {
                            const f32x4 v0 = acc[ai][bj][m][0] + *(const f32x4*)(ada_b + c), v1 = acc[ai][bj][m][1] + *(const f32x4*)(ada_b + c + 4);
                            *(f32x4*)(mod + (size_t)r * 12288 + c) = v0; *(f32x4*)(mod + (size_t)r * 12288 + c + 4) = v1;
                            const int li = c / 3072, cc = c - li * 3072;
                            if (cc < 1024) *(u32x4*)(shiftA + ((size_t)li * 256 + r) * 1024 + cc) = pack8(v0, v1);
                        } else {
                            float* sp = sb + ((size_t)u.q * 136 + r) * 6400 + c;
                            *(f32x4*)sp = acc[ai][bj][m][0]; *(f32x4*)(sp + 4) = acc[ai][bj][m][1];
                        }
                    }
                }
            }
    }
};

__device__ void phase_prep0(const Params& p, const WTab& wt, LAS unsigned char* lds) {
    LAS float* tl = (LAS float*)lds;
    const int tid = otid();
    for (int tile = blockIdx.x; tile < wt.wtiles; tile += gridDim.x) {
        int j = 0;
#pragma unroll 1
        for (int q = 1; q < NWJ; ++q) if (tile >= wt.wj[q].tile_begin) j = q;
        const WJob job = wt.wj[j];
        bf16_t* jdst = (bf16_t*)(p.ws + job.doff);
        const int lt = tile - job.tile_begin, tk = lt / job.tiles_n, tn = lt - tk * job.tiles_n, k0 = tk * 64, n0 = tn * 64;
        {
            const int kk = tid >> 3, nn = (tid & 7) * 8;
            f32x4 a = (f32x4){0.f, 0.f, 0.f, 0.f}, b = a;
            if (n0 + nn < job.N) { const __attribute__((address_space(1))) f32x4* sp = (const __attribute__((address_space(1))) f32x4*)(job.src + (size_t)(k0 + kk) * job.N + n0 + nn); a = sp[0]; b = sp[1]; }
            LAS float* d = tl + kk * 65 + nn;
            d[0] = a.x; d[1] = a.y; d[2] = a.z; d[3] = a.w; d[4] = b.x; d[5] = b.y; d[6] = b.z; d[7] = b.w;
        }
        __syncthreads();
        {
            const int n = tid >> 3, k8 = (tid & 7) * 8;
            const LAS float* s = tl + k8 * 65 + n;
            u32x4 o; o.x = cvt_pk_bf16(s[0], s[65]); o.y = cvt_pk_bf16(s[130], s[195]); o.z = cvt_pk_bf16(s[260], s[325]); o.w = cvt_pk_bf16(s[390], s[455]);
            *(u32x4*)(jdst + (size_t)(n0 + n) * job.K + k0 + k8) = o;
        }
        __syncthreads();
    }
    bf16_t* ac = (bf16_t*)(p.ws + WS_AC);
    const int gt = blockIdx.x * 512 + tid, nth = gridDim.x * 512;
    for (int i = gt; i < 256 * 1024 / 8; i += nth) {
        const int r = i >> 7, c = (i & 127) * 8;
        u32x4 o = (u32x4){0u, 0u, 0u, 0u};
        if (r < 136) {
            const float* cp = r < 8 ? p.in[5] + (size_t)r * 1024 + c : p.in[6] + (size_t)(r - 8) * 1024 + c;
            const f32x4 a = *(const f32x4*)cp, b = *(const f32x4*)(cp + 4);
            o.x = cvt_pk_bf16(silu_f(a.x), silu_f(a.y)); o.y = cvt_pk_bf16(silu_f(a.z), silu_f(a.w)); o.z = cvt_pk_bf16(silu_f(b.x), silu_f(b.y)); o.w = cvt_pk_bf16(silu_f(b.z), silu_f(b.w));
        }
        *(u32x4*)(ac + (size_t)i * 8) = o;
    }
    { u32x4* sq = (u32x4*)(p.ws + WS_SSQ + 17408ull * 4); for (int i = gt; i < 4 * 17408 / 4; i += nth) sq[i] = (u32x4){0u, 0u, 0u, 0u}; }
    u32x4* sh = (u32x4*)(p.ws + WS_SHIFTA);
    for (int i = gt; i < 4 * 256 * 1024 / 8; i += nth) sh[i] = (u32x4){0u, 0u, 0u, 0u};
}

__device__ void phase_xprep(const Params& p) {
    const int tid_ = otid(), lane = tid_ & 63, wv = blockIdx.x * 8 + (tid_ >> 6), nw = gridDim.x * 8;
    const float* mod = (const float*)(p.ws + WS_MOD);
    bf16_t* ap = (bf16_t*)(p.ws + WS_APRIME);
    float* ssq = (float*)(p.ws + WS_SSQ);
    const float* ng = p.in[9];
    for (int r0 = wv * 2; r0 < MT; r0 += nw * 2) {
        f32x4 x[2][4];
#pragma unroll
        for (int h = 0; h < 2; ++h) {
            const int r = r0 + h;
            const float* xr = r < MP ? p.in[0] + (size_t)r * DM : p.in[1] + (size_t)(r - MP) * DM;
#pragma unroll
            for (int q = 0; q < 4; ++q) x[h][q] = *(const f32x4*)(xr + q * 256 + lane * 4);
        }
#pragma unroll
        for (int h = 0; h < 2; ++h) {
            const int r = r0 + h;
            const float* mb = mod + (size_t)row_b(r) * 12288 + 1024;
            float ss = 0.f;
#pragma unroll
            for (int q = 0; q < 4; ++q) {
                const int c = q * 256 + lane * 4;
                const f32x4 xv = x[h][q], sv = *(const f32x4*)(mb + c), g = *(const f32x4*)(ng + c);
                ss += (xv.x * xv.x + xv.y * xv.y) + (xv.z * xv.z + xv.w * xv.w);
                const f32x4 a = xv * g * (sv + 1.f);
                u32x2 o; o.x = cvt_pk_bf16(a.x, a.y); o.y = cvt_pk_bf16(a.z, a.w);
                *(u32x2*)(ap + (size_t)r * DM + c) = o;
            }
#pragma unroll
            for (int o = 1; o < 64; o <<= 1) ss += __shfl_xor(ss, o);
            if (lane == 0) ssq[r] = ss;
        }
    }
}

__device__ void phase_final(const Params& p, int r_begin, int r_end, int blk0) {
    if ((int)blockIdx.x < blk0) return;
    const int tid_ = otid(), lane = tid_ & 63, wv = ((int)blockIdx.x - blk0) * 8 + (tid_ >> 6), nw = ((int)gridDim.x - blk0) * 8;
    const float* xw = (const float*)(p.ws + WS_XW);
    const float* ssq = (const float*)(p.ws + WS_SSQ) + 4 * 17408;
    const float* fg = p.in[22];
    for (int r0 = r_begin + wv * 2; r0 < r_end; r0 += nw * 2) {
        f32x4 x[2][4];
#pragma unroll
        for (int h = 0; h < 2; ++h)
#pragma unroll
            for (int q = 0; q < 4; ++q) x[h][q] = *(const f32x4*)(xw + (size_t)(r0 + h) * DM + q * 256 + lane * 4);
#pragma unroll
        for (int h = 0; h < 2; ++h) {
            const int r = r0 + h;
            const float rstd = rsqrtf(ssq[r] * (1.f / 1024.f) + 1e-6f);
#pragma unroll
            for (int q = 0; q < 4; ++q) {
                const int c = q * 256 + lane * 4;
                const f32x4 g = *(const f32x4*)(fg + c);
                *(f32x4*)(p.out + (size_t)r * DM + c) = x[h][q] * rstd * g;
            }
        }
    }
}

__device__ void phase_ssdnorm(const Params& p, int j) {
    const int tid_ = otid(), lane = tid_ & 63, wv = blockIdx.x * 8 + (tid_ >> 6), nw = gridDim.x * 8;
    const bf16_t* yg = (const bf16_t*)(p.ws + WS_YG);
    bf16_t* a2 = (bf16_t*)(p.ws + WS_A2);
    const float* ng = p.in[16] + (size_t)j * 2048;
    for (int r0 = wv * 2; r0 < MT; r0 += nw * 2) {
        u32x4 vv[2][4];
#pragma unroll
        for (int h = 0; h < 2; ++h)
#pragma unroll
            for (int q = 0; q < 4; ++q) vv[h][q] = *(const u32x4*)(yg + (size_t)(r0 + h) * 2048 + q * 512 + lane * 8);
#pragma unroll
        for (int h = 0; h < 2; ++h)
#pragma unroll
            for (int q = 0; q < 4; ++q) {
                const int c = q * 512 + lane * 8;
                const u32x4 v = vv[h][q];
                f32x4 a, b;
                a.x = bf_lo(v.x); a.y = bf_hi(v.x); a.z = bf_lo(v.y); a.w = bf_hi(v.y); b.x = bf_lo(v.z); b.y = bf_hi(v.z); b.z = bf_lo(v.w); b.w = bf_hi(v.w);
                float ss = (a.x * a.x + a.y * a.y) + (a.z * a.z + a.w * a.w) + (b.x * b.x + b.y * b.y) + (b.z * b.z + b.w * b.w);
#pragma unroll
                for (int o = 1; o < 32; o <<= 1) ss += __shfl_xor(ss, o);
                const float rstd = rsqrtf(ss * (1.f / 256.f) + 1e-6f);
                const f32x4 g0 = *(const f32x4*)(ng + c), g1 = *(const f32x4*)(ng + c + 4);
                *(u32x4*)(a2 + (size_t)(r0 + h) * 2048 + c) = pack8(a * rstd * g0, b * rstd * g1);
            }
    }
}

__device__ void phase_pool(const Params& p, int j) {
    const bf16_t* uz = (const bf16_t*)(p.ws + WS_ZX);
    bf16_t* pooled = (bf16_t*)(p.ws + WS_YG);
    const int gt = blockIdx.x * 512 + otid(), nth = gridDim.x * 512;
    for (int u = gt; u < 131072 + 32768; u += nth) {
        int cv, row0, t0, R; const float* prev = nullptr; bool prompt;
        if (u < 131072) { cv = u & 255; const int run = (u >> 8) & 63, b = u >> 14; row0 = b * 2048; t0 = run * 32; R = 32; prompt = true; }
        else { const int v = u - 131072; cv = v & 255; const int b = v >> 8; row0 = MP + b * 8; t0 = 0; R = 8; prompt = false; prev = p.in[4] + ((size_t)(j * 128 + b) * 15) * 2048; }
        const int c = cv * 8, w = 2 << (c >> 9);
        float s[8];
#pragma unroll
        for (int i = 0; i < 8; ++i) s[i] = 0.f;
        auto getu = [&](int tt, float (&o)[8]) {
            if (tt >= 0) {
                const u32x4 v = *(const u32x4*)(uz + (size_t)(row0 + tt) * 4096 + c);
                o[0] = bf_lo(v.x); o[1] = bf_hi(v.x); o[2] = bf_lo(v.y); o[3] = bf_hi(v.y); o[4] = bf_lo(v.z); o[5] = bf_hi(v.z); o[6] = bf_lo(v.w); o[7] = bf_hi(v.w);
            } else if (!prompt) {
                const float* pp = prev + (size_t)(15 + tt) * 2048 + c;
                const f32x4 a = *(const f32x4*)pp, b = *(const f32x4*)(pp + 4);
                o[0] = a.x; o[1] = a.y; o[2] = a.z; o[3] = a.w; o[4] = b.x; o[5] = b.y; o[6] = b.z; o[7] = b.w;
            } else {
#pragma unroll
                for (int i = 0; i < 8; ++i) o[i] = 0.f;
            }
        };
        for (int i = 1; i < w; ++i) {
            float o[8]; getu(t0 - i, o);
#pragma unroll
            for (int k = 0; k < 8; ++k) s[k] += o[k];
        }
        for (int tb = t0; tb < t0 + R; tb += 4) {
            float cur[4][8], old[4][8];
#pragma unroll
            for (int k = 0; k < 4; ++k) { getu(tb + k, cur[k]); getu(tb + k - w + 1, old[k]); }
#pragma unroll
            for (int k = 0; k < 4; ++k) {
                const int t = tb + k;
                const float inv = 1.f / (float)(prompt ? min(w, t + 1) : w);
                f32x4 a, b;
#pragma unroll
                for (int i = 0; i < 8; ++i) s[i] += cur[k][i];
                a.x = s[0] * inv - cur[k][0]; a.y = s[1] * inv - cur[k][1]; a.z = s[2] * inv - cur[k][2]; a.w = s[3] * inv - cur[k][3];
                b.x = s[4] * inv - cur[k][4]; b.y = s[5] * inv - cur[k][5]; b.z = s[6] * inv - cur[k][6]; b.w = s[7] * inv - cur[k][7];
                *(u32x4*)(pooled + (size_t)(row0 + t) * 2048 + c) = pack8(a, b);
#pragma unroll
                for (int i = 0; i < 8; ++i) s[i] -= old[k][i];
            }
        }
    }
    for (int i = gt; i < (8 + 128) * 15 * 256; i += nth) {
        const int cv = i & 255, k = (i >> 8) % 15, sq = (i >> 8) / 15, ch = cv * 8;
        f32x4 a, b2;
        float* dst;
        bool from_state = false; size_t urow = 0;
        if (sq < 8) { urow = (size_t)(sq * 2048 + 2033 + k); dst = p.out + O_POOL_P + ((size_t)(j * 8 + sq) * 15 + k) * 2048 + ch; }
        else { const int bb = sq - 8; dst = p.out + O_POOL_S + ((size_t)(j * 128 + bb) * 15 + k) * 2048 + ch; if (k < 7) from_state = true; else urow = (size_t)(MP + bb * 8 + k - 7); }
        if (from_state) { const float* sp = p.in[4] + ((size_t)(j * 128 + (sq - 8)) * 15 + 8 + k) * 2048 + ch; a = *(const f32x4*)sp; b2 = *(const f32x4*)(sp + 4); }
        else { const u32x4 v = *(const u32x4*)(uz + urow * 4096 + ch); a = (f32x4){bf_lo(v.x), bf_hi(v.x), bf_lo(v.y), bf_hi(v.y)}; b2 = (f32x4){bf_lo(v.z), bf_hi(v.z), bf_lo(v.w), bf_hi(v.w)}; }
        *(f32x4*)dst = a; *(f32x4*)(dst + 4) = b2;
    }
}

constexpr int RS = 272;
constexpr int L_XT = 0, L_BN = 17408, L_BT = 52224, L_CN = 87040, L_HB = 121856, L_SM = 139264, L_CW = 141312;
__device__ __forceinline__ int xt_addr(int pr, int t) { return L_XT + pr * RS + ((((t >> 3) ^ (pr >> 1)) & 15) << 4) + (t & 7) * 2; }
__device__ __forceinline__ int bt_addr(int n, int t) { return L_BT + n * RS + ((((t >> 3) ^ (n >> 3)) & 15) << 4) + (t & 7) * 2; }
__device__ __forceinline__ f32x16 mfma32(bf16x8 a, bf16x8 b, f32x16 c) { return __builtin_amdgcn_mfma_f32_32x32x16_bf16(a, b, c, 0, 0, 0); }

#define OPQ(x) asm volatile("" : "+v"(x))
__device__ void ssd_prompt_item(const Params& p, int j, int b, int h, LAS unsigned char* lds) {
    const int tid0 = otid(), wid = __builtin_amdgcn_readfirstlane(tid0 >> 6), g = h >> 2;
    const char* zxc = (const char*)(p.ws + WS_ZX);
    const char* dtc = (const char*)(p.ws + WS_DTRAW);
    char* ygc = (char*)(p.ws + WS_YG);
    const int rowbase = b * 2048;
    LAS float* sm_acum = (LAS float*)(lds + L_SM);
    LAS float* sm_dt = sm_acum + 128;
    LAS float* sm_w = sm_acum + 256;
    LAS float* sm_ea = sm_acum + 384;
    LAS float* cw = (LAS float*)(lds + L_CW);
    const float Ah = -__expf(p.in[14][j * 32 + h]), Dh = p.in[15][j * 32 + h], dtb = p.in[13][j * 32 + h];
    const bool roleB = wid < 4;
    const int qq = wid >> 1, tt = qq ^ (qq >> 1), pt = wid & 1, hp = wid & 1, hn = wid >> 1;

    __syncthreads();
    if (tid0 < 320) {
        const int ch = tid0 < 64 ? h * 64 + tid0 : (tid0 < 192 ? 2048 + g * 128 + (tid0 - 64) : 3072 + g * 128 + (tid0 - 192));
#pragma unroll
        for (int k = 0; k < 4; ++k) cw[k * 320 + tid0] = p.in[11][((size_t)j * 4 + k) * 4096 + ch];
        cw[4 * 320 + tid0] = p.in[12][(size_t)j * 4096 + ch];
    }
    for (int i = tid0; i < 17408 / 4; i += 512) *(LAS unsigned*)(lds + L_HB + i * 4) = 0u;

    u32x4 rawBC[11]; unsigned rawX[11]; float dtp0 = 0.f, dtp1 = 0.f;
    auto prefetch = [&](int t0) {
        int tid = tid0; OPQ(tid);
        const int bt_ = tid & 255, tqb = bt_ >> 4, cg8 = bt_ & 15, tqx = tid >> 5, cp = tid & 31, lane = tid & 63;
        const int colBC = (roleB ? 4096 : 5120) + g * 128 + cg8 * 8, colX = 2048 + h * 64 + cp * 2;
        const int rB = t0 + tqb * 8 - 3, rX = t0 + tqx * 8 - 3;
        const unsigned oB = (unsigned)((rowbase + rB) * ZXW + colBC) * 2u, oX = (unsigned)((rowbase + rX) * ZXW + colX) * 2u;
#pragma unroll
        for (int i = 0; i < 11; ++i) {
            rawBC[i] = (rB + i >= 0) ? *(const u32x4*)(zxc + (oB + (unsigned)i * 12288u)) : (u32x4){0u, 0u, 0u, 0u};
            rawX[i] = (rX + i >= 0) ? *(const unsigned*)(zxc + (oX + (unsigned)i * 12288u)) : 0u;
        }
        if (wid == 0) { const unsigned od = (unsigned)((rowbase + t0 + 2 * lane) * 32 + h) * 4u; dtp0 = *(const float*)(dtc + od); dtp1 = *(const float*)(dtc + (od + 128u)); }
    };
    prefetch(0);

    f32x16 hacc;
#pragma unroll
    for (int i = 0; i < 16; ++i) hacc[i] = 0.f;

#pragma unroll 1
    for (int c = 0; c < 16; ++c) {
        const int t0 = c * 128;
        if (wid == 0) {
            int lane = tid0 & 63; OPQ(lane);
            const float d0 = softplus_f(dtp0 + dtb), d1 = softplus_f(dtp1 + dtb);
            const float a0 = d0 * Ah, a1 = a0 + d1 * Ah;
            float sc = a1;
#pragma unroll
            for (int o = 1; o < 64; o <<= 1) { const float v = __shfl_up(sc, o); if (lane >= o) sc += v; }
            const float c1 = sc, c0 = sc - a1 + a0;
            const float last = __shfl(sc, 63);
            sm_acum[2 * lane] = c0; sm_acum[2 * lane + 1] = c1;
            sm_dt[2 * lane] = d0; sm_dt[2 * lane + 1] = d1;
            sm_w[2 * lane] = __expf(last - c0) * d0; sm_w[2 * lane + 1] = __expf(last - c1) * d1;
            sm_ea[2 * lane] = __expf(c0); sm_ea[2 * lane + 1] = __expf(c1);
        }
        __syncthreads();
        {
            int tid = tid0; OPQ(tid);
            const int bt_ = tid & 255, tqb = bt_ >> 4, cg8 = bt_ & 15;
            const int lcBC = (roleB ? 64 : 192) + cg8 * 8;
            const f32x4 wv0 = *(const LAS f32x4*)(sm_w + tqb * 8), wv1 = *(const LAS f32x4*)(sm_w + tqb * 8 + 4);
            const float wt[8] = {wv0.x, wv0.y, wv0.z, wv0.w, wv1.x, wv1.y, wv1.z, wv1.w};
            const int natbase = (roleB ? L_BN : L_CN) + (tqb * 8) * RS + cg8 * 16;
#pragma unroll
            for (int half = 0; half < 2; ++half) {
                u32x2 nat[8]; u32x4 tr[4];
#pragma unroll
                for (int ipp = 0; ipp < 2; ++ipp) {
                    const int ip = half * 2 + ipp;
                    const float k0a = cw[0 * 320 + lcBC + 2 * ip], k0b = cw[0 * 320 + lcBC + 2 * ip + 1];
                    const float k1a = cw[1 * 320 + lcBC + 2 * ip], k1b = cw[1 * 320 + lcBC + 2 * ip + 1];
                    const float k2a = cw[2 * 320 + lcBC + 2 * ip], k2b = cw[2 * 320 + lcBC + 2 * ip + 1];
                    const float k3a = cw[3 * 320 + lcBC + 2 * ip], k3b = cw[3 * 320 + lcBC + 2 * ip + 1];
                    const float bba = cw[4 * 320 + lcBC + 2 * ip], bbb = cw[4 * 320 + lcBC + 2 * ip + 1];
                    f32x2 rr[11];
#pragma unroll
                    for (int i = 0; i < 11; ++i) { const unsigned v = rawBC[i][ip]; rr[i] = (f32x2){bf_lo(v), bf_hi(v)}; }
                    const f32x2 K0 = {k0a, k0b}, K1 = {k1a, k1b}, K2 = {k2a, k2b}, K3 = {k3a, k3b}, BB = {bba, bbb};
                    float va[8], vb[8];
#pragma unroll
                    for (int t = 0; t < 8; ++t) {
                        const f32x2 v = silu2(BB + K0 * rr[t] + K1 * rr[t + 1] + K2 * rr[t + 2] + K3 * rr[t + 3]);
                        va[t] = v.x; vb[t] = v.y;
                        nat[t][ipp] = cvt_pk_bf16(v.x, v.y);
                    }
                    if (roleB) {
#pragma unroll
                        for (int tp = 0; tp < 4; ++tp) {
                            tr[2 * ipp][tp] = cvt_pk_bf16(va[2 * tp] * wt[2 * tp], va[2 * tp + 1] * wt[2 * tp + 1]);
                            tr[2 * ipp + 1][tp] = cvt_pk_bf16(vb[2 * tp] * wt[2 * tp], vb[2 * tp + 1] * wt[2 * tp + 1]);
                        }
                    }
                }
#pragma unroll
                for (int t = 0; t < 8; ++t) *(LAS u32x2*)(lds + natbase + t * RS + half * 8) = nat[t];
                if (roleB) {
#pragma unroll
                    for (int i = 0; i < 4; ++i) *(LAS u32x4*)(lds + bt_addr(cg8 * 8 + half * 4 + i, tqb * 8)) = tr[i];
                }
                __builtin_amdgcn_sched_barrier(0);
            }
        }
        {
            int tid = tid0; OPQ(tid);
            const int tqx = tid >> 5, cp = tid & 31, lcX = cp * 2;
            const float k0a = cw[0 * 320 + lcX], k0b = cw[0 * 320 + lcX + 1], k1a = cw[1 * 320 + lcX], k1b = cw[1 * 320 + lcX + 1];
            const float k2a = cw[2 * 320 + lcX], k2b = cw[2 * 320 + lcX + 1], k3a = cw[3 * 320 + lcX], k3b = cw[3 * 320 + lcX + 1];
            const float bba = cw[4 * 320 + lcX], bbb = cw[4 * 320 + lcX + 1];
            f32x2 rr[11];
#pragma unroll
            for (int i = 0; i < 11; ++i) rr[i] = (f32x2){bf_lo(rawX[i]), bf_hi(rawX[i])};
            const f32x2 K0 = {k0a, k0b}, K1 = {k1a, k1b}, K2 = {k2a, k2b}, K3 = {k3a, k3b}, BB = {bba, bbb};
            float va[8], vb[8];
#pragma unroll
            for (int t = 0; t < 8; ++t) { const f32x2 v = silu2(BB + K0 * rr[t] + K1 * rr[t + 1] + K2 * rr[t + 2] + K3 * rr[t + 3]); va[t] = v.x; vb[t] = v.y; }
            u32x4 xa, xb;
            xa.x = cvt_pk_bf16(va[0], va[1]); xa.y = cvt_pk_bf16(va[2], va[3]); xa.z = cvt_pk_bf16(va[4], va[5]); xa.w = cvt_pk_bf16(va[6], va[7]);
            xb.x = cvt_pk_bf16(vb[0], vb[1]); xb.y = cvt_pk_bf16(vb[2], vb[3]); xb.z = cvt_pk_bf16(vb[4], vb[5]); xb.w = cvt_pk_bf16(vb[6], vb[7]);
            *(LAS u32x4*)(lds + xt_addr(cp * 2, tqx * 8)) = xa;
            *(LAS u32x4*)(lds + xt_addr(cp * 2 + 1, tqx * 8)) = xb;
        }
        if (c + 1 < 16) prefetch(t0 + 128);
        bf16_t zr[16];
        {
            int ln = tid0 & 63; OPQ(ln);
            const int l31 = ln & 31, hh = ln >> 5;
            const unsigned oz = (unsigned)((rowbase + t0 + tt * 32 + 4 * hh) * ZXW + h * 64 + pt * 32 + l31) * 2u;
#pragma unroll
            for (int rg = 0; rg < 16; ++rg) zr[rg] = *(const bf16_t*)(zxc + (oz + (unsigned)((rg & 3) + 8 * (rg >> 2)) * 12288u));
        }
        __syncthreads();
        f32x16 y;
        {
            int ln = tid0 & 63; OPQ(ln);
            const int l31 = ln & 31, hh = ln >> 5;
            const int cbase = L_CN + (tt * 32 + l31) * RS + 16 * hh, hbase = L_HB + (pt * 32 + l31) * RS + 16 * hh;
#pragma unroll
            for (int i = 0; i < 16; ++i) y[i] = 0.f;
            {
                const float dec = sm_ea[127];
#pragma unroll
                for (int i = 0; i < 16; ++i) hacc[i] *= dec;
            }
            bf16x8 cf[8];
#pragma unroll
            for (int ks = 0; ks < 8; ++ks) {
                cf[ks] = *(const LAS bf16x8*)(lds + cbase + ks * 32);
                const bf16x8 bfr = *(const LAS bf16x8*)(lds + hbase + ks * 32);
                const bf16x8 a = *(const LAS bf16x8*)(lds + xt_addr(hp * 32 + l31, ks * 16 + 8 * hh));
                const bf16x8 bb = *(const LAS bf16x8*)(lds + bt_addr(hn * 32 + l31, ks * 16 + 8 * hh));
                y = mfma32(cf[ks], bfr, y);
                hacc = mfma32(a, bb, hacc);
            }
#pragma unroll
            for (int rq = 0; rq < 4; ++rq) { const f32x4 e = *(const LAS f32x4*)(sm_ea + tt * 32 + 8 * rq + 4 * hh); y[4 * rq] *= e.x; y[4 * rq + 1] *= e.y; y[4 * rq + 2] *= e.z; y[4 * rq + 3] *= e.w; }
            const int tidx = tt * 32 + l31;
            const float at = sm_acum[tidx];
#pragma unroll 1
            for (int st = 0; st <= tt; ++st) {
                f32x16 s;
#pragma unroll
                for (int i = 0; i < 16; ++i) s[i] = 0.f;
                const int bbase = L_BN + (st * 32 + l31) * RS + 16 * hh;
#pragma unroll
                for (int ks = 0; ks < 8; ++ks) { const bf16x8 afr = *(const LAS bf16x8*)(lds + bbase + ks * 32); s = mfma32(afr, cf[ks], s); }
#pragma unroll
                for (int rq = 0; rq < 4; ++rq) {
                    const int sb0 = st * 32 + 8 * rq + 4 * hh;
                    const f32x4 asv = *(const LAS f32x4*)(sm_acum + sb0), dsv = *(const LAS f32x4*)(sm_dt + sb0);
#pragma unroll
                    for (int i = 0; i < 4; ++i) {
                        float e = at - asv[i];
                        if (sb0 + i > tidx) e = -INFINITY;
                        s[4 * rq + i] *= __expf(e) * dsv[i];
                    }
                }
#pragma unroll
                for (int k2 = 0; k2 < 2; ++k2) {
                    u32x4 au; au.x = cvt_pk_bf16(s[8 * k2], s[8 * k2 + 1]); au.y = cvt_pk_bf16(s[8 * k2 + 2], s[8 * k2 + 3]); au.z = cvt_pk_bf16(s[8 * k2 + 4], s[8 * k2 + 5]); au.w = cvt_pk_bf16(s[8 * k2 + 6], s[8 * k2 + 7]);
                    const int sbase = st * 32 + 16 * k2 + 4 * hh;
                    const u32x2 lo = *(const LAS u32x2*)(lds + xt_addr(pt * 32 + l31, sbase)), hi = *(const LAS u32x2*)(lds + xt_addr(pt * 32 + l31, sbase + 8));
                    u32x4 bu; bu.x = lo.x; bu.y = lo.y; bu.z = hi.x; bu.w = hi.y;
                    y = mfma32(__builtin_bit_cast(bf16x8, au), __builtin_bit_cast(bf16x8, bu), y);
                }
            }
        }
        {
            int ln = tid0 & 63; OPQ(ln);
            const int l31 = ln & 31, hh = ln >> 5;
            const unsigned oy = (unsigned)((rowbase + t0 + tt * 32 + 4 * hh) * 2048 + h * 64 + pt * 32 + l31) * 2u;
#pragma unroll
            for (int rq = 0; rq < 4; ++rq) {
                const u32x2 xv = *(const LAS u32x2*)(lds + xt_addr(pt * 32 + l31, tt * 32 + 8 * rq + 4 * hh));
                const float xs[4] = {bf_lo(xv.x), bf_hi(xv.x), bf_lo(xv.y), bf_hi(xv.y)};
#pragma unroll
                for (int i = 0; i < 4; ++i) {
                    const int rg = 4 * rq + i;
                    const float yv = y[rg] + Dh * xs[i];
                    const float gv = yv * silu_f(bf2f(zr[rg]));
                    *(bf16_t*)(ygc + (oy + (unsigned)(8 * rq + i) * 4096u)) = (bf16_t)(cvt_pk_bf16(gv, 0.f) & 0xffffu);
                }
            }
        }
        __syncthreads();
        {
            int ln = tid0 & 63; OPQ(ln);
            const int l31 = ln & 31, hh = ln >> 5;
#pragma unroll
            for (int rg = 0; rg < 16; ++rg) {
                const int pr = hp * 32 + (rg & 3) + 8 * (rg >> 2) + 4 * hh;
                *(LAS bf16_t*)(lds + L_HB + pr * RS + (hn * 32 + l31) * 2) = (bf16_t)(cvt_pk_bf16(hacc[rg], 0.f) & 0xffffu);
            }
        }
    }
    {
        int ln = tid0 & 63; OPQ(ln);
        const int l31 = ln & 31, hh = ln >> 5;
        float* so = p.out + O_SSM_P + ((size_t)(j * 8 + b) * 32 + h) * 8192;
#pragma unroll
        for (int rg = 0; rg < 16; ++rg) {
            const int pr = hp * 32 + (rg & 3) + 8 * (rg >> 2) + 4 * hh;
            so[pr * 128 + hn * 32 + l31] = hacc[rg];
        }
    }
}

__device__ void ssd_sample_all(const Params& p, int j, LAS unsigned char* lds) {
    const int tid = otid();
    const bf16_t* zx = (const bf16_t*)(p.ws + WS_ZX);
    const float* dtraw = (const float*)(p.ws + WS_DTRAW);
    bf16_t* yg = (bf16_t*)(p.ws + WS_YG);
    LAS float* sx = (LAS float*)lds;
    LAS float* sB = sx + 2048;
    LAS float* sC = sB + 1024;
    LAS float* sdt = sC + 1024;
    LAS float* sdec = sdt + 32;
    const int pp = tid >> 3, nl = (tid & 7) * 4;
    int item = (int)blockIdx.x;
    f32x4 hs[4][4];
    if (item < 1024) {
        const float* st = p.in[2] + ((size_t)(j * 128 + (item >> 3)) * 32 + (item & 7) * 4) * 8192;
#pragma unroll
        for (int r = 0; r < 4; ++r)
#pragma unroll
            for (int q = 0; q < 4; ++q) hs[r][q] = *(const f32x4*)(st + r * 8192 + pp * 128 + nl + 32 * q);
    }
#pragma unroll 1
    for (; item < 1024; item += (int)gridDim.x) {
        const int b = item >> 3, g = item & 7;
        __syncthreads();
        {
            const int cc = tid < 256 ? g * 256 + tid : (tid < 384 ? 2048 + g * 128 + (tid - 256) : 3072 + g * 128 + (tid - 384));
            float raw[11];
#pragma unroll
            for (int k = 0; k < 3; ++k) raw[k] = p.in[3][((size_t)(j * 128 + b) * 3 + k) * 4096 + cc];
#pragma unroll
            for (int t = 0; t < 8; ++t) raw[3 + t] = bf2f(zx[(size_t)(MP + b * 8 + t) * ZXW + 2048 + cc]);
            const float w0 = p.in[11][((size_t)j * 4 + 0) * 4096 + cc], w1 = p.in[11][((size_t)j * 4 + 1) * 4096 + cc];
            const float w2 = p.in[11][((size_t)j * 4 + 2) * 4096 + cc], w3 = p.in[11][((size_t)j * 4 + 3) * 4096 + cc];
            const float bs = p.in[12][(size_t)j * 4096 + cc];
            LAS float* dst = tid < 256 ? sx + tid : (tid < 384 ? sB + (tid - 256) : sC + (tid - 384));
            const int dstride = tid < 256 ? 256 : 128;
#pragma unroll
            for (int t = 0; t < 8; ++t) dst[t * dstride] = silu_f(bs + w0 * raw[t] + w1 * raw[t + 1] + w2 * raw[t + 2] + w3 * raw[t + 3]);
            if (tid < 32) {
                const int t = tid >> 2, r = tid & 3, hd = g * 4 + r;
                const float dtv = softplus_f(dtraw[(size_t)(MP + b * 8 + t) * 32 + hd] + p.in[13][j * 32 + hd]);
                sdt[tid] = dtv; sdec[tid] = __expf(-dtv * __expf(p.in[14][j * 32 + hd]));
            }
        }
        const int tsel = tid & 7;
        const size_t row = (size_t)(MP + b * 8 + tsel);
        bf16_t zv[4];
#pragma unroll
        for (int r = 0; r < 4; ++r) zv[r] = zx[row * ZXW + g * 256 + r * 64 + pp];
        const int nitem = item + (int)gridDim.x;
        f32x4 hn[4][4];
        if (nitem < 1024) {
            const float* st = p.in[2] + ((size_t)(j * 128 + (nitem >> 3)) * 32 + (nitem & 7) * 4) * 8192;
#pragma unroll
            for (int r = 0; r < 4; ++r)
#pragma unroll
                for (int q = 0; q < 4; ++q) hn[r][q] = *(const f32x4*)(st + r * 8192 + pp * 128 + nl + 32 * q);
        }
        __syncthreads();
        float ysel[4] = {0.f, 0.f, 0.f, 0.f};
#pragma unroll
        for (int t = 0; t < 8; ++t) {
            const f32x4 dt4 = *(const LAS f32x4*)(sdt + t * 4), dc4 = *(const LAS f32x4*)(sdec + t * 4);
            const float dx[4] = {dt4.x * sx[t * 256 + pp], dt4.y * sx[t * 256 + 64 + pp], dt4.z * sx[t * 256 + 128 + pp], dt4.w * sx[t * 256 + 192 + pp]};
            const float dc[4] = {dc4.x, dc4.y, dc4.z, dc4.w};
            float yp[4] = {0.f, 0.f, 0.f, 0.f};
#pragma unroll
            for (int q = 0; q < 4; ++q) {
                const f32x4 B4 = *(const LAS f32x4*)(sB + t * 128 + nl + 32 * q), C4 = *(const LAS f32x4*)(sC + t * 128 + nl + 32 * q);
#pragma unroll
                for (int r = 0; r < 4; ++r) {
                    hs[r][q] = hs[r][q] * dc[r] + B4 * dx[r];
                    yp[r] += (hs[r][q].x * C4.x + hs[r][q].y * C4.y) + (hs[r][q].z * C4.z + hs[r][q].w * C4.w);
                }
            }
#pragma unroll
            for (int r = 0; r < 4; ++r) {
                float v = yp[r];
                v += __shfl_xor(v, 1); v += __shfl_xor(v, 2); v += __shfl_xor(v, 4);
                if (tsel == t) ysel[r] = v;
            }
        }
        float* so = p.out + O_SSM_S + ((size_t)(j * 128 + b) * 32 + g * 4) * 8192;
#pragma unroll
        for (int r = 0; r < 4; ++r) {
            const int ch = g * 256 + r * 64 + pp;
            const float yv = ysel[r] + p.in[15][j * 32 + g * 4 + r] * sx[tsel * 256 + r * 64 + pp];
            const float gv = yv * silu_f(bf2f(zv[r]));
            yg[row * 2048 + ch] = (bf16_t)(cvt_pk_bf16(gv, 0.f) & 0xffffu);
#pragma unroll
            for (int q = 0; q < 4; ++q) *(f32x4*)(so + r * 8192 + pp * 128 + nl + 32 * q) = hs[r][q];
        }
        if (nitem < 1024) {
#pragma unroll
            for (int r = 0; r < 4; ++r)
#pragma unroll
                for (int q = 0; q < 4; ++q) hs[r][q] = hn[r][q];
        }
    }
}

__device__ void phase_scan(const Params& p, int j, LAS unsigned char* lds) {
    for (int item = blockIdx.x; item < 256; item += gridDim.x) {
        const int g = item & 7, k = item >> 3, b = k >> 2, r = k & 3;
        for (int rep = 0; rep < REP_PROMPT; ++rep) ssd_prompt_item(p, j, b, g * 4 + r, lds);
    }
    ssd_sample_all(p, j, lds);
    const bf16_t* zx = (const bf16_t*)(p.ws + WS_ZX);
    const int gt = blockIdx.x * 512 + otid(), nth = gridDim.x * 512;
    for (int i = gt; i < 136 * 3 * 512; i += nth) {
        const int ch = (i & 511) * 8, k = (i >> 9) % 3, sq = (i >> 9) / 3;
        const size_t row = sq < 8 ? (size_t)(sq * 2048 + 2045 + k) : (size_t)(MP + (sq - 8) * 8 + 5 + k);
        float* dst = sq < 8 ? p.out + O_CONV_P + ((size_t)(j * 8 + sq) * 3 + k) * 4096 + ch : p.out + O_CONV_S + ((size_t)(j * 128 + (sq - 8)) * 3 + k) * 4096 + ch;
        const u32x4 v = *(const u32x4*)(zx + row * ZXW + 2048 + ch);
        *(f32x4*)dst = (f32x4){bf_lo(v.x), bf_hi(v.x), bf_lo(v.y), bf_hi(v.y)}; *(f32x4*)(dst + 4) = (f32x4){bf_lo(v.z), bf_hi(v.z), bf_lo(v.w), bf_hi(v.w)};
    }
}

#define XB_TMO      128
#define XB_XCNT(j)  (256  + 64 * (j))
#define XB_XSUB(j)  (1280 + 64 * (j))
#define XB_XGEN(j)  (2304 + 64 * (j))
#define XB_TOP      3328
#define XB_TOPGEN   3392
#define XCD_BAR_WORDS 3456
#define XB_SPIN_CAP (1u << 22)
__device__ __forceinline__ unsigned xb_ld(unsigned* p)              { return __hip_atomic_load(p, __ATOMIC_RELAXED, __HIP_MEMORY_SCOPE_AGENT); }
__device__ __forceinline__ unsigned xb_add(unsigned* p, unsigned v) { return __hip_atomic_fetch_add(p, v, __ATOMIC_RELAXED, __HIP_MEMORY_SCOPE_AGENT); }
__device__ __forceinline__ unsigned xb_xcc_id() { return (unsigned)__builtin_amdgcn_s_getreg((3 << 11) | 20) & 0xFu; }
#define XB_SPIN(cond, bar) do { unsigned _sp = 0; while (cond) { __builtin_amdgcn_s_sleep(1); \
    if ((++_sp & 255u) == 0u) { if (xb_ld(&(bar)[XB_TMO])) break; if (_sp > XB_SPIN_CAP) { atomicAdd(&(bar)[XB_TMO], 1u); break; } } } } while (0)
struct XcdBarrier { unsigned* bar; unsigned x; volatile LAS unsigned* st; };
__device__ __forceinline__ XcdBarrier xcd_barrier_post(unsigned* bar, volatile LAS unsigned* st) {
    XcdBarrier b; b.bar = bar; b.x = xb_xcc_id(); b.st = st;
    if (threadIdx.x == 0) (void)xb_add(&bar[XB_XCNT(b.x)], 1u);
    return b;
}
__device__ __forceinline__ void xcd_barrier_complete(unsigned* bar, unsigned x, unsigned& nloc, unsigned& nx) {
    const unsigned G = gridDim.x * gridDim.y * gridDim.z;
    unsigned sum, cnt, mine, sp = 0u;
    for (;;) {
        sum = 0u; cnt = 0u; mine = 0u;
#pragma unroll
        for (unsigned j = 0; j < 16; ++j) { const unsigned c = xb_ld(&bar[XB_XCNT(j)]); sum += c; cnt += (c > 0u) ? 1u : 0u; mine = (j == x) ? c : mine; }
        if (sum == G) break;
        __builtin_amdgcn_s_sleep(1);
        if ((++sp & 255u) == 0u) { if (xb_ld(&bar[XB_TMO])) break; if (sp > XB_SPIN_CAP) { atomicAdd(&bar[XB_TMO], 1u); break; } }
    }
    nloc = mine > 0u ? mine : 1u; nx = cnt > 0u ? cnt : 1u;
}
__device__ __forceinline__ void xcd_barrier(const XcdBarrier& b) {
    asm volatile("s_waitcnt vmcnt(0)" ::: "memory");
    __syncthreads();
    if (threadIdx.x == 0) {
        unsigned* bar = b.bar;
        __builtin_amdgcn_s_waitcnt(0);
        unsigned nloc = b.st[0], nx = b.st[1];
        if (nloc == 0u) { xcd_barrier_complete(bar, b.x, nloc, nx); b.st[0] = nloc; b.st[1] = nx; }
        const unsigned old = xb_add(&bar[XB_XSUB(b.x)], 1u);
        const unsigned gen = old / nloc;
        if (old + 1u == (gen + 1u) * nloc) {
            __builtin_amdgcn_fence(__ATOMIC_RELEASE, "agent");
            asm volatile("s_waitcnt vmcnt(0)" ::: "memory");
            const unsigned og = xb_add(&bar[XB_TOP], 1u);
            const unsigned tg = og / nx;
            if (og + 1u == (tg + 1u) * nx) xb_add(&bar[XB_TOPGEN], 1u);
            else XB_SPIN(xb_ld(&bar[XB_TOPGEN]) == tg, bar);
            __builtin_amdgcn_fence(__ATOMIC_ACQUIRE, "agent");
            xb_add(&bar[XB_XGEN(b.x)], 1u);
            asm volatile("s_waitcnt vmcnt(0)" ::: "memory");
        } else {
            XB_SPIN(xb_ld(&bar[XB_XGEN(b.x)]) == gen, bar);
            __builtin_amdgcn_fence(__ATOMIC_ACQUIRE, "agent");
            asm volatile("s_waitcnt vmcnt(0)" ::: "memory");
        }
    }
    __syncthreads();
}

#ifndef REP_PREP0
#define REP_PREP0 1
#endif
#ifndef REP_SMALL
#define REP_SMALL 1
#endif
#ifndef REP_GGRP
#define REP_GGRP 1
#endif
#ifndef REP_GGRP
#define REP_GGRP 1
#endif
#ifndef REP_SYNC
#define REP_SYNC 1
#endif
#ifndef REP_SCAN
#define REP_SCAN 1
#endif
#ifndef REP_GIN
#define REP_GIN 1
#endif
#ifndef REP_GOUT
#define REP_GOUT 1
#endif
#ifndef REP_ELEM
#define REP_ELEM 1
#endif
#define GSYNC() do { for (int _r = 0; _r < REP_SYNC; ++_r) xcd_barrier(xb); } while (0)
__global__ __launch_bounds__(512, 2) void hybrid_fwd(const float* i0, const float* i1, const float* i2, const float* i3, const float* i4, const float* i5, const float* i6, const float* i7,
        const float* i8, const float* i9, const float* i10, const float* i11, const float* i12, const float* i13, const float* i14, const float* i15, const float* i16, const float* i17,
        const float* i18, const float* i19, const float* i20, const float* i21, const float* i22, float* outp, unsigned char* wsp, WTab wt) {
    Params p;
    p.in[0] = i0; p.in[1] = i1; p.in[2] = i2; p.in[3] = i3; p.in[4] = i4; p.in[5] = i5; p.in[6] = i6; p.in[7] = i7; p.in[8] = i8; p.in[9] = i9; p.in[10] = i10; p.in[11] = i11;
    p.in[12] = i12; p.in[13] = i13; p.in[14] = i14; p.in[15] = i15; p.in[16] = i16; p.in[17] = i17; p.in[18] = i18; p.in[19] = i19; p.in[20] = i20; p.in[21] = i21; p.in[22] = i22;
    p.out = outp; p.ws = wsp;
    extern __shared__ __attribute__((aligned(16))) unsigned char smem[];
    LAS unsigned char* lds = (LAS unsigned char*)smem;
    cg::grid_group grid = cg::this_grid();
    unsigned char* ws = p.ws;
    volatile LAS unsigned* xst = (volatile LAS unsigned*)(lds + LDS_XB);
    if (threadIdx.x == 0) { xst[0] = 0u; xst[1] = 0u; }
    __syncthreads();
    const XcdBarrier xb = xcd_barrier_post((unsigned*)(ws + WS_BAR), xst);

    for (int rep = 0; rep < REP_PREP0; ++rep) phase_prep0(p, wt, lds);
    if (wt.wtiles < 0) grid.sync();
    xcd_barrier(xb);
#pragma unroll 1
    for (int mode_ = 0; mode_ < 2 * REP_SMALL; ++mode_) {
        const int mode = mode_ % 2;
        pg8::SmallSched S; S.mode = mode; S.G = (int)gridDim.x; S.c = (int)blockIdx.x; S.lda = 1024; S.ldb = 1024; S.K = 1024;
        S.A0 = (const char*)(ws + (mode == 0 ? WS_AC : WS_SHIFTA)); S.ada = (const char*)(ws + WS_WT_ADA); S.ssd_in = (const char*)(ws + WS_WT_SSD_IN); S.pool_in = (const char*)(ws + WS_WT_POOL_IN);
        EpiSmall E; E.mode = mode; E.mod = (float*)(ws + WS_MOD); E.ada_b = p.in[8]; E.shiftA = (bf16_t*)(ws + WS_SHIFTA); E.sb = (float*)(ws + WS_SB);
#ifndef NO_GSMALL
        pg8::gemm_phase<EpiSmall, pg8::SmallSched>(lds, S, E);
#endif
        if (mode == 1) phase_xprep(p);
        GSYNC();
    }
    unsigned* tailw = (unsigned*)(ws + WS_BAR) + 3584;
    unsigned* tmow = (unsigned*)(ws + WS_BAR) + XB_TMO;
#pragma unroll 1
    for (int layer = 0; layer < 4; ++layer) {
        const int j = layer >> 1; const bool ssd = (layer & 1) == 0;
        {
            pg8::InSched S;
            S.init(ssd ? 6400 : 4096, ws + WS_APRIME, ssd ? ws + WS_WT_SSD_IN + (size_t)j * 6400 * 1024 * 2 : ws + WS_WT_POOL_IN + (size_t)j * 4096 * 1024 * 2, layer > 0 ? tailw + 64 * (layer - 1) : nullptr, tmow);
            EpiIn E; E.ssq = (const float*)(ws + WS_SSQ) + (size_t)layer * 17408; E.sb = (const float*)(ws + WS_SB) + (size_t)layer * 136 * 6400; E.out = (bf16_t*)(ws + WS_ZX);
            E.ldo = ssd ? ZXW : 4096; E.nbf = ssd ? ZXW : 4096; E.dtraw = ssd ? (float*)(ws + WS_DTRAW) : nullptr;
            for (int rep = 0; rep < REP_GIN; ++rep) pg8::gemm_phase<EpiIn, pg8::InSched>(lds, S, E);
        }
        GSYNC();
        if (ssd) { for (int rep = 0; rep < REP_SCAN; ++rep) phase_scan(p, j, lds); } else { for (int rep = 0; rep < REP_ELEM; ++rep) phase_pool(p, j); }
        GSYNC();
        if (ssd) { for (int rep = 0; rep < REP_ELEM; ++rep) phase_ssdnorm(p, j); }
        else {
            pg8::MainSched S; S.init(MT, 2048, 512, 2048, 512, ws + WS_YG, ws + WS_WT_POOL_G + (size_t)j * 2048 * 512 * 2, 1);
            EpiGrp E; E.uz = (const bf16_t*)(ws + WS_ZX); E.chs = p.in[20] + (size_t)j * 2048; E.out = (bf16_t*)(ws + WS_A2);
            for (int rep = 0; rep < REP_GGRP; ++rep) pg8::gemm_phase<EpiGrp, pg8::MainSched>(lds, S, E);
        }
        GSYNC();
#pragma unroll 1
        for (int part = 0; part < 2; ++part) {
            pg8::MainSched S; S.init(part == 0 ? MP : MT, 1024, 2048, 2048, 2048, ws + WS_A2, ssd ? ws + WS_WT_SSD_OUT + (size_t)j * 1024 * 2048 * 2 : ws + WS_WT_POOL_OUT + (size_t)j * 1024 * 2048 * 2, 30, part);
            EpiOut E; float* xw = (float*)(ws + WS_XW);
            E.xin_p = layer == 0 ? p.in[0] : xw; E.xin_s = layer == 0 ? p.in[1] : xw + (size_t)MP * DM; E.xw = xw;
            E.modl = (const float*)(ws + WS_MOD) + (size_t)layer * 3072; E.ng_next = layer < 3 ? p.in[9] + (size_t)(layer + 1) * 1024 : nullptr;
            E.aprime = (bf16_t*)(ws + WS_APRIME); E.ssq = (float*)(ws + WS_SSQ) + (size_t)(layer + 1) * 17408;
            pg8::gemm_phase<EpiOut, pg8::MainSched>(lds, S, E);
            if (part == 0) GSYNC();
        }
        if (blockIdx.x < 16) {
            asm volatile("s_waitcnt vmcnt(0)" ::: "memory");
            __syncthreads();
            if (threadIdx.x == 0) { __builtin_amdgcn_fence(__ATOMIC_RELEASE, "agent"); asm volatile("s_waitcnt vmcnt(0)" ::: "memory"); __hip_atomic_fetch_add(tailw + 64 * layer, 1u, __ATOMIC_RELAXED, __HIP_MEMORY_SCOPE_AGENT); }
        }
    }
    phase_final(p, 0, MP, 16);
    GSYNC();
    phase_final(p, MP, MT, 0);
}

extern "C" void kernel_launch(void* const* d_in, const int* in_sizes, int n_in, void* d_out, int out_size, void* d_ws, size_t ws_size, hipStream_t stream) {
    static int grid = 0;
    if (grid == 0) {
        if (n_in != 23 || ws_size < WS_END) { fprintf(stderr, "kernel_launch: unexpected n_in %d or ws_size %zu (need %zu)\n", n_in, ws_size, (size_t)WS_END); grid = -1; return; }
        int dev = 0, cus = 0, per_cu = 0;
        hipGetDevice(&dev);
        hipDeviceGetAttribute(&cus, hipDeviceAttributeMultiprocessorCount, dev);
        if (hipFuncSetAttribute((const void*)hybrid_fwd, hipFuncAttributeMaxDynamicSharedMemorySize, LDS_BYTES) != hipSuccess) { fprintf(stderr, "kernel_launch: hipFuncSetAttribute failed\n"); grid = -1; return; }
        if (hipOccupancyMaxActiveBlocksPerMultiprocessor(&per_cu, (const void*)hybrid_fwd, 512, LDS_BYTES) != hipSuccess || per_cu < 1) { fprintf(stderr, "kernel_launch: occupancy query gave %d\n", per_cu); (void)hipGetLastError(); per_cu = 1; }
        grid = cus * 1;
    }
    if (grid < 0) return;
    WTab wt{};
    unsigned char* ws = (unsigned char*)d_ws;
    int nj = 0, tb = 0;
    auto add = [&](int srci, long long soff, size_t dst_off, int K, int N, int Npad) {
        WJob& w = wt.wj[nj++]; w.src = (const float*)d_in[srci] + soff; w.doff = (long long)dst_off; w.K = K; w.N = N; w.tiles_n = Npad / 64; w.tile_begin = tb; tb += (K / 64) * (Npad / 64);
    };
    for (int i = 0; i < 4; ++i) add(7, (long long)i * 1024 * 3072, WS_WT_ADA + (size_t)i * 3072 * 1024 * 2, 1024, 3072, 3072);
    for (int j = 0; j < 2; ++j) add(10, (long long)j * 1024 * 6176, WS_WT_SSD_IN + (size_t)j * 6400 * 1024 * 2, 1024, 6176, 6400);
    for (int j = 0; j < 2; ++j) add(18, (long long)j * 1024 * 4096, WS_WT_POOL_IN + (size_t)j * 4096 * 1024 * 2, 1024, 4096, 4096);
    for (int j = 0; j < 2; ++j) add(17, (long long)j * 2048 * 1024, WS_WT_SSD_OUT + (size_t)j * 1024 * 2048 * 2, 2048, 1024, 1024);
    for (int j = 0; j < 2; ++j) add(21, (long long)j * 2048 * 1024, WS_WT_POOL_OUT + (size_t)j * 1024 * 2048 * 2, 2048, 1024, 1024);
    for (int q = 0; q < 8; ++q) add(19, (long long)q * 512 * 512, WS_WT_POOL_G + (size_t)q * 512 * 512 * 2, 512, 512, 512);
    wt.wtiles = tb;
    if (hipMemsetAsync(ws + WS_BAR, 0, 16384, stream) != hipSuccess) { fprintf(stderr, "kernel_launch: memset of the barrier words failed\n"); return; }
    const float* ip[23]; for (int i = 0; i < 23; ++i) ip[i] = (const float*)d_in[i];
    float* outp = (float*)d_out;
    void* args[26];
    for (int i = 0; i < 23; ++i) args[i] = (void*)&ip[i];
    args[23] = (void*)&outp; args[24] = (void*)&ws; args[25] = (void*)&wt;
    hipError_t e = hipLaunchCooperativeKernel((const void*)hybrid_fwd, dim3(grid), dim3(512), args, LDS_BYTES, stream);
    if (e != hipSuccess) fprintf(stderr, "cooperative launch failed: %s (grid %d)\n", hipGetErrorString(e), grid);
}
```

```cpp
#include <hip/hip_runtime.h>
#include <hip/hip_cooperative_groups.h>
#include <cstdio>
namespace cg = cooperative_groups;

#ifndef REP_PROMPT
#define REP_PROMPT 1
#endif
#define LAS __attribute__((address_space(3)))
typedef unsigned short bf16_t;
typedef short bf16x8 __attribute__((ext_vector_type(8)));
typedef float f32x4 __attribute__((ext_vector_type(4)));
typedef float f32x16 __attribute__((ext_vector_type(16)));
typedef unsigned u32x4 __attribute__((ext_vector_type(4)));
typedef unsigned u32x2 __attribute__((ext_vector_type(2)));
typedef float f32x2 __attribute__((ext_vector_type(2)));

constexpr int MP = 16384, MT = 17408, DM = 1024;
constexpr int ZXW = 6144;
constexpr size_t O_SSM_P = 17825792, O_CONV_P = 22020096, O_POOL_P = 22216704, O_SSM_S = 22708224, O_CONV_S = 89817088, O_POOL_S = 92962816;

constexpr size_t WS_WT_SSD_IN = 0;
constexpr size_t WS_WT_SSD_OUT = WS_WT_SSD_IN + 2ull * 6400 * 1024 * 2;
constexpr size_t WS_WT_POOL_IN = WS_WT_SSD_OUT + 2ull * 1024 * 2048 * 2;
constexpr size_t WS_WT_POOL_G = WS_WT_POOL_IN + 2ull * 4096 * 1024 * 2;
constexpr size_t WS_WT_POOL_OUT = WS_WT_POOL_G + 2ull * 2048 * 512 * 2;
constexpr size_t WS_WT_ADA = WS_WT_POOL_OUT + 2ull * 1024 * 2048 * 2;
constexpr size_t WS_AC = WS_WT_ADA + 12288ull * 1024 * 2;
constexpr size_t WS_SHIFTA = WS_AC + 256ull * 1024 * 2;
constexpr size_t WS_MOD = WS_SHIFTA + 4ull * 256 * 1024 * 2;
constexpr size_t WS_SB = WS_MOD + 136ull * 12288 * 4;
constexpr size_t WS_APRIME = WS_SB + 4ull * 136 * 6400 * 4;
constexpr size_t WS_SSQ = WS_APRIME + 17408ull * 1024 * 2;
constexpr size_t WS_XW = WS_SSQ + 17408ull * 16 * 4;
constexpr size_t WS_ZX = WS_XW + 17408ull * 1024 * 4;
constexpr size_t WS_DTRAW = WS_ZX + 17408ull * 6144 * 2;
constexpr size_t WS_YG = WS_DTRAW + 17408ull * 32 * 4;
constexpr size_t WS_A2 = WS_YG + 17408ull * 2048 * 2;
constexpr size_t WS_BAR = WS_A2 + 17408ull * 2048 * 2;
constexpr size_t WS_END = WS_BAR + 16384;

constexpr int LDS_XB = 149760;
constexpr int LDS_BYTES = 149776;

struct WJob { const float* src; long long doff; int K, N, tiles_n, tile_begin; };
struct WTab { WJob wj[20]; int wtiles; int pad0; };
constexpr int NWJ = 20;
struct Params {
    const float* in[23];
    float* out;
    unsigned char* ws;
};

__device__ __forceinline__ unsigned cvt_pk_bf16(float lo, float hi) { unsigned r; asm("v_cvt_pk_bf16_f32 %0, %1, %2" : "=v"(r) : "v"(lo), "v"(hi)); return r; }
__device__ __forceinline__ float bf_lo(unsigned u) { return __uint_as_float(u << 16); }
__device__ __forceinline__ float bf_hi(unsigned u) { return __uint_as_float(u & 0xffff0000u); }
__device__ __forceinline__ float bf2f(bf16_t b) { return __uint_as_float(((unsigned)b) << 16); }
__device__ __forceinline__ float silu_f(float v) { return v * __builtin_amdgcn_rcpf(1.f + __expf(-v)); }
__device__ __forceinline__ f32x2 silu2(f32x2 v) { const f32x2 e = v * (-1.44269504f); f32x2 d; d.x = __builtin_amdgcn_exp2f(e.x); d.y = __builtin_amdgcn_exp2f(e.y); d = d + 1.f; f32x2 r; r.x = __builtin_amdgcn_rcpf(d.x); r.y = __builtin_amdgcn_rcpf(d.y); return v * r; }
__device__ __forceinline__ float softplus_f(float v) { return v > 20.f ? v : log1pf(__expf(v)); }
__device__ __forceinline__ int otid() { int t = threadIdx.x; asm volatile("" : "+v"(t)); return t; }
__device__ __forceinline__ int row_b(int r) { return r < MP ? (r >> 11) : 8 + ((r - MP) >> 3); }
__device__ __forceinline__ u32x4 pack8(f32x4 a, f32x4 b) { u32x4 r; r.x = cvt_pk_bf16(a.x, a.y); r.y = cvt_pk_bf16(a.z, a.w); r.z = cvt_pk_bf16(b.x, b.y); r.w = cvt_pk_bf16(b.z, b.w); return r; }

namespace pg8 {
constexpr int BM = 256, BK = 64, HALF = 128, HTB = HALF * BK * 2, STAGE_BYTES = 8 * HTB, NXCD = 8, WGM = 8;
__device__ __forceinline__ int lds_byte(int r, int c) { const int st = (r >> 4) * 2 + (c >> 5), rr = r & 15, cc = c & 31, ob = rr * 64 + cc * 2; return st * 1024 + (ob ^ (((ob >> 9) & 1) << 5)); }
__device__ __forceinline__ void stage_rc(int b, int& R, int& C) { const int st = b / 1024, sb = b % 1024, swz = sb ^ (((sb >> 9) & 1) << 5); R = (st >> 1) * 16 + swz / 64; C = (st & 1) * 32 + (swz % 64) / 2; }
__device__ __forceinline__ int perm32(int rho) { const int n = rho >> 4, i = rho & 15; return 8 * (i >> 2) + 4 * n + (i & 3); }

struct Unit { int pm, pn, q; const char* A; const char* B; };

__device__ __forceinline__ void static_unit(int L, int nM, int nN, int& pm, int& pn) {
    const int nwg = nM * nN;
    int wgid = L; { const int q = nwg / NXCD, r = nwg % NXCD, xcd = wgid % NXCD, off = wgid / NXCD; wgid = (xcd < r ? xcd * (q + 1) : r * (q + 1) + (xcd - r) * q) + off; }
    const int nig = WGM * nN, gid = wgid / nig, fm = gid * WGM, gsz = (nM - fm) < WGM ? (nM - fm) : WGM;
    pm = fm + ((wgid % nig) % gsz); pn = (wgid % nig) / gsz;
}
struct MainSched {
    int nM, nN, nwg, G, c, lda, ldb, K, gsh, single;
    const char* A; const char* Bt;
    __device__ void init(int M, int N, int K_, int lda_, int ldb_, const void* A_, const void* Bt_, int gsh_, int single_ = 0) {
        nM = M / BM; nN = N / BM; nwg = nM * nN; G = (int)gridDim.x; c = (int)blockIdx.x; lda = lda_; ldb = ldb_; K = K_; A = (const char*)A_; Bt = (const char*)Bt_; gsh = gsh_; single = single_;
    }
    __device__ bool next(int i, Unit& u) const {
        if (single) { if (i > 0 || c >= 16) return false; u.pm = 64 + (c >> 2); u.pn = c & 3; }
        else { const long L = (long)i * G + c; if (L >= nwg) return false; static_unit((int)L, nM, nN, u.pm, u.pn); }
        u.q = 0;
        u.A = A + ((size_t)u.pm * BM * lda + (size_t)(u.pn >> gsh) * 512) * 2;
        u.B = Bt + (size_t)u.pn * BM * ldb * 2;
        return true;
    }
    __device__ __forceinline__ void a_ready(const Unit&) const {}
};
struct InSched {
    int nN, nP, E, nskip, c, r0, cnt, lda, ldb, K;
    const char* A; const char* Bt; unsigned* tail; unsigned* tmo;
    __device__ void init(int N, const void* A_, const void* Bt_, unsigned* tail_, unsigned* tmo_) {
        nN = N / BM; nP = 64 * nN; c = (int)blockIdx.x; lda = 1024; ldb = 1024; K = 1024; A = (const char*)A_; Bt = (const char*)Bt_; tail = tail_; tmo = tmo_;
        nskip = tail_ != nullptr ? 32 : 0; E = nskip + 4 * nN; r0 = (tail_ != nullptr && c < 16) ? 2 : 0;
        const int tot = (nP - c + 255) / 256; cnt = tot - r0 > 0 ? tot - r0 : 0;
    }
    __device__ bool next(int i, Unit& u) const {
        if (i < cnt) static_unit((i + r0) * 256 + c, 64, nN, u.pm, u.pn);
        else {
            if (c < 16) return false;
            const int e = 255 - c + 240 * (i - cnt); if (e >= E) return false;
            if (e < nskip) static_unit(e < 16 ? e : 256 + (e - 16), 64, nN, u.pm, u.pn);
            else { const int sidx = e - nskip; u.pm = 64 + sidx / nN; u.pn = sidx - (sidx / nN) * nN; }
        }
        u.q = 0;
        u.A = A + (size_t)u.pm * BM * 1024 * 2; u.B = Bt + (size_t)u.pn * BM * 1024 * 2;
        return true;
    }
    __device__ __forceinline__ void a_ready(const Unit& u) const {
        if (tail == nullptr || u.pm < 64) return;
        if (threadIdx.x < 64) {
            unsigned polls = 0;
            while ((unsigned)__builtin_amdgcn_readfirstlane(__hip_atomic_load(tail, __ATOMIC_RELAXED, __HIP_MEMORY_SCOPE_AGENT)) < 16u) {
                __builtin_amdgcn_s_sleep(2);
                if ((++polls & 255u) == 0u) { if (__builtin_amdgcn_readfirstlane(__hip_atomic_load(tmo, __ATOMIC_RELAXED, __HIP_MEMORY_SCOPE_AGENT)) != 0u) break; if (polls > (1u << 22)) { if (threadIdx.x == 0) atomicAdd(tmo, 1u); break; } }
            }
            __builtin_amdgcn_fence(__ATOMIC_ACQUIRE, "agent");
            asm volatile("s_waitcnt vmcnt(0)" ::: "memory");
        }
        asm volatile("" ::: "memory"); __builtin_amdgcn_s_barrier(); asm volatile("" ::: "memory");
    }
};
struct SmallSched {
    int mode, G, c, lda, ldb, K;
    const char* A0; const char* ada; const char* ssd_in; const char* pool_in;
    __device__ bool next(int i, Unit& u) const {
        const long L = (long)i * G + c;
        u.pm = 0;
        if (mode == 0) { if (L >= 48) return false; u.pn = (int)L; u.q = 0; u.A = A0; u.B = ada + (size_t)u.pn * BM * 1024 * 2; return true; }
        if (L >= 82) return false;
        int l = (int)L, q, pn;
        if (l < 25) { q = 0; pn = l; } else if (l < 41) { q = 1; pn = l - 25; } else if (l < 66) { q = 2; pn = l - 41; } else { q = 3; pn = l - 66; }
        u.q = q; u.pn = pn; u.A = A0 + (size_t)q * 256 * 1024 * 2;
        u.B = ((q & 1) ? pool_in + (size_t)(q >> 1) * 4096 * 1024 * 2 : ssd_in + (size_t)(q >> 1) * 6400 * 1024 * 2) + (size_t)pn * BM * 1024 * 2;
        return true;
    }
    __device__ __forceinline__ void a_ready(const Unit&) const {}
};

template <class Epi, class Sched>
__device__ __forceinline__ void gemm_phase(LAS unsigned char* lds, const Sched& S, const Epi& E) {
    const int tid = otid(), wid = __builtin_amdgcn_readfirstlane(tid >> 6), lane = tid & 63, wr = wid >> 2, wc = wid & 3, fr = lane & 15, fq = lane >> 4;
    const int K = S.K, nt = K / BK;
    unsigned voffA[2], voffB[2];
#pragma unroll
    for (int i = 0; i < 2; ++i) { int R, C; stage_rc(tid * 16 + i * 8192, R, C); const int Rb = Epi::PERM ? ((R & ~31) + perm32(R & 31)) : R;
        voffA[i] = (unsigned)(R * S.lda + C) * 2u; voffB[i] = (unsigned)(Rb * S.ldb + C) * 2u; }
    const size_t kstep = (size_t)(BK * 2);
    const size_t hstepA = (size_t)HALF * S.lda * 2, hstepB = (size_t)HALF * S.ldb * 2;
    const unsigned ldsw = (unsigned)wid * 1024u;
    const int aoff = lds_byte(wr * 64 + fr, fq * 8), boff = lds_byte(wc * 32 + fr, fq * 8);
#define PG8_SA(b, h) (((b) * 2 + (h)) * HTB)
#define PG8_SB(b, h) ((4 + (b) * 2 + (h)) * HTB)
#define PG8_STAGE(bufoff, gbase, voff) do { _Pragma("unroll") for (int _i = 0; _i < 2; ++_i) \
        __builtin_amdgcn_global_load_lds((const unsigned*)((const char*)(gbase) + (voff)[_i]), (LAS unsigned*)(lds + (bufoff) + ldsw + _i * 8192), 16, 0, 0); } while (0)
#define PG8_LDA(dst, b, h) do { _Pragma("unroll") for (int m = 0; m < 4; ++m) _Pragma("unroll") for (int k = 0; k < 2; ++k) dst[m][k] = *(const LAS bf16x8*)(lds + PG8_SA(b, h) + aoff + m * 2048 + k * 1024); } while (0)
#define PG8_LDB(dst, b, h) do { _Pragma("unroll") for (int n = 0; n < 2; ++n) _Pragma("unroll") for (int k = 0; k < 2; ++k) dst[n][k] = *(const LAS bf16x8*)(lds + PG8_SB(b, h) + boff + n * 2048 + k * 1024); } while (0)
#define PG8_MMA(ai, bj, At, Bt) do { __builtin_amdgcn_s_setprio(1); _Pragma("unroll") for (int m = 0; m < 4; ++m) _Pragma("unroll") for (int n = 0; n < 2; ++n) _Pragma("unroll") for (int k = 0; k < 2; ++k) \
        acc[ai][bj][m][n] = __builtin_amdgcn_mfma_f32_16x16x32_bf16(Bt[n][k], At[m][k], acc[ai][bj][m][n], 0, 0, 0); __builtin_amdgcn_s_setprio(0); } while (0)
#define PG8_WAIT_V(n) asm volatile("s_waitcnt vmcnt(" #n ")" ::: "memory")
#define PG8_WAIT_L(n) asm volatile("s_waitcnt lgkmcnt(" #n ")" ::: "memory")
#define PG8_BAR __builtin_amdgcn_s_barrier()
#define PG8_SCHED __builtin_amdgcn_sched_barrier(0)
    Unit cur, nxt; int ui = 0;
    if (!S.next(0, cur)) return;
    f32x4 acc[2][2][4][2];
#pragma unroll
    for (int a = 0; a < 2; ++a)
#pragma unroll
        for (int b = 0; b < 2; ++b)
#pragma unroll
            for (int m = 0; m < 4; ++m)
#pragma unroll
                for (int n = 0; n < 2; ++n) acc[a][b][m][n] = (f32x4){0.f, 0.f, 0.f, 0.f};
    bf16x8 At[4][2], B0[2][2], B1[2][2];
    const char* cA = cur.A; const char* cB = cur.B;
    S.a_ready(cur);
    PG8_STAGE(PG8_SB(0, 0), cB, voffB); PG8_STAGE(PG8_SA(0, 0), cA, voffA); PG8_STAGE(PG8_SB(0, 1), cB + hstepB, voffB); PG8_STAGE(PG8_SA(0, 1), cA + hstepA, voffA);
    if (wr == 1) PG8_BAR;
    PG8_WAIT_V(4); PG8_BAR;
    PG8_STAGE(PG8_SB(1, 0), cB + kstep, voffB); PG8_STAGE(PG8_SA(1, 0), cA + kstep, voffA); PG8_STAGE(PG8_SB(1, 1), cB + hstepB + kstep, voffB);
    PG8_WAIT_V(6); PG8_BAR;
    for (;;) {
        const bool has_next = S.next(ui + 1, nxt);
        const char* nA = has_next ? nxt.A : cA; const char* nB = has_next ? nxt.B : cB;
        for (int t = 0; t < nt; t += 2) {
            const bool last = (t == nt - 2);
            const char* a1 = cA + (size_t)(t + 1) * kstep;
            const char* a2 = last ? nA : cA + (size_t)(t + 2) * kstep; const char* b2 = last ? nB : cB + (size_t)(t + 2) * kstep;
            const char* a3 = a2 + kstep; const char* b3 = b2 + kstep;
            if (last && has_next) S.a_ready(nxt);
            PG8_LDB(B0, 0, 0); PG8_SCHED; PG8_LDA(At, 0, 0); PG8_STAGE(PG8_SA(1, 1), a1 + hstepA, voffA);
            PG8_WAIT_L(8); PG8_BAR; PG8_WAIT_L(0); PG8_MMA(0, 0, At, B0); PG8_BAR; PG8_SCHED;
            PG8_LDB(B1, 0, 1); PG8_STAGE(PG8_SB(0, 0), b2, voffB);
            PG8_BAR; PG8_WAIT_L(0); PG8_MMA(0, 1, At, B1); PG8_BAR;
            PG8_LDA(At, 0, 1); PG8_STAGE(PG8_SA(0, 0), a2, voffA);
            PG8_BAR; PG8_WAIT_L(0); PG8_MMA(1, 0, At, B0); PG8_BAR; PG8_SCHED;
            PG8_STAGE(PG8_SB(0, 1), b2 + hstepB, voffB);
            PG8_WAIT_V(6); PG8_BAR; PG8_MMA(1, 1, At, B1); PG8_BAR;
            PG8_LDB(B0, 1, 0); PG8_SCHED; PG8_LDA(At, 1, 0); PG8_STAGE(PG8_SA(0, 1), a2 + hstepA, voffA);
            PG8_WAIT_L(8); PG8_BAR; PG8_WAIT_L(0); PG8_MMA(0, 0, At, B0); PG8_BAR; PG8_SCHED;
            PG8_LDB(B1, 1, 1); PG8_STAGE(PG8_SB(1, 0), b3, voffB);
            PG8_BAR; PG8_WAIT_L(0); PG8_MMA(0, 1, At, B1); PG8_BAR;
            PG8_LDA(At, 1, 1); PG8_STAGE(PG8_SA(1, 0), a3, voffA);
            PG8_BAR; PG8_WAIT_L(0); PG8_MMA(1, 0, At, B0); PG8_BAR; PG8_SCHED;
            PG8_STAGE(PG8_SB(1, 1), b3 + hstepB, voffB);
            PG8_WAIT_V(6); PG8_BAR; PG8_MMA(1, 1, At, B1); PG8_BAR;
        }
        E(acc, cur, wr, wc, fr, fq);
        if (!has_next) break;
#pragma unroll
        for (int a = 0; a < 2; ++a)
#pragma unroll
            for (int b = 0; b < 2; ++b)
#pragma unroll
                for (int m = 0; m < 4; ++m)
#pragma unroll
                    for (int n = 0; n < 2; ++n) acc[a][b][m][n] = (f32x4){0.f, 0.f, 0.f, 0.f};
        cur = nxt; cA = nA; cB = nB; ++ui;
    }
    PG8_WAIT_V(0);
    if (wr == 0) PG8_BAR;
    PG8_BAR;
#undef PG8_SA
#undef PG8_SB
#undef PG8_STAGE
#undef PG8_LDA
#undef PG8_LDB
#undef PG8_MMA
#undef PG8_WAIT_V
#undef PG8_WAIT_L
#undef PG8_BAR
#undef PG8_SCHED
}
}
using pg8::Unit;

struct EpiIn {
    static constexpr bool PERM = true;
    const float* ssq; const float* sb; bf16_t* out; int ldo, nbf; float* dtraw;
    template <bool UNI>
    __device__ __forceinline__ void body(const f32x4 (&acc)[2][2][4][2], const Unit& u, int wr, int wc, int fr, int fq) const {
        const int row0 = u.pm * 256 + wr * 64 + fr, colt = u.pn * 256 + wc * 32 + 8 * fq;
        f32x4 ub[2][2];
        if (UNI) {
            const float* sbr = sb + (size_t)(u.pm >> 3) * 6400;
#pragma unroll
            for (int bj = 0; bj < 2; ++bj) { const int c = colt + bj * 128; if (c < nbf + 32) { ub[bj][0] = *(const f32x4*)(sbr + c); ub[bj][1] = *(const f32x4*)(sbr + c + 4); } }
        }
        float rsv[2][4];
#pragma unroll
        for (int ai = 0; ai < 2; ++ai)
#pragma unroll
            for (int m = 0; m < 4; ++m) rsv[ai][m] = ssq[row0 + ai * 128 + m * 16];
#pragma unroll
        for (int ai = 0; ai < 2; ++ai) {
            f32x4 nb[4][2][2];
            if (!UNI) {
#pragma unroll
                for (int m = 0; m < 4; ++m) {
                    const float* sbr = sb + (size_t)row_b(row0 + ai * 128 + m * 16) * 6400;
#pragma unroll
                    for (int bj = 0; bj < 2; ++bj) { const int c = colt + bj * 128; if (c < nbf + 32) { nb[m][bj][0] = *(const f32x4*)(sbr + c); nb[m][bj][1] = *(const f32x4*)(sbr + c + 4); } }
                }
            }
#pragma unroll
            for (int m = 0; m < 4; ++m) {
                const int r = row0 + ai * 128 + m * 16;
                const float rstd = rsqrtf(rsv[ai][m] * (1.f / 1024.f) + 1e-6f);
#pragma unroll
                for (int bj = 0; bj < 2; ++bj) {
                    const int c = colt + bj * 128;
                    if (c < nbf + 32) {
                        f32x4 b0, b1;
                        if (UNI) { b0 = ub[bj][0]; b1 = ub[bj][1]; } else { b0 = nb[m][bj][0]; b1 = nb[m][bj][1]; }
                        const f32x4 v0 = acc[ai][bj][m][0] * rstd + b0, v1 = acc[ai][bj][m][1] * rstd + b1;
                        if (c < nbf) *(u32x4*)(out + (size_t)r * ldo + c) = pack8(v0, v1);
                        else if (dtraw != nullptr) { float* dp = dtraw + (size_t)r * 32 + (c - nbf); *(f32x4*)dp = v0; *(f32x4*)(dp + 4) = v1; }
                    }
                }
            }
        }
    }
    __device__ __forceinline__ void operator()(const f32x4 (&acc)[2][2][4][2], const Unit& u, int wr, int wc, int fr, int fq) const {
        asm volatile("" : "+v"(fr), "+v"(fq));
        if (u.pm < 64) body<true>(acc, u, wr, wc, fr, fq); else body<false>(acc, u, wr, wc, fr, fq);
    }
};
struct EpiOut {
    static constexpr bool PERM = true;
    const float* xin_p; const float* xin_s; float* xw; const float* modl; const float* ng_next; bf16_t* aprime; float* ssq;
    template <bool UNI>
    __device__ __forceinline__ void body(const f32x4 (&acc)[2][2][4][2], const Unit& u, int wr, int wc, int fr, int fq) const {
        const int row0 = u.pm * 256 + wr * 64 + fr, colt = u.pn * 256 + wc * 32 + 8 * fq;
        const bool has_next = ng_next != nullptr;
        f32x4 ug[2][2], us[2][2], uw[2][2];
#pragma unroll
        for (int bj = 0; bj < 2; ++bj) {
            const int c = colt + bj * 128;
            if (has_next) { uw[bj][0] = *(const f32x4*)(ng_next + c); uw[bj][1] = *(const f32x4*)(ng_next + c + 4); }
            if (UNI) {
                const float* mb = modl + (size_t)(u.pm >> 3) * 12288;
                ug[bj][0] = *(const f32x4*)(mb + 2048 + c) + 1.f; ug[bj][1] = *(const f32x4*)(mb + 2048 + c + 4) + 1.f;
                if (has_next) { us[bj][0] = (*(const f32x4*)(mb + 4096 + c) + 1.f) * uw[bj][0]; us[bj][1] = (*(const f32x4*)(mb + 4096 + c + 4) + 1.f) * uw[bj][1]; }
            }
        }
#pragma unroll
        for (int ai = 0; ai < 2; ++ai)
#pragma unroll
            for (int mp = 0; mp < 2; ++mp) {
                f32x4 xv[2][2][2];
#pragma unroll
                for (int mm = 0; mm < 2; ++mm) {
                    const int r = row0 + ai * 128 + (mp * 2 + mm) * 16;
                    const float* xr = r < MP ? xin_p + (size_t)r * DM : xin_s + (size_t)(r - MP) * DM;
#pragma unroll
                    for (int bj = 0; bj < 2; ++bj) { xv[mm][bj][0] = *(const f32x4*)(xr + colt + bj * 128); xv[mm][bj][1] = *(const f32x4*)(xr + colt + bj * 128 + 4); }
                }
#pragma unroll
                for (int mm = 0; mm < 2; ++mm) {
                    const int m = mp * 2 + mm;
                    const int r = row0 + ai * 128 + m * 16;
                    const float* mb = modl + (size_t)row_b(r) * 12288;
                    float ss = 0.f;
#pragma unroll
                    for (int bj = 0; bj < 2; ++bj) {
                        const int c = colt + bj * 128;
                        f32x4 g0, g1;
                        if (UNI) { g0 = ug[bj][0]; g1 = ug[bj][1]; } else { g0 = *(const f32x4*)(mb + 2048 + c) + 1.f; g1 = *(const f32x4*)(mb + 2048 + c + 4) + 1.f; }
                        const f32x4 n0 = xv[mm][bj][0] + g0 * acc[ai][bj][m][0], n1 = xv[mm][bj][1] + g1 * acc[ai][bj][m][1];
                        *(f32x4*)(xw + (size_t)r * DM + c) = n0; *(f32x4*)(xw + (size_t)r * DM + c + 4) = n1;
                        ss += (n0.x * n0.x + n0.y * n0.y) + (n0.z * n0.z + n0.w * n0.w) + (n1.x * n1.x + n1.y * n1.y) + (n1.z * n1.z + n1.w * n1.w);
                        if (has_next) {
                            f32x4 s0, s1;
                            if (UNI) { s0 = us[bj][0]; s1 = us[bj][1]; } else { s0 = (*(const f32x4*)(mb + 4096 + c) + 1.f) * uw[bj][0]; s1 = (*(const f32x4*)(mb + 4096 + c + 4) + 1.f) * uw[bj][1]; }
                            *(u32x4*)(aprime + (size_t)r * DM + c) = pack8(n0 * s0, n1 * s1);
                        }
                    }
                    ss += __shfl_xor(ss, 16); ss += __shfl_xor(ss, 32);
                    if (fq == 0) atomicAdd(ssq + r, ss);
                }
            }
    }
    __device__ __forceinline__ void operator()(const f32x4 (&acc)[2][2][4][2], const Unit& u, int wr, int wc, int fr, int fq) const {
        asm volatile("" : "+v"(fr), "+v"(fq));
        if (u.pm < 64) body<true>(acc, u, wr, wc, fr, fq); else body<false>(acc, u, wr, wc, fr, fq);
    }
};
struct EpiGrp {
    static constexpr bool PERM = true;
    const bf16_t* uz; const float* chs; bf16_t* out;
    __device__ __forceinline__ void operator()(const f32x4 (&acc)[2][2][4][2], const Unit& u, int wr, int wc, int fr, int fq) const {
        asm volatile("" : "+v"(fr), "+v"(fq));
        const int row0 = u.pm * 256 + wr * 64 + fr, colt = u.pn * 256 + wc * 32 + 8 * fq;
        f32x4 cs[2][2];
#pragma unroll
        for (int bj = 0; bj < 2; ++bj) { cs[bj][0] = *(const f32x4*)(chs + colt + bj * 128); cs[bj][1] = *(const f32x4*)(chs + colt + bj * 128 + 4); }
#pragma unroll
        for (int ai = 0; ai < 2; ++ai) {
            u32x4 zz[4][2];
#pragma unroll
            for (int m = 0; m < 4; ++m)
#pragma unroll
                for (int bj = 0; bj < 2; ++bj) zz[m][bj] = *(const u32x4*)(uz + (size_t)(row0 + ai * 128 + m * 16) * 4096 + 2048 + colt + bj * 128);
#pragma unroll
            for (int m = 0; m < 4; ++m) {
                const int r = row0 + ai * 128 + m * 16;
#pragma unroll
                for (int bj = 0; bj < 2; ++bj) {
                    const int c = colt + bj * 128;
                    const u32x4 z = zz[m][bj];
                    const f32x2 a = silu2((f32x2){bf_lo(z.x), bf_hi(z.x)}), b = silu2((f32x2){bf_lo(z.y), bf_hi(z.y)}), cc = silu2((f32x2){bf_lo(z.z), bf_hi(z.z)}), d = silu2((f32x2){bf_lo(z.w), bf_hi(z.w)});
                    const f32x4 z0 = {a.x, a.y, b.x, b.y}, z1 = {cc.x, cc.y, d.x, d.y};
                    *(u32x4*)(out + (size_t)r * 2048 + c) = pack8(acc[ai][bj][m][0] * cs[bj][0] * z0, acc[ai][bj][m][1] * cs[bj][1] * z1);
                }
            }
        }
    }
};
struct EpiSmall {
    static constexpr bool PERM = true;
    int mode; float* mod; const float* ada_b; bf16_t* shiftA; float* sb;
    __device__ __forceinline__ void operator()(const f32x4 (&acc)[2][2][4][2], const Unit& u, int wr, int wc, int fr, int fq) const {
        asm volatile("" : "+v"(fr), "+v"(fq));
        const int row0 = wr * 64 + fr, colt = u.pn * 256 + wc * 32 + 8 * fq;
#pragma unroll
        for (int ai = 0; ai < 2; ++ai)
#pragma unroll
            for (int m = 0; m < 4; ++m) {
                const int r = row0 + ai * 128 + m * 16;
                if (r < 136) {
#pragma unroll
                    for (int bj = 0; bj < 2; ++bj) {
                        const int c = colt + bj * 128;
                        if (mode == 0) {
                            const f32x4 v0 = acc[ai][bj][m][0] + *(const f32x4*)(ada_b + c), v1 = acc[ai][bj][m][1] + *(const f32x4*)(ada_b + c + 4);
                            *(f32x4*)(mod + (size_t)r * 12288 + c) = v0; *(f32x4*)(mod + (size_t)r * 12288 + c + 4) = v1;
                            const int li = c / 3072, cc = c - li * 3072;
                            if (cc < 1024) *(u32x4*)(shiftA + ((size_t)li * 256 + r) * 1024 + cc) = pack8(v0, v1);
                        } else {
                            float* sp = sb + ((size_t)u.q * 136 + r) * 6400 + c;
                            *(f32x4*)sp = acc[ai][bj][m][0]; *(f32x4*)(sp + 4) = acc[ai][bj][m][1];
                        }
                    }
                }
            }
    }
};

__device__ void phase_prep0(const Params& p, const WTab& wt, LAS unsigned char* lds) {
    LAS float* tl = (LAS float*)lds;
    const int tid = otid();
    for (int tile = blockIdx.x; tile < wt.wtiles; tile += gridDim.x) {
        int j = 0;
#pragma unroll 1
        for (int q = 1; q < NWJ; ++q) if (tile >= wt.wj[q].tile_begin) j = q;
        const WJob job = wt.wj[j];
        bf16_t* jdst = (bf16_t*)(p.ws + job.doff);
        const int lt = tile - job.tile_begin, tk = lt / job.tiles_n, tn = lt - tk * job.tiles_n, k0 = tk * 64, n0 = tn * 64;
        {
            const int kk = tid >> 3, nn = (tid & 7) * 8;
            f32x4 a = (f32x4){0.f, 0.f, 0.f, 0.f}, b = a;
            if (n0 + nn < job.N) { const __attribute__((address_space(1))) f32x4* sp = (const __attribute__((address_space(1))) f32x4*)(job.src + (size_t)(k0 + kk) * job.N + n0 + nn); a = sp[0]; b = sp[1]; }
            LAS float* d = tl + kk * 65 + nn;
            d[0] = a.x; d[1] = a.y; d[2] = a.z; d[3] = a.w; d[4] = b.x; d[5] = b.y; d[6] = b.z; d[7] = b.w;
        }
        __syncthreads();
        {
            const int n = tid >> 3, k8 = (tid & 7) * 8;
            const LAS float* s = tl + k8 * 65 + n;
            u32x4 o; o.x = cvt_pk_bf16(s[0], s[65]); o.y = cvt_pk_bf16(s[130], s[195]); o.z = cvt_pk_bf16(s[260], s[325]); o.w = cvt_pk_bf16(s[390], s[455]);
            *(u32x4*)(jdst + (size_t)(n0 + n) * job.K + k0 + k8) = o;
        }
        __syncthreads();
    }
    bf16_t* ac = (bf16_t*)(p.ws + WS_AC);
    const int gt = blockIdx.x * 512 + tid, nth = gridDim.x * 512;
    for (int i = gt; i < 256 * 1024 / 8; i += nth) {
        const int r = i >> 7, c = (i & 127) * 8;
        u32x4 o = (u32x4){0u, 0u, 0u, 0u};
        if (r < 136) {
            const float* cp = r < 8 ? p.in[5] + (size_t)r * 1024 + c : p.in[6] + (size_t)(r - 8) * 1024 + c;
            const f32x4 a = *(const f32x4*)cp, b = *(const f32x4*)(cp + 4);
            o.x = cvt_pk_bf16(silu_f(a.x), silu_f(a.y)); o.y = cvt_pk_bf16(silu_f(a.z), silu_f(a.w)); o.z = cvt_pk_bf16(silu_f(b.x), silu_f(b.y)); o.w = cvt_pk_bf16(silu_f(b.z), silu_f(b.w));
        }
        *(u32x4*)(ac + (size_t)i * 8) = o;
    }
    { u32x4* sq = (u32x4*)(p.ws + WS_SSQ + 17408ull * 4); for (int i = gt; i < 4 * 17408 / 4; i += nth) sq[i] = (u32x4){0u, 0u, 0u, 0u}; }
    u32x4* sh = (u32x4*)(p.ws + WS_SHIFTA);
    for (int i = gt; i < 4 * 256 * 1024 / 8; i += nth) sh[i] = (u32x4){0u, 0u, 0u, 0u};
}

__device__ void phase_xprep(const Params& p) {
    const int tid_ = otid(), lane = tid_ & 63, wv = blockIdx.x * 8 + (tid_ >> 6), nw = gridDim.x * 8;
    const float* mod = (const float*)(p.ws + WS_MOD);
    bf16_t* ap = (bf16_t*)(p.ws + WS_APRIME);
    float* ssq = (float*)(p.ws + WS_SSQ);
    const float* ng = p.in[9];
    for (int r0 = wv * 2; r0 < MT; r0 += nw * 2) {
        f32x4 x[2][4];
#pragma unroll
        for (int h = 0; h < 2; ++h) {
            const int r = r0 + h;
            const float* xr = r < MP ? p.in[0] + (size_t)r * DM : p.in[1] + (size_t)(r - MP) * DM;
#pragma unroll
            for (int q = 0; q < 4; ++q) x[h][q] = *(const f32x4*)(xr + q * 256 + lane * 4);
        }
#pragma unroll
        for (int h = 0; h < 2; ++h) {
            const int r = r0 + h;
            const float* mb = mod + (size_t)row_b(r) * 12288 + 1024;
            float ss = 0.f;
#pragma unroll
            for (int q = 0; q < 4; ++q) {
                const int c = q * 256 + lane * 4;
                const f32x4 xv = x[h][q], sv = *(const f32x4*)(mb + c), g = *(const f32x4*)(ng + c);
                ss += (xv.x * xv.x + xv.y * xv.y) + (xv.z * xv.z + xv.w * xv.w);
                const f32x4 a = xv * g * (sv + 1.f);
                u32x2 o; o.x = cvt_pk_bf16(a.x, a.y); o.y = cvt_pk_bf16(a.z, a.w);
                *(u32x2*)(ap + (size_t)r * DM + c) = o;
            }
#pragma unroll
            for (int o = 1; o < 64; o <<= 1) ss += __shfl_xor(ss, o);
            if (lane == 0) ssq[r] = ss;
        }
    }
}

__device__ void phase_final(const Params& p, int r_begin, int r_end, int blk0) {
    if ((int)blockIdx.x < blk0) return;
    const int tid_ = otid(), lane = tid_ & 63, wv = ((int)blockIdx.x - blk0) * 8 + (tid_ >> 6), nw = ((int)gridDim.x - blk0) * 8;
    const float* xw = (const float*)(p.ws + WS_XW);
    const float* ssq = (const float*)(p.ws + WS_SSQ) + 4 * 17408;
    const float* fg = p.in[22];
    for (int r0 = r_begin + wv * 2; r0 < r_end; r0 += nw * 2) {
        f32x4 x[2][4];
#pragma unroll
        for (int h = 0; h < 2; ++h)
#pragma unroll
            for (int q = 0; q < 4; ++q) x[h][q] = *(const f32x4*)(xw + (size_t)(r0 + h) * DM + q * 256 + lane * 4);
#pragma unroll
        for (int h = 0; h < 2; ++h) {
            const int r = r0 + h;
            const float rstd = rsqrtf(ssq[r] * (1.f / 1024.f) + 1e-6f);
#pragma unroll
            for (int q = 0; q < 4; ++q) {
                const int c = q * 256 + lane * 4;
                const f32x4 g = *(const f32x4*)(fg + c);
                *(f32x4*)(p.out + (size_t)r * DM + c) = x[h][q] * rstd * g;
            }
        }
    }
}

__device__ void phase_ssdnorm(const Params& p, int j) {
    const int tid_ = otid(), lane = tid_ & 63, wv = blockIdx.x * 8 + (tid_ >> 6), nw = gridDim.x * 8;
    const bf16_t* yg = (const bf16_t*)(p.ws + WS_YG);
    bf16_t* a2 = (bf16_t*)(p.ws + WS_A2);
    const float* ng = p.in[16] + (size_t)j * 2048;
    for (int r0 = wv * 2; r0 < MT; r0 += nw * 2) {
        u32x4 vv[2][4];
#pragma unroll
        for (int h = 0; h < 2; ++h)
#pragma unroll
            for (int q = 0; q < 4; ++q) vv[h][q] = *(const u32x4*)(yg + (size_t)(r0 + h) * 2048 + q * 512 + lane * 8);
#pragma unroll
        for (int h = 0; h < 2; ++h)
#pragma unroll
            for (int q = 0; q < 4; ++q) {
                const int c = q * 512 + lane * 8;
                const u32x4 v = vv[h][q];
                f32x4 a, b;
                a.x = bf_lo(v.x); a.y = bf_hi(v.x); a.z = bf_lo(v.y); a.w = bf_hi(v.y); b.x = bf_lo(v.z); b.y = bf_hi(v.z); b.z = bf_lo(v.w); b.w = bf_hi(v.w);
                float ss = (a.x * a.x + a.y * a.y) + (a.z * a.z + a.w * a.w) + (b.x * b.x + b.y * b.y) + (b.z * b.z + b.w * b.w);
#pragma unroll
                for (int o = 1; o < 32; o <<= 1) ss += __shfl_xor(ss, o);
                const float rstd = rsqrtf(ss * (1.f / 256.f) + 1e-6f);
                const f32x4 g0 = *(const f32x4*)(ng + c), g1 = *(const f32x4*)(ng + c + 4);
                *(u32x4*)(a2 + (size_t)(r0 + h) * 2048 + c) = pack8(a * rstd * g0, b * rstd * g1);
            }
    }
}

__device__ void phase_pool(const Params& p, int j) {
    const bf16_t* uz = (const bf16_t*)(p.ws + WS_ZX);
    bf16_t* pooled = (bf16_t*)(p.ws + WS_YG);
    const int gt = blockIdx.x * 512 + otid(), nth = gridDim.x * 512;
    for (int u = gt; u < 131072 + 32768; u += nth) {
        int cv, row0, t0, R; const float* prev = nullptr; bool prompt;
        if (u < 131072) { cv = u & 255; const int run = (u >> 8) & 63, b = u >> 14; row0 = b * 2048; t0 = run * 32; R = 32; prompt = true; }
        else { const int v = u - 131072; cv = v & 255; const int b = v >> 8; row0 = MP + b * 8; t0 = 0; R = 8; prompt = false; prev = p.in[4] + ((size_t)(j * 128 + b) * 15) * 2048; }
        const int c = cv * 8, w = 2 << (c >> 9);
        float s[8];
#pragma unroll
        for (int i = 0; i < 8; ++i) s[i] = 0.f;
        auto getu = [&](int tt, float (&o)[8]) {
            if (tt >= 0) {
                const u32x4 v = *(const u32x4*)(uz + (size_t)(row0 + tt) * 4096 + c);
                o[0] = bf_lo(v.x); o[1] = bf_hi(v.x); o[2] = bf_lo(v.y); o[3] = bf_hi(v.y); o[4] = bf_lo(v.z); o[5] = bf_hi(v.z); o[6] = bf_lo(v.w); o[7] = bf_hi(v.w);
            } else if (!prompt) {
                const float* pp = prev + (size_t)(15 + tt) * 2048 + c;
                const f32x4 a = *(const f32x4*)pp, b = *(const f32x4*)(pp + 4);
                o[0] = a.x; o[1] = a.y; o[2] = a.z; o[3] = a.w; o[4] = b.x; o[5] = b.y; o[6] = b.z; o[7] = b.w;
            } else {
#pragma unroll
                for (int i = 0; i < 8; ++i) o[i] = 0.f;
            }
        };
        for (int i = 1; i < w; ++i) {
            float o[8]; getu(t0 - i, o);
#pragma unroll
            for (int k = 0; k < 8; ++k) s[k] += o[k];
        }
        for (int tb = t0; tb < t0 + R; tb += 4) {
            float cur[4][8], old[4][8];
#pragma unroll
            for (int k = 0; k < 4; ++k) { getu(tb + k, cur[k]); getu(tb + k - w + 1, old[k]); }
#pragma unroll
            for (int k = 0; k < 4; ++k) {
                const int t = tb + k;
                const float inv = 1.f / (float)(prompt ? min(w, t + 1) : w);
                f32x4 a, b;
#pragma unroll
                for (int i = 0; i < 8; ++i) s[i] += cur[k][i];
                a.x = s[0] * inv - cur[k][0]; a.y = s[1] * inv - cur[k][1]; a.z = s[2] * inv - cur[k][2]; a.w = s[3] * inv - cur[k][3];
                b.x = s[4] * inv - cur[k][4]; b.y = s[5] * inv - cur[k][5]; b.z = s[6] * inv - cur[k][6]; b.w = s[7] * inv - cur[k][7];
                *(u32x4*)(pooled + (size_t)(row0 + t) * 2048 + c) = pack8(a, b);
#pragma unroll
                for (int i = 0; i < 8; ++i) s[i] -= old[k][i];
            }
        }
    }
    for (int i = gt; i < (8 + 128) * 15 * 256; i += nth) {
        const int cv = i & 255, k = (i >> 8) % 15, sq = (i >> 8) / 15, ch = cv * 8;
        f32x4 a, b2;
        float* dst;
        bool from_state = false; size_t urow = 0;
        if (sq < 8) { urow = (size_t)(sq * 2048 + 2033 + k); dst = p.out + O_POOL_P + ((size_t)(j * 8 + sq) * 15 + k) * 2048 + ch; }
        else { const int bb = sq - 8; dst = p.out + O_POOL_S + ((size_t)(j * 128 + bb) * 15 + k) * 2048 + ch; if (k < 7) from_state = true; else urow = (size_t)(MP + bb * 8 + k - 7); }
        if (from_state) { const float* sp = p.in[4] + ((size_t)(j * 128 + (sq - 8)) * 15 + 8 + k) * 2048 + ch; a = *(const f32x4*)sp; b2 = *(const f32x4*)(sp + 4); }
        else { const u32x4 v = *(const u32x4*)(uz + urow * 4096 + ch); a = (f32x4){bf_lo(v.x), bf_hi(v.x), bf_lo(v.y), bf_hi(v.y)}; b2 = (f32x4){bf_lo(v.z), bf_hi(v.z), bf_lo(v.w), bf_hi(v.w)}; }
        *(f32x4*)dst = a; *(f32x4*)(dst + 4) = b2;
    }
}

constexpr int RS = 272;
constexpr int L_XT = 0, L_BN = 17408, L_BT = 52224, L_CN = 87040, L_HB = 121856, L_SM = 139264, L_CW = 143360;
__device__ __forceinline__ int xt_addr(int pr, int t) { return L_XT + pr * RS + ((((t >> 3) ^ (pr >> 1)) & 15) << 4) + (t & 7) * 2; }
__device__ __forceinline__ int bt_addr(int n, int t) { return L_BT + n * RS + ((((t >> 3) ^ (n >> 3)) & 15) << 4) + (t & 7) * 2; }
__device__ __forceinline__ f32x16 mfma32(bf16x8 a, bf16x8 b, f32x16 c) { return __builtin_amdgcn_mfma_f32_32x32x16_bf16(a, b, c, 0, 0, 0); }

#define OPQ(x) asm volatile("" : "+v"(x))
__device__ void ssd_prompt_item(const Params& p, int j, int b, int h, LAS unsigned char* lds) {
    const int tid0 = otid(), wid = __builtin_amdgcn_readfirstlane(tid0 >> 6), g = h >> 2;
    const char* zxc = (const char*)(p.ws + WS_ZX);
    const char* dtc = (const char*)(p.ws + WS_DTRAW);
    char* ygc = (char*)(p.ws + WS_YG);
    const int rowbase = b * 2048;
    LAS float* cw = (LAS float*)(lds + L_CW);
    const float Ah = -__expf(p.in[14][j * 32 + h]), Dh = p.in[15][j * 32 + h], dtb = p.in[13][j * 32 + h];
    const bool roleB = wid < 4;
    const int qq = wid >> 1, tt = qq ^ (qq >> 1), pt = wid & 1, hp = wid & 1, hn = wid >> 1;

    __syncthreads();
    if (tid0 < 320) {
        const int ch = tid0 < 64 ? h * 64 + tid0 : (tid0 < 192 ? 2048 + g * 128 + (tid0 - 64) : 3072 + g * 128 + (tid0 - 192));
#pragma unroll
        for (int k = 0; k < 4; ++k) cw[k * 320 + tid0] = p.in[11][((size_t)j * 4 + k) * 4096 + ch];
        cw[4 * 320 + tid0] = p.in[12][(size_t)j * 4096 + ch];
    }
    for (int i = tid0; i < 17408 / 4; i += 512) *(LAS unsigned*)(lds + L_HB + i * 4) = 0u;

    u32x4 rawBC[11]; unsigned rawX[11]; float dtp0 = 0.f, dtp1 = 0.f;
    auto prefetch = [&](int t0) {
        int tid = tid0; OPQ(tid);
        const int bt_ = tid & 255, tqb = bt_ >> 4, cg8 = bt_ & 15, tqx = tid >> 5, cp = tid & 31, lane = tid & 63;
        const int colBC = (roleB ? 4096 : 5120) + g * 128 + cg8 * 8, colX = 2048 + h * 64 + cp * 2;
        const int rB = t0 + tqb * 8 - 3, rX = t0 + tqx * 8 - 3;
        const unsigned oB = (unsigned)((rowbase + rB) * ZXW + colBC) * 2u, oX = (unsigned)((rowbase + rX) * ZXW + colX) * 2u;
#pragma unroll
        for (int i = 0; i < 11; ++i) {
            rawBC[i] = (rB + i >= 0) ? *(const u32x4*)(zxc + (oB + (unsigned)i * 12288u)) : (u32x4){0u, 0u, 0u, 0u};
            rawX[i] = (rX + i >= 0) ? *(const unsigned*)(zxc + (oX + (unsigned)i * 12288u)) : 0u;
        }
        if (wid == 0) { const unsigned od = (unsigned)((rowbase + t0 + 2 * lane) * 32 + h) * 4u; dtp0 = *(const float*)(dtc + od); dtp1 = *(const float*)(dtc + (od + 128u)); }
    };
    prefetch(0);

    auto acum_stage = [&](int par) {
        if (wid == 0) {
            LAS float* sm_acum = (LAS float*)(lds + L_SM + par * 2048);
            LAS float* sm_dt = sm_acum + 128;
            LAS float* sm_w = sm_acum + 256;
            LAS float* sm_ea = sm_acum + 384;
            int lane = tid0 & 63; OPQ(lane);
            const float d0 = softplus_f(dtp0 + dtb), d1 = softplus_f(dtp1 + dtb);
            const float a0 = d0 * Ah, a1 = a0 + d1 * Ah;
            float sc = a1;
#pragma unroll
            for (int o = 1; o < 64; o <<= 1) { const float v = __shfl_up(sc, o); if (lane >= o) sc += v; }
            const float c1 = sc, c0 = sc - a1 + a0;
            const float last = __shfl(sc, 63);
            sm_acum[2 * lane] = c0; sm_acum[2 * lane + 1] = c1;
            sm_dt[2 * lane] = d0; sm_dt[2 * lane + 1] = d1;
            sm_w[2 * lane] = __expf(last - c0) * d0; sm_w[2 * lane + 1] = __expf(last - c1) * d1;
            sm_ea[2 * lane] = __expf(c0); sm_ea[2 * lane + 1] = __expf(c1);
        }
    };
    acum_stage(0);
    __syncthreads();

    f32x16 hacc;
#pragma unroll
    for (int i = 0; i < 16; ++i) hacc[i] = 0.f;

#pragma unroll 1
    for (int c = 0; c < 16; ++c) {
        const int t0 = c * 128;
        LAS float* sm_acum = (LAS float*)(lds + L_SM + (c & 1) * 2048);
        LAS float* sm_dt = sm_acum + 128;
        LAS float* sm_w = sm_acum + 256;
        LAS float* sm_ea = sm_acum + 384;
        {
            int tid = tid0; OPQ(tid);
            const int bt_ = tid & 255, tqb = bt_ >> 4, cg8 = bt_ & 15;
            const int lcBC = (roleB ? 64 : 192) + cg8 * 8;
            const f32x4 wv0 = *(const LAS f32x4*)(sm_w + tqb * 8), wv1 = *(const LAS f32x4*)(sm_w + tqb * 8 + 4);
            const float wt[8] = {wv0.x, wv0.y, wv0.z, wv0.w, wv1.x, wv1.y, wv1.z, wv1.w};
            const int natbase = (roleB ? L_BN : L_CN) + (tqb * 8) * RS + cg8 * 16;
#pragma unroll
            for (int half = 0; half < 2; ++half) {
                u32x2 nat[8]; u32x4 tr[4];
#pragma unroll
                for (int ipp = 0; ipp < 2; ++ipp) {
                    const int ip = half * 2 + ipp;
                    const float k0a = cw[0 * 320 + lcBC + 2 * ip], k0b = cw[0 * 320 + lcBC + 2 * ip + 1];
                    const float k1a = cw[1 * 320 + lcBC + 2 * ip], k1b = cw[1 * 320 + lcBC + 2 * ip + 1];
                    const float k2a = cw[2 * 320 + lcBC + 2 * ip], k2b = cw[2 * 320 + lcBC + 2 * ip + 1];
                    const float k3a = cw[3 * 320 + lcBC + 2 * ip], k3b = cw[3 * 320 + lcBC + 2 * ip + 1];
                    const float bba = cw[4 * 320 + lcBC + 2 * ip], bbb = cw[4 * 320 + lcBC + 2 * ip + 1];
                    f32x2 rr[11];
#pragma unroll
                    for (int i = 0; i < 11; ++i) { const unsigned v = rawBC[i][ip]; rr[i] = (f32x2){bf_lo(v), bf_hi(v)}; }
                    const f32x2 K0 = {k0a, k0b}, K1 = {k1a, k1b}, K2 = {k2a, k2b}, K3 = {k3a, k3b}, BB = {bba, bbb};
                    float va[8], vb[8];
#pragma unroll
                    for (int t = 0; t < 8; ++t) {
                        const f32x2 v = silu2(BB + K0 * rr[t] + K1 * rr[t + 1] + K2 * rr[t + 2] + K3 * rr[t + 3]);
                        va[t] = v.x; vb[t] = v.y;
                        nat[t][ipp] = cvt_pk_bf16(v.x, v.y);
                    }
                    if (roleB) {
#pragma unroll
                        for (int tp = 0; tp < 4; ++tp) {
                            tr[2 * ipp][tp] = cvt_pk_bf16(va[2 * tp] * wt[2 * tp], va[2 * tp + 1] * wt[2 * tp + 1]);
                            tr[2 * ipp + 1][tp] = cvt_pk_bf16(vb[2 * tp] * wt[2 * tp], vb[2 * tp + 1] * wt[2 * tp + 1]);
                        }
                    }
                }
#pragma unroll
                for (int t = 0; t < 8; ++t) *(LAS u32x2*)(lds + natbase + t * RS + half * 8) = nat[t];
                if (roleB) {
#pragma unroll
                    for (int i = 0; i < 4; ++i) *(LAS u32x4*)(lds + bt_addr(cg8 * 8 + half * 4 + i, tqb * 8)) = tr[i];
                }
                __builtin_amdgcn_sched_barrier(0);
            }
        }
        {
            int tid = tid0; OPQ(tid);
            const int tqx = tid >> 5, cp = tid & 31, lcX = cp * 2;
            const float k0a = cw[0 * 320 + lcX], k0b = cw[0 * 320 + lcX + 1], k1a = cw[1 * 320 + lcX], k1b = cw[1 * 320 + lcX + 1];
            const float k2a = cw[2 * 320 + lcX], k2b = cw[2 * 320 + lcX + 1], k3a = cw[3 * 320 + lcX], k3b = cw[3 * 320 + lcX + 1];
            const float bba = cw[4 * 320 + lcX], bbb = cw[4 * 320 + lcX + 1];
            f32x2 rr[11];
#pragma unroll
            for (int i = 0; i < 11; ++i) rr[i] = (f32x2){bf_lo(rawX[i]), bf_hi(rawX[i])};
            const f32x2 K0 = {k0a, k0b}, K1 = {k1a, k1b}, K2 = {k2a, k2b}, K3 = {k3a, k3b}, BB = {bba, bbb};
            float va[8], vb[8];
#pragma unroll
            for (int t = 0; t < 8; ++t) { const f32x2 v = silu2(BB + K0 * rr[t] + K1 * rr[t + 1] + K2 * rr[t + 2] + K3 * rr[t + 3]); va[t] = v.x; vb[t] = v.y; }
            u32x4 xa, xb;
            xa.x = cvt_pk_bf16(va[0], va[1]); xa.y = cvt_pk_bf16(va[2], va[3]); xa.z = cvt_pk_bf16(va[4], va[5]); xa.w = cvt_pk_bf16(va[6], va[7]);
            xb.x = cvt_pk_bf16(vb[0], vb[1]); xb.y = cvt_pk_bf16(vb[2], vb[3]); xb.z = cvt_pk_bf16(vb[4], vb[5]); xb.w = cvt_pk_bf16(vb[6], vb[7]);
            *(LAS u32x4*)(lds + xt_addr(cp * 2, tqx * 8)) = xa;
            *(LAS u32x4*)(lds + xt_addr(cp * 2 + 1, tqx * 8)) = xb;
        }
        if (c + 1 < 16) prefetch(t0 + 128);
        bf16_t zr[16];
        {
            int ln = tid0 & 63; OPQ(ln);
            const int l31 = ln & 31, hh = ln >> 5;
            const unsigned oz = (unsigned)((rowbase + t0 + tt * 32 + 4 * hh) * ZXW + h * 64 + pt * 32 + l31) * 2u;
#pragma unroll
            for (int rg = 0; rg < 16; ++rg) zr[rg] = *(const bf16_t*)(zxc + (oz + (unsigned)((rg & 3) + 8 * (rg >> 2)) * 12288u));
        }
        __syncthreads();
        f32x16 y;
        {
            int ln = tid0 & 63; OPQ(ln);
            const int l31 = ln & 31, hh = ln >> 5;
            const int cbase = L_CN + (tt * 32 + l31) * RS + 16 * hh, hbase = L_HB + (pt * 32 + l31) * RS + 16 * hh;
#pragma unroll
            for (int i = 0; i < 16; ++i) y[i] = 0.f;
            {
                const float dec = sm_ea[127];
#pragma unroll
                for (int i = 0; i < 16; ++i) hacc[i] *= dec;
            }
            bf16x8 cf[8];
#pragma unroll
            for (int ks = 0; ks < 8; ++ks) {
                cf[ks] = *(const LAS bf16x8*)(lds + cbase + ks * 32);
                const bf16x8 bfr = *(const LAS bf16x8*)(lds + hbase + ks * 32);
                const bf16x8 a = *(const LAS bf16x8*)(lds + xt_addr(hp * 32 + l31, ks * 16 + 8 * hh));
                const bf16x8 bb = *(const LAS bf16x8*)(lds + bt_addr(hn * 32 + l31, ks * 16 + 8 * hh));
                y = mfma32(cf[ks], bfr, y);
                hacc = mfma32(a, bb, hacc);
            }
#pragma unroll
            for (int rq = 0; rq < 4; ++rq) { const f32x4 e = *(const LAS f32x4*)(sm_ea + tt * 32 + 8 * rq + 4 * hh); y[4 * rq] *= e.x; y[4 * rq + 1] *= e.y; y[4 * rq + 2] *= e.z; y[4 * rq + 3] *= e.w; }
            const int tidx = tt * 32 + l31;
            const float at = sm_acum[tidx];
#pragma unroll 1
            for (int st = 0; st <= tt; ++st) {
                f32x16 s;
#pragma unroll
                for (int i = 0; i < 16; ++i) s[i] = 0.f;
                const int bbase = L_BN + (st * 32 + l31) * RS + 16 * hh;
#pragma unroll
                for (int ks = 0; ks < 8; ++ks) { const bf16x8 afr = *(const LAS bf16x8*)(lds + bbase + ks * 32); s = mfma32(afr, cf[ks], s); }
#pragma unroll
                for (int rq = 0; rq < 4; ++rq) {
                    const int sb0 = st * 32 + 8 * rq + 4 * hh;
                    const f32x4 asv = *(const LAS f32x4*)(sm_acum + sb0), dsv = *(const LAS f32x4*)(sm_dt + sb0);
#pragma unroll
                    for (int i = 0; i < 4; ++i) {
                        float e = at - asv[i];
                        if (sb0 + i > tidx) e = -INFINITY;
                        s[4 * rq + i] *= __expf(e) * dsv[i];
                    }
                }
#pragma unroll
                for (int k2 = 0; k2 < 2; ++k2) {
                    u32x4 au; au.x = cvt_pk_bf16(s[8 * k2], s[8 * k2 + 1]); au.y = cvt_pk_bf16(s[8 * k2 + 2], s[8 * k2 + 3]); au.z = cvt_pk_bf16(s[8 * k2 + 4], s[8 * k2 + 5]); au.w = cvt_pk_bf16(s[8 * k2 + 6], s[8 * k2 + 7]);
                    const int sbase = st * 32 + 16 * k2 + 4 * hh;
                    const u32x2 lo = *(const LAS u32x2*)(lds + xt_addr(pt * 32 + l31, sbase)), hi = *(const LAS u32x2*)(lds + xt_addr(pt * 32 + l31, sbase + 8));
                    u32x4 bu; bu.x = lo.x; bu.y = lo.y; bu.z = hi.x; bu.w = hi.y;
                    y = mfma32(__builtin_bit_cast(bf16x8, au), __builtin_bit_cast(bf16x8, bu), y);
                }
            }
        }
        {
            int ln = tid0 & 63; OPQ(ln);
            const int l31 = ln & 31, hh = ln >> 5;
            const unsigned oy = (unsigned)((rowbase + t0 + tt * 32 + 4 * hh) * 2048 + h * 64 + pt * 32 + l31) * 2u;
#pragma unroll
            for (int rq = 0; rq < 4; ++rq) {
                const u32x2 xv = *(const LAS u32x2*)(lds + xt_addr(pt * 32 + l31, tt * 32 + 8 * rq + 4 * hh));
                const float xs[4] = {bf_lo(xv.x), bf_hi(xv.x), bf_lo(xv.y), bf_hi(xv.y)};
#pragma unroll
                for (int i = 0; i < 4; ++i) {
                    const int rg = 4 * rq + i;
                    const float yv = y[rg] + Dh * xs[i];
                    const float gv = yv * silu_f(bf2f(zr[rg]));
                    *(bf16_t*)(ygc + (oy + (unsigned)(8 * rq + i) * 4096u)) = (bf16_t)(cvt_pk_bf16(gv, 0.f) & 0xffffu);
                }
            }
        }
        if (c + 1 < 16) acum_stage((c + 1) & 1);
        __syncthreads();
        {
            int ln = tid0 & 63; OPQ(ln);
            const int l31 = ln & 31, hh = ln >> 5;
#pragma unroll
            for (int rg = 0; rg < 16; ++rg) {
                const int pr = hp * 32 + (rg & 3) + 8 * (rg >> 2) + 4 * hh;
                *(LAS bf16_t*)(lds + L_HB + pr * RS + (hn * 32 + l31) * 2) = (bf16_t)(cvt_pk_bf16(hacc[rg], 0.f) & 0xffffu);
            }
        }
    }
    {
        int ln = tid0 & 63; OPQ(ln);
        const int l31 = ln & 31, hh = ln >> 5;
        float* so = p.out + O_SSM_P + ((size_t)(j * 8 + b) * 32 + h) * 8192;
#pragma unroll
        for (int rg = 0; rg < 16; ++rg) {
            const int pr = hp * 32 + (rg & 3) + 8 * (rg >> 2) + 4 * hh;
            so[pr * 128 + hn * 32 + l31] = hacc[rg];
        }
    }
}

__device__ void ssd_sample_all(const Params& p, int j, LAS unsigned char* lds) {
    const int tid = otid();
    const bf16_t* zx = (const bf16_t*)(p.ws + WS_ZX);
    const float* dtraw = (const float*)(p.ws + WS_DTRAW);
    bf16_t* yg = (bf16_t*)(p.ws + WS_YG);
    LAS float* sx = (LAS float*)lds;
    LAS float* sB = sx + 2048;
    LAS float* sC = sB + 1024;
    LAS float* sdt = sC + 1024;
    LAS float* sdec = sdt + 32;
    const int pp = tid >> 3, nl = (tid & 7) * 4;
    int item = (int)blockIdx.x;
    f32x4 hs[4][4];
    if (item < 1024) {
        const float* st = p.in[2] + ((size_t)(j * 128 + (item >> 3)) * 32 + (item & 7) * 4) * 8192;
#pragma unroll
        for (int r = 0; r < 4; ++r)
#pragma unroll
            for (int q = 0; q < 4; ++q) hs[r][q] = *(const f32x4*)(st + r * 8192 + pp * 128 + nl + 32 * q);
    }
#pragma unroll 1
    for (; item < 1024; item += (int)gridDim.x) {
        const int b = item >> 3, g = item & 7;
        __syncthreads();
        {
            const int cc = tid < 256 ? g * 256 + tid : (tid < 384 ? 2048 + g * 128 + (tid - 256) : 3072 + g * 128 + (tid - 384));
            float raw[11];
#pragma unroll
            for (int k = 0; k < 3; ++k) raw[k] = p.in[3][((size_t)(j * 128 + b) * 3 + k) * 4096 + cc];
#pragma unroll
            for (int t = 0; t < 8; ++t) raw[3 + t] = bf2f(zx[(size_t)(MP + b * 8 + t) * ZXW + 2048 + cc]);
            const float w0 = p.in[11][((size_t)j * 4 + 0) * 4096 + cc], w1 = p.in[11][((size_t)j * 4 + 1) * 4096 + cc];
            const float w2 = p.in[11][((size_t)j * 4 + 2) * 4096 + cc], w3 = p.in[11][((size_t)j * 4 + 3) * 4096 + cc];
            const float bs = p.in[12][(size_t)j * 4096 + cc];
            LAS float* dst = tid < 256 ? sx + tid : (tid < 384 ? sB + (tid - 256) : sC + (tid - 384));
            const int dstride = tid < 256 ? 256 : 128;
#pragma unroll
            for (int t = 0; t < 8; ++t) dst[t * dstride] = silu_f(bs + w0 * raw[t] + w1 * raw[t + 1] + w2 * raw[t + 2] + w3 * raw[t + 3]);
            if (tid < 32) {
                const int t = tid >> 2, r = tid & 3, hd = g * 4 + r;
                const float dtv = softplus_f(dtraw[(size_t)(MP + b * 8 + t) * 32 + hd] + p.in[13][j * 32 + hd]);
                sdt[tid] = dtv; sdec[tid] = __expf(-dtv * __expf(p.in[14][j * 32 + hd]));
            }
        }
        const int tsel = tid & 7;
        const size_t row = (size_t)(MP + b * 8 + tsel);
        bf16_t zv[4];
#pragma unroll
        for (int r = 0; r < 4; ++r) zv[r] = zx[row * ZXW + g * 256 + r * 64 + pp];
        const int nitem = item + (int)gridDim.x;
        f32x4 hn[4][4];
        if (nitem < 1024) {
            const float* st = p.in[2] + ((size_t)(j * 128 + (nitem >> 3)) * 32 + (nitem & 7) * 4) * 8192;
#pragma unroll
            for (int r = 0; r < 4; ++r)
#pragma unroll
                for (int q = 0; q < 4; ++q) hn[r][q] = *(const f32x4*)(st + r * 8192 + pp * 128 + nl + 32 * q);
        }
        __syncthreads();
        float ysel[4] = {0.f, 0.f, 0.f, 0.f};
#pragma unroll
        for (int t = 0; t < 8; ++t) {
            const f32x4 dt4 = *(const LAS f32x4*)(sdt + t * 4), dc4 = *(const LAS f32x4*)(sdec + t * 4);
            const float dx[4] = {dt4.x * sx[t * 256 + pp], dt4.y * sx[t * 256 + 64 + pp], dt4.z * sx[t * 256 + 128 + pp], dt4.w * sx[t * 256 + 192 + pp]};
            const float dc[4] = {dc4.x, dc4.y, dc4.z, dc4.w};
            float yp[4] = {0.f, 0.f, 0.f, 0.f};
#pragma unroll
            for (int q = 0; q < 4; ++q) {
                const f32x4 B4 = *(const LAS f32x4*)(sB + t * 128 + nl + 32 * q), C4 = *(const LAS f32x4*)(sC + t * 128 + nl + 32 * q);
#pragma unroll
                for (int r = 0; r < 4; ++r) {
                    hs[r][q] = hs[r][q] * dc[r] + B4 * dx[r];
                    yp[r] += (hs[r][q].x * C4.x + hs[r][q].y * C4.y) + (hs[r][q].z * C4.z + hs[r][q].w * C4.w);
                }
            }
#pragma unroll
            for (int r = 0; r < 4; ++r) {
                float v = yp[r];
                v += __shfl_xor(v, 1); v += __shfl_xor(v, 2); v += __shfl_xor(v, 4);
                if (tsel == t) ysel[r] = v;
            }
        }
        float* so = p.out + O_SSM_S + ((size_t)(j * 128 + b) * 32 + g * 4) * 8192;
#pragma unroll
        for (int r = 0; r < 4; ++r) {
            const int ch = g * 256 + r * 64 + pp;
            const float yv = ysel[r] + p.in[15][j * 32 + g * 4 + r] * sx[tsel * 256 + r * 64 + pp];
            const float gv = yv * silu_f(bf2f(zv[r]));
            yg[row * 2048 + ch] = (bf16_t)(cvt_pk_bf16(gv, 0.f) & 0xffffu);
#pragma unroll
            for (int q = 0; q < 4; ++q) *(f32x4*)(so + r * 8192 + pp * 128 + nl + 32 * q) = hs[r][q];
        }
        if (nitem < 1024) {
#pragma unroll
            for (int r = 0; r < 4; ++r)
#pragma unroll
                for (int q = 0; q < 4; ++q) hs[r][q] = hn[r][q];
        }
    }
}

__device__ void phase_scan(const Params& p, int j, LAS unsigned char* lds) {
    for (int item = blockIdx.x; item < 256; item += gridDim.x) {
        const int g = item & 7, k = item >> 3, b = k >> 2, r = k & 3;
        for (int rep = 0; rep < REP_PROMPT; ++rep) ssd_prompt_item(p, j, b, g * 4 + r, lds);
    }
    ssd_sample_all(p, j, lds);
    const bf16_t* zx = (const bf16_t*)(p.ws + WS_ZX);
    const int gt = blockIdx.x * 512 + otid(), nth = gridDim.x * 512;
    for (int i = gt; i < 136 * 3 * 512; i += nth) {
        const int ch = (i & 511) * 8, k = (i >> 9) % 3, sq = (i >> 9) / 3;
        const size_t row = sq < 8 ? (size_t)(sq * 2048 + 2045 + k) : (size_t)(MP + (sq - 8) * 8 + 5 + k);
        float* dst = sq < 8 ? p.out + O_CONV_P + ((size_t)(j * 8 + sq) * 3 + k) * 4096 + ch : p.out + O_CONV_S + ((size_t)(j * 128 + (sq - 8)) * 3 + k) * 4096 + ch;
        const u32x4 v = *(const u32x4*)(zx + row * ZXW + 2048 + ch);
        *(f32x4*)dst = (f32x4){bf_lo(v.x), bf_hi(v.x), bf_lo(v.y), bf_hi(v.y)}; *(f32x4*)(dst + 4) = (f32x4){bf_lo(v.z), bf_hi(v.z), bf_lo(v.w), bf_hi(v.w)};
    }
}

#define XB_TMO      128
#define XB_XCNT(j)  (256  + 64 * (j))
#define XB_XSUB(j)  (1280 + 64 * (j))
#define XB_XGEN(j)  (2304 + 64 * (j))
#define XB_TOP      3328
#define XB_TOPGEN   3392
#define XCD_BAR_WORDS 3456
#define XB_SPIN_CAP (1u << 22)
__device__ __forceinline__ unsigned xb_ld(unsigned* p)              { return __hip_atomic_load(p, __ATOMIC_RELAXED, __HIP_MEMORY_SCOPE_AGENT); }
__device__ __forceinline__ unsigned xb_add(unsigned* p, unsigned v) { return __hip_atomic_fetch_add(p, v, __ATOMIC_RELAXED, __HIP_MEMORY_SCOPE_AGENT); }
__device__ __forceinline__ unsigned xb_xcc_id() { return (unsigned)__builtin_amdgcn_s_getreg((3 << 11) | 20) & 0xFu; }
#define XB_SPIN(cond, bar) do { unsigned _sp = 0; while (cond) { __builtin_amdgcn_s_sleep(1); \
    if ((++_sp & 255u) == 0u) { if (xb_ld(&(bar)[XB_TMO])) break; if (_sp > XB_SPIN_CAP) { atomicAdd(&(bar)[XB_TMO], 1u); break; } } } } while (0)
struct XcdBarrier { unsigned* bar; unsigned x; volatile LAS unsigned* st; };
__device__ __forceinline__ XcdBarrier xcd_barrier_post(unsigned* bar, volatile LAS unsigned* st) {
    XcdBarrier b; b.bar = bar; b.x = xb_xcc_id(); b.st = st;
    if (threadIdx.x == 0) (void)xb_add(&bar[XB_XCNT(b.x)], 1u);
    return b;
}
__device__ __forceinline__ void xcd_barrier_complete(unsigned* bar, unsigned x, unsigned& nloc, unsigned& nx) {
    const unsigned G = gridDim.x * gridDim.y * gridDim.z;
    unsigned sum, cnt, mine, sp = 0u;
    for (;;) {
        sum = 0u; cnt = 0u; mine = 0u;
#pragma unroll
        for (unsigned j = 0; j < 16; ++j) { const unsigned c = xb_ld(&bar[XB_XCNT(j)]); sum += c; cnt += (c > 0u) ? 1u : 0u; mine = (j == x) ? c : mine; }
        if (sum == G) break;
        __builtin_amdgcn_s_sleep(1);
        if ((++sp & 255u) == 0u) { if (xb_ld(&bar[XB_TMO])) break; if (sp > XB_SPIN_CAP) { atomicAdd(&bar[XB_TMO], 1u); break; } }
    }
    nloc = mine > 0u ? mine : 1u; nx = cnt > 0u ? cnt : 1u;
}
__device__ __forceinline__ void xcd_barrier(const XcdBarrier& b) {
    asm volatile("s_waitcnt vmcnt(0)" ::: "memory");
    __syncthreads();
    if (threadIdx.x == 0) {
        unsigned* bar = b.bar;
        __builtin_amdgcn_s_waitcnt(0);
        unsigned nloc = b.st[0], nx = b.st[1];
        if (nloc == 0u) { xcd_barrier_complete(bar, b.x, nloc, nx); b.st[0] = nloc; b.st[1] = nx; }
        const unsigned old = xb_add(&bar[XB_XSUB(b.x)], 1u);
        const unsigned gen = old / nloc;
        if (old + 1u == (gen + 1u) * nloc) {
            __builtin_amdgcn_fence(__ATOMIC_RELEASE, "agent");
            asm volatile("s_waitcnt vmcnt(0)" ::: "memory");
            const unsigned og = xb_add(&bar[XB_TOP], 1u);
            const unsigned tg = og / nx;
            if (og + 1u == (tg + 1u) * nx) xb_add(&bar[XB_TOPGEN], 1u);
            else XB_SPIN(xb_ld(&bar[XB_TOPGEN]) == tg, bar);
            __builtin_amdgcn_fence(__ATOMIC_ACQUIRE, "agent");
            xb_add(&bar[XB_XGEN(b.x)], 1u);
            asm volatile("s_waitcnt vmcnt(0)" ::: "memory");
        } else {
            XB_SPIN(xb_ld(&bar[XB_XGEN(b.x)]) == gen, bar);
            __builtin_amdgcn_fence(__ATOMIC_ACQUIRE, "agent");
            asm volatile("s_waitcnt vmcnt(0)" ::: "memory");
        }
    }
    __syncthreads();
}

#ifndef REP_PREP0
#define REP_PREP0 1
#endif
#ifndef REP_SMALL
#define REP_SMALL 1
#endif
#ifndef REP_GGRP
#define REP_GGRP 1
#endif
#ifndef REP_GGRP
#define REP_GGRP 1
#endif
#ifndef REP_SYNC
#define REP_SYNC 1
#endif
#ifndef REP_SCAN
#define REP_SCAN 1
#endif
#ifndef REP_GIN
#define REP_GIN 1
#endif
#ifndef REP_GOUT
#define REP_GOUT 1
#endif
#ifndef REP_ELEM
#define REP_ELEM 1
#endif
#define GSYNC() do { for (int _r = 0; _r < REP_SYNC; ++_r) xcd_barrier(xb); } while (0)
__global__ __launch_bounds__(512, 2) void hybrid_fwd(const float* i0, const float* i1, const float* i2, const float* i3, const float* i4, const float* i5, const float* i6, const float* i7,
        const float* i8, const float* i9, const float* i10, const float* i11, const float* i12, const float* i13, const float* i14, const float* i15, const float* i16, const float* i17,
        const float* i18, const float* i19, const float* i20, const float* i21, const float* i22, float* outp, unsigned char* wsp, WTab wt) {
    Params p;
    p.in[0] = i0; p.in[1] = i1; p.in[2] = i2; p.in[3] = i3; p.in[4] = i4; p.in[5] = i5; p.in[6] = i6; p.in[7] = i7; p.in[8] = i8; p.in[9] = i9; p.in[10] = i10; p.in[11] = i11;
    p.in[12] = i12; p.in[13] = i13; p.in[14] = i14; p.in[15] = i15; p.in[16] = i16; p.in[17] = i17; p.in[18] = i18; p.in[19] = i19; p.in[20] = i20; p.in[21] = i21; p.in[22] = i22;
    p.out = outp; p.ws = wsp;
    extern __shared__ __attribute__((aligned(16))) unsigned char smem[];
    LAS unsigned char* lds = (LAS unsigned char*)smem;
    cg::grid_group grid = cg::this_grid();
    unsigned char* ws = p.ws;
    volatile LAS unsigned* xst = (volatile LAS unsigned*)(lds + LDS_XB);
    if (threadIdx.x == 0) { xst[0] = 0u; xst[1] = 0u; }
    __syncthreads();
    const XcdBarrier xb = xcd_barrier_post((unsigned*)(ws + WS_BAR), xst);

    for (int rep = 0; rep < REP_PREP0; ++rep) phase_prep0(p, wt, lds);
    if (wt.wtiles < 0) grid.sync();
    xcd_barrier(xb);
#pragma unroll 1
    for (int mode_ = 0; mode_ < 2 * REP_SMALL; ++mode_) {
        const int mode = mode_ % 2;
        pg8::SmallSched S; S.mode = mode; S.G = (int)gridDim.x; S.c = (int)blockIdx.x; S.lda = 1024; S.ldb = 1024; S.K = 1024;
        S.A0 = (const char*)(ws + (mode == 0 ? WS_AC : WS_SHIFTA)); S.ada = (const char*)(ws + WS_WT_ADA); S.ssd_in = (const char*)(ws + WS_WT_SSD_IN); S.pool_in = (const char*)(ws + WS_WT_POOL_IN);
        EpiSmall E; E.mode = mode; E.mod = (float*)(ws + WS_MOD); E.ada_b = p.in[8]; E.shiftA = (bf16_t*)(ws + WS_SHIFTA); E.sb = (float*)(ws + WS_SB);
#ifndef NO_GSMALL
        pg8::gemm_phase<EpiSmall, pg8::SmallSched>(lds, S, E);
#endif
        if (mode == 1) phase_xprep(p);
        GSYNC();
    }
    unsigned* tailw = (unsigned*)(ws + WS_BAR) + 3584;
    unsigned* tmow = (unsigned*)(ws + WS_BAR) + XB_TMO;
#pragma unroll 1
    for (int layer = 0; layer < 4; ++layer) {
        const int j = layer >> 1; const bool ssd = (layer & 1) == 0;
        {
            pg8::InSched S;
            S.init(ssd ? 6400 : 4096, ws + WS_APRIME, ssd ? ws + WS_WT_SSD_IN + (size_t)j * 6400 * 1024 * 2 : ws + WS_WT_POOL_IN + (size_t)j * 4096 * 1024 * 2, layer > 0 ? tailw + 64 * (layer - 1) : nullptr, tmow);
            EpiIn E; E.ssq = (const float*)(ws + WS_SSQ) + (size_t)layer * 17408; E.sb = (const float*)(ws + WS_SB) + (size_t)layer * 136 * 6400; E.out = (bf16_t*)(ws + WS_ZX);
            E.ldo = ssd ? ZXW : 4096; E.nbf = ssd ? ZXW : 4096; E.dtraw = ssd ? (float*)(ws + WS_DTRAW) : nullptr;
            for (int rep = 0; rep < REP_GIN; ++rep) pg8::gemm_phase<EpiIn, pg8::InSched>(lds, S, E);
        }
        GSYNC();
        if (ssd) { for (int rep = 0; rep < REP_SCAN; ++rep) phase_scan(p, j, lds); } else { for (int rep = 0; rep < REP_ELEM; ++rep) phase_pool(p, j); }
        GSYNC();
        if (ssd) { for (int rep = 0; rep < REP_ELEM; ++rep) phase_ssdnorm(p, j); }
        else {
            pg8::MainSched S; S.init(MT, 2048, 512, 2048, 512, ws + WS_YG, ws + WS_WT_POOL_G + (size_t)j * 2048 * 512 * 2, 1);
            EpiGrp E; E.uz = (const bf16_t*)(ws + WS_ZX); E.chs = p.in[20] + (size_t)j * 2048; E.out = (bf16_t*)(ws + WS_A2);
            for (int rep = 0; rep < REP_GGRP; ++rep) pg8::gemm_phase<EpiGrp, pg8::MainSched>(lds, S, E);
        }
        GSYNC();
#pragma unroll 1
        for (int part = 0; part < 2; ++part) {
            pg8::MainSched S; S.init(part == 0 ? MP : MT, 1024, 2048, 2048, 2048, ws + WS_A2, ssd ? ws + WS_WT_SSD_OUT + (size_t)j * 1024 * 2048 * 2 : ws + WS_WT_POOL_OUT + (size_t)j * 1024 * 2048 * 2, 30, part);
            EpiOut E; float* xw = (float*)(ws + WS_XW);
            E.xin_p = layer == 0 ? p.in[0] : xw; E.xin_s = layer == 0 ? p.in[1] : xw + (size_t)MP * DM; E.xw = xw;
            E.modl = (const float*)(ws + WS_MOD) + (size_t)layer * 3072; E.ng_next = layer < 3 ? p.in[9] + (size_t)(layer + 1) * 1024 : nullptr;
            E.aprime = (bf16_t*)(ws + WS_APRIME); E.ssq = (float*)(ws + WS_SSQ) + (size_t)(layer + 1) * 17408;
            pg8::gemm_phase<EpiOut, pg8::MainSched>(lds, S, E);
            if (part == 0) GSYNC();
        }
        if (blockIdx.x < 16) {
            asm volatile("s_waitcnt vmcnt(0)" ::: "memory");
            __syncthreads();
            if (threadIdx.x == 0) { __builtin_amdgcn_fence(__ATOMIC_RELEASE, "agent"); asm volatile("s_waitcnt vmcnt(0)" ::: "memory"); __hip_atomic_fetch_add(tailw + 64 * layer, 1u, __ATOMIC_RELAXED, __HIP_MEMORY_SCOPE_AGENT); }
        }
    }
    phase_final(p, 0, MP, 16);
    GSYNC();
    phase_final(p, MP, MT, 0);
}

extern "C" void kernel_launch(void* const* d_in, const int* in_sizes, int n_in, void* d_out, int out_size, void* d_ws, size_t ws_size, hipStream_t stream) {
    static int grid = 0;
    if (grid == 0) {
        if (n_in != 23 || ws_size < WS_END) { fprintf(stderr, "kernel_launch: unexpected n_in %d or ws_size %zu (need %zu)\n", n_in, ws_size, (size_t)WS_END); grid = -1; return; }
        int dev = 0, cus = 0, per_cu = 0;
        hipGetDevice(&dev);
        hipDeviceGetAttribute(&cus, hipDeviceAttributeMultiprocessorCount, dev);
        if (hipFuncSetAttribute((const void*)hybrid_fwd, hipFuncAttributeMaxDynamicSharedMemorySize, LDS_BYTES) != hipSuccess) { fprintf(stderr, "kernel_launch: hipFuncSetAttribute failed\n"); grid = -1; return; }
        if (hipOccupancyMaxActiveBlocksPerMultiprocessor(&per_cu, (const void*)hybrid_fwd, 512, LDS_BYTES) != hipSuccess || per_cu < 1) { fprintf(stderr, "kernel_launch: occupancy query gave %d\n", per_cu); (void)hipGetLastError(); per_cu = 1; }
        grid = cus * 1;
    }
    if (grid < 0) return;
    WTab wt{};
    unsigned char* ws = (unsigned char*)d_ws;
    int nj = 0, tb = 0;
    auto add = [&](int srci, long long soff, size_t dst_off, int K, int N, int Npad) {
        WJob& w = wt.wj[nj++]; w.src = (const float*)d_in[srci] + soff; w.doff = (long long)dst_off; w.K = K; w.N = N; w.tiles_n = Npad / 64; w.tile_begin = tb; tb += (K / 64) * (Npad / 64);
    };
    for (int i = 0; i < 4; ++i) add(7, (long long)i * 1024 * 3072, WS_WT_ADA + (size_t)i * 3072 * 1024 * 2, 1024, 3072, 3072);
    for (int j = 0; j < 2; ++j) add(10, (long long)j * 1024 * 6176, WS_WT_SSD_IN + (size_t)j * 6400 * 1024 * 2, 1024, 6176, 6400);
    for (int j = 0; j < 2; ++j) add(18, (long long)j * 1024 * 4096, WS_WT_POOL_IN + (size_t)j * 4096 * 1024 * 2, 1024, 4096, 4096);
    for (int j = 0; j < 2; ++j) add(17, (long long)j * 2048 * 1024, WS_WT_SSD_OUT + (size_t)j * 1024 * 2048 * 2, 2048, 1024, 1024);
    for (int j = 0; j < 2; ++j) add(21, (long long)j * 2048 * 1024, WS_WT_POOL_OUT + (size_t)j * 1024 * 2048 * 2, 2048, 1024, 1024);
    for (int q = 0; q < 8; ++q) add(19, (long long)q * 512 * 512, WS_WT_POOL_G + (size_t)q * 512 * 512 * 2, 512, 512, 512);
    wt.wtiles = tb;
    if (hipMemsetAsync(ws + WS_BAR, 0, 16384, stream) != hipSuccess) { fprintf(stderr, "kernel_launch: memset of the barrier words failed\n"); return; }
    const float* ip[23]; for (int i = 0; i < 23; ++i) ip[i] = (const float*)d_in[i];
    float* outp = (float*)d_out;
    void* args[26];
    for (int i = 0; i < 23; ++i) args[i] = (void*)&ip[i];
    args[23] = (void*)&outp; args[24] = (void*)&ws; args[25] = (void*)&wt;
    hipError_t e = hipLaunchCooperativeKernel((const void*)hybrid_fwd, dim3(grid), dim3(512), args, LDS_BYTES, stream);
    if (e != hipSuccess) fprintf(stderr, "cooperative launch failed: %s (grid %d)\n", hipGetErrorString(e), grid);
}
```

```cpp
#include <hip/hip_runtime.h>
#include <hip/hip_cooperative_groups.h>
#include <cstdio>
namespace cg = cooperative_groups;

#ifndef REP_PROMPT
#define REP_PROMPT 1
#endif
#define LAS __attribute__((address_space(3)))
typedef unsigned short bf16_t;
typedef short bf16x8 __attribute__((ext_vector_type(8)));
typedef float f32x4 __attribute__((ext_vector_type(4)));
typedef float f32x16 __attribute__((ext_vector_type(16)));
typedef unsigned u32x4 __attribute__((ext_vector_type(4)));
typedef unsigned u32x2 __attribute__((ext_vector_type(2)));
typedef float f32x2 __attribute__((ext_vector_type(2)));

constexpr int MP = 16384, MT = 17408, DM = 1024;
constexpr int ZXW = 6144;
constexpr size_t O_SSM_P = 17825792, O_CONV_P = 22020096, O_POOL_P = 22216704, O_SSM_S = 22708224, O_CONV_S = 89817088, O_POOL_S = 92962816;

constexpr size_t WS_WT_SSD_IN = 0;
constexpr size_t WS_WT_SSD_OUT = WS_WT_SSD_IN + 2ull * 6400 * 1024 * 2;
constexpr size_t WS_WT_POOL_IN = WS_WT_SSD_OUT + 2ull * 1024 * 2048 * 2;
constexpr size_t WS_WT_POOL_G = WS_WT_POOL_IN + 2ull * 4096 * 1024 * 2;
constexpr size_t WS_WT_POOL_OUT = WS_WT_POOL_G + 2ull * 2048 * 512 * 2;
constexpr size_t WS_WT_ADA = WS_WT_POOL_OUT + 2ull * 1024 * 2048 * 2;
constexpr size_t WS_AC = WS_WT_ADA + 12288ull * 1024 * 2;
constexpr size_t WS_SHIFTA = WS_AC + 256ull * 1024 * 2;
constexpr size_t WS_MOD = WS_SHIFTA + 4ull * 256 * 1024 * 2;
constexpr size_t WS_SB = WS_MOD + 136ull * 12288 * 4;
constexpr size_t WS_APRIME = WS_SB + 4ull * 136 * 6400 * 4;
constexpr size_t WS_SSQ = WS_APRIME + 17408ull * 1024 * 2;
constexpr size_t WS_XW = WS_SSQ + 17408ull * 16 * 4;
constexpr size_t WS_ZX = WS_XW + 17408ull * 1024 * 4;
constexpr size_t WS_DTRAW = WS_ZX + 17408ull * 6144 * 2;
constexpr size_t WS_YG = WS_DTRAW + 17408ull * 32 * 4;
constexpr size_t WS_A2 = WS_YG + 17408ull * 2048 * 2;
constexpr size_t WS_BAR = WS_A2 + 17408ull * 2048 * 2;
constexpr size_t WS_END = WS_BAR + 16384;

constexpr int LDS_XB = 149760;
constexpr int LDS_BYTES = 149776;

struct WJob { const float* src; long long doff; int K, N, tiles_n, tile_begin; };
struct WTab { WJob wj[20]; int wtiles; int pad0; };
constexpr int NWJ = 20;
struct Params {
    const float* in[23];
    float* out;
    unsigned char* ws;
};

__device__ __forceinline__ unsigned cvt_pk_bf16(float lo, float hi) { unsigned r; asm("v_cvt_pk_bf16_f32 %0, %1, %2" : "=v"(r) : "v"(lo), "v"(hi)); return r; }
__device__ __forceinline__ float bf_lo(unsigned u) { return __uint_as_float(u << 16); }
__device__ __forceinline__ float bf_hi(unsigned u) { return __uint_as_float(u & 0xffff0000u); }
__device__ __forceinline__ float bf2f(bf16_t b) { return __uint_as_float(((unsigned)b) << 16); }
__device__ __forceinline__ float silu_f(float v) { return v * __builtin_amdgcn_rcpf(1.f + __expf(-v)); }
__device__ __forceinline__ f32x2 silu2(f32x2 v) { const f32x2 e = v * (-1.44269504f); f32x2 d; d.x = __builtin_amdgcn_exp2f(e.x); d.y = __builtin_amdgcn_exp2f(e.y); d = d + 1.f; f32x2 r; r.x = __builtin_amdgcn_rcpf(d.x); r.y = __builtin_amdgcn_rcpf(d.y); return v * r; }
__device__ __forceinline__ float softplus_f(float v) { return v > 20.f ? v : log1pf(__expf(v)); }
__device__ __forceinline__ int otid() { int t = threadIdx.x; asm volatile("" : "+v"(t)); return t; }
__device__ __forceinline__ int row_b(int r) { return r < MP ? (r >> 11) : 8 + ((r - MP) >> 3); }
__device__ __forceinline__ u32x4 pack8(f32x4 a, f32x4 b) { u32x4 r; r.x = cvt_pk_bf16(a.x, a.y); r.y = cvt_pk_bf16(a.z, a.w); r.z = cvt_pk_bf16(b.x, b.y); r.w = cvt_pk_bf16(b.z, b.w); return r; }

namespace pg8 {
constexpr int BM = 256, BK = 64, HALF = 128, HTB = HALF * BK * 2, STAGE_BYTES = 8 * HTB, NXCD = 8, WGM = 8;
__device__ __forceinline__ int lds_byte(int r, int c) { const int st = (r >> 4) * 2 + (c >> 5), rr = r & 15, cc = c & 31, ob = rr * 64 + cc * 2; return st * 1024 + (ob ^ (((ob >> 9) & 1) << 5)); }
__device__ __forceinline__ void stage_rc(int b, int& R, int& C) { const int st = b / 1024, sb = b % 1024, swz = sb ^ (((sb >> 9) & 1) << 5); R = (st >> 1) * 16 + swz / 64; C = (st & 1) * 32 + (swz % 64) / 2; }
__device__ __forceinline__ int perm32(int rho) { const int n = rho >> 4, i = rho & 15; return 8 * (i >> 2) + 4 * n + (i & 3); }

struct Unit { int pm, pn, q; const char* A; const char* B; };

__device__ __forceinline__ void static_unit(int L, int nM, int nN, int& pm, int& pn) {
    const int nwg = nM * nN;
    int wgid = L; { const int q = nwg / NXCD, r = nwg % NXCD, xcd = wgid % NXCD, off = wgid / NXCD; wgid = (xcd < r ? xcd * (q + 1) : r * (q + 1) + (xcd - r) * q) + off; }
    const int nig = WGM * nN, gid = wgid / nig, fm = gid * WGM, gsz = (nM - fm) < WGM ? (nM - fm) : WGM;
    pm = fm + ((wgid % nig) % gsz); pn = (wgid % nig) / gsz;
}
struct MainSched {
    int nM, nN, nwg, G, c, lda, ldb, K, gsh, single;
    const char* A; const char* Bt;
    __device__ void init(int M, int N, int K_, int lda_, int ldb_, const void* A_, const void* Bt_, int gsh_, int single_ = 0) {
        nM = M / BM; nN = N / BM; nwg = nM * nN; G = (int)gridDim.x; c = (int)blockIdx.x; lda = lda_; ldb = ldb_; K = K_; A = (const char*)A_; Bt = (const char*)Bt_; gsh = gsh_; single = single_;
    }
    __device__ bool next(int i, Unit& u) const {
        if (single) { if (i > 0 || c >= 16) return false; u.pm = 64 + (c >> 2); u.pn = c & 3; }
        else { const long L = (long)i * G + c; if (L >= nwg) return false; static_unit((int)L, nM, nN, u.pm, u.pn); }
        u.q = 0;
        u.A = A + ((size_t)u.pm * BM * lda + (size_t)(u.pn >> gsh) * 512) * 2;
        u.B = Bt + (size_t)u.pn * BM * ldb * 2;
        return true;
    }
    __device__ __forceinline__ void a_ready(const Unit&) const {}
};
struct InSched {
    int nN, nP, E, nskip, c, r0, cnt, lda, ldb, K;
    const char* A; const char* Bt; unsigned* tail; unsigned* tmo;
    __device__ void init(int N, const void* A_, const void* Bt_, unsigned* tail_, unsigned* tmo_) {
        nN = N / BM; nP = 64 * nN; c = (int)blockIdx.x; lda = 1024; ldb = 1024; K = 1024; A = (const char*)A_; Bt = (const char*)Bt_; tail = tail_; tmo = tmo_;
        nskip = tail_ != nullptr ? 32 : 0; E = nskip + 4 * nN; r0 = (tail_ != nullptr && c < 16) ? 2 : 0;
        const int tot = (nP - c + 255) / 256; cnt = tot - r0 > 0 ? tot - r0 : 0;
    }
    __device__ bool next(int i, Unit& u) const {
        if (i < cnt) static_unit((i + r0) * 256 + c, 64, nN, u.pm, u.pn);
        else {
            if (c < 16) return false;
            const int e = 255 - c + 240 * (i - cnt); if (e >= E) return false;
            if (e < nskip) static_unit(e < 16 ? e : 256 + (e - 16), 64, nN, u.pm, u.pn);
            else { const int sidx = e - nskip; u.pm = 64 + sidx / nN; u.pn = sidx - (sidx / nN) * nN; }
        }
        u.q = 0;
        u.A = A + (size_t)u.pm * BM * 1024 * 2; u.B = Bt + (size_t)u.pn * BM * 1024 * 2;
        return true;
    }
    __device__ __forceinline__ void a_ready(const Unit& u) const {
        if (tail == nullptr || u.pm < 64) return;
        if (threadIdx.x < 64) {
            unsigned polls = 0;
            while ((unsigned)__builtin_amdgcn_readfirstlane(__hip_atomic_load(tail, __ATOMIC_RELAXED, __HIP_MEMORY_SCOPE_AGENT)) < 16u) {
                __builtin_amdgcn_s_sleep(2);
                if ((++polls & 255u) == 0u) { if (__builtin_amdgcn_readfirstlane(__hip_atomic_load(tmo, __ATOMIC_RELAXED, __HIP_MEMORY_SCOPE_AGENT)) != 0u) break; if (polls > (1u << 22)) { if (threadIdx.x == 0) atomicAdd(tmo, 1u); break; } }
            }
            __builtin_amdgcn_fence(__ATOMIC_ACQUIRE, "agent");
            asm volatile("s_waitcnt vmcnt(0)" ::: "memory");
        }
        asm volatile("" ::: "memory"); __builtin_amdgcn_s_barrier(); asm volatile("" ::: "memory");
    }
};
struct SmallSched {
    int mode, G, c, lda, ldb, K;
    const char* A0; const char* ada; const char* ssd_in; const char* pool_in;
    __device__ bool next(int i, Unit& u) const {
        const long L = (long)i * G + c;
        u.pm = 0;
        if (mode == 0) { if (L >= 48) return false; u.pn = (int)L; u.q = 0; u.A = A0; u.B = ada + (size_t)u.pn * BM * 1024 * 2; return true; }
        if (L >= 82) return false;
        int l = (int)L, q, pn;
        if (l < 25) { q = 0; pn = l; } else if (l < 41) { q = 1; pn = l - 25; } else if (l < 66) { q = 2; pn = l - 41; } else { q = 3; pn = l - 66; }
        u.q = q; u.pn = pn; u.A = A0 + (size_t)q * 256 * 1024 * 2;
        u.B = ((q & 1) ? pool_in + (size_t)(q >> 1) * 4096 * 1024 * 2 : ssd_in + (size_t)(q >> 1) * 6400 * 1024 * 2) + (size_t)pn * BM * 1024 * 2;
        return true;
    }
    __device__ __forceinline__ void a_ready(const Unit&) const {}
};

template <class Epi, class Sched>
__device__ __forceinline__ void gemm_phase(LAS unsigned char* lds, const Sched& S, const Epi& E) {
    const int tid = otid(), wid = __builtin_amdgcn_readfirstlane(tid >> 6), lane = tid & 63, wr = wid >> 2, wc = wid & 3, fr = lane & 15, fq = lane >> 4;
    const int K = S.K, nt = K / BK;
    unsigned voffA[2], voffB[2];
#pragma unroll
    for (int i = 0; i < 2; ++i) { int R, C; stage_rc(tid * 16 + i * 8192, R, C); const int Rb = Epi::PERM ? ((R & ~31) + perm32(R & 31)) : R;
        voffA[i] = (unsigned)(R * S.lda + C) * 2u; voffB[i] = (unsigned)(Rb * S.ldb + C) * 2u; }
    const size_t kstep = (size_t)(BK * 2);
    const size_t hstepA = (size_t)HALF * S.lda * 2, hstepB = (size_t)HALF * S.ldb * 2;
    const unsigned ldsw = (unsigned)wid * 1024u;
    const int aoff = lds_byte(wr * 64 + fr, fq * 8), boff = lds_byte(wc * 32 + fr, fq * 8);
#define PG8_SA(b, h) (((b) * 2 + (h)) * HTB)
#define PG8_SB(b, h) ((4 + (b) * 2 + (h)) * HTB)
#define PG8_STAGE(bufoff, gbase, voff) do { _Pragma("unroll") for (int _i = 0; _i < 2; ++_i) \
        __builtin_amdgcn_global_load_lds((const unsigned*)((const char*)(gbase) + (voff)[_i]), (LAS unsigned*)(lds + (bufoff) + ldsw + _i * 8192), 16, 0, 0); } while (0)
#define PG8_LDA(dst, b, h) do { _Pragma("unroll") for (int m = 0; m < 4; ++m) _Pragma("unroll") for (int k = 0; k < 2; ++k) dst[m][k] = *(const LAS bf16x8*)(lds + PG8_SA(b, h) + aoff + m * 2048 + k * 1024); } while (0)
#define PG8_LDB(dst, b, h) do { _Pragma("unroll") for (int n = 0; n < 2; ++n) _Pragma("unroll") for (int k = 0; k < 2; ++k) dst[n][k] = *(const LAS bf16x8*)(lds + PG8_SB(b, h) + boff + n * 2048 + k * 1024); } while (0)
#define PG8_MMA(ai, bj, At, Bt) do { __builtin_amdgcn_s_setprio(1); _Pragma("unroll") for (int m = 0; m < 4; ++m) _Pragma("unroll") for (int n = 0; n < 2; ++n) _Pragma("unroll") for (int k = 0; k < 2; ++k) \
        acc[ai][bj][m][n] = __builtin_amdgcn_mfma_f32_16x16x32_bf16(Bt[n][k], At[m][k], acc[ai][bj][m][n], 0, 0, 0); __builtin_amdgcn_s_setprio(0); } while (0)
#define PG8_WAIT_V(n) asm volatile("s_waitcnt vmcnt(" #n ")" ::: "memory")
#define PG8_WAIT_L(n) asm volatile("s_waitcnt lgkmcnt(" #n ")" ::: "memory")
#define PG8_BAR __builtin_amdgcn_s_barrier()
#define PG8_SCHED __builtin_amdgcn_sched_barrier(0)
    Unit cur, nxt; int ui = 0;
    if (!S.next(0, cur)) return;
    f32x4 acc[2][2][4][2];
#pragma unroll
    for (int a = 0; a < 2; ++a)
#pragma unroll
        for (int b = 0; b < 2; ++b)
#pragma unroll
            for (int m = 0; m < 4; ++m)
#pragma unroll
                for (int n = 0; n < 2; ++n) acc[a][b][m][n] = (f32x4){0.f, 0.f, 0.f, 0.f};
    bf16x8 At[4][2], B0[2][2], B1[2][2];
    const char* cA = cur.A; const char* cB = cur.B;
    S.a_ready(cur);
    PG8_STAGE(PG8_SB(0, 0), cB, voffB); PG8_STAGE(PG8_SA(0, 0), cA, voffA); PG8_STAGE(PG8_SB(0, 1), cB + hstepB, voffB); PG8_STAGE(PG8_SA(0, 1), cA + hstepA, voffA);
    if (wr == 1) PG8_BAR;
    PG8_WAIT_V(4); PG8_BAR;
    PG8_STAGE(PG8_SB(1, 0), cB + kstep, voffB); PG8_STAGE(PG8_SA(1, 0), cA + kstep, voffA); PG8_STAGE(PG8_SB(1, 1), cB + hstepB + kstep, voffB);
    PG8_WAIT_V(6); PG8_BAR;
    for (;;) {
        const bool has_next = S.next(ui + 1, nxt);
        const char* nA = has_next ? nxt.A : cA; const char* nB = has_next ? nxt.B : cB;
        for (int t = 0; t < nt; t += 2) {
            const bool last = (t == nt - 2);
            const char* a1 = cA + (size_t)(t + 1) * kstep;
            const char* a2 = last ? nA : cA + (size_t)(t + 2) * kstep; const char* b2 = last ? nB : cB + (size_t)(t + 2) * kstep;
            const char* a3 = a2 + kstep; const char* b3 = b2 + kstep;
            if (last && has_next) S.a_ready(nxt);
            PG8_LDB(B0, 0, 0); PG8_SCHED; PG8_LDA(At, 0, 0); PG8_STAGE(PG8_SA(1, 1), a1 + hstepA, voffA);
            PG8_WAIT_L(8); PG8_BAR; PG8_WAIT_L(0); PG8_MMA(0, 0, At, B0); PG8_BAR; PG8_SCHED;
            PG8_LDB(B1, 0, 1); PG8_STAGE(PG8_SB(0, 0), b2, voffB);
            PG8_BAR; PG8_WAIT_L(0); PG8_MMA(0, 1, At, B1); PG8_BAR;
            PG8_LDA(At, 0, 1); PG8_STAGE(PG8_SA(0, 0), a2, voffA);
            PG8_BAR; PG8_WAIT_L(0); PG8_MMA(1, 0, At, B0); PG8_BAR; PG8_SCHED;
            PG8_STAGE(PG8_SB(0, 1), b2 + hstepB, voffB);
            PG8_WAIT_V(6); PG8_BAR; PG8_MMA(1, 1, At, B1); PG8_BAR;
            PG8_LDB(B0, 1, 0); PG8_SCHED; PG8_LDA(At, 1, 0); PG8_STAGE(PG8_SA(0, 1), a2 + hstepA, voffA);
            PG8_WAIT_L(8); PG8_BAR; PG8_WAIT_L(0); PG8_MMA(0, 0, At, B0); PG8_BAR; PG8_SCHED;
            PG8_LDB(B1, 1, 1); PG8_STAGE(PG8_SB(1, 0), b3, voffB);
            PG8_BAR; PG8_WAIT_L(0); PG8_MMA(0, 1, At, B1); PG8_BAR;
            PG8_LDA(At, 1, 1); PG8_STAGE(PG8_SA(1, 0), a3, voffA);
            PG8_BAR; PG8_WAIT_L(0); PG8_MMA(1, 0, At, B0); PG8_BAR; PG8_SCHED;
            PG8_STAGE(PG8_SB(1, 1), b3 + hstepB, voffB);
            PG8_WAIT_V(6); PG8_BAR; PG8_MMA(1, 1, At, B1); PG8_BAR;
        }
        E(acc, cur, wr, wc, fr, fq);
        if (!has_next) break;
#pragma unroll
        for (int a = 0; a < 2; ++a)
#pragma unroll
            for (int b = 0; b < 2; ++b)
#pragma unroll
                for (int m = 0; m < 4; ++m)
#pragma unroll
                    for (int n = 0; n < 2; ++n) acc[a][b][m][n] = (f32x4){0.f, 0.f, 0.f, 0.f};
        cur = nxt; cA = nA; cB = nB; ++ui;
    }
    PG8_WAIT_V(0);
    if (wr == 0) PG8_BAR;
    PG8_BAR;
#undef PG8_SA
#undef PG8_SB
#undef PG8_STAGE
#undef PG8_LDA
#undef PG8_LDB
#undef PG8_MMA
#undef PG8_WAIT_V
#undef PG8_WAIT_L
#undef PG8_BAR
#undef PG8_SCHED
}
}
using pg8::Unit;

struct EpiIn {
    static constexpr bool PERM = true;
    const float* ssq; const float* sb; bf16_t* out; int ldo, nbf; float* dtraw;
    template <bool UNI>
    __device__ __forceinline__ void body(const f32x4 (&acc)[2][2][4][2], const Unit& u, int wr, int wc, int fr, int fq) const {
        const int row0 = u.pm * 256 + wr * 64 + fr, colt = u.pn * 256 + wc * 32 + 8 * fq;
        f32x4 ub[2][2];
        if (UNI) {
            const float* sbr = sb + (size_t)(u.pm >> 3) * 6400;
#pragma unroll
            for (int bj = 0; bj < 2; ++bj) { const int c = colt + bj * 128; if (c < nbf + 32) { ub[bj][0] = *(const f32x4*)(sbr + c); ub[bj][1] = *(const f32x4*)(sbr + c + 4); } }
        }
        float rsv[2][4];
#pragma unroll
        for (int ai = 0; ai < 2; ++ai)
#pragma unroll
            for (int m = 0; m < 4; ++m) rsv[ai][m] = ssq[row0 + ai * 128 + m * 16];
#pragma unroll
        for (int ai = 0; ai < 2; ++ai) {
            f32x4 nb[4][2][2];
            if (!UNI) {
#pragma unroll
                for (int m = 0; m < 4; ++m) {
                    const float* sbr = sb + (size_t)row_b(row0 + ai * 128 + m * 16) * 6400;
#pragma unroll
                    for (int bj = 0; bj < 2; ++bj) { const int c = colt + bj * 128; if (c < nbf + 32) { nb[m][bj][0] = *(const f32x4*)(sbr + c); nb[m][bj][1] = *(const f32x4*)(sbr + c + 4); } }
                }
            }
#pragma unroll
            for (int m = 0; m < 4; ++m) {
                const int r = row0 + ai * 128 + m * 16;
                const float rstd = rsqrtf(rsv[ai][m] * (1.f / 1024.f) + 1e-6f);
#pragma unroll
                for (int bj = 0; bj < 2; ++bj) {
                    const int c = colt + bj * 128;
                    if (c < nbf + 32) {
                        f32x4 b0, b1;
                        if (UNI) { b0 = ub[bj][0]; b1 = ub[bj][1]; } else { b0 = nb[m][bj][0]; b1 = nb[m][bj][1]; }
                        const f32x4 v0 = acc[ai][bj][m][0] * rstd + b0, v1 = acc[ai][bj][m][1] * rstd + b1;
                        if (c < nbf) *(u32x4*)(out + (size_t)r * ldo + c) = pack8(v0, v1);
                        else if (dtraw != nullptr) { float* dp = dtraw + (size_t)r * 32 + (c - nbf); *(f32x4*)dp = v0; *(f32x4*)(dp + 4) = v1; }
                    }
                }
            }
        }
    }
    __device__ __forceinline__ void operator()(const f32x4 (&acc)[2][2][4][2], const Unit& u, int wr, int wc, int fr, int fq) const {
        asm volatile("" : "+v"(fr), "+v"(fq));
        if (u.pm < 64) body<true>(acc, u, wr, wc, fr, fq); else body<false>(acc, u, wr, wc, fr, fq);
    }
};
struct EpiOut {
    static constexpr bool PERM = true;
    const float* xin_p; const float* xin_s; float* xw; const float* modl; const float* ng_next; bf16_t* aprime; float* ssq;
    template <bool UNI>
    __device__ __forceinline__ void body(const f32x4 (&acc)[2][2][4][2], const Unit& u, int wr, int wc, int fr, int fq) const {
        const int row0 = u.pm * 256 + wr * 64 + fr, colt = u.pn * 256 + wc * 32 + 8 * fq;
        const bool has_next = ng_next != nullptr;
        f32x4 ug[2][2], us[2][2], uw[2][2];
#pragma unroll
        for (int bj = 0; bj < 2; ++bj) {
            const int c = colt + bj * 128;
            if (has_next) { uw[bj][0] = *(const f32x4*)(ng_next + c); uw[bj][1] = *(const f32x4*)(ng_next + c + 4); }
            if (UNI) {
                const float* mb = modl + (size_t)(u.pm >> 3) * 12288;
                ug[bj][0] = *(const f32x4*)(mb + 2048 + c) + 1.f; ug[bj][1] = *(const f32x4*)(mb + 2048 + c + 4) + 1.f;
                if (has_next) { us[bj][0] = (*(const f32x4*)(mb + 4096 + c) + 1.f) * uw[bj][0]; us[bj][1] = (*(const f32x4*)(mb + 4096 + c + 4) + 1.f) * uw[bj][1]; }
            }
        }
#pragma unroll
        for (int ai = 0; ai < 2; ++ai)
#pragma unroll
            for (int mp = 0; mp < 2; ++mp) {
                f32x4 xv[2][2][2];
#pragma unroll
                for (int mm = 0; mm < 2; ++mm) {
                    const int r = row0 + ai * 128 + (mp * 2 + mm) * 16;
                    const float* xr = r < MP ? xin_p + (size_t)r * DM : xin_s + (size_t)(r - MP) * DM;
#pragma unroll
                    for (int bj = 0; bj < 2; ++bj) { xv[mm][bj][0] = *(const f32x4*)(xr + colt + bj * 128); xv[mm][bj][1] = *(const f32x4*)(xr + colt + bj * 128 + 4); }
                }
#pragma unroll
                for (int mm = 0; mm < 2; ++mm) {
                    const int m = mp * 2 + mm;
                    const int r = row0 + ai * 128 + m * 16;
                    const float* mb = modl + (size_t)row_b(r) * 12288;
                    float ss = 0.f;
#pragma unroll
                    for (int bj = 0; bj < 2; ++bj) {
                        const int c = colt + bj * 128;
                        f32x4 g0, g1;
                        if (UNI) { g0 = ug[bj][0]; g1 = ug[bj][1]; } else { g0 = *(const f32x4*)(mb + 2048 + c) + 1.f; g1 = *(const f32x4*)(mb + 2048 + c + 4) + 1.f; }
                        const f32x4 n0 = xv[mm][bj][0] + g0 * acc[ai][bj][m][0], n1 = xv[mm][bj][1] + g1 * acc[ai][bj][m][1];
                        *(f32x4*)(xw + (size_t)r * DM + c) = n0; *(f32x4*)(xw + (size_t)r * DM + c + 4) = n1;
                        ss += (n0.x * n0.x + n0.y * n0.y) + (n0.z * n0.z + n0.w * n0.w) + (n1.x * n1.x + n1.y * n1.y) + (n1.z * n1.z + n1.w * n1.w);
                        if (has_next) {
                            f32x4 s0, s1;
                            if (UNI) { s0 = us[bj][0]; s1 = us[bj][1]; } else { s0 = (*(const f32x4*)(mb + 4096 + c) + 1.f) * uw[bj][0]; s1 = (*(const f32x4*)(mb + 4096 + c + 4) + 1.f) * uw[bj][1]; }
                            *(u32x4*)(aprime + (size_t)r * DM + c) = pack8(n0 * s0, n1 * s1);
                        }
                    }
                    ss += __shfl_xor(ss, 16); ss += __shfl_xor(ss, 32);
                    if (fq == 0) atomicAdd(ssq + r, ss);
                }
            }
    }
    __device__ __forceinline__ void operator()(const f32x4 (&acc)[2][2][4][2], const Unit& u, int wr, int wc, int fr, int fq) const {
        asm volatile("" : "+v"(fr), "+v"(fq));
        if (u.pm < 64) body<true>(acc, u, wr, wc, fr, fq); else body<false>(acc, u, wr, wc, fr, fq);
    }
};
struct EpiGrp {
    static constexpr bool PERM = true;
    const bf16_t* uz; const float* chs; bf16_t* out;
    __device__ __forceinline__ void operator()(const f32x4 (&acc)[2][2][4][2], const Unit& u, int wr, int wc, int fr, int fq) const {
        asm volatile("" : "+v"(fr), "+v"(fq));
        const int row0 = u.pm * 256 + wr * 64 + fr, colt = u.pn * 256 + wc * 32 + 8 * fq;
        f32x4 cs[2][2];
#pragma unroll
        for (int bj = 0; bj < 2; ++bj) { cs[bj][0] = *(const f32x4*)(chs + colt + bj * 128); cs[bj][1] = *(const f32x4*)(chs + colt + bj * 128 + 4); }
#pragma unroll
        for (int ai = 0; ai < 2; ++ai) {
            u32x4 zz[4][2];
#pragma unroll
            for (int m = 0; m < 4; ++m)
#pragma unroll
                for (int bj = 0; bj < 2; ++bj) zz[m][bj] = *(const u32x4*)(uz + (size_t)(row0 + ai * 128 + m * 16) * 4096 + 2048 + colt + bj * 128);
#pragma unroll
            for (int m = 0; m < 4; ++m) {
                const int r = row0 + ai * 128 + m * 16;
#pragma unroll
                for (int bj = 0; bj < 2; ++bj) {
                    const int c = colt + bj * 128;
                    const u32x4 z = zz[m][bj];
                    const f32x2 a = silu2((f32x2){bf_lo(z.x), bf_hi(z.x)}), b = silu2((f32x2){bf_lo(z.y), bf_hi(z.y)}), cc = silu2((f32x2){bf_lo(z.z), bf_hi(z.z)}), d = silu2((f32x2){bf_lo(z.w), bf_hi(z.w)});
                    const f32x4 z0 = {a.x, a.y, b.x, b.y}, z1 = {cc.x, cc.y, d.x, d.y};
                    *(u32x4*)(out + (size_t)r * 2048 + c) = pack8(acc[ai][bj][m][0] * cs[bj][0] * z0, acc[ai][bj][m][1] * cs[bj][1] * z1);
                }
            }
        }
    }
};
struct EpiSmall {
    static constexpr bool PERM = true;
    int mode; float* mod; const float* ada_b; bf16_t* shiftA; float* sb;
    __device__ __forceinline__ void operator()(const f32x4 (&acc)[2][2][4][2], const Unit& u, int wr, int wc, int fr, int fq) const {
        asm volatile("" : "+v"(fr), "+v"(fq));
        const int row0 = wr * 64 + fr, colt = u.pn * 256 + wc * 32 + 8 * fq;
#pragma unroll
        for (int ai = 0; ai < 2; ++ai)
#pragma unroll
            for (int m = 0; m < 4; ++m) {
                const int r = row0 + ai * 128 + m * 16;
                if (r < 136) {
#pragma unroll
                    for (int bj = 0; bj < 2; ++bj) {
                        const int c = colt + bj * 128;
                        if (mode == 0) {
                            const f32x4 v0 = acc[ai][bj][m][0] + *(const f32x4*)(ada_b + c), v1 = acc[ai][bj][m][1] + *(const f32x4*)(ada_b + c + 4);
                            *(f32x4*)(mod + (size_t)r * 12288 + c) = v0; *(f32x4*)(mod + (size_t)r * 12288 + c + 4) = v1;
                            const int li = c / 3072, cc = c - li * 3072;
                            if (cc < 1024) *(u32x4*)(shiftA + ((size_t)li * 256 + r) * 1024 + cc) = pack8(v0, v1);
                        } else {
                            float* sp = sb + ((size_t)u.q * 136 + r) * 6400 + c;
                            *(f32x4*)sp = acc[ai][bj][m][0]; *(f32x4*)(sp + 4) = acc[ai][bj][m][1];
                        }
                    }
                }
            }
    }
};

__device__ void phase_prep0(const Params& p, const WTab& wt, LAS unsigned char* lds) {
    LAS float* tl = (LAS float*)lds;
    const int tid = otid();
    for (int tile = blockIdx.x; tile < wt.wtiles; tile += gridDim.x) {
        int j = 0;
#pragma unroll 1
        for (int q = 1; q < NWJ; ++q) if (tile >= wt.wj[q].tile_begin) j = q;
        const WJob job = wt.wj[j];
        bf16_t* jdst = (bf16_t*)(p.ws + job.doff);
        const int lt = tile - job.tile_begin, tk = lt / job.tiles_n, tn = lt - tk * job.tiles_n, k0 = tk * 64, n0 = tn * 64;
        {
            const int kk = tid >> 3, nn = (tid & 7) * 8;
            f32x4 a = (f32x4){0.f, 0.f, 0.f, 0.f}, b = a;
            if (n0 + nn < job.N) { const __attribute__((address_space(1))) f32x4* sp = (const __attribute__((address_space(1))) f32x4*)(job.src + (size_t)(k0 + kk) * job.N + n0 + nn); a = sp[0]; b = sp[1]; }
            LAS float* d = tl + kk * 65 + nn;
            d[0] = a.x; d[1] = a.y; d[2] = a.z; d[3] = a.w; d[4] = b.x; d[5] = b.y; d[6] = b.z; d[7] = b.w;
        }
        __syncthreads();
        {
            const int n = tid >> 3, k8 = (tid & 7) * 8;
            const LAS float* s = tl + k8 * 65 + n;
            u32x4 o; o.x = cvt_pk_bf16(s[0], s[65]); o.y = cvt_pk_bf16(s[130], s[195]); o.z = cvt_pk_bf16(s[260], s[325]); o.w = cvt_pk_bf16(s[390], s[455]);
            *(u32x4*)(jdst + (size_t)(n0 + n) * job.K + k0 + k8) = o;
        }
        __syncthreads();
    }
    bf16_t* ac = (bf16_t*)(p.ws + WS_AC);
    const int gt = blockIdx.x * 512 + tid, nth = gridDim.x * 512;
    for (int i = gt; i < 256 * 1024 / 8; i += nth) {
        const int r = i >> 7, c = (i & 127) * 8;
        u32x4 o = (u32x4){0u, 0u, 0u, 0u};
        if (r < 136) {
            const float* cp = r < 8 ? p.in[5] + (size_t)r * 1024 + c : p.in[6] + (size_t)(r - 8) * 1024 + c;
            const f32x4 a = *(const f32x4*)cp, b = *(const f32x4*)(cp + 4);
            o.x = cvt_pk_bf16(silu_f(a.x), silu_f(a.y)); o.y = cvt_pk_bf16(silu_f(a.z), silu_f(a.w)); o.z = cvt_pk_bf16(silu_f(b.x), silu_f(b.y)); o.w = cvt_pk_bf16(silu_f(b.z), silu_f(b.w));
        }
        *(u32x4*)(ac + (size_t)i * 8) = o;
    }
    { u32x4* sq = (u32x4*)(p.ws + WS_SSQ + 17408ull * 4); for (int i = gt; i < 4 * 17408 / 4; i += nth) sq[i] = (u32x4){0u, 0u, 0u, 0u}; }
    u32x4* sh = (u32x4*)(p.ws + WS_SHIFTA);
    for (int i = gt; i < 4 * 256 * 1024 / 8; i += nth) sh[i] = (u32x4){0u, 0u, 0u, 0u};
}

__device__ void phase_xprep(const Params& p) {
    const int tid_ = otid(), lane = tid_ & 63, wv = blockIdx.x * 8 + (tid_ >> 6), nw = gridDim.x * 8;
    const float* mod = (const float*)(p.ws + WS_MOD);
    bf16_t* ap = (bf16_t*)(p.ws + WS_APRIME);
    float* ssq = (float*)(p.ws + WS_SSQ);
    const float* ng = p.in[9];
    for (int r0 = wv * 2; r0 < MT; r0 += nw * 2) {
        f32x4 x[2][4];
#pragma unroll
        for (int h = 0; h < 2; ++h) {
            const int r = r0 + h;
            const float* xr = r < MP ? p.in[0] + (size_t)r * DM : p.in[1] + (size_t)(r - MP) * DM;
#pragma unroll
            for (int q = 0; q < 4; ++q) x[h][q] = *(const f32x4*)(xr + q * 256 + lane * 4);
        }
#pragma unroll
        for (int h = 0; h < 2; ++h) {
            const int r = r0 + h;
            const float* mb = mod + (size_t)row_b(r) * 12288 + 1024;
            float ss = 0.f;
#pragma unroll
            for (int q = 0; q < 4; ++q) {
                const int c = q * 256 + lane * 4;
                const f32x4 xv = x[h][q], sv = *(const f32x4*)(mb + c), g = *(const f32x4*)(ng + c);
                ss += (xv.x * xv.x + xv.y * xv.y) + (xv.z * xv.z + xv.w * xv.w);
                const f32x4 a = xv * g * (sv + 1.f);
                u32x2 o; o.x = cvt_pk_bf16(a.x, a.y); o.y = cvt_pk_bf16(a.z, a.w);
                *(u32x2*)(ap + (size_t)r * DM + c) = o;
            }
#pragma unroll
            for (int o = 1; o < 64; o <<= 1) ss += __shfl_xor(ss, o);
            if (lane == 0) ssq[r] = ss;
        }
    }
}

__device__ void phase_final(const Params& p, int r_begin, int r_end, int blk0) {
    if ((int)blockIdx.x < blk0) return;
    const int tid_ = otid(), lane = tid_ & 63, wv = ((int)blockIdx.x - blk0) * 8 + (tid_ >> 6), nw = ((int)gridDim.x - blk0) * 8;
    const float* xw = (const float*)(p.ws + WS_XW);
    const float* ssq = (const float*)(p.ws + WS_SSQ) + 4 * 17408;
    const float* fg = p.in[22];
    for (int r0 = r_begin + wv * 2; r0 < r_end; r0 += nw * 2) {
        f32x4 x[2][4];
#pragma unroll
        for (int h = 0; h < 2; ++h)
#pragma unroll
            for (int q = 0; q < 4; ++q) x[h][q] = *(const f32x4*)(xw + (size_t)(r0 + h) * DM + q * 256 + lane * 4);
#pragma unroll
        for (int h = 0; h < 2; ++h) {
            const int r = r0 + h;
            const float rstd = rsqrtf(ssq[r] * (1.f / 1024.f) + 1e-6f);
#pragma unroll
            for (int q = 0; q < 4; ++q) {
                const int c = q * 256 + lane * 4;
                const f32x4 g = *(const f32x4*)(fg + c);
                *(f32x4*)(p.out + (size_t)r * DM + c) = x[h][q] * rstd * g;
            }
        }
    }
}

__device__ void phase_ssdnorm(const Params& p, int j) {
    const int tid_ = otid(), lane = tid_ & 63, wv = blockIdx.x * 8 + (tid_ >> 6), nw = gridDim.x * 8;
    const bf16_t* yg = (const bf16_t*)(p.ws + WS_YG);
    bf16_t* a2 = (bf16_t*)(p.ws + WS_A2);
    const float* ng = p.in[16] + (size_t)j * 2048;
    for (int r0 = wv * 2; r0 < MT; r0 += nw * 2) {
        u32x4 vv[2][4];
#pragma unroll
        for (int h = 0; h < 2; ++h)
#pragma unroll
            for (int q = 0; q < 4; ++q) vv[h][q] = *(const u32x4*)(yg + (size_t)(r0 + h) * 2048 + q * 512 + lane * 8);
#pragma unroll
        for (int h = 0; h < 2; ++h)
#pragma unroll
            for (int q = 0; q < 4; ++q) {
                const int c = q * 512 + lane * 8;
                const u32x4 v = vv[h][q];
                f32x4 a, b;
                a.x = bf_lo(v.x); a.y = bf_hi(v.x); a.z = bf_lo(v.y); a.w = bf_hi(v.y); b.x = bf_lo(v.z); b.y = bf_hi(v.z); b.z = bf_lo(v.w); b.w = bf_hi(v.w);
                float ss = (a.x * a.x + a.y * a.y) + (a.z * a.z + a.w * a.w) + (b.x * b.x + b.y * b.y) + (b.z * b.z + b.w * b.w);
#pragma unroll
                for (int o = 1; o < 32; o <<= 1) ss += __shfl_xor(ss, o);
                const float rstd = rsqrtf(ss * (1.f / 256.f) + 1e-6f);
                const f32x4 g0 = *(const f32x4*)(ng + c), g1 = *(const f32x4*)(ng + c + 4);
                *(u32x4*)(a2 + (size_t)(r0 + h) * 2048 + c) = pack8(a * rstd * g0, b * rstd * g1);
            }
    }
}

__device__ void phase_pool(const Params& p, int j) {
    const bf16_t* uz = (const bf16_t*)(p.ws + WS_ZX);
    bf16_t* pooled = (bf16_t*)(p.ws + WS_YG);
    const int gt = blockIdx.x * 512 + otid(), nth = gridDim.x * 512;
    for (int u = gt; u < 131072 + 32768; u += nth) {
        int cv, row0, t0, R; const float* prev = nullptr; bool prompt;
        if (u < 131072) { cv = u & 255; const int run = (u >> 8) & 63, b = u >> 14; row0 = b * 2048; t0 = run * 32; R = 32; prompt = true; }
        else { const int v = u - 131072; cv = v & 255; const int b = v >> 8; row0 = MP + b * 8; t0 = 0; R = 8; prompt = false; prev = p.in[4] + ((size_t)(j * 128 + b) * 15) * 2048; }
        const int c = cv * 8, w = 2 << (c >> 9);
        float s[8];
#pragma unroll
        for (int i = 0; i < 8; ++i) s[i] = 0.f;
        auto getu = [&](int tt, float (&o)[8]) {
            if (tt >= 0) {
                const u32x4 v = *(const u32x4*)(uz + (size_t)(row0 + tt) * 4096 + c);
                o[0] = bf_lo(v.x); o[1] = bf_hi(v.x); o[2] = bf_lo(v.y); o[3] = bf_hi(v.y); o[4] = bf_lo(v.z); o[5] = bf_hi(v.z); o[6] = bf_lo(v.w); o[7] = bf_hi(v.w);
            } else if (!prompt) {
                const float* pp = prev + (size_t)(15 + tt) * 2048 + c;
                const f32x4 a = *(const f32x4*)pp, b = *(const f32x4*)(pp + 4);
                o[0] = a.x; o[1] = a.y; o[2] = a.z; o[3] = a.w; o[4] = b.x; o[5] = b.y; o[6] = b.z; o[7] = b.w;
            } else {
#pragma unroll
                for (int i = 0; i < 8; ++i) o[i] = 0.f;
            }
        };
        for (int i = 1; i < w; ++i) {
            float o[8]; getu(t0 - i, o);
#pragma unroll
            for (int k = 0; k < 8; ++k) s[k] += o[k];
        }
        for (int tb = t0; tb < t0 + R; tb += 4) {
            float cur[4][8], old[4][8];
#pragma unroll
            for (int k = 0; k < 4; ++k) { getu(tb + k, cur[k]); getu(tb + k - w + 1, old[k]); }
#pragma unroll
            for (int k = 0; k < 4; ++k) {
                const int t = tb + k;
                const float inv = 1.f / (float)(prompt ? min(w, t + 1) : w);
                f32x4 a, b;
#pragma unroll
                for (int i = 0; i < 8; ++i) s[i] += cur[k][i];
                a.x = s[0] * inv - cur[k][0]; a.y = s[1] * inv - cur[k][1]; a.z = s[2] * inv - cur[k][2]; a.w = s[3] * inv - cur[k][3];
                b.x = s[4] * inv - cur[k][4]; b.y = s[5] * inv - cur[k][5]; b.z = s[6] * inv - cur[k][6]; b.w = s[7] * inv - cur[k][7];
                *(u32x4*)(pooled + (size_t)(row0 + t) * 2048 + c) = pack8(a, b);
#pragma unroll
                for (int i = 0; i < 8; ++i) s[i] -= old[k][i];
            }
        }
    }
    for (int i = gt; i < (8 + 128) * 15 * 256; i += nth) {
        const int cv = i & 255, k = (i >> 8) % 15, sq = (i >> 8) / 15, ch = cv * 8;
        f32x4 a, b2;
        float* dst;
        bool from_state = false; size_t urow = 0;
        if (sq < 8) { urow = (size_t)(sq * 2048 + 2033 + k); dst = p.out + O_POOL_P + ((size_t)(j * 8 + sq) * 15 + k) * 2048 + ch; }
        else { const int bb = sq - 8; dst = p.out + O_POOL_S + ((size_t)(j * 128 + bb) * 15 + k) * 2048 + ch; if (k < 7) from_state = true; else urow = (size_t)(MP + bb * 8 + k - 7); }
        if (from_state) { const float* sp = p.in[4] + ((size_t)(j * 128 + (sq - 8)) * 15 + 8 + k) * 2048 + ch; a = *(const f32x4*)sp; b2 = *(const f32x4*)(sp + 4); }
        else { const u32x4 v = *(const u32x4*)(uz + urow * 4096 + ch); a = (f32x4){bf_lo(v.x), bf_hi(v.x), bf_lo(v.y), bf_hi(v.y)}; b2 = (f32x4){bf_lo(v.z), bf_hi(v.z), bf_lo(v.w), bf_hi(v.w)}; }
        *(f32x4*)dst = a; *(f32x4*)(dst + 4) = b2;
    }
}

constexpr int RS = 272;
constexpr int L_XT = 0, L_BN = 17408, L_BT = 52224, L_CN = 87040, L_HB = 121856, L_SM = 139264, L_CW = 143360;
__device__ __forceinline__ int xt_addr(int pr, int t) { return L_XT + pr * RS + ((((t >> 3) ^ (pr >> 1)) & 15) << 4) + (t & 7) * 2; }
__device__ __forceinline__ int bt_addr(int n, int t) { return L_BT + n * RS + ((((t >> 3) ^ (n >> 3)) & 15) << 4) + (t & 7) * 2; }
__device__ __forceinline__ f32x16 mfma32(bf16x8 a, bf16x8 b, f32x16 c) { return __builtin_amdgcn_mfma_f32_32x32x16_bf16(a, b, c, 0, 0, 0); }

#define OPQ(x) asm volatile("" : "+v"(x))
__device__ void ssd_prompt_item(const Params& p, int j, int b, int h, LAS unsigned char* lds) {
    const int tid0 = otid(), wid = __builtin_amdgcn_readfirstlane(tid0 >> 6), g = h >> 2;
    const char* zxc = (const char*)(p.ws + WS_ZX);
    const char* dtc = (const char*)(p.ws + WS_DTRAW);
    char* ygc = (char*)(p.ws + WS_YG);
    const int rowbase = b * 2048;
    LAS float* cw = (LAS float*)(lds + L_CW);
    const float Ah = -__expf(p.in[14][j * 32 + h]), Dh = p.in[15][j * 32 + h], dtb = p.in[13][j * 32 + h];
    const bool roleB = wid < 4;
    const int qq = wid >> 1, tt = qq ^ (qq >> 1), pt = wid & 1, hp = wid & 1, hn = wid >> 1;

    __syncthreads();
    if (tid0 < 320) {
        const int ch = tid0 < 64 ? h * 64 + tid0 : (tid0 < 192 ? 2048 + g * 128 + (tid0 - 64) : 3072 + g * 128 + (tid0 - 192));
#pragma unroll
        for (int k = 0; k < 4; ++k) cw[k * 320 + tid0] = p.in[11][((size_t)j * 4 + k) * 4096 + ch];
        cw[4 * 320 + tid0] = p.in[12][(size_t)j * 4096 + ch];
    }
    for (int i = tid0; i < 17408 / 4; i += 512) *(LAS unsigned*)(lds + L_HB + i * 4) = 0u;

    u32x4 rawBC[11]; unsigned rawX[11]; float dtp0 = 0.f, dtp1 = 0.f;
    auto prefetch = [&](int t0) {
        int tid = tid0; OPQ(tid);
        const int bt_ = tid & 255, tqb = bt_ >> 4, cg8 = bt_ & 15, tqx = tid >> 5, cp = tid & 31, lane = tid & 63;
        const int colBC = (roleB ? 4096 : 5120) + g * 128 + cg8 * 8, colX = 2048 + h * 64 + cp * 2;
        const int rB = t0 + tqb * 8 - 3, rX = t0 + tqx * 8 - 3;
        const unsigned oB = (unsigned)((rowbase + rB) * ZXW + colBC) * 2u, oX = (unsigned)((rowbase + rX) * ZXW + colX) * 2u;
#pragma unroll
        for (int i = 0; i < 11; ++i) {
            rawBC[i] = (rB + i >= 0) ? *(const u32x4*)(zxc + (oB + (unsigned)i * 12288u)) : (u32x4){0u, 0u, 0u, 0u};
            rawX[i] = (rX + i >= 0) ? *(const unsigned*)(zxc + (oX + (unsigned)i * 12288u)) : 0u;
        }
        if (wid == 0) { const unsigned od = (unsigned)((rowbase + t0 + 2 * lane) * 32 + h) * 4u; dtp0 = *(const float*)(dtc + od); dtp1 = *(const float*)(dtc + (od + 128u)); }
    };
    prefetch(0);

    auto acum_stage = [&](int par) {
        if (wid == 0) {
            LAS float* sm_acum = (LAS float*)(lds + L_SM + par * 2048);
            LAS float* sm_dt = sm_acum + 128;
            LAS float* sm_w = sm_acum + 256;
            LAS float* sm_ea = sm_acum + 384;
            int lane = tid0 & 63; OPQ(lane);
            const float d0 = softplus_f(dtp0 + dtb), d1 = softplus_f(dtp1 + dtb);
            const float a0 = d0 * Ah, a1 = a0 + d1 * Ah;
            float sc = a1;
#pragma unroll
            for (int o = 1; o < 64; o <<= 1) { const float v = __shfl_up(sc, o); if (lane >= o) sc += v; }
            const float c1 = sc, c0 = sc - a1 + a0;
            const float last = __shfl(sc, 63);
            sm_acum[2 * lane] = c0; sm_acum[2 * lane + 1] = c1;
            sm_dt[2 * lane] = d0; sm_dt[2 * lane + 1] = d1;
            sm_w[2 * lane] = __expf(last - c0) * d0; sm_w[2 * lane + 1] = __expf(last - c1) * d1;
            sm_ea[2 * lane] = __expf(c0); sm_ea[2 * lane + 1] = __expf(c1);
        }
    };
    acum_stage(0);
    __syncthreads();

    f32x16 hacc;
#pragma unroll
    for (int i = 0; i < 16; ++i) hacc[i] = 0.f;

#pragma unroll 1
    for (int c = 0; c < 16; ++c) {
        const int t0 = c * 128;
        LAS float* sm_acum = (LAS float*)(lds + L_SM + (c & 1) * 2048);
        LAS float* sm_dt = sm_acum + 128;
        LAS float* sm_w = sm_acum + 256;
        LAS float* sm_ea = sm_acum + 384;
        {
            int tid = tid0; OPQ(tid);
            const int bt_ = tid & 255, tqb = bt_ >> 4, cg8 = bt_ & 15;
            const int lcBC = (roleB ? 64 : 192) + cg8 * 8;
            const f32x4 wv0 = *(const LAS f32x4*)(sm_w + tqb * 8), wv1 = *(const LAS f32x4*)(sm_w + tqb * 8 + 4);
            const float wt[8] = {wv0.x, wv0.y, wv0.z, wv0.w, wv1.x, wv1.y, wv1.z, wv1.w};
            const int natbase = (roleB ? L_BN : L_CN) + (tqb * 8) * RS + cg8 * 16;
#pragma unroll
            for (int half = 0; half < 2; ++half) {
                u32x2 nat[8]; u32x4 tr[4];
#pragma unroll
                for (int ipp = 0; ipp < 2; ++ipp) {
                    const int ip = half * 2 + ipp;
                    const float k0a = cw[0 * 320 + lcBC + 2 * ip], k0b = cw[0 * 320 + lcBC + 2 * ip + 1];
                    const float k1a = cw[1 * 320 + lcBC + 2 * ip], k1b = cw[1 * 320 + lcBC + 2 * ip + 1];
                    const float k2a = cw[2 * 320 + lcBC + 2 * ip], k2b = cw[2 * 320 + lcBC + 2 * ip + 1];
                    const float k3a = cw[3 * 320 + lcBC + 2 * ip], k3b = cw[3 * 320 + lcBC + 2 * ip + 1];
                    const float bba = cw[4 * 320 + lcBC + 2 * ip], bbb = cw[4 * 320 + lcBC + 2 * ip + 1];
                    f32x2 rr[11];
#pragma unroll
                    for (int i = 0; i < 11; ++i) { const unsigned v = rawBC[i][ip]; rr[i] = (f32x2){bf_lo(v), bf_hi(v)}; }
                    const f32x2 K0 = {k0a, k0b}, K1 = {k1a, k1b}, K2 = {k2a, k2b}, K3 = {k3a, k3b}, BB = {bba, bbb};
                    float va[8], vb[8];
#pragma unroll
                    for (int t = 0; t < 8; ++t) {
                        const f32x2 v = silu2(BB + K0 * rr[t] + K1 * rr[t + 1] + K2 * rr[t + 2] + K3 * rr[t + 3]);
                        va[t] = v.x; vb[t] = v.y;
                        nat[t][ipp] = cvt_pk_bf16(v.x, v.y);
                    }
                    if (roleB) {
#pragma unroll
                        for (int tp = 0; tp < 4; ++tp) {
                            tr[2 * ipp][tp] = cvt_pk_bf16(va[2 * tp] * wt[2 * tp], va[2 * tp + 1] * wt[2 * tp + 1]);
                            tr[2 * ipp + 1][tp] = cvt_pk_bf16(vb[2 * tp] * wt[2 * tp], vb[2 * tp + 1] * wt[2 * tp + 1]);
                        }
                    }
                }
#pragma unroll
                for (int t = 0; t < 8; ++t) *(LAS u32x2*)(lds + natbase + t * RS + half * 8) = nat[t];
                if (roleB) {
#pragma unroll
                    for (int i = 0; i < 4; ++i) *(LAS u32x4*)(lds + bt_addr(cg8 * 8 + half * 4 + i, tqb * 8)) = tr[i];
                }
                __builtin_amdgcn_sched_barrier(0);
            }
        }
        {
            int tid = tid0; OPQ(tid);
            const int tqx = tid >> 5, cp = tid & 31, lcX = cp * 2;
            const float k0a = cw[0 * 320 + lcX], k0b = cw[0 * 320 + lcX + 1], k1a = cw[1 * 320 + lcX], k1b = cw[1 * 320 + lcX + 1];
            const float k2a = cw[2 * 320 + lcX], k2b = cw[2 * 320 + lcX + 1], k3a = cw[3 * 320 + lcX], k3b = cw[3 * 320 + lcX + 1];
            const float bba = cw[4 * 320 + lcX], bbb = cw[4 * 320 + lcX + 1];
            f32x2 rr[11];
#pragma unroll
            for (int i = 0; i < 11; ++i) rr[i] = (f32x2){bf_lo(rawX[i]), bf_hi(rawX[i])};
            const f32x2 K0 = {k0a, k0b}, K1 = {k1a, k1b}, K2 = {k2a, k2b}, K3 = {k3a, k3b}, BB = {bba, bbb};
            float va[8], vb[8];
#pragma unroll
            for (int t = 0; t < 8; ++t) { const f32x2 v = silu2(BB + K0 * rr[t] + K1 * rr[t + 1] + K2 * rr[t + 2] + K3 * rr[t + 3]); va[t] = v.x; vb[t] = v.y; }
            u32x4 xa, xb;
            xa.x = cvt_pk_bf16(va[0], va[1]); xa.y = cvt_pk_bf16(va[2], va[3]); xa.z = cvt_pk_bf16(va[4], va[5]); xa.w = cvt_pk_bf16(va[6], va[7]);
            xb.x = cvt_pk_bf16(vb[0], vb[1]); xb.y = cvt_pk_bf16(vb[2], vb[3]); xb.z = cvt_pk_bf16(vb[4], vb[5]); xb.w = cvt_pk_bf16(vb[6], vb[7]);
            *(LAS u32x4*)(lds + xt_addr(cp * 2, tqx * 8)) = xa;
            *(LAS u32x4*)(lds + xt_addr(cp * 2 + 1, tqx * 8)) = xb;
        }
        if (c + 1 < 16) prefetch(t0 + 128);
        bf16_t zr[16];
        {
            int ln = tid0 & 63; OPQ(ln);
            const int l31 = ln & 31, hh = ln >> 5;
            const unsigned oz = (unsigned)((rowbase + t0 + tt * 32 + 4 * hh) * ZXW + h * 64 + pt * 32 + l31) * 2u;
#pragma unroll
            for (int rg = 0; rg < 16; ++rg) zr[rg] = *(const bf16_t*)(zxc + (oz + (unsigned)((rg & 3) + 8 * (rg >> 2)) * 12288u));
        }
        __syncthreads();
        f32x16 y;
        {
            int ln = tid0 & 63; OPQ(ln);
            const int l31 = ln & 31, hh = ln >> 5;
            const int cbase = L_CN + (tt * 32 + l31) * RS + 16 * hh, hbase = L_HB + (pt * 32 + l31) * RS + 16 * hh;
#pragma unroll
            for (int i = 0; i < 16; ++i) y[i] = 0.f;
            {
                const float dec = sm_ea[127];
#pragma unroll
                for (int i = 0; i < 16; ++i) hacc[i] *= dec;
            }
            bf16x8 cf[8];
#pragma unroll
            for (int ks = 0; ks < 8; ++ks) {
                cf[ks] = *(const LAS bf16x8*)(lds + cbase + ks * 32);
                const bf16x8 bfr = *(const LAS bf16x8*)(lds + hbase + ks * 32);
                const bf16x8 a = *(const LAS bf16x8*)(lds + xt_addr(hp * 32 + l31, ks * 16 + 8 * hh));
                const bf16x8 bb = *(const LAS bf16x8*)(lds + bt_addr(hn * 32 + l31, ks * 16 + 8 * hh));
                y = mfma32(cf[ks], bfr, y);
                hacc = mfma32(a, bb, hacc);
            }
#pragma unroll
            for (int rq = 0; rq < 4; ++rq) { const f32x4 e = *(const LAS f32x4*)(sm_ea + tt * 32 + 8 * rq + 4 * hh); y[4 * rq] *= e.x; y[4 * rq + 1] *= e.y; y[4 * rq + 2] *= e.z; y[4 * rq + 3] *= e.w; }
            const int tidx = tt * 32 + l31;
            const float at = sm_acum[tidx];
#pragma unroll 1
            for (int st = 0; st <= tt; ++st) {
                f32x16 s;
#pragma unroll
                for (int i = 0; i < 16; ++i) s[i] = 0.f;
                const int bbase = L_BN + (st * 32 + l31) * RS + 16 * hh;
#pragma unroll
                for (int ks = 0; ks < 8; ++ks) { const bf16x8 afr = *(const LAS bf16x8*)(lds + bbase + ks * 32); s = mfma32(afr, cf[ks], s); }
#pragma unroll
                for (int rq = 0; rq < 4; ++rq) {
                    const int sb0 = st * 32 + 8 * rq + 4 * hh;
                    const f32x4 asv = *(const LAS f32x4*)(sm_acum + sb0), dsv = *(const LAS f32x4*)(sm_dt + sb0);
#pragma unroll
                    for (int i = 0; i < 4; ++i) {
                        float e = at - asv[i];
                        if (sb0 + i > tidx) e = -INFINITY;
                        s[4 * rq + i] *= __expf(e) * dsv[i];
                    }
                }
#pragma unroll
                for (int k2 = 0; k2 < 2; ++k2) {
                    u32x4 au; au.x = cvt_pk_bf16(s[8 * k2], s[8 * k2 + 1]); au.y = cvt_pk_bf16(s[8 * k2 + 2], s[8 * k2 + 3]); au.z = cvt_pk_bf16(s[8 * k2 + 4], s[8 * k2 + 5]); au.w = cvt_pk_bf16(s[8 * k2 + 6], s[8 * k2 + 7]);
                    const int sbase = st * 32 + 16 * k2 + 4 * hh;
                    const u32x2 lo = *(const LAS u32x2*)(lds + xt_addr(pt * 32 + l31, sbase)), hi = *(const LAS u32x2*)(lds + xt_addr(pt * 32 + l31, sbase + 8));
                    u32x4 bu; bu.x = lo.x; bu.y = lo.y; bu.z = hi.x; bu.w = hi.y;
                    y = mfma32(__builtin_bit_cast(bf16x8, au), __builtin_bit_cast(bf16x8, bu), y);
                }
            }
        }
        {
            int ln = tid0 & 63; OPQ(ln);
            const int l31 = ln & 31, hh = ln >> 5;
            const unsigned oy = (unsigned)((rowbase + t0 + tt * 32 + 4 * hh) * 2048 + h * 64 + pt * 32 + l31) * 2u;
#pragma unroll
            for (int rq = 0; rq < 4; ++rq) {
                const u32x2 xv = *(const LAS u32x2*)(lds + xt_addr(pt * 32 + l31, tt * 32 + 8 * rq + 4 * hh));
                const float xs[4] = {bf_lo(xv.x), bf_hi(xv.x), bf_lo(xv.y), bf_hi(xv.y)};
#pragma unroll
                for (int i = 0; i < 4; ++i) {
                    const int rg = 4 * rq + i;
                    const float yv = y[rg] + Dh * xs[i];
                    const float gv = yv * silu_f(bf2f(zr[rg]));
                    *(bf16_t*)(ygc + (oy + (unsigned)(8 * rq + i) * 4096u)) = (bf16_t)(cvt_pk_bf16(gv, 0.f) & 0xffffu);
                }
            }
        }
        if (c + 1 < 16) acum_stage((c + 1) & 1);
        __syncthreads();
        {
            int ln = tid0 & 63; OPQ(ln);
            const int l31 = ln & 31, hh = ln >> 5;
#pragma unroll
            for (int rg = 0; rg < 16; ++rg) {
                const int pr = hp * 32 + (rg & 3) + 8 * (rg >> 2) + 4 * hh;
                *(LAS bf16_t*)(lds + L_HB + pr * RS + (hn * 32 + l31) * 2) = (bf16_t)(cvt_pk_bf16(hacc[rg], 0.f) & 0xffffu);
            }
        }
    }
    {
        int ln = tid0 & 63; OPQ(ln);
        const int l31 = ln & 31, hh = ln >> 5;
        float* so = p.out + O_SSM_P + ((size_t)(j * 8 + b) * 32 + h) * 8192;
#pragma unroll
        for (int rg = 0; rg < 16; ++rg) {
            const int pr = hp * 32 + (rg & 3) + 8 * (rg >> 2) + 4 * hh;
            so[pr * 128 + hn * 32 + l31] = hacc[rg];
        }
    }
}

__device__ void ssd_sample_all(const Params& p, int j, LAS unsigned char* lds) {
    const int tid = otid();
    const bf16_t* zx = (const bf16_t*)(p.ws + WS_ZX);
    const float* dtraw = (const float*)(p.ws + WS_DTRAW);
    bf16_t* yg = (bf16_t*)(p.ws + WS_YG);
    LAS float* sx = (LAS float*)lds;
    LAS float* sB = sx + 2048;
    LAS float* sC = sB + 1024;
    LAS float* sdt = sC + 1024;
    LAS float* sdec = sdt + 32;
    const int pp = tid >> 3, nl = (tid & 7) * 4;
    int item = (int)blockIdx.x;
    f32x4 hs[4][4];
    if (item < 1024) {
        const float* st = p.in[2] + ((size_t)(j * 128 + (item >> 3)) * 32 + (item & 7) * 4) * 8192;
#pragma unroll
        for (int r = 0; r < 4; ++r)
#pragma unroll
            for (int q = 0; q < 4; ++q) hs[r][q] = *(const f32x4*)(st + r * 8192 + pp * 128 + nl + 32 * q);
    }
#pragma unroll 1
    for (; item < 1024; item += (int)gridDim.x) {
        const int b = item >> 3, g = item & 7;
        __syncthreads();
        {
            const int cc = tid < 256 ? g * 256 + tid : (tid < 384 ? 2048 + g * 128 + (tid - 256) : 3072 + g * 128 + (tid - 384));
            float raw[11];
#pragma unroll
            for (int k = 0; k < 3; ++k) raw[k] = p.in[3][((size_t)(j * 128 + b) * 3 + k) * 4096 + cc];
#pragma unroll
            for (int t = 0; t < 8; ++t) raw[3 + t] = bf2f(zx[(size_t)(MP + b * 8 + t) * ZXW + 2048 + cc]);
            const float w0 = p.in[11][((size_t)j * 4 + 0) * 4096 + cc], w1 = p.in[11][((size_t)j * 4 + 1) * 4096 + cc];
            const float w2 = p.in[11][((size_t)j * 4 + 2) * 4096 + cc], w3 = p.in[11][((size_t)j * 4 + 3) * 4096 + cc];
            const float bs = p.in[12][(size_t)j * 4096 + cc];
            LAS float* dst = tid < 256 ? sx + tid : (tid < 384 ? sB + (tid - 256) : sC + (tid - 384));
            const int dstride = tid < 256 ? 256 : 128;
#pragma unroll
            for (int t = 0; t < 8; ++t) dst[t * dstride] = silu_f(bs + w0 * raw[t] + w1 * raw[t + 1] + w2 * raw[t + 2] + w3 * raw[t + 3]);
            if (tid < 32) {
                const int t = tid >> 2, r = tid & 3, hd = g * 4 + r;
                const float dtv = softplus_f(dtraw[(size_t)(MP + b * 8 + t) * 32 + hd] + p.in[13][j * 32 + hd]);
                sdt[tid] = dtv; sdec[tid] = __expf(-dtv * __expf(p.in[14][j * 32 + hd]));
            }
        }
        const int tsel = tid & 7;
        const size_t row = (size_t)(MP + b * 8 + tsel);
        bf16_t zv[4];
#pragma unroll
        for (int r = 0; r < 4; ++r) zv[r] = zx[row * ZXW + g * 256 + r * 64 + pp];
        const int nitem = item + (int)gridDim.x;
        f32x4 hn[4][4];
        if (nitem < 1024) {
            const float* st = p.in[2] + ((size_t)(j * 128 + (nitem >> 3)) * 32 + (nitem & 7) * 4) * 8192;
#pragma unroll
            for (int r = 0; r < 4; ++r)
#pragma unroll
                for (int q = 0; q < 4; ++q) hn[r][q] = *(const f32x4*)(st + r * 8192 + pp * 128 + nl + 32 * q);
        }
        __syncthreads();
        float ysel[4] = {0.f, 0.f, 0.f, 0.f};
#pragma unroll
        for (int t = 0; t < 8; ++t) {
            const f32x4 dt4 = *(const LAS f32x4*)(sdt + t * 4), dc4 = *(const LAS f32x4*)(sdec + t * 4);
            const float dx[4] = {dt4.x * sx[t * 256 + pp], dt4.y * sx[t * 256 + 64 + pp], dt4.z * sx[t * 256 + 128 + pp], dt4.w * sx[t * 256 + 192 + pp]};
            const float dc[4] = {dc4.x, dc4.y, dc4.z, dc4.w};
            float yp[4] = {0.f, 0.f, 0.f, 0.f};
#pragma unroll
            for (int q = 0; q < 4; ++q) {
                const f32x4 B4 = *(const LAS f32x4*)(sB + t * 128 + nl + 32 * q), C4 = *(const LAS f32x4*)(sC + t * 128 + nl + 32 * q);
#pragma unroll
                for (int r = 0; r < 4; ++r) {
                    hs[r][q] = hs[r][q] * dc[r] + B4 * dx[r];
                    yp[r] += (hs[r][q].x * C4.x + hs[r][q].y * C4.y) + (hs[r][q].z * C4.z + hs[r][q].w * C4.w);
                }
            }
#pragma unroll
            for (int r = 0; r < 4; ++r) {
                float v = yp[r];
                v += __shfl_xor(v, 1); v += __shfl_xor(v, 2); v += __shfl_xor(v, 4);
                if (tsel == t) ysel[r] = v;
            }
        }
        float* so = p.out + O_SSM_S + ((size_t)(j * 128 + b) * 32 + g * 4) * 8192;
#pragma unroll
        for (int r = 0; r < 4; ++r) {
            const int ch = g * 256 + r * 64 + pp;
            const float yv = ysel[r] + p.in[15][j * 32 + g * 4 + r] * sx[tsel * 256 + r * 64 + pp];
            const float gv = yv * silu_f(bf2f(zv[r]));
            yg[row * 2048 + ch] = (bf16_t)(cvt_pk_bf16(gv, 0.f) & 0xffffu);
#pragma unroll
            for (int q = 0; q < 4; ++q) *(f32x4*)(so + r * 8192 + pp * 128 + nl + 32 * q) = hs[r][q];
        }
        if (nitem < 1024) {
#pragma unroll
            for (int r = 0; r < 4; ++r)
#pragma unroll
                for (int q = 0; q < 4; ++q) hs[r][q] = hn[r][q];
        }
    }
}

__device__ void phase_scan(const Params& p, int j, LAS unsigned char* lds) {
    for (int item = blockIdx.x; item < 256; item += gridDim.x) {
        const int g = item & 7, k = item >> 3, b = k >> 2, r = k & 3;
        for (int rep = 0; rep < REP_PROMPT; ++rep) ssd_prompt_item(p, j, b, g * 4 + r, lds);
    }
    ssd_sample_all(p, j, lds);
    const bf16_t* zx = (const bf16_t*)(p.ws + WS_ZX);
    const int gt = blockIdx.x * 512 + otid(), nth = gridDim.x * 512;
    for (int i = gt; i < 136 * 3 * 512; i += nth) {
        const int ch = (i & 511) * 8, k = (i >> 9) % 3, sq = (i >> 9) / 3;
        const size_t row = sq < 8 ? (size_t)(sq * 2048 + 2045 + k) : (size_t)(MP + (sq - 8) * 8 + 5 + k);
        float* dst = sq < 8 ? p.out + O_CONV_P + ((size_t)(j * 8 + sq) * 3 + k) * 4096 + ch : p.out + O_CONV_S + ((size_t)(j * 128 + (sq - 8)) * 3 + k) * 4096 + ch;
        const u32x4 v = *(const u32x4*)(zx + row * ZXW + 2048 + ch);
        *(f32x4*)dst = (f32x4){bf_lo(v.x), bf_hi(v.x), bf_lo(v.y), bf_hi(v.y)}; *(f32x4*)(dst + 4) = (f32x4){bf_lo(v.z), bf_hi(v.z), bf_lo(v.w), bf_hi(v.w)};
    }
}

#define XB_TMO      128
#define XB_XCNT(j)  (256  + 64 * (j))
#define XB_XSUB(j)  (1280 + 64 * (j))
#define XB_XGEN(j)  (2304 + 64 * (j))
#define XB_TOP      3328
#define XB_TOPGEN   3392
#define XCD_BAR_WORDS 3456
#define XB_SPIN_CAP (1u << 22)
__device__ __forceinline__ unsigned xb_ld(unsigned* p)              { return __hip_atomic_load(p, __ATOMIC_RELAXED, __HIP_MEMORY_SCOPE_AGENT); }
__device__ __forceinline__ unsigned xb_add(unsigned* p, unsigned v) { return __hip_atomic_fetch_add(p, v, __ATOMIC_RELAXED, __HIP_MEMORY_SCOPE_AGENT); }
__device__ __forceinline__ unsigned xb_xcc_id() { return (unsigned)__builtin_amdgcn_s_getreg((3 << 11) | 20) & 0xFu; }
#define XB_SPIN(cond, bar) do { unsigned _sp = 0; while (cond) { __builtin_amdgcn_s_sleep(1); \
    if ((++_sp & 255u) == 0u) { if (xb_ld(&(bar)[XB_TMO])) break; if (_sp > XB_SPIN_CAP) { atomicAdd(&(bar)[XB_TMO], 1u); break; } } } } while (0)
struct XcdBarrier { unsigned* bar; unsigned x; volatile LAS unsigned* st; };
__device__ __forceinline__ XcdBarrier xcd_barrier_post(unsigned* bar, volatile LAS unsigned* st) {
    XcdBarrier b; b.bar = bar; b.x = xb_xcc_id(); b.st = st;
    if (threadIdx.x == 0) (void)xb_add(&bar[XB_XCNT(b.x)], 1u);
    return b;
}
__device__ __forceinline__ void xcd_barrier_complete(unsigned* bar, unsigned x, unsigned& nloc, unsigned& nx) {
    const unsigned G = gridDim.x * gridDim.y * gridDim.z;
    unsigned sum, cnt, mine, sp = 0u;
    for (;;) {
        sum = 0u; cnt = 0u; mine = 0u;
#pragma unroll
        for (unsigned j = 0; j < 16; ++j) { const unsigned c = xb_ld(&bar[XB_XCNT(j)]); sum += c; cnt += (c > 0u) ? 1u : 0u; mine = (j == x) ? c : mine; }
        if (sum == G) break;
        __builtin_amdgcn_s_sleep(1);
        if ((++sp & 255u) == 0u) { if (xb_ld(&bar[XB_TMO])) break; if (sp > XB_SPIN_CAP) { atomicAdd(&bar[XB_TMO], 1u); break; } }
    }
    nloc = mine > 0u ? mine : 1u; nx = cnt > 0u ? cnt : 1u;
}
__device__ __forceinline__ void xcd_barrier(const XcdBarrier& b) {
    asm volatile("s_waitcnt vmcnt(0)" ::: "memory");
    __syncthreads();
    if (threadIdx.x == 0) {
        unsigned* bar = b.bar;
        __builtin_amdgcn_s_waitcnt(0);
        unsigned nloc = b.st[0], nx = b.st[1];
        if (nloc == 0u) { xcd_barrier_complete(bar, b.x, nloc, nx); b.st[0] = nloc; b.st[1] = nx; }
        const unsigned old = xb_add(&bar[XB_XSUB(b.x)], 1u);
        const unsigned gen = old / nloc;
        if (old + 1u == (gen + 1u) * nloc) {
            __builtin_amdgcn_fence(__ATOMIC_RELEASE, "agent");
            asm volatile("s_waitcnt vmcnt(0)" ::: "memory");
            const unsigned og = xb_add(&bar[XB_TOP], 1u);
            const unsigned tg = og / nx;
            if (og + 1u == (tg + 1u) * nx) xb_add(&bar[XB_TOPGEN], 1u);
            else XB_SPIN(xb_ld(&bar[XB_TOPGEN]) == tg, bar);
            __builtin_amdgcn_fence(__ATOMIC_ACQUIRE, "agent");
            xb_add(&bar[XB_XGEN(b.x)], 1u);
            asm volatile("s_waitcnt vmcnt(0)" ::: "memory");
        } else {
            XB_SPIN(xb_ld(&bar[XB_XGEN(b.x)]) == gen, bar);
            __builtin_amdgcn_fence(__ATOMIC_ACQUIRE, "agent");
            asm volatile("s_waitcnt vmcnt(0)" ::: "memory");
        }
    }
    __syncthreads();
}

#ifndef REP_PREP0
#define REP_PREP0 1
#endif
#ifndef REP_SMALL
#define REP_SMALL 1
#endif
#ifndef REP_GGRP
#define REP_GGRP 1
#endif
#ifndef REP_GGRP
#define REP_GGRP 1
#endif
#ifndef REP_SYNC
#define REP_SYNC 1
#endif
#ifndef REP_SCAN
#define REP_SCAN 1
#endif
#ifndef REP_GIN
#define REP_GIN 1
#endif
#ifndef REP_GOUT
#define REP_GOUT 1
#endif
#ifndef REP_ELEM
#define REP_ELEM 1
#endif
#define GSYNC() do { for (int _r = 0; _r < REP_SYNC; ++_r) xcd_barrier(xb); } while (0)
__global__ __launch_bounds__(512, 2) void hybrid_fwd(const float* i0, const float* i1, const float* i2, const float* i3, const float* i4, const float* i5, const float* i6, const float* i7,
        const float* i8, const float* i9, const float* i10, const float* i11, const float* i12, const float* i13, const float* i14, const float* i15, const float* i16, const float* i17,
        const float* i18, const float* i19, const float* i20, const float* i21, const float* i22, float* outp, unsigned char* wsp, WTab wt) {
    Params p;
    p.in[0] = i0; p.in[1] = i1; p.in[2] = i2; p.in[3] = i3; p.in[4] = i4; p.in[5] = i5; p.in[6] = i6; p.in[7] = i7; p.in[8] = i8; p.in[9] = i9; p.in[10] = i10; p.in[11] = i11;
    p.in[12] = i12; p.in[13] = i13; p.in[14] = i14; p.in[15] = i15; p.in[16] = i16; p.in[17] = i17; p.in[18] = i18; p.in[19] = i19; p.in[20] = i20; p.in[21] = i21; p.in[22] = i22;
    p.out = outp; p.ws = wsp;
    extern __shared__ __attribute__((aligned(16))) unsigned char smem[];
    LAS unsigned char* lds = (LAS unsigned char*)smem;
    cg::grid_group grid = cg::this_grid();
    unsigned char* ws = p.ws;
    volatile LAS unsigned* xst = (volatile LAS unsigned*)(lds + LDS_XB);
    if (threadIdx.x == 0) { xst[0] = 0u; xst[1] = 0u; }
    __syncthreads();
    const XcdBarrier xb = xcd_barrier_post((unsigned*)(ws + WS_BAR), xst);

    for (int rep = 0; rep < REP_PREP0; ++rep) phase_prep0(p, wt, lds);
    if (wt.wtiles < 0) grid.sync();
    xcd_barrier(xb);
#pragma unroll 1
    for (int mode_ = 0; mode_ < 2 * REP_SMALL; ++mode_) {
        const int mode = mode_ % 2;
        pg8::SmallSched S; S.mode = mode; S.G = (int)gridDim.x; S.c = (int)blockIdx.x; S.lda = 1024; S.ldb = 1024; S.K = 1024;
        S.A0 = (const char*)(ws + (mode == 0 ? WS_AC : WS_SHIFTA)); S.ada = (const char*)(ws + WS_WT_ADA); S.ssd_in = (const char*)(ws + WS_WT_SSD_IN); S.pool_in = (const char*)(ws + WS_WT_POOL_IN);
        EpiSmall E; E.mode = mode; E.mod = (float*)(ws + WS_MOD); E.ada_b = p.in[8]; E.shiftA = (bf16_t*)(ws + WS_SHIFTA); E.sb = (float*)(ws + WS_SB);
#ifndef NO_GSMALL
        pg8::gemm_phase<EpiSmall, pg8::SmallSched>(lds, S, E);
#endif
        if (mode == 1) phase_xprep(p);
        GSYNC();
    }
    unsigned* tailw = (unsigned*)(ws + WS_BAR) + 3584;
    unsigned* tmow = (unsigned*)(ws + WS_BAR) + XB_TMO;
#pragma unroll 1
    for (int layer = 0; layer < 4; ++layer) {
        const int j = layer >> 1; const bool ssd = (layer & 1) == 0;
        {
            pg8::InSched S;
            S.init(ssd ? 6400 : 4096, ws + WS_APRIME, ssd ? ws + WS_WT_SSD_IN + (size_t)j * 6400 * 1024 * 2 : ws + WS_WT_POOL_IN + (size_t)j * 4096 * 1024 * 2, layer > 0 ? tailw + 64 * (layer - 1) : nullptr, tmow);
            EpiIn E; E.ssq = (const float*)(ws + WS_SSQ) + (size_t)layer * 17408; E.sb = (const float*)(ws + WS_SB) + (size_t)layer * 136 * 6400; E.out = (bf16_t*)(ws + WS_ZX);
            E.ldo = ssd ? ZXW : 4096; E.nbf = ssd ? ZXW : 4096; E.dtraw = ssd ? (float*)(ws + WS_DTRAW) : nullptr;
            for (int rep = 0; rep < REP_GIN; ++rep) pg8::gemm_phase<EpiIn, pg8::InSched>(lds, S, E);
        }
        GSYNC();
        if (ssd) { for (int rep = 0; rep < REP_SCAN; ++rep) phase_scan(p, j, lds); } else { for (int rep = 0; rep < REP_ELEM; ++rep) phase_pool(p, j); }
        GSYNC();
        if (ssd) { for (int rep = 0; rep < REP_ELEM; ++rep) phase_ssdnorm(p, j); }
        else {
            pg8::MainSched S; S.init(MT, 2048, 512, 2048, 512, ws + WS_YG, ws + WS_WT_POOL_G + (size_t)j * 2048 * 512 * 2, 1);
            EpiGrp E; E.uz = (const bf16_t*)(ws + WS_ZX); E.chs = p.in[20] + (size_t)j * 2048; E.out = (bf16_t*)(ws + WS_A2);
            for (int rep = 0; rep < REP_GGRP; ++rep) pg8::gemm_phase<EpiGrp, pg8::MainSched>(lds, S, E);
        }
        GSYNC();
#pragma unroll 1
        for (int part = 0; part < 2; ++part) {
            pg8::MainSched S; S.init(part == 0 ? MP : MT, 1024, 2048, 2048, 2048, ws + WS_A2, ssd ? ws + WS_WT_SSD_OUT + (size_t)j * 1024 * 2048 * 2 : ws + WS_WT_POOL_OUT + (size_t)j * 1024 * 2048 * 2, 30, part);
            EpiOut E; float* xw = (float*)(ws + WS_XW);
            E.xin_p = layer == 0 ? p.in[0] : xw; E.xin_s = layer == 0 ? p.in[1] : xw + (size_t)MP * DM; E.xw = xw;
            E.modl = (const float*)(ws + WS_MOD) + (size_t)layer * 3072; E.ng_next = layer < 3 ? p.in[9] + (size_t)(layer + 1) * 1024 : nullptr;
            E.aprime = (bf16_t*)(ws + WS_APRIME); E.ssq = (float*)(ws + WS_SSQ) + (size_t)(layer + 1) * 17408;
            pg8::gemm_phase<EpiOut, pg8::MainSched>(lds, S, E);
            if (part == 0) GSYNC();
        }
        if (blockIdx.x < 16) {
            asm volatile("s_waitcnt vmcnt(0)" ::: "memory");
            __syncthreads();
            if (threadIdx.x == 0) { __builtin_amdgcn_fence(__ATOMIC_RELEASE, "agent"); asm volatile("s_waitcnt vmcnt(0)" ::: "memory"); __hip_atomic_fetch_add(tailw + 64 * layer, 1u, __ATOMIC_RELAXED, __HIP_MEMORY_SCOPE_AGENT); }
        }
    }
    phase_final(p, 0, MP, 16);
    GSYNC();
    phase_final(p, MP, MT, 0);
}

extern "C" void kernel_launch(void* const* d_in, const int* in_sizes, int n_in, void* d_out, int out_size, void* d_ws, size_t ws_size, hipStream_t stream) {
    static int grid = 0;
    if (grid == 0) {
        if (n_in != 23 || ws_size < WS_END) { fprintf(stderr, "kernel_launch: unexpected n_in %d or ws_size %zu (need %zu)\n", n_in, ws_size, (size_t)WS_END); grid = -1; return; }
        int dev = 0, cus = 0, per_cu = 0;
        hipGetDevice(&dev);
        hipDeviceGetAttribute(&cus, hipDeviceAttributeMultiprocessorCount, dev);
        if (hipFuncSetAttribute((const void*)hybrid_fwd, hipFuncAttributeMaxDynamicSharedMemorySize, LDS_BYTES) != hipSuccess) { fprintf(stderr, "kernel_launch: hipFuncSetAttribute failed\n"); grid = -1; return; }
        if (hipOccupancyMaxActiveBlocksPerMultiprocessor(&per_cu, (const void*)hybrid_fwd, 512, LDS_BYTES) != hipSuccess || per_cu < 1) { fprintf(stderr, "kernel_launch: occupancy query gave %d\n", per_cu); (void)hipGetLastError(); per_cu = 1; }
        if (cus < 256) { fprintf(stderr, "kernel_launch: needs a 256-CU device (got %d CUs)\n", cus); grid = -1; return; }
        grid = 256;
    }
    if (grid < 0) return;
    WTab wt{};
    unsigned char* ws = (unsigned char*)d_ws;
    int nj = 0, tb = 0;
    auto add = [&](int srci, long long soff, size_t dst_off, int K, int N, int Npad) {
        WJob& w = wt.wj[nj++]; w.src = (const float*)d_in[srci] + soff; w.doff = (long long)dst_off; w.K = K; w.N = N; w.tiles_n = Npad / 64; w.tile_begin = tb; tb += (K / 64) * (Npad / 64);
    };
    for (int i = 0; i < 4; ++i) add(7, (long long)i * 1024 * 3072, WS_WT_ADA + (size_t)i * 3072 * 1024 * 2, 1024, 3072, 3072);
    for (int j = 0; j < 2; ++j) add(10, (long long)j * 1024 * 6176, WS_WT_SSD_IN + (size_t)j * 6400 * 1024 * 2, 1024, 6176, 6400);
    for (int j = 0; j < 2; ++j) add(18, (long long)j * 1024 * 4096, WS_WT_POOL_IN + (size_t)j * 4096 * 1024 * 2, 1024, 4096, 4096);
    for (int j = 0; j < 2; ++j) add(17, (long long)j * 2048 * 1024, WS_WT_SSD_OUT + (size_t)j * 1024 * 2048 * 2, 2048, 1024, 1024);
    for (int j = 0; j < 2; ++j) add(21, (long long)j * 2048 * 1024, WS_WT_POOL_OUT + (size_t)j * 1024 * 2048 * 2, 2048, 1024, 1024);
    for (int q = 0; q < 8; ++q) add(19, (long long)q * 512 * 512, WS_WT_POOL_G + (size_t)q * 512 * 512 * 2, 512, 512, 512);
    wt.wtiles = tb;
    if (hipMemsetAsync(ws + WS_BAR, 0, 16384, stream) != hipSuccess) { fprintf(stderr, "kernel_launch: memset of the barrier words failed\n"); return; }
    const float* ip[23]; for (int i = 0; i < 23; ++i) ip[i] = (const float*)d_in[i];
    float* outp = (float*)d_out;
    void* args[26];
    for (int i = 0; i < 23; ++i) args[i] = (void*)&ip[i];
    args[23] = (void*)&outp; args[24] = (void*)&ws; args[25] = (void*)&wt;
    hipError_t e = hipLaunchCooperativeKernel((const void*)hybrid_fwd, dim3(grid), dim3(512), args, LDS_BYTES, stream);
    if (e != hipSuccess) fprintf(stderr, "cooperative launch failed: %s (grid %d)\n", hipGetErrorString(e), grid);
}
```

```cpp
#include <hip/hip_runtime.h>
#include <hip/hip_cooperative_groups.h>
#include <cstdio>
namespace cg = cooperative_groups;

#ifndef REP_PROMPT
#define REP_PROMPT 1
#endif
#define LAS __attribute__((address_space(3)))
typedef unsigned short bf16_t;
typedef short bf16x8 __attribute__((ext_vector_type(8)));
typedef float f32x4 __attribute__((ext_vector_type(4)));
typedef float f32x16 __attribute__((ext_vector_type(16)));
typedef unsigned u32x4 __attribute__((ext_vector_type(4)));
typedef unsigned u32x2 __attribute__((ext_vector_type(2)));
typedef float f32x2 __attribute__((ext_vector_type(2)));

constexpr int MP = 16384, MT = 17408, DM = 1024;
constexpr int ZXW = 6144;
constexpr size_t O_SSM_P = 17825792, O_CONV_P = 22020096, O_POOL_P = 22216704, O_SSM_S = 22708224, O_CONV_S = 89817088, O_POOL_S = 92962816;

constexpr size_t WS_WT_SSD_IN = 0;
constexpr size_t WS_WT_SSD_OUT = WS_WT_SSD_IN + 2ull * 6400 * 1024 * 2;
constexpr size_t WS_WT_POOL_IN = WS_WT_SSD_OUT + 2ull * 1024 * 2048 * 2;
constexpr size_t WS_WT_POOL_G = WS_WT_POOL_IN + 2ull * 4096 * 1024 * 2;
constexpr size_t WS_WT_POOL_OUT = WS_WT_POOL_G + 2ull * 2048 * 512 * 2;
constexpr size_t WS_WT_ADA = WS_WT_POOL_OUT + 2ull * 1024 * 2048 * 2;
constexpr size_t WS_AC = WS_WT_ADA + 12288ull * 1024 * 2;
constexpr size_t WS_SHIFTA = WS_AC + 256ull * 1024 * 2;
constexpr size_t WS_MOD = WS_SHIFTA + 4ull * 256 * 1024 * 2;
constexpr size_t WS_SB = WS_MOD + 136ull * 12288 * 4;
constexpr size_t WS_APRIME = WS_SB + 4ull * 136 * 6400 * 4;
constexpr size_t WS_SSQ = WS_APRIME + 17408ull * 1024 * 2;
constexpr size_t WS_XW = WS_SSQ + 17408ull * 16 * 4;
constexpr size_t WS_ZX = WS_XW + 17408ull * 1024 * 4;
constexpr size_t WS_DTRAW = WS_ZX + 17408ull * 6144 * 2;
constexpr size_t WS_YG = WS_DTRAW + 17408ull * 32 * 4;
constexpr size_t WS_A2 = WS_YG + 17408ull * 2048 * 2;
constexpr size_t WS_BAR = WS_A2 + 17408ull * 2048 * 2;
constexpr size_t WS_END = WS_BAR + 16384;

constexpr int LDS_XB = 149760;
constexpr int LDS_BYTES = 149776;

struct WJob { const float* src; long long doff; int K, N, tiles_n, tile_begin; };
struct WTab { WJob wj[20]; int wtiles; int pad0; };
constexpr int NWJ = 20;
struct Params {
    const float* in[23];
    float* out;
    unsigned char* ws;
};

__device__ __forceinline__ unsigned cvt_pk_bf16(float lo, float hi) { unsigned r; asm("v_cvt_pk_bf16_f32 %0, %1, %2" : "=v"(r) : "v"(lo), "v"(hi)); return r; }
__device__ __forceinline__ float bf_lo(unsigned u) { return __uint_as_float(u << 16); }
__device__ __forceinline__ float bf_hi(unsigned u) { return __uint_as_float(u & 0xffff0000u); }
__device__ __forceinline__ float bf2f(bf16_t b) { return __uint_as_float(((unsigned)b) << 16); }
__device__ __forceinline__ float silu_f(float v) { return v * __builtin_amdgcn_rcpf(1.f + __expf(-v)); }
__device__ __forceinline__ f32x2 silu2(f32x2 v) { const f32x2 e = v * (-1.44269504f); f32x2 d; d.x = __builtin_amdgcn_exp2f(e.x); d.y = __builtin_amdgcn_exp2f(e.y); d = d + 1.f; f32x2 r; r.x = __builtin_amdgcn_rcpf(d.x); r.y = __builtin_amdgcn_rcpf(d.y); return v * r; }
__device__ __forceinline__ float softplus_f(float v) { return v > 20.f ? v : log1pf(__expf(v)); }
__device__ __forceinline__ int otid() { int t = threadIdx.x; asm volatile("" : "+v"(t)); return t; }
__device__ __forceinline__ int row_b(int r) { return r < MP ? (r >> 11) : 8 + ((r - MP) >> 3); }
__device__ __forceinline__ u32x4 pack8(f32x4 a, f32x4 b) { u32x4 r; r.x = cvt_pk_bf16(a.x, a.y); r.y = cvt_pk_bf16(a.z, a.w); r.z = cvt_pk_bf16(b.x, b.y); r.w = cvt_pk_bf16(b.z, b.w); return r; }

namespace pg8 {
constexpr int BM = 256, BK = 64, HALF = 128, HTB = HALF * BK * 2, STAGE_BYTES = 8 * HTB, NXCD = 8, WGM = 8;
__device__ __forceinline__ int lds_byte(int r, int c) { const int st = (r >> 4) * 2 + (c >> 5), rr = r & 15, cc = c & 31, ob = rr * 64 + cc * 2; return st * 1024 + (ob ^ (((ob >> 9) & 1) << 5)); }
__device__ __forceinline__ void stage_rc(int b, int& R, int& C) { const int st = b / 1024, sb = b % 1024, swz = sb ^ (((sb >> 9) & 1) << 5); R = (st >> 1) * 16 + swz / 64; C = (st & 1) * 32 + (swz % 64) / 2; }
__device__ __forceinline__ int perm32(int rho) { const int n = rho >> 4, i = rho & 15; return 8 * (i >> 2) + 4 * n + (i & 3); }

struct Unit { int pm, pn, q; const char* A; const char* B; };

__device__ __forceinline__ void static_unit(int L, int nM, int nN, int& pm, int& pn) {
    const int nwg = nM * nN;
    int wgid = L; { const int q = nwg / NXCD, r = nwg % NXCD, xcd = wgid % NXCD, off = wgid / NXCD; wgid = (xcd < r ? xcd * (q + 1) : r * (q + 1) + (xcd - r) * q) + off; }
    const int nig = WGM * nN, gid = wgid / nig, fm = gid * WGM, gsz = (nM - fm) < WGM ? (nM - fm) : WGM;
    pm = fm + ((wgid % nig) % gsz); pn = (wgid % nig) / gsz;
}
struct MainSched {
    int nM, nN, nwg, G, c, lda, ldb, K, gsh, single;
    const char* A; const char* Bt;
    __device__ void init(int M, int N, int K_, int lda_, int ldb_, const void* A_, const void* Bt_, int gsh_, int single_ = 0) {
        nM = M / BM; nN = N / BM; nwg = nM * nN; G = (int)gridDim.x; c = (int)blockIdx.x; lda = lda_; ldb = ldb_; K = K_; A = (const char*)A_; Bt = (const char*)Bt_; gsh = gsh_; single = single_;
    }
    __device__ bool next(int i, Unit& u) const {
        if (single) { if (i > 0 || c >= 16) return false; u.pm = 64 + (c >> 2); u.pn = c & 3; }
        else { const long L = (long)i * G + c; if (L >= nwg) return false; static_unit((int)L, nM, nN, u.pm, u.pn); }
        u.q = 0;
        u.A = A + ((size_t)u.pm * BM * lda + (size_t)(u.pn >> gsh) * 512) * 2;
        u.B = Bt + (size_t)u.pn * BM * ldb * 2;
        return true;
    }
    __device__ __forceinline__ void a_ready(const Unit&) const {}
};
struct InSched {
    int nN, nP, E, nskip, c, r0, cnt, lda, ldb, K;
    const char* A; const char* Bt; unsigned* tail; unsigned* tmo;
    __device__ void init(int N, const void* A_, const void* Bt_, unsigned* tail_, unsigned* tmo_) {
        nN = N / BM; nP = 64 * nN; c = (int)blockIdx.x; lda = 1024; ldb = 1024; K = 1024; A = (const char*)A_; Bt = (const char*)Bt_; tail = tail_; tmo = tmo_;
        nskip = tail_ != nullptr ? 32 : 0; E = nskip + 4 * nN; r0 = (tail_ != nullptr && c < 16) ? 2 : 0;
        const int tot = (nP - c + 255) / 256; cnt = tot - r0 > 0 ? tot - r0 : 0;
    }
    __device__ bool next(int i, Unit& u) const {
        if (i < cnt) static_unit((i + r0) * 256 + c, 64, nN, u.pm, u.pn);
        else {
            if (c < 16) return false;
            const int e = 255 - c + 240 * (i - cnt); if (e >= E) return false;
            if (e < nskip) static_unit(e < 16 ? e : 256 + (e - 16), 64, nN, u.pm, u.pn);
            else { const int sidx = e - nskip; u.pm = 64 + sidx / nN; u.pn = sidx - (sidx / nN) * nN; }
        }
        u.q = 0;
        u.A = A + (size_t)u.pm * BM * 1024 * 2; u.B = Bt + (size_t)u.pn * BM * 1024 * 2;
        return true;
    }
    __device__ __forceinline__ void a_ready(const Unit& u) const {
        if (tail == nullptr || u.pm < 64) return;
        if (threadIdx.x < 64) {
            unsigned polls = 0;
            while ((unsigned)__builtin_amdgcn_readfirstlane(__hip_atomic_load(tail, __ATOMIC_RELAXED, __HIP_MEMORY_SCOPE_AGENT)) < 16u) {
                __builtin_amdgcn_s_sleep(2);
                if ((++polls & 255u) == 0u) { if (__builtin_amdgcn_readfirstlane(__hip_atomic_load(tmo, __ATOMIC_RELAXED, __HIP_MEMORY_SCOPE_AGENT)) != 0u) break; if (polls > (1u << 22)) { if (threadIdx.x == 0) atomicAdd(tmo, 1u); break; } }
            }
            __builtin_amdgcn_fence(__ATOMIC_ACQUIRE, "agent");
            asm volatile("s_waitcnt vmcnt(0)" ::: "memory");
        }
        asm volatile("" ::: "memory"); __builtin_amdgcn_s_barrier(); asm volatile("" ::: "memory");
    }
};
struct SmallSched {
    int mode, G, c, lda, ldb, K;
    const char* A0; const char* ada; const char* ssd_in; const char* pool_in;
    __device__ bool next(int i, Unit& u) const {
        const long L = (long)i * G + c;
        u.pm = 0;
        if (mode == 0) { if (L >= 48) return false; u.pn = (int)L; u.q = 0; u.A = A0; u.B = ada + (size_t)u.pn * BM * 1024 * 2; return true; }
        if (L >= 82) return false;
        int l = (int)L, q, pn;
        if (l < 25) { q = 0; pn = l; } else if (l < 41) { q = 1; pn = l - 25; } else if (l < 66) { q = 2; pn = l - 41; } else { q = 3; pn = l - 66; }
        u.q = q; u.pn = pn; u.A = A0 + (size_t)q * 256 * 1024 * 2;
        u.B = ((q & 1) ? pool_in + (size_t)(q >> 1) * 4096 * 1024 * 2 : ssd_in + (size_t)(q >> 1) * 6400 * 1024 * 2) + (size_t)pn * BM * 1024 * 2;
        return true;
    }
    __device__ __forceinline__ void a_ready(const Unit&) const {}
};

template <class Epi, class Sched>
__device__ __forceinline__ void gemm_phase(LAS unsigned char* lds, const Sched& S, const Epi& E) {
    const int tid = otid(), wid = __builtin_amdgcn_readfirstlane(tid >> 6), lane = tid & 63, wr = wid >> 2, wc = wid & 3, fr = lane & 15, fq = lane >> 4;
    const int K = S.K, nt = K / BK;
    unsigned voffA[2], voffB[2];
#pragma unroll
    for (int i = 0; i < 2; ++i) { int R, C; stage_rc(tid * 16 + i * 8192, R, C); const int Rb = Epi::PERM ? ((R & ~31) + perm32(R & 31)) : R;
        voffA[i] = (unsigned)(R * S.lda + C) * 2u; voffB[i] = (unsigned)(Rb * S.ldb + C) * 2u; }
    const size_t kstep = (size_t)(BK * 2);
    const size_t hstepA = (size_t)HALF * S.lda * 2, hstepB = (size_t)HALF * S.ldb * 2;
    const unsigned ldsw = (unsigned)wid * 1024u;
    const int aoff = lds_byte(wr * 64 + fr, fq * 8), boff = lds_byte(wc * 32 + fr, fq * 8);
#define PG8_SA(b, h) (((b) * 2 + (h)) * HTB)
#define PG8_SB(b, h) ((4 + (b) * 2 + (h)) * HTB)
#define PG8_STAGE(bufoff, gbase, voff) do { _Pragma("unroll") for (int _i = 0; _i < 2; ++_i) \
        __builtin_amdgcn_global_load_lds((const unsigned*)((const char*)(gbase) + (voff)[_i]), (LAS unsigned*)(lds + (bufoff) + ldsw + _i * 8192), 16, 0, 0); } while (0)
#define PG8_LDA(dst, b, h) do { _Pragma("unroll") for (int m = 0; m < 4; ++m) _Pragma("unroll") for (int k = 0; k < 2; ++k) dst[m][k] = *(const LAS bf16x8*)(lds + PG8_SA(b, h) + aoff + m * 2048 + k * 1024); } while (0)
#define PG8_LDB(dst, b, h) do { _Pragma("unroll") for (int n = 0; n < 2; ++n) _Pragma("unroll") for (int k = 0; k < 2; ++k) dst[n][k] = *(const LAS bf16x8*)(lds + PG8_SB(b, h) + boff + n * 2048 + k * 1024); } while (0)
#define PG8_MMA(ai, bj, At, Bt) do { __builtin_amdgcn_s_setprio(1); _Pragma("unroll") for (int m = 0; m < 4; ++m) _Pragma("unroll") for (int n = 0; n < 2; ++n) _Pragma("unroll") for (int k = 0; k < 2; ++k) \
        acc[ai][bj][m][n] = __builtin_amdgcn_mfma_f32_16x16x32_bf16(Bt[n][k], At[m][k], acc[ai][bj][m][n], 0, 0, 0); __builtin_amdgcn_s_setprio(0); } while (0)
#define PG8_WAIT_V(n) asm volatile("s_waitcnt vmcnt(" #n ")" ::: "memory")
#define PG8_WAIT_L(n) asm volatile("s_waitcnt lgkmcnt(" #n ")" ::: "memory")
#define PG8_BAR __builtin_amdgcn_s_barrier()
#define PG8_SCHED __builtin_amdgcn_sched_barrier(0)
    Unit cur, nxt; int ui = 0;
    if (!S.next(0, cur)) return;
    f32x4 acc[2][2][4][2];
#pragma unroll
    for (int a = 0; a < 2; ++a)
#pragma unroll
        for (int b = 0; b < 2; ++b)
#pragma unroll
            for (int m = 0; m < 4; ++m)
#pragma unroll
                for (int n = 0; n < 2; ++n) acc[a][b][m][n] = (f32x4){0.f, 0.f, 0.f, 0.f};
    bf16x8 At[4][2], B0[2][2], B1[2][2];
    const char* cA = cur.A; const char* cB = cur.B;
    S.a_ready(cur);
    PG8_STAGE(PG8_SB(0, 0), cB, voffB); PG8_STAGE(PG8_SA(0, 0), cA, voffA); PG8_STAGE(PG8_SB(0, 1), cB + hstepB, voffB); PG8_STAGE(PG8_SA(0, 1), cA + hstepA, voffA);
    if (wr == 1) PG8_BAR;
    PG8_WAIT_V(4); PG8_BAR;
    PG8_STAGE(PG8_SB(1, 0), cB + kstep, voffB); PG8_STAGE(PG8_SA(1, 0), cA + kstep, voffA); PG8_STAGE(PG8_SB(1, 1), cB + hstepB + kstep, voffB);
    PG8_WAIT_V(6); PG8_BAR;
    for (;;) {
        const bool has_next = S.next(ui + 1, nxt);
        const char* nA = has_next ? nxt.A : cA; const char* nB = has_next ? nxt.B : cB;
        for (int t = 0; t < nt; t += 2) {
            const bool last = (t == nt - 2);
            const char* a1 = cA + (size_t)(t + 1) * kstep;
            const char* a2 = last ? nA : cA + (size_t)(t + 2) * kstep; const char* b2 = last ? nB : cB + (size_t)(t + 2) * kstep;
            const char* a3 = a2 + kstep; const char* b3 = b2 + kstep;
            if (last && has_next) S.a_ready(nxt);
            PG8_LDB(B0, 0, 0); PG8_SCHED; PG8_LDA(At, 0, 0); PG8_STAGE(PG8_SA(1, 1), a1 + hstepA, voffA);
            PG8_WAIT_L(8); PG8_BAR; PG8_WAIT_L(0); PG8_MMA(0, 0, At, B0); PG8_BAR; PG8_SCHED;
            PG8_LDB(B1, 0, 1); PG8_STAGE(PG8_SB(0, 0), b2, voffB);
            PG8_BAR; PG8_WAIT_L(0); PG8_MMA(0, 1, At, B1); PG8_BAR;
            PG8_LDA(At, 0, 1); PG8_STAGE(PG8_SA(0, 0), a2, voffA);
            PG8_BAR; PG8_WAIT_L(0); PG8_MMA(1, 0, At, B0); PG8_BAR; PG8_SCHED;
            PG8_STAGE(PG8_SB(0, 1), b2 + hstepB, voffB);
            PG8_WAIT_V(6); PG8_BAR; PG8_MMA(1, 1, At, B1); PG8_BAR;
            PG8_LDB(B0, 1, 0); PG8_SCHED; PG8_LDA(At, 1, 0); PG8_STAGE(PG8_SA(0, 1), a2 + hstepA, voffA);
            PG8_WAIT_L(8); PG8_BAR; PG8_WAIT_L(0); PG8_MMA(0, 0, At, B0); PG8_BAR; PG8_SCHED;
            PG8_LDB(B1, 1, 1); PG8_STAGE(PG8_SB(1, 0), b3, voffB);
            PG8_BAR; PG8_WAIT_L(0); PG8_MMA(0, 1, At, B1); PG8_BAR;
            PG8_LDA(At, 1, 1); PG8_STAGE(PG8_SA(1, 0), a3, voffA);
            PG8_BAR; PG8_WAIT_L(0); PG8_MMA(1, 0, At, B0); PG8_BAR; PG8_SCHED;
            PG8_STAGE(PG8_SB(1, 1), b3 + hstepB, voffB);
            PG8_WAIT_V(6); PG8_BAR; PG8_MMA(1, 1, At, B1); PG8_BAR;
        }
        E(acc, cur, wr, wc, fr, fq);
        if (!has_next) break;
#pragma unroll
        for (int a = 0; a < 2; ++a)
#pragma unroll
            for (int b = 0; b < 2; ++b)
#pragma unroll
                for (int m = 0; m < 4; ++m)
#pragma unroll
                    for (int n = 0; n < 2; ++n) acc[a][b][m][n] = (f32x4){0.f, 0.f, 0.f, 0.f};
        cur = nxt; cA = nA; cB = nB; ++ui;
    }
    PG8_WAIT_V(0);
    if (wr == 0) PG8_BAR;
    PG8_BAR;
#undef PG8_SA
#undef PG8_SB
#undef PG8_STAGE
#undef PG8_LDA
#undef PG8_LDB
#undef PG8_MMA
#undef PG8_WAIT_V
#undef PG8_WAIT_L
#undef PG8_BAR
#undef PG8_SCHED
}
}
using pg8::Unit;

struct EpiIn {
    static constexpr bool PERM = true;
    const float* ssq; const float* sb; bf16_t* out; int ldo, nbf; float* dtraw;
    template <bool UNI>
    __device__ __forceinline__ void body(const f32x4 (&acc)[2][2][4][2], const Unit& u, int wr, int wc, int fr, int fq) const {
        const int row0 = u.pm * 256 + wr * 64 + fr, colt = u.pn * 256 + wc * 32 + 8 * fq;
        f32x4 ub[2][2];
        if (UNI) {
            const float* sbr = sb + (size_t)(u.pm >> 3) * 6400;
#pragma unroll
            for (int bj = 0; bj < 2; ++bj) { const int c = colt + bj * 128; if (c < nbf + 32) { ub[bj][0] = *(const f32x4*)(sbr + c); ub[bj][1] = *(const f32x4*)(sbr + c + 4); } }
        }
        float rsv[2][4];
#pragma unroll
        for (int ai = 0; ai < 2; ++ai)
#pragma unroll
            for (int m = 0; m < 4; ++m) rsv[ai][m] = ssq[row0 + ai * 128 + m * 16];
#pragma unroll
        for (int ai = 0; ai < 2; ++ai) {
            f32x4 nb[4][2][2];
            if (!UNI) {
#pragma unroll
                for (int m = 0; m < 4; ++m) {
                    const float* sbr = sb + (size_t)row_b(row0 + ai * 128 + m * 16) * 6400;
#pragma unroll
                    for (int bj = 0; bj < 2; ++bj) { const int c = colt + bj * 128; if (c < nbf + 32) { nb[m][bj][0] = *(const f32x4*)(sbr + c); nb[m][bj][1] = *(const f32x4*)(sbr + c + 4); } }
                }
            }
#pragma unroll
            for (int m = 0; m < 4; ++m) {
                const int r = row0 + ai * 128 + m * 16;
                const float rstd = rsqrtf(rsv[ai][m] * (1.f / 1024.f) + 1e-6f);
#pragma unroll
                for (int bj = 0; bj < 2; ++bj) {
                    const int c = colt + bj * 128;
                    if (c < nbf + 32) {
                        f32x4 b0, b1;
                        if (UNI) { b0 = ub[bj][0]; b1 = ub[bj][1]; } else { b0 = nb[m][bj][0]; b1 = nb[m][bj][1]; }
                        const f32x4 v0 = acc[ai][bj][m][0] * rstd + b0, v1 = acc[ai][bj][m][1] * rstd + b1;
                        if (c < nbf) *(u32x4*)(out + (size_t)r * ldo + c) = pack8(v0, v1);
                        else if (dtraw != nullptr) { float* dp = dtraw + (size_t)r * 32 + (c - nbf); *(f32x4*)dp = v0; *(f32x4*)(dp + 4) = v1; }
                    }
                }
            }
        }
    }
    __device__ __forceinline__ void operator()(const f32x4 (&acc)[2][2][4][2], const Unit& u, int wr, int wc, int fr, int fq) const {
        asm volatile("" : "+v"(fr), "+v"(fq));
        if (u.pm < 64) body<true>(acc, u, wr, wc, fr, fq); else body<false>(acc, u, wr, wc, fr, fq);
    }
};
struct EpiOut {
    static constexpr bool PERM = true;
    const float* xin_p; const float* xin_s; float* xw; const float* modl; const float* ng_next; bf16_t* aprime; float* ssq;
    template <bool UNI>
    __device__ __forceinline__ void body(const f32x4 (&acc)[2][2][4][2], const Unit& u, int wr, int wc, int fr, int fq) const {
        const int row0 = u.pm * 256 + wr * 64 + fr, colt = u.pn * 256 + wc * 32 + 8 * fq;
        const bool has_next = ng_next != nullptr;
        f32x4 ug[2][2], us[2][2], uw[2][2];
#pragma unroll
        for (int bj = 0; bj < 2; ++bj) {
            const int c = colt + bj * 128;
            if (has_next) { uw[bj][0] = *(const f32x4*)(ng_next + c); uw[bj][1] = *(const f32x4*)(ng_next + c + 4); }
            if (UNI) {
                const float* mb = modl + (size_t)(u.pm >> 3) * 12288;
                ug[bj][0] = *(const f32x4*)(mb + 2048 + c) + 1.f; ug[bj][1] = *(const f32x4*)(mb + 2048 + c + 4) + 1.f;
                if (has_next) { us[bj][0] = (*(const f32x4*)(mb + 4096 + c) + 1.f) * uw[bj][0]; us[bj][1] = (*(const f32x4*)(mb + 4096 + c + 4) + 1.f) * uw[bj][1]; }
            }
        }
#pragma unroll
        for (int ai = 0; ai < 2; ++ai)
#pragma unroll
            for (int mp = 0; mp < 2; ++mp) {
                f32x4 xv[2][2][2];
#pragma unroll
                for (int mm = 0; mm < 2; ++mm) {
                    const int r = row0 + ai * 128 + (mp * 2 + mm) * 16;
                    const float* xr = r < MP ? xin_p + (size_t)r * DM : xin_s + (size_t)(r - MP) * DM;
#pragma unroll
                    for (int bj = 0; bj < 2; ++bj) { xv[mm][bj][0] = *(const f32x4*)(xr + colt + bj * 128); xv[mm][bj][1] = *(const f32x4*)(xr + colt + bj * 128 + 4); }
                }
#pragma unroll
                for (int mm = 0; mm < 2; ++mm) {
                    const int m = mp * 2 + mm;
                    const int r = row0 + ai * 128 + m * 16;
                    const float* mb = modl + (size_t)row_b(r) * 12288;
                    float ss = 0.f;
#pragma unroll
                    for (int bj = 0; bj < 2; ++bj) {
                        const int c = colt + bj * 128;
                        f32x4 g0, g1;
                        if (UNI) { g0 = ug[bj][0]; g1 = ug[bj][1]; } else { g0 = *(const f32x4*)(mb + 2048 + c) + 1.f; g1 = *(const f32x4*)(mb + 2048 + c + 4) + 1.f; }
                        const f32x4 n0 = xv[mm][bj][0] + g0 * acc[ai][bj][m][0], n1 = xv[mm][bj][1] + g1 * acc[ai][bj][m][1];
                        *(f32x4*)(xw + (size_t)r * DM + c) = n0; *(f32x4*)(xw + (size_t)r * DM + c + 4) = n1;
                        ss += (n0.x * n0.x + n0.y * n0.y) + (n0.z * n0.z + n0.w * n0.w) + (n1.x * n1.x + n1.y * n1.y) + (n1.z * n1.z + n1.w * n1.w);
                        if (has_next) {
                            f32x4 s0, s1;
                            if (UNI) { s0 = us[bj][0]; s1 = us[bj][1]; } else { s0 = (*(const f32x4*)(mb + 4096 + c) + 1.f) * uw[bj][0]; s1 = (*(const f32x4*)(mb + 4096 + c + 4) + 1.f) * uw[bj][1]; }
                            *(u32x4*)(aprime + (size_t)r * DM + c) = pack8(n0 * s0, n1 * s1);
                        }
                    }
                    ss += __shfl_xor(ss, 16); ss += __shfl_xor(ss, 32);
                    if (fq == 0) atomicAdd(ssq + r, ss);
                }
            }
    }
    __device__ __forceinline__ void operator()(const f32x4 (&acc)[2][2][4][2], const Unit& u, int wr, int wc, int fr, int fq) const {
        asm volatile("" : "+v"(fr), "+v"(fq));
        if (u.pm < 64) body<true>(acc, u, wr, wc, fr, fq); else body<false>(acc, u, wr, wc, fr, fq);
    }
};
struct EpiGrp {
    static constexpr bool PERM = true;
    const bf16_t* uz; const float* chs; bf16_t* out;
    __device__ __forceinline__ void operator()(const f32x4 (&acc)[2][2][4][2], const Unit& u, int wr, int wc, int fr, int fq) const {
        asm volatile("" : "+v"(fr), "+v"(fq));
        const int row0 = u.pm * 256 + wr * 64 + fr, colt = u.pn * 256 + wc * 32 + 8 * fq;
        f32x4 cs[2][2];
#pragma unroll
        for (int bj = 0; bj < 2; ++bj) { cs[bj][0] = *(const f32x4*)(chs + colt + bj * 128); cs[bj][1] = *(const f32x4*)(chs + colt + bj * 128 + 4); }
#pragma unroll
        for (int ai = 0; ai < 2; ++ai) {
            u32x4 zz[4][2];
#pragma unroll
            for (int m = 0; m < 4; ++m)
#pragma unroll
                for (int bj = 0; bj < 2; ++bj) zz[m][bj] = *(const u32x4*)(uz + (size_t)(row0 + ai * 128 + m * 16) * 4096 + 2048 + colt + bj * 128);
#pragma unroll
            for (int m = 0; m < 4; ++m) {
                const int r = row0 + ai * 128 + m * 16;
#pragma unroll
                for (int bj = 0; bj < 2; ++bj) {
                    const int c = colt + bj * 128;
                    const u32x4 z = zz[m][bj];
                    const f32x2 a = silu2((f32x2){bf_lo(z.x), bf_hi(z.x)}), b = silu2((f32x2){bf_lo(z.y), bf_hi(z.y)}), cc = silu2((f32x2){bf_lo(z.z), bf_hi(z.z)}), d = silu2((f32x2){bf_lo(z.w), bf_hi(z.w)});
                    const f32x4 z0 = {a.x, a.y, b.x, b.y}, z1 = {cc.x, cc.y, d.x, d.y};
                    *(u32x4*)(out + (size_t)r * 2048 + c) = pack8(acc[ai][bj][m][0] * cs[bj][0] * z0, acc[ai][bj][m][1] * cs[bj][1] * z1);
                }
            }
        }
    }
};
struct EpiSmall {
    static constexpr bool PERM = true;
    int mode; float* mod; const float* ada_b; bf16_t* shiftA; float* sb;
    __device__ __forceinline__ void operator()(const f32x4 (&acc)[2][2][4][2], const Unit& u, int wr, int wc, int fr, int fq) const {
        asm volatile("" : "+v"(fr), "+v"(fq));
        const int row0 = wr * 64 + fr, colt = u.pn * 256 + wc * 32 + 8 * fq;
#pragma unroll
        for (int ai = 0; ai < 2; ++ai)
#pragma unroll
            for (int m = 0; m < 4; ++m) {
                const int r = row0 + ai * 128 + m * 16;
                if (r < 136) {
#pragma unroll
                    for (int bj = 0; bj < 2; ++bj) {
                        const int c = colt + bj * 128;
                        if (mode == 0) {
                            const f32x4 v0 = acc[ai][bj][m][0] + *(const f32x4*)(ada_b + c), v1 = acc[ai][bj][m][1] + *(const f32x4*)(ada_b + c + 4);
                            *(f32x4*)(mod + (size_t)r * 12288 + c) = v0; *(f32x4*)(mod + (size_t)r * 12288 + c + 4) = v1;
                            const int li = c / 3072, cc = c - li * 3072;
                            if (cc < 1024) *(u32x4*)(shiftA + ((size_t)li * 256 + r) * 1024 + cc) = pack8(v0, v1);
                        } else {
                            float* sp = sb + ((size_t)u.q * 136 + r) * 6400 + c;
                            *(f32x4*)sp = acc[ai][bj][m][0]; *(f32x4*)(sp + 4) = acc[ai][bj][m][1];
                        }
                    }
                }
            }
    }
};

__device__ void phase_prep0(const Params& p, const WTab& wt, LAS unsigned char* lds) {
    LAS float* tl = (LAS float*)lds;
    const int tid = otid();
    for (int tile = blockIdx.x; tile < wt.wtiles; tile += gridDim.x) {
        int j = 0;
#pragma unroll 1
        for (int q = 1; q < NWJ; ++q) if (tile >= wt.wj[q].tile_begin) j = q;
        const WJob job = wt.wj[j];
        bf16_t* jdst = (bf16_t*)(p.ws + job.doff);
        const int lt = tile - job.tile_begin, tk = lt / job.tiles_n, tn = lt - tk * job.tiles_n, k0 = tk * 64, n0 = tn * 64;
        {
            const int kk = tid >> 3, nn = (tid & 7) * 8;
            f32x4 a = (f32x4){0.f, 0.f, 0.f, 0.f}, b = a;
            if (n0 + nn < job.N) { const __attribute__((address_space(1))) f32x4* sp = (const __attribute__((address_space(1))) f32x4*)(job.src + (size_t)(k0 + kk) * job.N + n0 + nn); a = sp[0]; b = sp[1]; }
            LAS float* d = tl + kk * 65 + nn;
            d[0] = a.x; d[1] = a.y; d[2] = a.z; d[3] = a.w; d[4] = b.x; d[5] = b.y; d[6] = b.z; d[7] = b.w;
        }
        __syncthreads();
        {
            const int n = tid >> 3, k8 = (tid & 7) * 8;
            const LAS float* s = tl + k8 * 65 + n;
            u32x4 o; o.x = cvt_pk_bf16(s[0], s[65]); o.y = cvt_pk_bf16(s[130], s[195]); o.z = cvt_pk_bf16(s[260], s[325]); o.w = cvt_pk_bf16(s[390], s[455]);
            *(u32x4*)(jdst + (size_t)(n0 + n) * job.K + k0 + k8) = o;
        }
        __syncthreads();
    }
    bf16_t* ac = (bf16_t*)(p.ws + WS_AC);
    const int gt = blockIdx.x * 512 + tid, nth = gridDim.x * 512;
    for (int i = gt; i < 256 * 1024 / 8; i += nth) {
        const int r = i >> 7, c = (i & 127) * 8;
        u32x4 o = (u32x4){0u, 0u, 0u, 0u};
        if (r < 136) {
            const float* cp = r < 8 ? p.in[5] + (size_t)r * 1024 + c : p.in[6] + (size_t)(r - 8) * 1024 + c;
            const f32x4 a = *(const f32x4*)cp, b = *(const f32x4*)(cp + 4);
            o.x = cvt_pk_bf16(silu_f(a.x), silu_f(a.y)); o.y = cvt_pk_bf16(silu_f(a.z), silu_f(a.w)); o.z = cvt_pk_bf16(silu_f(b.x), silu_f(b.y)); o.w = cvt_pk_bf16(silu_f(b.z), silu_f(b.w));
        }
        *(u32x4*)(ac + (size_t)i * 8) = o;
    }
    { u32x4* sq = (u32x4*)(p.ws + WS_SSQ + 17408ull * 4); for (int i = gt; i < 4 * 17408 / 4; i += nth) sq[i] = (u32x4){0u, 0u, 0u, 0u}; }
    u32x4* sh = (u32x4*)(p.ws + WS_SHIFTA);
    for (int i = gt; i < 4 * 256 * 1024 / 8; i += nth) sh[i] = (u32x4){0u, 0u, 0u, 0u};
}

__device__ void phase_xprep(const Params& p, int blk0) {
    if ((int)blockIdx.x < blk0) return;
    const int tid_ = otid(), lane = tid_ & 63, wv = ((int)blockIdx.x - blk0) * 8 + (tid_ >> 6), nw = ((int)gridDim.x - blk0) * 8;
    const float* mod = (const float*)(p.ws + WS_MOD);
    bf16_t* ap = (bf16_t*)(p.ws + WS_APRIME);
    float* ssq = (float*)(p.ws + WS_SSQ);
    const float* ng = p.in[9];
    for (int r0 = wv * 2; r0 < MT; r0 += nw * 2) {
        f32x4 x[2][4];
#pragma unroll
        for (int h = 0; h < 2; ++h) {
            const int r = r0 + h;
            const float* xr = r < MP ? p.in[0] + (size_t)r * DM : p.in[1] + (size_t)(r - MP) * DM;
#pragma unroll
            for (int q = 0; q < 4; ++q) x[h][q] = *(const f32x4*)(xr + q * 256 + lane * 4);
        }
#pragma unroll
        for (int h = 0; h < 2; ++h) {
            const int r = r0 + h;
            const float* mb = mod + (size_t)row_b(r) * 12288 + 1024;
            float ss = 0.f;
#pragma unroll
            for (int q = 0; q < 4; ++q) {
                const int c = q * 256 + lane * 4;
                const f32x4 xv = x[h][q], sv = *(const f32x4*)(mb + c), g = *(const f32x4*)(ng + c);
                ss += (xv.x * xv.x + xv.y * xv.y) + (xv.z * xv.z + xv.w * xv.w);
                const f32x4 a = xv * g * (sv + 1.f);
                u32x2 o; o.x = cvt_pk_bf16(a.x, a.y); o.y = cvt_pk_bf16(a.z, a.w);
                *(u32x2*)(ap + (size_t)r * DM + c) = o;
            }
#pragma unroll
            for (int o = 1; o < 64; o <<= 1) ss += __shfl_xor(ss, o);
            if (lane == 0) ssq[r] = ss;
        }
    }
}

__device__ void phase_final(const Params& p, int r_begin, int r_end, int blk0) {
    if ((int)blockIdx.x < blk0) return;
    const int tid_ = otid(), lane = tid_ & 63, wv = ((int)blockIdx.x - blk0) * 8 + (tid_ >> 6), nw = ((int)gridDim.x - blk0) * 8;
    const float* xw = (const float*)(p.ws + WS_XW);
    const float* ssq = (const float*)(p.ws + WS_SSQ) + 4 * 17408;
    const float* fg = p.in[22];
    for (int r0 = r_begin + wv * 2; r0 < r_end; r0 += nw * 2) {
        f32x4 x[2][4];
#pragma unroll
        for (int h = 0; h < 2; ++h)
#pragma unroll
            for (int q = 0; q < 4; ++q) x[h][q] = *(const f32x4*)(xw + (size_t)(r0 + h) * DM + q * 256 + lane * 4);
#pragma unroll
        for (int h = 0; h < 2; ++h) {
            const int r = r0 + h;
            const float rstd = rsqrtf(ssq[r] * (1.f / 1024.f) + 1e-6f);
#pragma unroll
            for (int q = 0; q < 4; ++q) {
                const int c = q * 256 + lane * 4;
                const f32x4 g = *(const f32x4*)(fg + c);
                *(f32x4*)(p.out + (size_t)r * DM + c) = x[h][q] * rstd * g;
            }
        }
    }
}

__device__ void phase_ssdnorm(const Params& p, int j) {
    const int tid_ = otid(), lane = tid_ & 63, wv = blockIdx.x * 8 + (tid_ >> 6), nw = gridDim.x * 8;
    const bf16_t* yg = (const bf16_t*)(p.ws + WS_YG);
    bf16_t* a2 = (bf16_t*)(p.ws + WS_A2);
    const float* ng = p.in[16] + (size_t)j * 2048;
    for (int r0 = wv * 2; r0 < MT; r0 += nw * 2) {
        u32x4 vv[2][4];
#pragma unroll
        for (int h = 0; h < 2; ++h)
#pragma unroll
            for (int q = 0; q < 4; ++q) vv[h][q] = *(const u32x4*)(yg + (size_t)(r0 + h) * 2048 + q * 512 + lane * 8);
#pragma unroll
        for (int h = 0; h < 2; ++h)
#pragma unroll
            for (int q = 0; q < 4; ++q) {
                const int c = q * 512 + lane * 8;
                const u32x4 v = vv[h][q];
                f32x4 a, b;
                a.x = bf_lo(v.x); a.y = bf_hi(v.x); a.z = bf_lo(v.y); a.w = bf_hi(v.y); b.x = bf_lo(v.z); b.y = bf_hi(v.z); b.z = bf_lo(v.w); b.w = bf_hi(v.w);
                float ss = (a.x * a.x + a.y * a.y) + (a.z * a.z + a.w * a.w) + (b.x * b.x + b.y * b.y) + (b.z * b.z + b.w * b.w);
#pragma unroll
                for (int o = 1; o < 32; o <<= 1) ss += __shfl_xor(ss, o);
                const float rstd = rsqrtf(ss * (1.f / 256.f) + 1e-6f);
                const f32x4 g0 = *(const f32x4*)(ng + c), g1 = *(const f32x4*)(ng + c + 4);
                *(u32x4*)(a2 + (size_t)(r0 + h) * 2048 + c) = pack8(a * rstd * g0, b * rstd * g1);
            }
    }
}

__device__ void phase_pool(const Params& p, int j) {
    const bf16_t* uz = (const bf16_t*)(p.ws + WS_ZX);
    bf16_t* pooled = (bf16_t*)(p.ws + WS_YG);
    const int gt = blockIdx.x * 512 + otid(), nth = gridDim.x * 512;
    for (int u = gt; u < 131072 + 32768; u += nth) {
        int cv, row0, t0, R; const float* prev = nullptr; bool prompt;
        if (u < 131072) { cv = u & 255; const int run = (u >> 8) & 63, b = u >> 14; row0 = b * 2048; t0 = run * 32; R = 32; prompt = true; }
        else { const int v = u - 131072; cv = v & 255; const int b = v >> 8; row0 = MP + b * 8; t0 = 0; R = 8; prompt = false; prev = p.in[4] + ((size_t)(j * 128 + b) * 15) * 2048; }
        const int c = cv * 8, w = 2 << (c >> 9);
        float s[8];
#pragma unroll
        for (int i = 0; i < 8; ++i) s[i] = 0.f;
        auto getu = [&](int tt, float (&o)[8]) {
            if (tt >= 0) {
                const u32x4 v = *(const u32x4*)(uz + (size_t)(row0 + tt) * 4096 + c);
                o[0] = bf_lo(v.x); o[1] = bf_hi(v.x); o[2] = bf_lo(v.y); o[3] = bf_hi(v.y); o[4] = bf_lo(v.z); o[5] = bf_hi(v.z); o[6] = bf_lo(v.w); o[7] = bf_hi(v.w);
            } else if (!prompt) {
                const float* pp = prev + (size_t)(15 + tt) * 2048 + c;
                const f32x4 a = *(const f32x4*)pp, b = *(const f32x4*)(pp + 4);
                o[0] = a.x; o[1] = a.y; o[2] = a.z; o[3] = a.w; o[4] = b.x; o[5] = b.y; o[6] = b.z; o[7] = b.w;
            } else {
#pragma unroll
                for (int i = 0; i < 8; ++i) o[i] = 0.f;
            }
        };
        for (int i = 1; i < w; ++i) {
            float o[8]; getu(t0 - i, o);
#pragma unroll
            for (int k = 0; k < 8; ++k) s[k] += o[k];
        }
        for (int tb = t0; tb < t0 + R; tb += 4) {
            float cur[4][8], old[4][8];
#pragma unroll
            for (int k = 0; k < 4; ++k) { getu(tb + k, cur[k]); getu(tb + k - w + 1, old[k]); }
#pragma unroll
            for (int k = 0; k < 4; ++k) {
                const int t = tb + k;
                const float inv = 1.f / (float)(prompt ? min(w, t + 1) : w);
                f32x4 a, b;
#pragma unroll
                for (int i = 0; i < 8; ++i) s[i] += cur[k][i];
                a.x = s[0] * inv - cur[k][0]; a.y = s[1] * inv - cur[k][1]; a.z = s[2] * inv - cur[k][2]; a.w = s[3] * inv - cur[k][3];
                b.x = s[4] * inv - cur[k][4]; b.y = s[5] * inv - cur[k][5]; b.z = s[6] * inv - cur[k][6]; b.w = s[7] * inv - cur[k][7];
                *(u32x4*)(pooled + (size_t)(row0 + t) * 2048 + c) = pack8(a, b);
#pragma unroll
                for (int i = 0; i < 8; ++i) s[i] -= old[k][i];
            }
        }
    }
    for (int i = gt; i < (8 + 128) * 15 * 256; i += nth) {
        const int cv = i & 255, k = (i >> 8) % 15, sq = (i >> 8) / 15, ch = cv * 8;
        f32x4 a, b2;
        float* dst;
        bool from_state = false; size_t urow = 0;
        if (sq < 8) { urow = (size_t)(sq * 2048 + 2033 + k); dst = p.out + O_POOL_P + ((size_t)(j * 8 + sq) * 15 + k) * 2048 + ch; }
        else { const int bb = sq - 8; dst = p.out + O_POOL_S + ((size_t)(j * 128 + bb) * 15 + k) * 2048 + ch; if (k < 7) from_state = true; else urow = (size_t)(MP + bb * 8 + k - 7); }
        if (from_state) { const float* sp = p.in[4] + ((size_t)(j * 128 + (sq - 8)) * 15 + 8 + k) * 2048 + ch; a = *(const f32x4*)sp; b2 = *(const f32x4*)(sp + 4); }
        else { const u32x4 v = *(const u32x4*)(uz + urow * 4096 + ch); a = (f32x4){bf_lo(v.x), bf_hi(v.x), bf_lo(v.y), bf_hi(v.y)}; b2 = (f32x4){bf_lo(v.z), bf_hi(v.z), bf_lo(v.w), bf_hi(v.w)}; }
        *(f32x4*)dst = a; *(f32x4*)(dst + 4) = b2;
    }
}

constexpr int RS = 272;
constexpr int L_XT = 0, L_BN = 17408, L_BT = 52224, L_CN = 87040, L_HB = 121856, L_SM = 139264, L_CW = 143360;
__device__ __forceinline__ int xt_addr(int pr, int t) { return L_XT + pr * RS + ((((t >> 3) ^ (pr >> 1)) & 15) << 4) + (t & 7) * 2; }
__device__ __forceinline__ int bt_addr(int n, int t) { return L_BT + n * RS + ((((t >> 3) ^ (n >> 3)) & 15) << 4) + (t & 7) * 2; }
__device__ __forceinline__ f32x16 mfma32(bf16x8 a, bf16x8 b, f32x16 c) { return __builtin_amdgcn_mfma_f32_32x32x16_bf16(a, b, c, 0, 0, 0); }

#define OPQ(x) asm volatile("" : "+v"(x))
__device__ void ssd_prompt_item(const Params& p, int j, int b, int h, LAS unsigned char* lds) {
    const int tid0 = otid(), wid = __builtin_amdgcn_readfirstlane(tid0 >> 6), g = h >> 2;
    const char* zxc = (const char*)(p.ws + WS_ZX);
    const char* dtc = (const char*)(p.ws + WS_DTRAW);
    char* ygc = (char*)(p.ws + WS_YG);
    const int rowbase = b * 2048;
    LAS float* cw = (LAS float*)(lds + L_CW);
    const float Ah = -__expf(p.in[14][j * 32 + h]), Dh = p.in[15][j * 32 + h], dtb = p.in[13][j * 32 + h];
    const bool roleB = wid < 4;
    const int qq = wid >> 1, tt = qq ^ (qq >> 1), pt = wid & 1, hp = wid & 1, hn = wid >> 1;

    __syncthreads();
    if (tid0 < 320) {
        const int ch = tid0 < 64 ? h * 64 + tid0 : (tid0 < 192 ? 2048 + g * 128 + (tid0 - 64) : 3072 + g * 128 + (tid0 - 192));
#pragma unroll
        for (int k = 0; k < 4; ++k) cw[k * 320 + tid0] = p.in[11][((size_t)j * 4 + k) * 4096 + ch];
        cw[4 * 320 + tid0] = p.in[12][(size_t)j * 4096 + ch];
    }
    for (int i = tid0; i < 17408 / 4; i += 512) *(LAS unsigned*)(lds + L_HB + i * 4) = 0u;

    u32x4 rawBC[11]; unsigned rawX[11]; float dtp0 = 0.f, dtp1 = 0.f;
    auto prefetch = [&](int t0) {
        int tid = tid0; OPQ(tid);
        const int bt_ = tid & 255, tqb = bt_ >> 4, cg8 = bt_ & 15, tqx = tid >> 5, cp = tid & 31, lane = tid & 63;
        const int colBC = (roleB ? 4096 : 5120) + g * 128 + cg8 * 8, colX = 2048 + h * 64 + cp * 2;
        const int rB = t0 + tqb * 8 - 3, rX = t0 + tqx * 8 - 3;
        const unsigned oB = (unsigned)((rowbase + rB) * ZXW + colBC) * 2u, oX = (unsigned)((rowbase + rX) * ZXW + colX) * 2u;
#pragma unroll
        for (int i = 0; i < 11; ++i) {
            rawBC[i] = (rB + i >= 0) ? *(const u32x4*)(zxc + (oB + (unsigned)i * 12288u)) : (u32x4){0u, 0u, 0u, 0u};
            rawX[i] = (rX + i >= 0) ? *(const unsigned*)(zxc + (oX + (unsigned)i * 12288u)) : 0u;
        }
        if (wid == 0) { const unsigned od = (unsigned)((rowbase + t0 + 2 * lane) * 32 + h) * 4u; dtp0 = *(const float*)(dtc + od); dtp1 = *(const float*)(dtc + (od + 128u)); }
    };
    prefetch(0);

    auto acum_stage = [&](int par) {
        if (wid == 0) {
            LAS float* sm_acum = (LAS float*)(lds + L_SM + par * 2048);
            LAS float* sm_dt = sm_acum + 128;
            LAS float* sm_w = sm_acum + 256;
            LAS float* sm_ea = sm_acum + 384;
            int lane = tid0 & 63; OPQ(lane);
            const float d0 = softplus_f(dtp0 + dtb), d1 = softplus_f(dtp1 + dtb);
            const float a0 = d0 * Ah, a1 = a0 + d1 * Ah;
            float sc = a1;
#pragma unroll
            for (int o = 1; o < 64; o <<= 1) { const float v = __shfl_up(sc, o); if (lane >= o) sc += v; }
            const float c1 = sc, c0 = sc - a1 + a0;
            const float last = __shfl(sc, 63);
            sm_acum[2 * lane] = c0; sm_acum[2 * lane + 1] = c1;
            sm_dt[2 * lane] = d0; sm_dt[2 * lane + 1] = d1;
            sm_w[2 * lane] = __expf(last - c0) * d0; sm_w[2 * lane + 1] = __expf(last - c1) * d1;
            sm_ea[2 * lane] = __expf(c0); sm_ea[2 * lane + 1] = __expf(c1);
        }
    };
    acum_stage(0);
    __syncthreads();

    f32x16 hacc;
#pragma unroll
    for (int i = 0; i < 16; ++i) hacc[i] = 0.f;

#pragma unroll 1
    for (int c = 0; c < 16; ++c) {
        const int t0 = c * 128;
        LAS float* sm_acum = (LAS float*)(lds + L_SM + (c & 1) * 2048);
        LAS float* sm_dt = sm_acum + 128;
        LAS float* sm_w = sm_acum + 256;
        LAS float* sm_ea = sm_acum + 384;
        {
            int tid = tid0; OPQ(tid);
            const int bt_ = tid & 255, tqb = bt_ >> 4, cg8 = bt_ & 15;
            const int lcBC = (roleB ? 64 : 192) + cg8 * 8;
            const f32x4 wv0 = *(const LAS f32x4*)(sm_w + tqb * 8), wv1 = *(const LAS f32x4*)(sm_w + tqb * 8 + 4);
            const float wt[8] = {wv0.x, wv0.y, wv0.z, wv0.w, wv1.x, wv1.y, wv1.z, wv1.w};
            const int natbase = (roleB ? L_BN : L_CN) + (tqb * 8) * RS + cg8 * 16;
#pragma unroll
            for (int half = 0; half < 2; ++half) {
                u32x2 nat[8]; u32x4 tr[4];
#pragma unroll
                for (int ipp = 0; ipp < 2; ++ipp) {
                    const int ip = half * 2 + ipp;
                    const float k0a = cw[0 * 320 + lcBC + 2 * ip], k0b = cw[0 * 320 + lcBC + 2 * ip + 1];
                    const float k1a = cw[1 * 320 + lcBC + 2 * ip], k1b = cw[1 * 320 + lcBC + 2 * ip + 1];
                    const float k2a = cw[2 * 320 + lcBC + 2 * ip], k2b = cw[2 * 320 + lcBC + 2 * ip + 1];
                    const float k3a = cw[3 * 320 + lcBC + 2 * ip], k3b = cw[3 * 320 + lcBC + 2 * ip + 1];
                    const float bba = cw[4 * 320 + lcBC + 2 * ip], bbb = cw[4 * 320 + lcBC + 2 * ip + 1];
                    f32x2 rr[11];
#pragma unroll
                    for (int i = 0; i < 11; ++i) { const unsigned v = rawBC[i][ip]; rr[i] = (f32x2){bf_lo(v), bf_hi(v)}; }
                    const f32x2 K0 = {k0a, k0b}, K1 = {k1a, k1b}, K2 = {k2a, k2b}, K3 = {k3a, k3b}, BB = {bba, bbb};
                    float va[8], vb[8];
#pragma unroll
                    for (int t = 0; t < 8; ++t) {
                        const f32x2 v = silu2(BB + K0 * rr[t] + K1 * rr[t + 1] + K2 * rr[t + 2] + K3 * rr[t + 3]);
                        va[t] = v.x; vb[t] = v.y;
                        nat[t][ipp] = cvt_pk_bf16(v.x, v.y);
                    }
                    if (roleB) {
#pragma unroll
                        for (int tp = 0; tp < 4; ++tp) {
                            tr[2 * ipp][tp] = cvt_pk_bf16(va[2 * tp] * wt[2 * tp], va[2 * tp + 1] * wt[2 * tp + 1]);
                            tr[2 * ipp + 1][tp] = cvt_pk_bf16(vb[2 * tp] * wt[2 * tp], vb[2 * tp + 1] * wt[2 * tp + 1]);
                        }
                    }
                }
#pragma unroll
                for (int t = 0; t < 8; ++t) *(LAS u32x2*)(lds + natbase + t * RS + half * 8) = nat[t];
                if (roleB) {
#pragma unroll
                    for (int i = 0; i < 4; ++i) *(LAS u32x4*)(lds + bt_addr(cg8 * 8 + half * 4 + i, tqb * 8)) = tr[i];
                }
                __builtin_amdgcn_sched_barrier(0);
            }
        }
        {
            int tid = tid0; OPQ(tid);
            const int tqx = tid >> 5, cp = tid & 31, lcX = cp * 2;
            const float k0a = cw[0 * 320 + lcX], k0b = cw[0 * 320 + lcX + 1], k1a = cw[1 * 320 + lcX], k1b = cw[1 * 320 + lcX + 1];
            const float k2a = cw[2 * 320 + lcX], k2b = cw[2 * 320 + lcX + 1], k3a = cw[3 * 320 + lcX], k3b = cw[3 * 320 + lcX + 1];
            const float bba = cw[4 * 320 + lcX], bbb = cw[4 * 320 + lcX + 1];
            f32x2 rr[11];
#pragma unroll
            for (int i = 0; i < 11; ++i) rr[i] = (f32x2){bf_lo(rawX[i]), bf_hi(rawX[i])};
            const f32x2 K0 = {k0a, k0b}, K1 = {k1a, k1b}, K2 = {k2a, k2b}, K3 = {k3a, k3b}, BB = {bba, bbb};
            float va[8], vb[8];
#pragma unroll
            for (int t = 0; t < 8; ++t) { const f32x2 v = silu2(BB + K0 * rr[t] + K1 * rr[t + 1] + K2 * rr[t + 2] + K3 * rr[t + 3]); va[t] = v.x; vb[t] = v.y; }
            u32x4 xa, xb;
            xa.x = cvt_pk_bf16(va[0], va[1]); xa.y = cvt_pk_bf16(va[2], va[3]); xa.z = cvt_pk_bf16(va[4], va[5]); xa.w = cvt_pk_bf16(va[6], va[7]);
            xb.x = cvt_pk_bf16(vb[0], vb[1]); xb.y = cvt_pk_bf16(vb[2], vb[3]); xb.z = cvt_pk_bf16(vb[4], vb[5]); xb.w = cvt_pk_bf16(vb[6], vb[7]);
            *(LAS u32x4*)(lds + xt_addr(cp * 2, tqx * 8)) = xa;
            *(LAS u32x4*)(lds + xt_addr(cp * 2 + 1, tqx * 8)) = xb;
        }
        if (c + 1 < 16) prefetch(t0 + 128);
        bf16_t zr[16];
        {
            int ln = tid0 & 63; OPQ(ln);
            const int l31 = ln & 31, hh = ln >> 5;
            const unsigned oz = (unsigned)((rowbase + t0 + tt * 32 + 4 * hh) * ZXW + h * 64 + pt * 32 + l31) * 2u;
#pragma unroll
            for (int rg = 0; rg < 16; ++rg) zr[rg] = *(const bf16_t*)(zxc + (oz + (unsigned)((rg & 3) + 8 * (rg >> 2)) * 12288u));
        }
        __syncthreads();
        f32x16 y;
        {
            int ln = tid0 & 63; OPQ(ln);
            const int l31 = ln & 31, hh = ln >> 5;
            const int cbase = L_CN + (tt * 32 + l31) * RS + 16 * hh, hbase = L_HB + (pt * 32 + l31) * RS + 16 * hh;
#pragma unroll
            for (int i = 0; i < 16; ++i) y[i] = 0.f;
            {
                const float dec = sm_ea[127];
#pragma unroll
                for (int i = 0; i < 16; ++i) hacc[i] *= dec;
            }
            bf16x8 cf[8];
#pragma unroll
            for (int ks = 0; ks < 8; ++ks) {
                cf[ks] = *(const LAS bf16x8*)(lds + cbase + ks * 32);
                const bf16x8 bfr = *(const LAS bf16x8*)(lds + hbase + ks * 32);
                const bf16x8 a = *(const LAS bf16x8*)(lds + xt_addr(hp * 32 + l31, ks * 16 + 8 * hh));
                const bf16x8 bb = *(const LAS bf16x8*)(lds + bt_addr(hn * 32 + l31, ks * 16 + 8 * hh));
                y = mfma32(cf[ks], bfr, y);
                hacc = mfma32(a, bb, hacc);
            }
#pragma unroll
            for (int rq = 0; rq < 4; ++rq) { const f32x4 e = *(const LAS f32x4*)(sm_ea + tt * 32 + 8 * rq + 4 * hh); y[4 * rq] *= e.x; y[4 * rq + 1] *= e.y; y[4 * rq + 2] *= e.z; y[4 * rq + 3] *= e.w; }
            const int tidx = tt * 32 + l31;
            const float at = sm_acum[tidx];
#pragma unroll 1
            for (int st = 0; st <= tt; ++st) {
                f32x16 s;
#pragma unroll
                for (int i = 0; i < 16; ++i) s[i] = 0.f;
                const int bbase = L_BN + (st * 32 + l31) * RS + 16 * hh;
#pragma unroll
                for (int ks = 0; ks < 8; ++ks) { const bf16x8 afr = *(const LAS bf16x8*)(lds + bbase + ks * 32); s = mfma32(afr, cf[ks], s); }
#pragma unroll
                for (int rq = 0; rq < 4; ++rq) {
                    const int sb0 = st * 32 + 8 * rq + 4 * hh;
                    const f32x4 asv = *(const LAS f32x4*)(sm_acum + sb0), dsv = *(const LAS f32x4*)(sm_dt + sb0);
#pragma unroll
                    for (int i = 0; i < 4; ++i) {
                        float e = at - asv[i];
                        if (sb0 + i > tidx) e = -INFINITY;
                        s[4 * rq + i] *= __expf(e) * dsv[i];
                    }
                }
#pragma unroll
                for (int k2 = 0; k2 < 2; ++k2) {
                    u32x4 au; au.x = cvt_pk_bf16(s[8 * k2], s[8 * k2 + 1]); au.y = cvt_pk_bf16(s[8 * k2 + 2], s[8 * k2 + 3]); au.z = cvt_pk_bf16(s[8 * k2 + 4], s[8 * k2 + 5]); au.w = cvt_pk_bf16(s[8 * k2 + 6], s[8 * k2 + 7]);
                    const int sbase = st * 32 + 16 * k2 + 4 * hh;
                    const u32x2 lo = *(const LAS u32x2*)(lds + xt_addr(pt * 32 + l31, sbase)), hi = *(const LAS u32x2*)(lds + xt_addr(pt * 32 + l31, sbase + 8));
                    u32x4 bu; bu.x = lo.x; bu.y = lo.y; bu.z = hi.x; bu.w = hi.y;
                    y = mfma32(__builtin_bit_cast(bf16x8, au), __builtin_bit_cast(bf16x8, bu), y);
                }
            }
        }
        {
            int ln = tid0 & 63; OPQ(ln);
            const int l31 = ln & 31, hh = ln >> 5;
            const unsigned oy = (unsigned)((rowbase + t0 + tt * 32 + 4 * hh) * 2048 + h * 64 + pt * 32 + l31) * 2u;
#pragma unroll
            for (int rq = 0; rq < 4; ++rq) {
                const u32x2 xv = *(const LAS u32x2*)(lds + xt_addr(pt * 32 + l31, tt * 32 + 8 * rq + 4 * hh));
                const float xs[4] = {bf_lo(xv.x), bf_hi(xv.x), bf_lo(xv.y), bf_hi(xv.y)};
#pragma unroll
                for (int i = 0; i < 4; ++i) {
                    const int rg = 4 * rq + i;
                    const float yv = y[rg] + Dh * xs[i];
                    const float gv = yv * silu_f(bf2f(zr[rg]));
                    *(bf16_t*)(ygc + (oy + (unsigned)(8 * rq + i) * 4096u)) = (bf16_t)(cvt_pk_bf16(gv, 0.f) & 0xffffu);
                }
            }
        }
        if (c + 1 < 16) acum_stage((c + 1) & 1);
        __syncthreads();
        {
            int ln = tid0 & 63; OPQ(ln);
            const int l31 = ln & 31, hh = ln >> 5;
#pragma unroll
            for (int rg = 0; rg < 16; ++rg) {
                const int pr = hp * 32 + (rg & 3) + 8 * (rg >> 2) + 4 * hh;
                *(LAS bf16_t*)(lds + L_HB + pr * RS + (hn * 32 + l31) * 2) = (bf16_t)(cvt_pk_bf16(hacc[rg], 0.f) & 0xffffu);
            }
        }
    }
    {
        int ln = tid0 & 63; OPQ(ln);
        const int l31 = ln & 31, hh = ln >> 5;
        float* so = p.out + O_SSM_P + ((size_t)(j * 8 + b) * 32 + h) * 8192;
#pragma unroll
        for (int rg = 0; rg < 16; ++rg) {
            const int pr = hp * 32 + (rg & 3) + 8 * (rg >> 2) + 4 * hh;
            so[pr * 128 + hn * 32 + l31] = hacc[rg];
        }
    }
}

__device__ void ssd_sample_all(const Params& p, int j, LAS unsigned char* lds) {
    const int tid = otid();
    const bf16_t* zx = (const bf16_t*)(p.ws + WS_ZX);
    const float* dtraw = (const float*)(p.ws + WS_DTRAW);
    bf16_t* yg = (bf16_t*)(p.ws + WS_YG);
    LAS float* sx = (LAS float*)lds;
    LAS float* sB = sx + 2048;
    LAS float* sC = sB + 1024;
    LAS float* sdt = sC + 1024;
    LAS float* sdec = sdt + 32;
    const int pp = tid >> 3, nl = (tid & 7) * 4;
    int item = (int)blockIdx.x;
    f32x4 hs[4][4];
    if (item < 1024) {
        const float* st = p.in[2] + ((size_t)(j * 128 + (item >> 3)) * 32 + (item & 7) * 4) * 8192;
#pragma unroll
        for (int r = 0; r < 4; ++r)
#pragma unroll
            for (int q = 0; q < 4; ++q) hs[r][q] = *(const f32x4*)(st + r * 8192 + pp * 128 + nl + 32 * q);
    }
#pragma unroll 1
    for (; item < 1024; item += (int)gridDim.x) {
        const int b = item >> 3, g = item & 7;
        __syncthreads();
        {
            const int cc = tid < 256 ? g * 256 + tid : (tid < 384 ? 2048 + g * 128 + (tid - 256) : 3072 + g * 128 + (tid - 384));
            float raw[11];
#pragma unroll
            for (int k = 0; k < 3; ++k) raw[k] = p.in[3][((size_t)(j * 128 + b) * 3 + k) * 4096 + cc];
#pragma unroll
            for (int t = 0; t < 8; ++t) raw[3 + t] = bf2f(zx[(size_t)(MP + b * 8 + t) * ZXW + 2048 + cc]);
            const float w0 = p.in[11][((size_t)j * 4 + 0) * 4096 + cc], w1 = p.in[11][((size_t)j * 4 + 1) * 4096 + cc];
            const float w2 = p.in[11][((size_t)j * 4 + 2) * 4096 + cc], w3 = p.in[11][((size_t)j * 4 + 3) * 4096 + cc];
            const float bs = p.in[12][(size_t)j * 4096 + cc];
            LAS float* dst = tid < 256 ? sx + tid : (tid < 384 ? sB + (tid - 256) : sC + (tid - 384));
            const int dstride = tid < 256 ? 256 : 128;
#pragma unroll
            for (int t = 0; t < 8; ++t) dst[t * dstride] = silu_f(bs + w0 * raw[t] + w1 * raw[t + 1] + w2 * raw[t + 2] + w3 * raw[t + 3]);
            if (tid < 32) {
                const int t = tid >> 2, r = tid & 3, hd = g * 4 + r;
                const float dtv = softplus_f(dtraw[(size_t)(MP + b * 8 + t) * 32 + hd] + p.in[13][j * 32 + hd]);
                sdt[tid] = dtv; sdec[tid] = __expf(-dtv * __expf(p.in[14][j * 32 + hd]));
            }
        }
        const int tsel = tid & 7;
        const size_t row = (size_t)(MP + b * 8 + tsel);
        bf16_t zv[4];
#pragma unroll
        for (int r = 0; r < 4; ++r) zv[r] = zx[row * ZXW + g * 256 + r * 64 + pp];
        const int nitem = item + (int)gridDim.x;
        f32x4 hn[4][4];
        if (nitem < 1024) {
            const float* st = p.in[2] + ((size_t)(j * 128 + (nitem >> 3)) * 32 + (nitem & 7) * 4) * 8192;
#pragma unroll
            for (int r = 0; r < 4; ++r)
#pragma unroll
                for (int q = 0; q < 4; ++q) hn[r][q] = *(const f32x4*)(st + r * 8192 + pp * 128 + nl + 32 * q);
        }
        __syncthreads();
        float ysel[4] = {0.f, 0.f, 0.f, 0.f};
#pragma unroll
        for (int t = 0; t < 8; ++t) {
            const f32x4 dt4 = *(const LAS f32x4*)(sdt + t * 4), dc4 = *(const LAS f32x4*)(sdec + t * 4);
            const float dx[4] = {dt4.x * sx[t * 256 + pp], dt4.y * sx[t * 256 + 64 + pp], dt4.z * sx[t * 256 + 128 + pp], dt4.w * sx[t * 256 + 192 + pp]};
            const float dc[4] = {dc4.x, dc4.y, dc4.z, dc4.w};
            float yp[4] = {0.f, 0.f, 0.f, 0.f};
#pragma unroll
            for (int q = 0; q < 4; ++q) {
                const f32x4 B4 = *(const LAS f32x4*)(sB + t * 128 + nl + 32 * q), C4 = *(const LAS f32x4*)(sC + t * 128 + nl + 32 * q);
#pragma unroll
                for (int r = 0; r < 4; ++r) {
                    hs[r][q] = hs[r][q] * dc[r] + B4 * dx[r];
                    yp[r] += (hs[r][q].x * C4.x + hs[r][q].y * C4.y) + (hs[r][q].z * C4.z + hs[r][q].w * C4.w);
                }
            }
#pragma unroll
            for (int r = 0; r < 4; ++r) {
                float v = yp[r];
                v += __shfl_xor(v, 1); v += __shfl_xor(v, 2); v += __shfl_xor(v, 4);
                if (tsel == t) ysel[r] = v;
            }
        }
        float* so = p.out + O_SSM_S + ((size_t)(j * 128 + b) * 32 + g * 4) * 8192;
#pragma unroll
        for (int r = 0; r < 4; ++r) {
            const int ch = g * 256 + r * 64 + pp;
            const float yv = ysel[r] + p.in[15][j * 32 + g * 4 + r] * sx[tsel * 256 + r * 64 + pp];
            const float gv = yv * silu_f(bf2f(zv[r]));
            yg[row * 2048 + ch] = (bf16_t)(cvt_pk_bf16(gv, 0.f) & 0xffffu);
#pragma unroll
            for (int q = 0; q < 4; ++q) *(f32x4*)(so + r * 8192 + pp * 128 + nl + 32 * q) = hs[r][q];
        }
        if (nitem < 1024) {
#pragma unroll
            for (int r = 0; r < 4; ++r)
#pragma unroll
                for (int q = 0; q < 4; ++q) hs[r][q] = hn[r][q];
        }
    }
}

__device__ void phase_scan(const Params& p, int j, LAS unsigned char* lds) {
    for (int item = blockIdx.x; item < 256; item += gridDim.x) {
        const int g = item & 7, k = item >> 3, b = k >> 2, r = k & 3;
        for (int rep = 0; rep < REP_PROMPT; ++rep) ssd_prompt_item(p, j, b, g * 4 + r, lds);
    }
    ssd_sample_all(p, j, lds);
    const bf16_t* zx = (const bf16_t*)(p.ws + WS_ZX);
    const int gt = blockIdx.x * 512 + otid(), nth = gridDim.x * 512;
    for (int i = gt; i < 136 * 3 * 512; i += nth) {
        const int ch = (i & 511) * 8, k = (i >> 9) % 3, sq = (i >> 9) / 3;
        const size_t row = sq < 8 ? (size_t)(sq * 2048 + 2045 + k) : (size_t)(MP + (sq - 8) * 8 + 5 + k);
        float* dst = sq < 8 ? p.out + O_CONV_P + ((size_t)(j * 8 + sq) * 3 + k) * 4096 + ch : p.out + O_CONV_S + ((size_t)(j * 128 + (sq - 8)) * 3 + k) * 4096 + ch;
        const u32x4 v = *(const u32x4*)(zx + row * ZXW + 2048 + ch);
        *(f32x4*)dst = (f32x4){bf_lo(v.x), bf_hi(v.x), bf_lo(v.y), bf_hi(v.y)}; *(f32x4*)(dst + 4) = (f32x4){bf_lo(v.z), bf_hi(v.z), bf_lo(v.w), bf_hi(v.w)};
    }
}

#define XB_TMO      128
#define XB_XCNT(j)  (256  + 64 * (j))
#define XB_XSUB(j)  (1280 + 64 * (j))
#define XB_XGEN(j)  (2304 + 64 * (j))
#define XB_TOP      3328
#define XB_TOPGEN   3392
#define XCD_BAR_WORDS 3456
#define XB_SPIN_CAP (1u << 22)
__device__ __forceinline__ unsigned xb_ld(unsigned* p)              { return __hip_atomic_load(p, __ATOMIC_RELAXED, __HIP_MEMORY_SCOPE_AGENT); }
__device__ __forceinline__ unsigned xb_add(unsigned* p, unsigned v) { return __hip_atomic_fetch_add(p, v, __ATOMIC_RELAXED, __HIP_MEMORY_SCOPE_AGENT); }
__device__ __forceinline__ unsigned xb_xcc_id() { return (unsigned)__builtin_amdgcn_s_getreg((3 << 11) | 20) & 0xFu; }
#define XB_SPIN(cond, bar) do { unsigned _sp = 0; while (cond) { __builtin_amdgcn_s_sleep(1); \
    if ((++_sp & 255u) == 0u) { if (xb_ld(&(bar)[XB_TMO])) break; if (_sp > XB_SPIN_CAP) { atomicAdd(&(bar)[XB_TMO], 1u); break; } } } } while (0)
struct XcdBarrier { unsigned* bar; unsigned x; volatile LAS unsigned* st; };
__device__ __forceinline__ XcdBarrier xcd_barrier_post(unsigned* bar, volatile LAS unsigned* st) {
    XcdBarrier b; b.bar = bar; b.x = xb_xcc_id(); b.st = st;
    if (threadIdx.x == 0) (void)xb_add(&bar[XB_XCNT(b.x)], 1u);
    return b;
}
__device__ __forceinline__ void xcd_barrier_complete(unsigned* bar, unsigned x, unsigned& nloc, unsigned& nx) {
    const unsigned G = gridDim.x * gridDim.y * gridDim.z;
    unsigned sum, cnt, mine, sp = 0u;
    for (;;) {
        sum = 0u; cnt = 0u; mine = 0u;
#pragma unroll
        for (unsigned j = 0; j < 16; ++j) { const unsigned c = xb_ld(&bar[XB_XCNT(j)]); sum += c; cnt += (c > 0u) ? 1u : 0u; mine = (j == x) ? c : mine; }
        if (sum == G) break;
        __builtin_amdgcn_s_sleep(1);
        if ((++sp & 255u) == 0u) { if (xb_ld(&bar[XB_TMO])) break; if (sp > XB_SPIN_CAP) { atomicAdd(&bar[XB_TMO], 1u); break; } }
    }
    nloc = mine > 0u ? mine : 1u; nx = cnt > 0u ? cnt : 1u;
}
__device__ __forceinline__ void xcd_barrier(const XcdBarrier& b) {
    asm volatile("s_waitcnt vmcnt(0)" ::: "memory");
    __syncthreads();
    if (threadIdx.x == 0) {
        unsigned* bar = b.bar;
        __builtin_amdgcn_s_waitcnt(0);
        unsigned nloc = b.st[0], nx = b.st[1];
        if (nloc == 0u) { xcd_barrier_complete(bar, b.x, nloc, nx); b.st[0] = nloc; b.st[1] = nx; }
        const unsigned old = xb_add(&bar[XB_XSUB(b.x)], 1u);
        const unsigned gen = old / nloc;
        if (old + 1u == (gen + 1u) * nloc) {
            __builtin_amdgcn_fence(__ATOMIC_RELEASE, "agent");
            asm volatile("s_waitcnt vmcnt(0)" ::: "memory");
            const unsigned og = xb_add(&bar[XB_TOP], 1u);
            const unsigned tg = og / nx;
            if (og + 1u == (tg + 1u) * nx) xb_add(&bar[XB_TOPGEN], 1u);
            else XB_SPIN(xb_ld(&bar[XB_TOPGEN]) == tg, bar);
            __builtin_amdgcn_fence(__ATOMIC_ACQUIRE, "agent");
            xb_add(&bar[XB_XGEN(b.x)], 1u);
            asm volatile("s_waitcnt vmcnt(0)" ::: "memory");
        } else {
            XB_SPIN(xb_ld(&bar[XB_XGEN(b.x)]) == gen, bar);
            __builtin_amdgcn_fence(__ATOMIC_ACQUIRE, "agent");
            asm volatile("s_waitcnt vmcnt(0)" ::: "memory");
        }
    }
    __syncthreads();
}

#ifndef REP_PREP0
#define REP_PREP0 1
#endif
#ifndef REP_SMALL
#define REP_SMALL 1
#endif
#ifndef REP_GGRP
#define REP_GGRP 1
#endif
#ifndef REP_GGRP
#define REP_GGRP 1
#endif
#ifndef REP_SYNC
#define REP_SYNC 1
#endif
#ifndef REP_SCAN
#define REP_SCAN 1
#endif
#ifndef REP_GIN
#define REP_GIN 1
#endif
#ifndef REP_GOUT
#define REP_GOUT 1
#endif
#ifndef REP_ELEM
#define REP_ELEM 1
#endif
#define GSYNC() do { for (int _r = 0; _r < REP_SYNC; ++_r) xcd_barrier(xb); } while (0)
__global__ __launch_bounds__(512, 2) void hybrid_fwd(const float* i0, const float* i1, const float* i2, const float* i3, const float* i4, const float* i5, const float* i6, const float* i7,
        const float* i8, const float* i9, const float* i10, const float* i11, const float* i12, const float* i13, const float* i14, const float* i15, const float* i16, const float* i17,
        const float* i18, const float* i19, const float* i20, const float* i21, const float* i22, float* outp, unsigned char* wsp, WTab wt) {
    Params p;
    p.in[0] = i0; p.in[1] = i1; p.in[2] = i2; p.in[3] = i3; p.in[4] = i4; p.in[5] = i5; p.in[6] = i6; p.in[7] = i7; p.in[8] = i8; p.in[9] = i9; p.in[10] = i10; p.in[11] = i11;
    p.in[12] = i12; p.in[13] = i13; p.in[14] = i14; p.in[15] = i15; p.in[16] = i16; p.in[17] = i17; p.in[18] = i18; p.in[19] = i19; p.in[20] = i20; p.in[21] = i21; p.in[22] = i22;
    p.out = outp; p.ws = wsp;
    extern __shared__ __attribute__((aligned(16))) unsigned char smem[];
    LAS unsigned char* lds = (LAS unsigned char*)smem;
    cg::grid_group grid = cg::this_grid();
    unsigned char* ws = p.ws;
    volatile LAS unsigned* xst = (volatile LAS unsigned*)(lds + LDS_XB);
    if (threadIdx.x == 0) { xst[0] = 0u; xst[1] = 0u; }
    __syncthreads();
    const XcdBarrier xb = xcd_barrier_post((unsigned*)(ws + WS_BAR), xst);

    for (int rep = 0; rep < REP_PREP0; ++rep) phase_prep0(p, wt, lds);
    if (wt.wtiles < 0) grid.sync();
    xcd_barrier(xb);
#pragma unroll 1
    for (int mode_ = 0; mode_ < 2 * REP_SMALL; ++mode_) {
        const int mode = mode_ % 2;
        pg8::SmallSched S; S.mode = mode; S.G = (int)gridDim.x; S.c = (int)blockIdx.x; S.lda = 1024; S.ldb = 1024; S.K = 1024;
        S.A0 = (const char*)(ws + (mode == 0 ? WS_AC : WS_SHIFTA)); S.ada = (const char*)(ws + WS_WT_ADA); S.ssd_in = (const char*)(ws + WS_WT_SSD_IN); S.pool_in = (const char*)(ws + WS_WT_POOL_IN);
        EpiSmall E; E.mode = mode; E.mod = (float*)(ws + WS_MOD); E.ada_b = p.in[8]; E.shiftA = (bf16_t*)(ws + WS_SHIFTA); E.sb = (float*)(ws + WS_SB);
#ifndef NO_GSMALL
        pg8::gemm_phase<EpiSmall, pg8::SmallSched>(lds, S, E);
#endif
        if (mode == 1) phase_xprep(p, 82);
        GSYNC();
    }
    unsigned* tailw = (unsigned*)(ws + WS_BAR) + 3584;
    unsigned* tmow = (unsigned*)(ws + WS_BAR) + XB_TMO;
#pragma unroll 1
    for (int layer = 0; layer < 4; ++layer) {
        const int j = layer >> 1; const bool ssd = (layer & 1) == 0;
        {
            pg8::InSched S;
            S.init(ssd ? 6400 : 4096, ws + WS_APRIME, ssd ? ws + WS_WT_SSD_IN + (size_t)j * 6400 * 1024 * 2 : ws + WS_WT_POOL_IN + (size_t)j * 4096 * 1024 * 2, layer > 0 ? tailw + 64 * (layer - 1) : nullptr, tmow);
            EpiIn E; E.ssq = (const float*)(ws + WS_SSQ) + (size_t)layer * 17408; E.sb = (const float*)(ws + WS_SB) + (size_t)layer * 136 * 6400; E.out = (bf16_t*)(ws + WS_ZX);
            E.ldo = ssd ? ZXW : 4096; E.nbf = ssd ? ZXW : 4096; E.dtraw = ssd ? (float*)(ws + WS_DTRAW) : nullptr;
            for (int rep = 0; rep < REP_GIN; ++rep) pg8::gemm_phase<EpiIn, pg8::InSched>(lds, S, E);
        }
        GSYNC();
        if (ssd) { for (int rep = 0; rep < REP_SCAN; ++rep) phase_scan(p, j, lds); } else { for (int rep = 0; rep < REP_ELEM; ++rep) phase_pool(p, j); }
        GSYNC();
        if (ssd) { for (int rep = 0; rep < REP_ELEM; ++rep) phase_ssdnorm(p, j); }
        else {
            pg8::MainSched S; S.init(MT, 2048, 512, 2048, 512, ws + WS_YG, ws + WS_WT_POOL_G + (size_t)j * 2048 * 512 * 2, 1);
            EpiGrp E; E.uz = (const bf16_t*)(ws + WS_ZX); E.chs = p.in[20] + (size_t)j * 2048; E.out = (bf16_t*)(ws + WS_A2);
            for (int rep = 0; rep < REP_GGRP; ++rep) pg8::gemm_phase<EpiGrp, pg8::MainSched>(lds, S, E);
        }
        GSYNC();
#pragma unroll 1
        for (int part = 0; part < 2; ++part) {
            pg8::MainSched S; S.init(part == 0 ? MP : MT, 1024, 2048, 2048, 2048, ws + WS_A2, ssd ? ws + WS_WT_SSD_OUT + (size_t)j * 1024 * 2048 * 2 : ws + WS_WT_POOL_OUT + (size_t)j * 1024 * 2048 * 2, 30, part);
            EpiOut E; float* xw = (float*)(ws + WS_XW);
            E.xin_p = layer == 0 ? p.in[0] : xw; E.xin_s = layer == 0 ? p.in[1] : xw + (size_t)MP * DM; E.xw = xw;
            E.modl = (const float*)(ws + WS_MOD) + (size_t)layer * 3072; E.ng_next = layer < 3 ? p.in[9] + (size_t)(layer + 1) * 1024 : nullptr;
            E.aprime = (bf16_t*)(ws + WS_APRIME); E.ssq = (float*)(ws + WS_SSQ) + (size_t)(layer + 1) * 17408;
            pg8::gemm_phase<EpiOut, pg8::MainSched>(lds, S, E);
            if (part == 0) GSYNC();
        }
        if (blockIdx.x < 16) {
            asm volatile("s_waitcnt vmcnt(0)" ::: "memory");
            __syncthreads();
            if (threadIdx.x == 0) { __builtin_amdgcn_fence(__ATOMIC_RELEASE, "agent"); asm volatile("s_waitcnt vmcnt(0)" ::: "memory"); __hip_atomic_fetch_add(tailw + 64 * layer, 1u, __ATOMIC_RELAXED, __HIP_MEMORY_SCOPE_AGENT); }
        }
    }
    phase_final(p, 0, MP, 16);
    GSYNC();
    phase_final(p, MP, MT, 0);
}

extern "C" void kernel_launch(void* const* d_in, const int* in_sizes, int n_in, void* d_out, int out_size, void* d_ws, size_t ws_size, hipStream_t stream) {
    static int grid = 0;
    if (grid == 0) {
        if (n_in != 23 || ws_size < WS_END) { fprintf(stderr, "kernel_launch: unexpected n_in %d or ws_size %zu (need %zu)\n", n_in, ws_size, (size_t)WS_END); grid = -1; return; }
        int dev = 0, cus = 0, per_cu = 0;
        hipGetDevice(&dev);
        hipDeviceGetAttribute(&cus, hipDeviceAttributeMultiprocessorCount, dev);
        if (hipFuncSetAttribute((const void*)hybrid_fwd, hipFuncAttributeMaxDynamicSharedMemorySize, LDS_BYTES) != hipSuccess) { fprintf(stderr, "kernel_launch: hipFuncSetAttribute failed\n"); grid = -1; return; }
        if (hipOccupancyMaxActiveBlocksPerMultiprocessor(&per_cu, (const void*)hybrid_fwd, 512, LDS_BYTES) != hipSuccess || per_cu < 1) { fprintf(stderr, "kernel_launch: occupancy query gave %d\n", per_cu); (void)hipGetLastError(); per_cu = 1; }
        if (cus < 256) { fprintf(stderr, "kernel_launch: needs a 256-CU device (got %d CUs)\n", cus); grid = -1; return; }
        grid = 256;
    }
    if (grid < 0) return;
    WTab wt{};
    unsigned char* ws = (unsigned char*)d_ws;
    int nj = 0, tb = 0;
    auto add = [&](int srci, long long soff, size_t dst_off, int K, int N, int Npad) {
        WJob& w = wt.wj[nj++]; w.src = (const float*)d_in[srci] + soff; w.doff = (long long)dst_off; w.K = K; w.N = N; w.tiles_n = Npad / 64; w.tile_begin = tb; tb += (K / 64) * (Npad / 64);
    };
    for (int i = 0; i < 4; ++i) add(7, (long long)i * 1024 * 3072, WS_WT_ADA + (size_t)i * 3072 * 1024 * 2, 1024, 3072, 3072);
    for (int j = 0; j < 2; ++j) add(10, (long long)j * 1024 * 6176, WS_WT_SSD_IN + (size_t)j * 6400 * 1024 * 2, 1024, 6176, 6400);
    for (int j = 0; j < 2; ++j) add(18, (long long)j * 1024 * 4096, WS_WT_POOL_IN + (size_t)j * 4096 * 1024 * 2, 1024, 4096, 4096);
    for (int j = 0; j < 2; ++j) add(17, (long long)j * 2048 * 1024, WS_WT_SSD_OUT + (size_t)j * 1024 * 2048 * 2, 2048, 1024, 1024);
    for (int j = 0; j < 2; ++j) add(21, (long long)j * 2048 * 1024, WS_WT_POOL_OUT + (size_t)j * 1024 * 2048 * 2, 2048, 1024, 1024);
    for (int q = 0; q < 8; ++q) add(19, (long long)q * 512 * 512, WS_WT_POOL_G + (size_t)q * 512 * 512 * 2, 512, 512, 512);
    wt.wtiles = tb;
    if (hipMemsetAsync(ws + WS_BAR, 0, 16384, stream) != hipSuccess) { fprintf(stderr, "kernel_launch: memset of the barrier words failed\n"); return; }
    const float* ip[23]; for (int i = 0; i < 23; ++i) ip[i] = (const float*)d_in[i];
    float* outp = (float*)d_out;
    void* args[26];
    for (int i = 0; i < 23; ++i) args[i] = (void*)&ip[i];
    args[23] = (void*)&outp; args[24] = (void*)&ws; args[25] = (void*)&wt;
    hipError_t e = hipLaunchCooperativeKernel((const void*)hybrid_fwd, dim3(grid), dim3(512), args, LDS_BYTES, stream);
    if (e != hipSuccess) fprintf(stderr, "cooperative launch failed: %s (grid %d)\n", hipGetErrorString(e), grid);
}
```

```cpp
#include <hip/hip_runtime.h>
#include <hip/hip_cooperative_groups.h>
#include <cstdio>
namespace cg = cooperative_groups;

#ifndef REP_PROMPT
#define REP_PROMPT 1
#endif
#define LAS __attribute__((address_space(3)))
typedef unsigned short bf16_t;
typedef short bf16x8 __attribute__((ext_vector_type(8)));
typedef float f32x4 __attribute__((ext_vector_type(4)));
typedef float f32x16 __attribute__((ext_vector_type(16)));
typedef unsigned u32x4 __attribute__((ext_vector_type(4)));
typedef unsigned u32x2 __attribute__((ext_vector_type(2)));
typedef float f32x2 __attribute__((ext_vector_type(2)));

constexpr int MP = 16384, MT = 17408, DM = 1024;
constexpr int ZXW = 6144;
constexpr size_t O_SSM_P = 17825792, O_CONV_P = 22020096, O_POOL_P = 22216704, O_SSM_S = 22708224, O_CONV_S = 89817088, O_POOL_S = 92962816;

constexpr size_t WS_WT_SSD_IN = 0;
constexpr size_t WS_WT_SSD_OUT = WS_WT_SSD_IN + 2ull * 6400 * 1024 * 2;
constexpr size_t WS_WT_POOL_IN = WS_WT_SSD_OUT + 2ull * 1024 * 2048 * 2;
constexpr size_t WS_WT_POOL_G = WS_WT_POOL_IN + 2ull * 4096 * 1024 * 2;
constexpr size_t WS_WT_POOL_OUT = WS_WT_POOL_G + 2ull * 2048 * 512 * 2;
constexpr size_t WS_WT_ADA = WS_WT_POOL_OUT + 2ull * 1024 * 2048 * 2;
constexpr size_t WS_AC = WS_WT_ADA + 12288ull * 1024 * 2;
constexpr size_t WS_SHIFTA = WS_AC + 256ull * 1024 * 2;
constexpr size_t WS_MOD = WS_SHIFTA + 4ull * 256 * 1024 * 2;
constexpr size_t WS_SB = WS_MOD + 136ull * 12288 * 4;
constexpr size_t WS_APRIME = WS_SB + 4ull * 136 * 6400 * 4;
constexpr size_t WS_SSQ = WS_APRIME + 17408ull * 1024 * 2;
constexpr size_t WS_XW = WS_SSQ + 17408ull * 16 * 4;
constexpr size_t WS_ZX = WS_XW + 17408ull * 1024 * 4;
constexpr size_t WS_DTRAW = WS_ZX + 17408ull * 6144 * 2;
constexpr size_t WS_YG = WS_DTRAW + 17408ull * 32 * 4;
constexpr size_t WS_A2 = WS_YG + 17408ull * 2048 * 2;
constexpr size_t WS_BAR = WS_A2 + 17408ull * 2048 * 2;
constexpr size_t WS_END = WS_BAR + 16384;

constexpr int LDS_XB = 149760;
constexpr int LDS_BYTES = 149776;

struct WJob { const float* src; long long doff; int K, N, tiles_n, tile_begin; };
struct WTab { WJob wj[20]; int wtiles; int pad0; };
constexpr int NWJ = 20;
struct Params {
    const float* in[23];
    float* out;
    unsigned char* ws;
};

__device__ __forceinline__ unsigned cvt_pk_bf16(float lo, float hi) { unsigned r; asm("v_cvt_pk_bf16_f32 %0, %1, %2" : "=v"(r) : "v"(lo), "v"(hi)); return r; }
__device__ __forceinline__ float bf_lo(unsigned u) { return __uint_as_float(u << 16); }
__device__ __forceinline__ float bf_hi(unsigned u) { return __uint_as_float(u & 0xffff0000u); }
__device__ __forceinline__ float bf2f(bf16_t b) { return __uint_as_float(((unsigned)b) << 16); }
__device__ __forceinline__ float silu_f(float v) { return v * __builtin_amdgcn_rcpf(1.f + __expf(-v)); }
__device__ __forceinline__ f32x2 silu2(f32x2 v) { const f32x2 e = v * (-1.44269504f); f32x2 d; d.x = __builtin_amdgcn_exp2f(e.x); d.y = __builtin_amdgcn_exp2f(e.y); d = d + 1.f; f32x2 r; r.x = __builtin_amdgcn_rcpf(d.x); r.y = __builtin_amdgcn_rcpf(d.y); return v * r; }
__device__ __forceinline__ float softplus_f(float v) { return v > 20.f ? v : log1pf(__expf(v)); }
__device__ __forceinline__ int otid() { int t = threadIdx.x; asm volatile("" : "+v"(t)); return t; }
__device__ __forceinline__ int row_b(int r) { return r < MP ? (r >> 11) : 8 + ((r - MP) >> 3); }
__device__ __forceinline__ u32x4 pack8(f32x4 a, f32x4 b) { u32x4 r; r.x = cvt_pk_bf16(a.x, a.y); r.y = cvt_pk_bf16(a.z, a.w); r.z = cvt_pk_bf16(b.x, b.y); r.w = cvt_pk_bf16(b.z, b.w); return r; }

namespace pg8 {
constexpr int BM = 256, BK = 64, HALF = 128, HTB = HALF * BK * 2, STAGE_BYTES = 8 * HTB, NXCD = 8, WGM = 8;
__device__ __forceinline__ int lds_byte(int r, int c) { const int st = (r >> 4) * 2 + (c >> 5), rr = r & 15, cc = c & 31, ob = rr * 64 + cc * 2; return st * 1024 + (ob ^ (((ob >> 9) & 1) << 5)); }
__device__ __forceinline__ void stage_rc(int b, int& R, int& C) { const int st = b / 1024, sb = b % 1024, swz = sb ^ (((sb >> 9) & 1) << 5); R = (st >> 1) * 16 + swz / 64; C = (st & 1) * 32 + (swz % 64) / 2; }
__device__ __forceinline__ int perm32(int rho) { const int n = rho >> 4, i = rho & 15; return 8 * (i >> 2) + 4 * n + (i & 3); }

struct Unit { int pm, pn, q; const char* A; const char* B; };

__device__ __forceinline__ void static_unit(int L, int nM, int nN, int& pm, int& pn) {
    const int nwg = nM * nN;
    int wgid = L; { const int q = nwg / NXCD, r = nwg % NXCD, xcd = wgid % NXCD, off = wgid / NXCD; wgid = (xcd < r ? xcd * (q + 1) : r * (q + 1) + (xcd - r) * q) + off; }
    const int nig = WGM * nN, gid = wgid / nig, fm = gid * WGM, gsz = (nM - fm) < WGM ? (nM - fm) : WGM;
    pm = fm + ((wgid % nig) % gsz); pn = (wgid % nig) / gsz;
}
struct MainSched {
    int nM, nN, nwg, G, c, lda, ldb, K, gsh, single;
    const char* A; const char* Bt;
    __device__ void init(int M, int N, int K_, int lda_, int ldb_, const void* A_, const void* Bt_, int gsh_, int single_ = 0) {
        nM = M / BM; nN = N / BM; nwg = nM * nN; G = (int)gridDim.x; c = (int)blockIdx.x; lda = lda_; ldb = ldb_; K = K_; A = (const char*)A_; Bt = (const char*)Bt_; gsh = gsh_; single = single_;
    }
    __device__ bool next(int i, Unit& u) const {
        if (single) { if (i > 0 || c >= 16) return false; u.pm = 64 + (c >> 2); u.pn = c & 3; }
        else { const long L = (long)i * G + c; if (L >= nwg) return false; static_unit((int)L, nM, nN, u.pm, u.pn); }
        u.q = 0;
        u.A = A + ((size_t)u.pm * BM * lda + (size_t)(u.pn >> gsh) * 512) * 2;
        u.B = Bt + (size_t)u.pn * BM * ldb * 2;
        return true;
    }
    __device__ __forceinline__ void a_ready(const Unit&) const {}
};
struct InSched {
    int nN, nP, E, nskip, c, r0, cnt, lda, ldb, K;
    const char* A; const char* Bt; unsigned* tail; unsigned* tmo;
    __device__ void init(int N, const void* A_, const void* Bt_, unsigned* tail_, unsigned* tmo_) {
        nN = N / BM; nP = 64 * nN; c = (int)blockIdx.x; lda = 1024; ldb = 1024; K = 1024; A = (const char*)A_; Bt = (const char*)Bt_; tail = tail_; tmo = tmo_;
        nskip = tail_ != nullptr ? 32 : 0; E = nskip + 4 * nN; r0 = (tail_ != nullptr && c < 16) ? 2 : 0;
        const int tot = (nP - c + 255) / 256; cnt = tot - r0 > 0 ? tot - r0 : 0;
    }
    __device__ bool next(int i, Unit& u) const {
        if (i < cnt) static_unit((i + r0) * 256 + c, 64, nN, u.pm, u.pn);
        else {
            if (c < 16) return false;
            const int e = 255 - c + 240 * (i - cnt); if (e >= E) return false;
            if (e < nskip) static_unit(e < 16 ? e : 256 + (e - 16), 64, nN, u.pm, u.pn);
            else { const int sidx = e - nskip; u.pm = 64 + sidx / nN; u.pn = sidx - (sidx / nN) * nN; }
        }
        u.q = 0;
        u.A = A + (size_t)u.pm * BM * 1024 * 2; u.B = Bt + (size_t)u.pn * BM * 1024 * 2;
        return true;
    }
    __device__ __forceinline__ void a_ready(const Unit& u) const {
        if (tail == nullptr || u.pm < 64) return;
        if (threadIdx.x < 64) {
            unsigned polls = 0;
            while ((unsigned)__builtin_amdgcn_readfirstlane(__hip_atomic_load(tail, __ATOMIC_RELAXED, __HIP_MEMORY_SCOPE_AGENT)) < 16u) {
                __builtin_amdgcn_s_sleep(2);
                if ((++polls & 255u) == 0u) { if (__builtin_amdgcn_readfirstlane(__hip_atomic_load(tmo, __ATOMIC_RELAXED, __HIP_MEMORY_SCOPE_AGENT)) != 0u) break; if (polls > (1u << 22)) { if (threadIdx.x == 0) atomicAdd(tmo, 1u); break; } }
            }
            __builtin_amdgcn_fence(__ATOMIC_ACQUIRE, "agent");
            asm volatile("s_waitcnt vmcnt(0)" ::: "memory");
        }
        asm volatile("" ::: "memory"); __builtin_amdgcn_s_barrier(); asm volatile("" ::: "memory");
    }
};
struct SmallSched {
    int mode, G, c, lda, ldb, K;
    const char* A0; const char* ada; const char* ssd_in; const char* pool_in;
    __device__ bool next(int i, Unit& u) const {
        const long L = (long)i * G + c;
        u.pm = 0;
        if (mode == 0) { if (L >= 48) return false; u.pn = (int)L; u.q = 0; u.A = A0; u.B = ada + (size_t)u.pn * BM * 1024 * 2; return true; }
        if (L >= 82) return false;
        int l = (int)L, q, pn;
        if (l < 25) { q = 0; pn = l; } else if (l < 41) { q = 1; pn = l - 25; } else if (l < 66) { q = 2; pn = l - 41; } else { q = 3; pn = l - 66; }
        u.q = q; u.pn = pn; u.A = A0 + (size_t)q * 256 * 1024 * 2;
        u.B = ((q & 1) ? pool_in + (size_t)(q >> 1) * 4096 * 1024 * 2 : ssd_in + (size_t)(q >> 1) * 6400 * 1024 * 2) + (size_t)pn * BM * 1024 * 2;
        return true;
    }
    __device__ __forceinline__ void a_ready(const Unit&) const {}
};

template <class Epi, class Sched>
__device__ __forceinline__ void gemm_phase(LAS unsigned char* lds, const Sched& S, const Epi& E) {
    const int tid = otid(), wid = __builtin_amdgcn_readfirstlane(tid >> 6), lane = tid & 63, wr = wid >> 2, wc = wid & 3, fr = lane & 15, fq = lane >> 4;
    const int K = S.K, nt = K / BK;
    unsigned voffA[2], voffB[2];
#pragma unroll
    for (int i = 0; i < 2; ++i) { int R, C; stage_rc(tid * 16 + i * 8192, R, C); const int Rb = Epi::PERM ? ((R & ~31) + perm32(R & 31)) : R;
        voffA[i] = (unsigned)(R * S.lda + C) * 2u; voffB[i] = (unsigned)(Rb * S.ldb + C) * 2u; }
    const size_t kstep = (size_t)(BK * 2);
    const size_t hstepA = (size_t)HALF * S.lda * 2, hstepB = (size_t)HALF * S.ldb * 2;
    const unsigned ldsw = (unsigned)wid * 1024u;
    const int aoff = lds_byte(wr * 64 + fr, fq * 8), boff = lds_byte(wc * 32 + fr, fq * 8);
#define PG8_SA(b, h) (((b) * 2 + (h)) * HTB)
#define PG8_SB(b, h) ((4 + (b) * 2 + (h)) * HTB)
#define PG8_STAGE(bufoff, gbase, voff) do { _Pragma("unroll") for (int _i = 0; _i < 2; ++_i) \
        __builtin_amdgcn_global_load_lds((const unsigned*)((const char*)(gbase) + (voff)[_i]), (LAS unsigned*)(lds + (bufoff) + ldsw + _i * 8192), 16, 0, 0); } while (0)
#define PG8_LDA(dst, b, h) do { _Pragma("unroll") for (int m = 0; m < 4; ++m) _Pragma("unroll") for (int k = 0; k < 2; ++k) dst[m][k] = *(const LAS bf16x8*)(lds + PG8_SA(b, h) + aoff + m * 2048 + k * 1024); } while (0)
#define PG8_LDB(dst, b, h) do { _Pragma("unroll") for (int n = 0; n < 2; ++n) _Pragma("unroll") for (int k = 0; k < 2; ++k) dst[n][k] = *(const LAS bf16x8*)(lds + PG8_SB(b, h) + boff + n * 2048 + k * 1024); } while (0)
#define PG8_MMA(ai, bj, At, Bt) do { __builtin_amdgcn_s_setprio(1); _Pragma("unroll") for (int m = 0; m < 4; ++m) _Pragma("unroll") for (int n = 0; n < 2; ++n) _Pragma("unroll") for (int k = 0; k < 2; ++k) \
        acc[ai][bj][m][n] = __builtin_amdgcn_mfma_f32_16x16x32_bf16(Bt[n][k], At[m][k], acc[ai][bj][m][n], 0, 0, 0); __builtin_amdgcn_s_setprio(0); } while (0)
#define PG8_WAIT_V(n) asm volatile("s_waitcnt vmcnt(" #n ")" ::: "memory")
#define PG8_WAIT_L(n) asm volatile("s_waitcnt lgkmcnt(" #n ")" ::: "memory")
#define PG8_BAR __builtin_amdgcn_s_barrier()
#define PG8_SCHED __builtin_amdgcn_sched_barrier(0)
    Unit cur, nxt; int ui = 0;
    if (!S.next(0, cur)) return;
    f32x4 acc[2][2][4][2];
#pragma unroll
    for (int a = 0; a < 2; ++a)
#pragma unroll
        for (int b = 0; b < 2; ++b)
#pragma unroll
            for (int m = 0; m < 4; ++m)
#pragma unroll
                for (int n = 0; n < 2; ++n) acc[a][b][m][n] = (f32x4){0.f, 0.f, 0.f, 0.f};
    bf16x8 At[4][2], B0[2][2], B1[2][2];
    const char* cA = cur.A; const char* cB = cur.B;
    S.a_ready(cur);
    PG8_STAGE(PG8_SB(0, 0), cB, voffB); PG8_STAGE(PG8_SA(0, 0), cA, voffA); PG8_STAGE(PG8_SB(0, 1), cB + hstepB, voffB); PG8_STAGE(PG8_SA(0, 1), cA + hstepA, voffA);
    if (wr == 1) PG8_BAR;
    PG8_WAIT_V(4); PG8_BAR;
    PG8_STAGE(PG8_SB(1, 0), cB + kstep, voffB); PG8_STAGE(PG8_SA(1, 0), cA + kstep, voffA); PG8_STAGE(PG8_SB(1, 1), cB + hstepB + kstep, voffB);
    PG8_WAIT_V(6); PG8_BAR;
    for (;;) {
        const bool has_next = S.next(ui + 1, nxt);
        const char* nA = has_next ? nxt.A : cA; const char* nB = has_next ? nxt.B : cB;
        for (int t = 0; t < nt; t += 2) {
            const bool last = (t == nt - 2);
            const char* a1 = cA + (size_t)(t + 1) * kstep;
            const char* a2 = last ? nA : cA + (size_t)(t + 2) * kstep; const char* b2 = last ? nB : cB + (size_t)(t + 2) * kstep;
            const char* a3 = a2 + kstep; const char* b3 = b2 + kstep;
            if (last && has_next) S.a_ready(nxt);
            PG8_LDB(B0, 0, 0); PG8_SCHED; PG8_LDA(At, 0, 0); PG8_STAGE(PG8_SA(1, 1), a1 + hstepA, voffA);
            PG8_WAIT_L(8); PG8_BAR; PG8_WAIT_L(0); PG8_MMA(0, 0, At, B0); PG8_BAR; PG8_SCHED;
            PG8_LDB(B1, 0, 1); PG8_STAGE(PG8_SB(0, 0), b2, voffB);
            PG8_BAR; PG8_WAIT_L(0); PG8_MMA(0, 1, At, B1); PG8_BAR;
            PG8_LDA(At, 0, 1); PG8_STAGE(PG8_SA(0, 0), a2, voffA);
            PG8_BAR; PG8_WAIT_L(0); PG8_MMA(1, 0, At, B0); PG8_BAR; PG8_SCHED;
            PG8_STAGE(PG8_SB(0, 1), b2 + hstepB, voffB);
            PG8_WAIT_V(6); PG8_BAR; PG8_MMA(1, 1, At, B1); PG8_BAR;
            PG8_LDB(B0, 1, 0); PG8_SCHED; PG8_LDA(At, 1, 0); PG8_STAGE(PG8_SA(0, 1), a2 + hstepA, voffA);
            PG8_WAIT_L(8); PG8_BAR; PG8_WAIT_L(0); PG8_MMA(0, 0, At, B0); PG8_BAR; PG8_SCHED;
            PG8_LDB(B1, 1, 1); PG8_STAGE(PG8_SB(1, 0), b3, voffB);
            PG8_BAR; PG8_WAIT_L(0); PG8_MMA(0, 1, At, B1); PG8_BAR;
            PG8_LDA(At, 1, 1); PG8_STAGE(PG8_SA(1, 0), a3, voffA);
            PG8_BAR; PG8_WAIT_L(0); PG8_MMA(1, 0, At, B0); PG8_BAR; PG8_SCHED;
            PG8_STAGE(PG8_SB(1, 1), b3 + hstepB, voffB);
            PG8_WAIT_V(6); PG8_BAR; PG8_MMA(1, 1, At, B1); PG8_BAR;
        }
        E(acc, cur, wr, wc, fr, fq);
        if (!has_next) break;
#pragma unroll
        for (int a = 0; a < 2; ++a)
#pragma unroll
            for (int b = 0; b < 2; ++b)
#pragma unroll
                for (int m = 0; m < 4; ++m)
#pragma unroll
                    for (int n = 0; n < 2; ++n) acc[a][b][m][n] = (f32x4){0.f, 0.f, 0.f, 0.f};
        cur = nxt; cA = nA; cB = nB; ++ui;
    }
    PG8_WAIT_V(0);
    if (wr == 0) PG8_BAR;
    PG8_BAR;
#undef PG8_SA
#undef PG8_SB
#undef PG8_STAGE
#undef PG8_LDA
#undef PG8_LDB
#undef PG8_MMA
#undef PG8_WAIT_V
#undef PG8_WAIT_L
#undef PG8_BAR
#undef PG8_SCHED
}
}
using pg8::Unit;

struct EpiIn {
    static constexpr bool PERM = true;
    const float* ssq; const float* sb; bf16_t* out; int ldo, nbf; float* dtraw;
    template <bool UNI>
    __device__ __forceinline__ void body(const f32x4 (&acc)[2][2][4][2], const Unit& u, int wr, int wc, int fr, int fq) const {
        const int row0 = u.pm * 256 + wr * 64 + fr, colt = u.pn * 256 + wc * 32 + 8 * fq;
        f32x4 ub[2][2];
        if (UNI) {
            const float* sbr = sb + (size_t)(u.pm >> 3) * 6400;
#pragma unroll
            for (int bj = 0; bj < 2; ++bj) { const int c = colt + bj * 128; if (c < nbf + 32) { ub[bj][0] = *(const f32x4*)(sbr + c); ub[bj][1] = *(const f32x4*)(sbr + c + 4); } }
        }
        float rsv[2][4];
#pragma unroll
        for (int ai = 0; ai < 2; ++ai)
#pragma unroll
            for (int m = 0; m < 4; ++m) rsv[ai][m] = ssq[row0 + ai * 128 + m * 16];
#pragma unroll
        for (int ai = 0; ai < 2; ++ai) {
            f32x4 nb[4][2][2];
            if (!UNI) {
#pragma unroll
                for (int m = 0; m < 4; ++m) {
                    const float* sbr = sb + (size_t)row_b(row0 + ai * 128 + m * 16) * 6400;
#pragma unroll
                    for (int bj = 0; bj < 2; ++bj) { const int c = colt + bj * 128; if (c < nbf + 32) { nb[m][bj][0] = *(const f32x4*)(sbr + c); nb[m][bj][1] = *(const f32x4*)(sbr + c + 4); } }
                }
            }
#pragma unroll
            for (int m = 0; m < 4; ++m) {
                const int r = row0 + ai * 128 + m * 16;
                const float rstd = rsqrtf(rsv[ai][m] * (1.f / 1024.f) + 1e-6f);
#pragma unroll
                for (int bj = 0; bj < 2; ++bj) {
                    const int c = colt + bj * 128;
                    if (c < nbf + 32) {
                        f32x4 b0, b1;
                        if (UNI) { b0 = ub[bj][0]; b1 = ub[bj][1]; } else { b0 = nb[m][bj][0]; b1 = nb[m][bj][1]; }
                        const f32x4 v0 = acc[ai][bj][m][0] * rstd + b0, v1 = acc[ai][bj][m][1] * rstd + b1;
                        if (c < nbf) *(u32x4*)(out + (size_t)r * ldo + c) = pack8(v0, v1);
                        else if (dtraw != nullptr) { float* dp = dtraw + (size_t)r * 32 + (c - nbf); *(f32x4*)dp = v0; *(f32x4*)(dp + 4) = v1; }
                    }
                }
            }
        }
    }
    __device__ __forceinline__ void operator()(const f32x4 (&acc)[2][2][4][2], const Unit& u, int wr, int wc, int fr, int fq) const {
        asm volatile("" : "+v"(fr), "+v"(fq));
        if (u.pm < 64) body<true>(acc, u, wr, wc, fr, fq); else body<false>(acc, u, wr, wc, fr, fq);
    }
};
struct EpiOut {
    static constexpr bool PERM = true;
    const float* xin_p; const float* xin_s; float* xw; const float* modl; const float* ng_next; bf16_t* aprime; float* ssq;
    template <bool UNI>
    __device__ __forceinline__ void body(const f32x4 (&acc)[2][2][4][2], const Unit& u, int wr, int wc, int fr, int fq) const {
        const int row0 = u.pm * 256 + wr * 64 + fr, colt = u.pn * 256 + wc * 32 + 8 * fq;
        const bool has_next = ng_next != nullptr;
        f32x4 ug[2][2], us[2][2], uw[2][2];
#pragma unroll
        for (int bj = 0; bj < 2; ++bj) {
            const int c = colt + bj * 128;
            if (has_next) { uw[bj][0] = *(const f32x4*)(ng_next + c); uw[bj][1] = *(const f32x4*)(ng_next + c + 4); }
            if (UNI) {
                const float* mb = modl + (size_t)(u.pm >> 3) * 12288;
                ug[bj][0] = *(const f32x4*)(mb + 2048 + c) + 1.f; ug[bj][1] = *(const f32x4*)(mb + 2048 + c + 4) + 1.f;
                if (has_next) { us[bj][0] = (*(const f32x4*)(mb + 4096 + c) + 1.f) * uw[bj][0]; us[bj][1] = (*(const f32x4*)(mb + 4096 + c + 4) + 1.f) * uw[bj][1]; }
            }
        }
#pragma unroll
        for (int ai = 0; ai < 2; ++ai)
#pragma unroll
            for (int mp = 0; mp < 2; ++mp) {
                f32x4 xv[2][2][2];
#pragma unroll
                for (int mm = 0; mm < 2; ++mm) {
                    const int r = row0 + ai * 128 + (mp * 2 + mm) * 16;
                    const float* xr = r < MP ? xin_p + (size_t)r * DM : xin_s + (size_t)(r - MP) * DM;
#pragma unroll
                    for (int bj = 0; bj < 2; ++bj) { xv[mm][bj][0] = *(const f32x4*)(xr + colt + bj * 128); xv[mm][bj][1] = *(const f32x4*)(xr + colt + bj * 128 + 4); }
                }
#pragma unroll
                for (int mm = 0; mm < 2; ++mm) {
                    const int m = mp * 2 + mm;
                    const int r = row0 + ai * 128 + m * 16;
                    const float* mb = modl + (size_t)row_b(r) * 12288;
                    float ss = 0.f;
#pragma unroll
                    for (int bj = 0; bj < 2; ++bj) {
                        const int c = colt + bj * 128;
                        f32x4 g0, g1;
                        if (UNI) { g0 = ug[bj][0]; g1 = ug[bj][1]; } else { g0 = *(const f32x4*)(mb + 2048 + c) + 1.f; g1 = *(const f32x4*)(mb + 2048 + c + 4) + 1.f; }
                        const f32x4 n0 = xv[mm][bj][0] + g0 * acc[ai][bj][m][0], n1 = xv[mm][bj][1] + g1 * acc[ai][bj][m][1];
                        *(f32x4*)(xw + (size_t)r * DM + c) = n0; *(f32x4*)(xw + (size_t)r * DM + c + 4) = n1;
                        ss += (n0.x * n0.x + n0.y * n0.y) + (n0.z * n0.z + n0.w * n0.w) + (n1.x * n1.x + n1.y * n1.y) + (n1.z * n1.z + n1.w * n1.w);
                        if (has_next) {
                            f32x4 s0, s1;
                            if (UNI) { s0 = us[bj][0]; s1 = us[bj][1]; } else { s0 = (*(const f32x4*)(mb + 4096 + c) + 1.f) * uw[bj][0]; s1 = (*(const f32x4*)(mb + 4096 + c + 4) + 1.f) * uw[bj][1]; }
                            *(u32x4*)(aprime + (size_t)r * DM + c) = pack8(n0 * s0, n1 * s1);
                        }
                    }
                    ss += __shfl_xor(ss, 16); ss += __shfl_xor(ss, 32);
                    if (fq == 0) atomicAdd(ssq + r, ss);
                }
            }
    }
    __device__ __forceinline__ void operator()(const f32x4 (&acc)[2][2][4][2], const Unit& u, int wr, int wc, int fr, int fq) const {
        asm volatile("" : "+v"(fr), "+v"(fq));
        if (u.pm < 64) body<true>(acc, u, wr, wc, fr, fq); else body<false>(acc, u, wr, wc, fr, fq);
    }
};
struct EpiGrp {
    static constexpr bool PERM = true;
    const bf16_t* uz; const float* chs; bf16_t* out;
    __device__ __forceinline__ void operator()(const f32x4 (&acc)[2][2][4][2], const Unit& u, int wr, int wc, int fr, int fq) const {
        asm volatile("" : "+v"(fr), "+v"(fq));
        const int row0 = u.pm * 256 + wr * 64 + fr, colt = u.pn * 256 + wc * 32 + 8 * fq;
        f32x4 cs[2][2];
#pragma unroll
        for (int bj = 0; bj < 2; ++bj) { cs[bj][0] = *(const f32x4*)(chs + colt + bj * 128); cs[bj][1] = *(const f32x4*)(chs + colt + bj * 128 + 4); }
#pragma unroll
        for (int ai = 0; ai < 2; ++ai) {
            u32x4 zz[4][2];
#pragma unroll
            for (int m = 0; m < 4; ++m)
#pragma unroll
                for (int bj = 0; bj < 2; ++bj) zz[m][bj] = *(const u32x4*)(uz + (size_t)(row0 + ai * 128 + m * 16) * 4096 + 2048 + colt + bj * 128);
#pragma unroll
            for (int m = 0; m < 4; ++m) {
                const int r = row0 + ai * 128 + m * 16;
#pragma unroll
                for (int bj = 0; bj < 2; ++bj) {
                    const int c = colt + bj * 128;
                    const u32x4 z = zz[m][bj];
                    const f32x2 a = silu2((f32x2){bf_lo(z.x), bf_hi(z.x)}), b = silu2((f32x2){bf_lo(z.y), bf_hi(z.y)}), cc = silu2((f32x2){bf_lo(z.z), bf_hi(z.z)}), d = silu2((f32x2){bf_lo(z.w), bf_hi(z.w)});
                    const f32x4 z0 = {a.x, a.y, b.x, b.y}, z1 = {cc.x, cc.y, d.x, d.y};
                    *(u32x4*)(out + (size_t)r * 2048 + c) = pack8(acc[ai][bj][m][0] * cs[bj][0] * z0, acc[ai][bj][m][1] * cs[bj][1] * z1);
                }
            }
        }
    }
};
struct EpiSmall {
    static constexpr bool PERM = true;
    int mode; float* mod; const float* ada_b; bf16_t* shiftA; float* sb;
    __device__ __forceinline__ void operator()(const f32x4 (&acc)[2][2][4][2], const Unit& u, int wr, int wc, int fr, int fq) const {
        asm volatile("" : "+v"(fr), "+v"(fq));
        const int row0 = wr * 64 + fr, colt = u.pn * 256 + wc * 32 + 8 * fq;
#pragma unroll
        for (int ai = 0; ai < 2; ++ai)
#pragma unroll
            for (int m = 0; m < 4; ++m) {
                const int r = row0 + ai * 128 + m * 16;
                if (r < 136) {
#pragma unroll
                    for (int bj = 0; bj < 2; ++bj) {
                        const int c = colt + bj * 128;
                        if (mode == 0) {
                            const f32x4 v0 = acc[ai][bj][m][0] + *(const f32x4*)(ada_b + c), v1 = acc[ai][bj][m][1] + *(const f32x4*)(ada_b + c + 4);
                            *(f32x4*)(mod + (size_t)r * 12288 + c) = v0; *(f32x4*)(mod + (size_t)r * 12288 + c + 4) = v1;
                            const int li = c / 3072, cc = c - li * 3072;
                            if (cc < 1024) *(u32x4*)(shiftA + ((size_t)li * 256 + r) * 1024 + cc) = pack8(v0, v1);
                        } else {
                            float* sp = sb + ((size_t)u.q * 136 + r) * 6400 + c;
                            *(f32x4*)sp = acc[ai][bj][m][0]; *(f32x4*)(sp + 4) = acc[ai][bj][m][1];
                        }
                    }
                }
            }
    }
};

__device__ void phase_prep0(const Params& p, const WTab& wt, LAS unsigned char* lds, int tile_lo, int tile_hi, int blk0, bool misc) {
    if ((int)blockIdx.x < blk0) return;
    LAS float* tl = (LAS float*)lds;
    const int tid = otid();
    for (int tile = tile_lo + ((int)blockIdx.x - blk0); tile < tile_hi; tile += (int)gridDim.x - blk0) {
        int j = 0;
#pragma unroll 1
        for (int q = 1; q < NWJ; ++q) if (tile >= wt.wj[q].tile_begin) j = q;
        const WJob job = wt.wj[j];
        bf16_t* jdst = (bf16_t*)(p.ws + job.doff);
        const int lt = tile - job.tile_begin, tk = lt / job.tiles_n, tn = lt - tk * job.tiles_n, k0 = tk * 64, n0 = tn * 64;
        {
            const int kk = tid >> 3, nn = (tid & 7) * 8;
            f32x4 a = (f32x4){0.f, 0.f, 0.f, 0.f}, b = a;
            if (n0 + nn < job.N) { const __attribute__((address_space(1))) f32x4* sp = (const __attribute__((address_space(1))) f32x4*)(job.src + (size_t)(k0 + kk) * job.N + n0 + nn); a = sp[0]; b = sp[1]; }
            LAS float* d = tl + kk * 65 + nn;
            d[0] = a.x; d[1] = a.y; d[2] = a.z; d[3] = a.w; d[4] = b.x; d[5] = b.y; d[6] = b.z; d[7] = b.w;
        }
        __syncthreads();
        {
            const int n = tid >> 3, k8 = (tid & 7) * 8;
            const LAS float* s = tl + k8 * 65 + n;
            u32x4 o; o.x = cvt_pk_bf16(s[0], s[65]); o.y = cvt_pk_bf16(s[130], s[195]); o.z = cvt_pk_bf16(s[260], s[325]); o.w = cvt_pk_bf16(s[390], s[455]);
            *(u32x4*)(jdst + (size_t)(n0 + n) * job.K + k0 + k8) = o;
        }
        __syncthreads();
    }
    if (!misc) return;
    bf16_t* ac = (bf16_t*)(p.ws + WS_AC);
    const int gt = blockIdx.x * 512 + tid, nth = gridDim.x * 512;
    for (int i = gt; i < 256 * 1024 / 8; i += nth) {
        const int r = i >> 7, c = (i & 127) * 8;
        u32x4 o = (u32x4){0u, 0u, 0u, 0u};
        if (r < 136) {
            const float* cp = r < 8 ? p.in[5] + (size_t)r * 1024 + c : p.in[6] + (size_t)(r - 8) * 1024 + c;
            const f32x4 a = *(const f32x4*)cp, b = *(const f32x4*)(cp + 4);
            o.x = cvt_pk_bf16(silu_f(a.x), silu_f(a.y)); o.y = cvt_pk_bf16(silu_f(a.z), silu_f(a.w)); o.z = cvt_pk_bf16(silu_f(b.x), silu_f(b.y)); o.w = cvt_pk_bf16(silu_f(b.z), silu_f(b.w));
        }
        *(u32x4*)(ac + (size_t)i * 8) = o;
    }
    { u32x4* sq = (u32x4*)(p.ws + WS_SSQ + 17408ull * 4); for (int i = gt; i < 4 * 17408 / 4; i += nth) sq[i] = (u32x4){0u, 0u, 0u, 0u}; }
    u32x4* sh = (u32x4*)(p.ws + WS_SHIFTA);
    for (int i = gt; i < 4 * 256 * 1024 / 8; i += nth) sh[i] = (u32x4){0u, 0u, 0u, 0u};
}

__device__ void phase_xprep(const Params& p, int blk0) {
    if ((int)blockIdx.x < blk0) return;
    const int tid_ = otid(), lane = tid_ & 63, wv = ((int)blockIdx.x - blk0) * 8 + (tid_ >> 6), nw = ((int)gridDim.x - blk0) * 8;
    const float* mod = (const float*)(p.ws + WS_MOD);
    bf16_t* ap = (bf16_t*)(p.ws + WS_APRIME);
    float* ssq = (float*)(p.ws + WS_SSQ);
    const float* ng = p.in[9];
    for (int r0 = wv * 2; r0 < MT; r0 += nw * 2) {
        f32x4 x[2][4];
#pragma unroll
        for (int h = 0; h < 2; ++h) {
            const int r = r0 + h;
            const float* xr = r < MP ? p.in[0] + (size_t)r * DM : p.in[1] + (size_t)(r - MP) * DM;
#pragma unroll
            for (int q = 0; q < 4; ++q) x[h][q] = *(const f32x4*)(xr + q * 256 + lane * 4);
        }
#pragma unroll
        for (int h = 0; h < 2; ++h) {
            const int r = r0 + h;
            const float* mb = mod + (size_t)row_b(r) * 12288 + 1024;
            float ss = 0.f;
#pragma unroll
            for (int q = 0; q < 4; ++q) {
                const int c = q * 256 + lane * 4;
                const f32x4 xv = x[h][q], sv = *(const f32x4*)(mb + c), g = *(const f32x4*)(ng + c);
                ss += (xv.x * xv.x + xv.y * xv.y) + (xv.z * xv.z + xv.w * xv.w);
                const f32x4 a = xv * g * (sv + 1.f);
                u32x2 o; o.x = cvt_pk_bf16(a.x, a.y); o.y = cvt_pk_bf16(a.z, a.w);
                *(u32x2*)(ap + (size_t)r * DM + c) = o;
            }
#pragma unroll
            for (int o = 1; o < 64; o <<= 1) ss += __shfl_xor(ss, o);
            if (lane == 0) ssq[r] = ss;
        }
    }
}

__device__ void phase_final(const Params& p, int r_begin, int r_end, int blk0) {
    if ((int)blockIdx.x < blk0) return;
    const int tid_ = otid(), lane = tid_ & 63, wv = ((int)blockIdx.x - blk0) * 8 + (tid_ >> 6), nw = ((int)gridDim.x - blk0) * 8;
    const float* xw = (const float*)(p.ws + WS_XW);
    const float* ssq = (const float*)(p.ws + WS_SSQ) + 4 * 17408;
    const float* fg = p.in[22];
    for (int r0 = r_begin + wv * 2; r0 < r_end; r0 += nw * 2) {
        f32x4 x[2][4];
#pragma unroll
        for (int h = 0; h < 2; ++h)
#pragma unroll
            for (int q = 0; q < 4; ++q) x[h][q] = *(const f32x4*)(xw + (size_t)(r0 + h) * DM + q * 256 + lane * 4);
#pragma unroll
        for (int h = 0; h < 2; ++h) {
            const int r = r0 + h;
            const float rstd = rsqrtf(ssq[r] * (1.f / 1024.f) + 1e-6f);
#pragma unroll
            for (int q = 0; q < 4; ++q) {
                const int c = q * 256 + lane * 4;
                const f32x4 g = *(const f32x4*)(fg + c);
                *(f32x4*)(p.out + (size_t)r * DM + c) = x[h][q] * rstd * g;
            }
        }
    }
}

__device__ void phase_ssdnorm(const Params& p, int j) {
    const int tid_ = otid(), lane = tid_ & 63, wv = blockIdx.x * 8 + (tid_ >> 6), nw = gridDim.x * 8;
    const bf16_t* yg = (const bf16_t*)(p.ws + WS_YG);
    bf16_t* a2 = (bf16_t*)(p.ws + WS_A2);
    const float* ng = p.in[16] + (size_t)j * 2048;
    for (int r0 = wv * 2; r0 < MT; r0 += nw * 2) {
        u32x4 vv[2][4];
#pragma unroll
        for (int h = 0; h < 2; ++h)
#pragma unroll
            for (int q = 0; q < 4; ++q) vv[h][q] = *(const u32x4*)(yg + (size_t)(r0 + h) * 2048 + q * 512 + lane * 8);
#pragma unroll
        for (int h = 0; h < 2; ++h)
#pragma unroll
            for (int q = 0; q < 4; ++q) {
                const int c = q * 512 + lane * 8;
                const u32x4 v = vv[h][q];
                f32x4 a, b;
                a.x = bf_lo(v.x); a.y = bf_hi(v.x); a.z = bf_lo(v.y); a.w = bf_hi(v.y); b.x = bf_lo(v.z); b.y = bf_hi(v.z); b.z = bf_lo(v.w); b.w = bf_hi(v.w);
                float ss = (a.x * a.x + a.y * a.y) + (a.z * a.z + a.w * a.w) + (b.x * b.x + b.y * b.y) + (b.z * b.z + b.w * b.w);
#pragma unroll
                for (int o = 1; o < 32; o <<= 1) ss += __shfl_xor(ss, o);
                const float rstd = rsqrtf(ss * (1.f / 256.f) + 1e-6f);
                const f32x4 g0 = *(const f32x4*)(ng + c), g1 = *(const f32x4*)(ng + c + 4);
                *(u32x4*)(a2 + (size_t)(r0 + h) * 2048 + c) = pack8(a * rstd * g0, b * rstd * g1);
            }
    }
}

__device__ void phase_pool(const Params& p, int j) {
    const bf16_t* uz = (const bf16_t*)(p.ws + WS_ZX);
    bf16_t* pooled = (bf16_t*)(p.ws + WS_YG);
    const int gt = blockIdx.x * 512 + otid(), nth = gridDim.x * 512;
    for (int u = gt; u < 131072 + 32768; u += nth) {
        int cv, row0, t0, R; const float* prev = nullptr; bool prompt;
        if (u < 131072) { cv = u & 255; const int run = (u >> 8) & 63, b = u >> 14; row0 = b * 2048; t0 = run * 32; R = 32; prompt = true; }
        else { const int v = u - 131072; cv = v & 255; const int b = v >> 8; row0 = MP + b * 8; t0 = 0; R = 8; prompt = false; prev = p.in[4] + ((size_t)(j * 128 + b) * 15) * 2048; }
        const int c = cv * 8, w = 2 << (c >> 9);
        float s[8];
#pragma unroll
        for (int i = 0; i < 8; ++i) s[i] = 0.f;
        auto getu = [&](int tt, float (&o)[8]) {
            if (tt >= 0) {
                const u32x4 v = *(const u32x4*)(uz + (size_t)(row0 + tt) * 4096 + c);
                o[0] = bf_lo(v.x); o[1] = bf_hi(v.x); o[2] = bf_lo(v.y); o[3] = bf_hi(v.y); o[4] = bf_lo(v.z); o[5] = bf_hi(v.z); o[6] = bf_lo(v.w); o[7] = bf_hi(v.w);
            } else if (!prompt) {
                const float* pp = prev + (size_t)(15 + tt) * 2048 + c;
                const f32x4 a = *(const f32x4*)pp, b = *(const f32x4*)(pp + 4);
                o[0] = a.x; o[1] = a.y; o[2] = a.z; o[3] = a.w; o[4] = b.x; o[5] = b.y; o[6] = b.z; o[7] = b.w;
            } else {
#pragma unroll
                for (int i = 0; i < 8; ++i) o[i] = 0.f;
            }
        };
        for (int i = 1; i < w; ++i) {
            float o[8]; getu(t0 - i, o);
#pragma unroll
            for (int k = 0; k < 8; ++k) s[k] += o[k];
        }
        for (int tb = t0; tb < t0 + R; tb += 4) {
            float cur[4][8], old[4][8];
#pragma unroll
            for (int k = 0; k < 4; ++k) { getu(tb + k, cur[k]); getu(tb + k - w + 1, old[k]); }
#pragma unroll
            for (int k = 0; k < 4; ++k) {
                const int t = tb + k;
                const float inv = 1.f / (float)(prompt ? min(w, t + 1) : w);
                f32x4 a, b;
#pragma unroll
                for (int i = 0; i < 8; ++i) s[i] += cur[k][i];
                a.x = s[0] * inv - cur[k][0]; a.y = s[1] * inv - cur[k][1]; a.z = s[2] * inv - cur[k][2]; a.w = s[3] * inv - cur[k][3];
                b.x = s[4] * inv - cur[k][4]; b.y = s[5] * inv - cur[k][5]; b.z = s[6] * inv - cur[k][6]; b.w = s[7] * inv - cur[k][7];
                *(u32x4*)(pooled + (size_t)(row0 + t) * 2048 + c) = pack8(a, b);
#pragma unroll
                for (int i = 0; i < 8; ++i) s[i] -= old[k][i];
            }
        }
    }
    for (int i = gt; i < (8 + 128) * 15 * 256; i += nth) {
        const int cv = i & 255, k = (i >> 8) % 15, sq = (i >> 8) / 15, ch = cv * 8;
        f32x4 a, b2;
        float* dst;
        bool from_state = false; size_t urow = 0;
        if (sq < 8) { urow = (size_t)(sq * 2048 + 2033 + k); dst = p.out + O_POOL_P + ((size_t)(j * 8 + sq) * 15 + k) * 2048 + ch; }
        else { const int bb = sq - 8; dst = p.out + O_POOL_S + ((size_t)(j * 128 + bb) * 15 + k) * 2048 + ch; if (k < 7) from_state = true; else urow = (size_t)(MP + bb * 8 + k - 7); }
        if (from_state) { const float* sp = p.in[4] + ((size_t)(j * 128 + (sq - 8)) * 15 + 8 + k) * 2048 + ch; a = *(const f32x4*)sp; b2 = *(const f32x4*)(sp + 4); }
        else { const u32x4 v = *(const u32x4*)(uz + urow * 4096 + ch); a = (f32x4){bf_lo(v.x), bf_hi(v.x), bf_lo(v.y), bf_hi(v.y)}; b2 = (f32x4){bf_lo(v.z), bf_hi(v.z), bf_lo(v.w), bf_hi(v.w)}; }
        *(f32x4*)dst = a; *(f32x4*)(dst + 4) = b2;
    }
}

constexpr int RS = 272;
constexpr int L_XT = 0, L_BN = 17408, L_BT = 52224, L_CN = 87040, L_HB = 121856, L_SM = 139264, L_CW = 143360;
__device__ __forceinline__ int xt_addr(int pr, int t) { return L_XT + pr * RS + ((((t >> 3) ^ (pr >> 1)) & 15) << 4) + (t & 7) * 2; }
__device__ __forceinline__ int bt_addr(int n, int t) { return L_BT + n * RS + ((((t >> 3) ^ (n >> 3)) & 15) << 4) + (t & 7) * 2; }
__device__ __forceinline__ f32x16 mfma32(bf16x8 a, bf16x8 b, f32x16 c) { return __builtin_amdgcn_mfma_f32_32x32x16_bf16(a, b, c, 0, 0, 0); }

#define OPQ(x) asm volatile("" : "+v"(x))
__device__ void ssd_prompt_item(const Params& p, int j, int b, int h, LAS unsigned char* lds) {
    const int tid0 = otid(), wid = __builtin_amdgcn_readfirstlane(tid0 >> 6), g = h >> 2;
    const char* zxc = (const char*)(p.ws + WS_ZX);
    const char* dtc = (const char*)(p.ws + WS_DTRAW);
    char* ygc = (char*)(p.ws + WS_YG);
    const int rowbase = b * 2048;
    LAS float* cw = (LAS float*)(lds + L_CW);
    const float Ah = -__expf(p.in[14][j * 32 + h]), Dh = p.in[15][j * 32 + h], dtb = p.in[13][j * 32 + h];
    const bool roleB = wid < 4;
    const int qq = wid >> 1, tt = qq ^ (qq >> 1), pt = wid & 1, hp = wid & 1, hn = wid >> 1;

    __syncthreads();
    if (tid0 < 320) {
        const int ch = tid0 < 64 ? h * 64 + tid0 : (tid0 < 192 ? 2048 + g * 128 + (tid0 - 64) : 3072 + g * 128 + (tid0 - 192));
#pragma unroll
        for (int k = 0; k < 4; ++k) cw[k * 320 + tid0] = p.in[11][((size_t)j * 4 + k) * 4096 + ch];
        cw[4 * 320 + tid0] = p.in[12][(size_t)j * 4096 + ch];
    }
    for (int i = tid0; i < 17408 / 4; i += 512) *(LAS unsigned*)(lds + L_HB + i * 4) = 0u;

    u32x4 rawBC[11]; unsigned rawX[11]; float dtp0 = 0.f, dtp1 = 0.f;
    auto prefetch = [&](int t0) {
        int tid = tid0; OPQ(tid);
        const int bt_ = tid & 255, tqb = bt_ >> 4, cg8 = bt_ & 15, tqx = tid >> 5, cp = tid & 31, lane = tid & 63;
        const int colBC = (roleB ? 4096 : 5120) + g * 128 + cg8 * 8, colX = 2048 + h * 64 + cp * 2;
        const int rB = t0 + tqb * 8 - 3, rX = t0 + tqx * 8 - 3;
        const unsigned oB = (unsigned)((rowbase + rB) * ZXW + colBC) * 2u, oX = (unsigned)((rowbase + rX) * ZXW + colX) * 2u;
#pragma unroll
        for (int i = 0; i < 11; ++i) {
            rawBC[i] = (rB + i >= 0) ? *(const u32x4*)(zxc + (oB + (unsigned)i * 12288u)) : (u32x4){0u, 0u, 0u, 0u};
            rawX[i] = (rX + i >= 0) ? *(const unsigned*)(zxc + (oX + (unsigned)i * 12288u)) : 0u;
        }
        if (wid == 0) { const unsigned od = (unsigned)((rowbase + t0 + 2 * lane) * 32 + h) * 4u; dtp0 = *(const float*)(dtc + od); dtp1 = *(const float*)(dtc + (od + 128u)); }
    };
    prefetch(0);

    auto acum_stage = [&](int par) {
        if (wid == 0) {
            LAS float* sm_acum = (LAS float*)(lds + L_SM + par * 2048);
            LAS float* sm_dt = sm_acum + 128;
            LAS float* sm_w = sm_acum + 256;
            LAS float* sm_ea = sm_acum + 384;
            int lane = tid0 & 63; OPQ(lane);
            const float d0 = softplus_f(dtp0 + dtb), d1 = softplus_f(dtp1 + dtb);
            const float a0 = d0 * Ah, a1 = a0 + d1 * Ah;
            float sc = a1;
#pragma unroll
            for (int o = 1; o < 64; o <<= 1) { const float v = __shfl_up(sc, o); if (lane >= o) sc += v; }
            const float c1 = sc, c0 = sc - a1 + a0;
            const float last = __shfl(sc, 63);
            sm_acum[2 * lane] = c0; sm_acum[2 * lane + 1] = c1;
            sm_dt[2 * lane] = d0; sm_dt[2 * lane + 1] = d1;
            sm_w[2 * lane] = __expf(last - c0) * d0; sm_w[2 * lane + 1] = __expf(last - c1) * d1;
            sm_ea[2 * lane] = __expf(c0); sm_ea[2 * lane + 1] = __expf(c1);
        }
    };
    acum_stage(0);
    __syncthreads();

    f32x16 hacc;
#pragma unroll
    for (int i = 0; i < 16; ++i) hacc[i] = 0.f;

#pragma unroll 1
    for (int c = 0; c < 16; ++c) {
        const int t0 = c * 128;
        LAS float* sm_acum = (LAS float*)(lds + L_SM + (c & 1) * 2048);
        LAS float* sm_dt = sm_acum + 128;
        LAS float* sm_w = sm_acum + 256;
        LAS float* sm_ea = sm_acum + 384;
        {
            int tid = tid0; OPQ(tid);
            const int bt_ = tid & 255, tqb = bt_ >> 4, cg8 = bt_ & 15;
            const int lcBC = (roleB ? 64 : 192) + cg8 * 8;
            const f32x4 wv0 = *(const LAS f32x4*)(sm_w + tqb * 8), wv1 = *(const LAS f32x4*)(sm_w + tqb * 8 + 4);
            const float wt[8] = {wv0.x, wv0.y, wv0.z, wv0.w, wv1.x, wv1.y, wv1.z, wv1.w};
            const int natbase = (roleB ? L_BN : L_CN) + (tqb * 8) * RS + cg8 * 16;
#pragma unroll
            for (int half = 0; half < 2; ++half) {
                u32x2 nat[8]; u32x4 tr[4];
#pragma unroll
                for (int ipp = 0; ipp < 2; ++ipp) {
                    const int ip = half * 2 + ipp;
                    const float k0a = cw[0 * 320 + lcBC + 2 * ip], k0b = cw[0 * 320 + lcBC + 2 * ip + 1];
                    const float k1a = cw[1 * 320 + lcBC + 2 * ip], k1b = cw[1 * 320 + lcBC + 2 * ip + 1];
                    const float k2a = cw[2 * 320 + lcBC + 2 * ip], k2b = cw[2 * 320 + lcBC + 2 * ip + 1];
                    const float k3a = cw[3 * 320 + lcBC + 2 * ip], k3b = cw[3 * 320 + lcBC + 2 * ip + 1];
                    const float bba = cw[4 * 320 + lcBC + 2 * ip], bbb = cw[4 * 320 + lcBC + 2 * ip + 1];
                    f32x2 rr[11];
#pragma unroll
                    for (int i = 0; i < 11; ++i) { const unsigned v = rawBC[i][ip]; rr[i] = (f32x2){bf_lo(v), bf_hi(v)}; }
                    const f32x2 K0 = {k0a, k0b}, K1 = {k1a, k1b}, K2 = {k2a, k2b}, K3 = {k3a, k3b}, BB = {bba, bbb};
                    float va[8], vb[8];
#pragma unroll
                    for (int t = 0; t < 8; ++t) {
                        const f32x2 v = silu2(BB + K0 * rr[t] + K1 * rr[t + 1] + K2 * rr[t + 2] + K3 * rr[t + 3]);
                        va[t] = v.x; vb[t] = v.y;
                        nat[t][ipp] = cvt_pk_bf16(v.x, v.y);
                    }
                    if (roleB) {
#pragma unroll
                        for (int tp = 0; tp < 4; ++tp) {
                            tr[2 * ipp][tp] = cvt_pk_bf16(va[2 * tp] * wt[2 * tp], va[2 * tp + 1] * wt[2 * tp + 1]);
                            tr[2 * ipp + 1][tp] = cvt_pk_bf16(vb[2 * tp] * wt[2 * tp], vb[2 * tp + 1] * wt[2 * tp + 1]);
                        }
                    }
                }
#pragma unroll
                for (int t = 0; t < 8; ++t) *(LAS u32x2*)(lds + natbase + t * RS + half * 8) = nat[t];
                if (roleB) {
#pragma unroll
                    for (int i = 0; i < 4; ++i) *(LAS u32x4*)(lds + bt_addr(cg8 * 8 + half * 4 + i, tqb * 8)) = tr[i];
                }
                __builtin_amdgcn_sched_barrier(0);
            }
        }
        {
            int tid = tid0; OPQ(tid);
            const int tqx = tid >> 5, cp = tid & 31, lcX = cp * 2;
            const float k0a = cw[0 * 320 + lcX], k0b = cw[0 * 320 + lcX + 1], k1a = cw[1 * 320 + lcX], k1b = cw[1 * 320 + lcX + 1];
            const float k2a = cw[2 * 320 + lcX], k2b = cw[2 * 320 + lcX + 1], k3a = cw[3 * 320 + lcX], k3b = cw[3 * 320 + lcX + 1];
            const float bba = cw[4 * 320 + lcX], bbb = cw[4 * 320 + lcX + 1];
            f32x2 rr[11];
#pragma unroll
            for (int i = 0; i < 11; ++i) rr[i] = (f32x2){bf_lo(rawX[i]), bf_hi(rawX[i])};
            const f32x2 K0 = {k0a, k0b}, K1 = {k1a, k1b}, K2 = {k2a, k2b}, K3 = {k3a, k3b}, BB = {bba, bbb};
            float va[8], vb[8];
#pragma unroll
            for (int t = 0; t < 8; ++t) { const f32x2 v = silu2(BB + K0 * rr[t] + K1 * rr[t + 1] + K2 * rr[t + 2] + K3 * rr[t + 3]); va[t] = v.x; vb[t] = v.y; }
            u32x4 xa, xb;
            xa.x = cvt_pk_bf16(va[0], va[1]); xa.y = cvt_pk_bf16(va[2], va[3]); xa.z = cvt_pk_bf16(va[4], va[5]); xa.w = cvt_pk_bf16(va[6], va[7]);
            xb.x = cvt_pk_bf16(vb[0], vb[1]); xb.y = cvt_pk_bf16(vb[2], vb[3]); xb.z = cvt_pk_bf16(vb[4], vb[5]); xb.w = cvt_pk_bf16(vb[6], vb[7]);
            *(LAS u32x4*)(lds + xt_addr(cp * 2, tqx * 8)) = xa;
            *(LAS u32x4*)(lds + xt_addr(cp * 2 + 1, tqx * 8)) = xb;
        }
        if (c + 1 < 16) prefetch(t0 + 128);
        bf16_t zr[16];
        {
            int ln = tid0 & 63; OPQ(ln);
            const int l31 = ln & 31, hh = ln >> 5;
            const unsigned oz = (unsigned)((rowbase + t0 + tt * 32 + 4 * hh) * ZXW + h * 64 + pt * 32 + l31) * 2u;
#pragma unroll
            for (int rg = 0; rg < 16; ++rg) zr[rg] = *(const bf16_t*)(zxc + (oz + (unsigned)((rg & 3) + 8 * (rg >> 2)) * 12288u));
        }
        __syncthreads();
        f32x16 y;
        {
            int ln = tid0 & 63; OPQ(ln);
            const int l31 = ln & 31, hh = ln >> 5;
            const int cbase = L_CN + (tt * 32 + l31) * RS + 16 * hh, hbase = L_HB + (pt * 32 + l31) * RS + 16 * hh;
#pragma unroll
            for (int i = 0; i < 16; ++i) y[i] = 0.f;
            {
                const float dec = sm_ea[127];
#pragma unroll
                for (int i = 0; i < 16; ++i) hacc[i] *= dec;
            }
            bf16x8 cf[8];
#pragma unroll
            for (int ks = 0; ks < 8; ++ks) {
                cf[ks] = *(const LAS bf16x8*)(lds + cbase + ks * 32);
                const bf16x8 bfr = *(const LAS bf16x8*)(lds + hbase + ks * 32);
                const bf16x8 a = *(const LAS bf16x8*)(lds + xt_addr(hp * 32 + l31, ks * 16 + 8 * hh));
                const bf16x8 bb = *(const LAS bf16x8*)(lds + bt_addr(hn * 32 + l31, ks * 16 + 8 * hh));
                y = mfma32(cf[ks], bfr, y);
                hacc = mfma32(a, bb, hacc);
            }
#pragma unroll
            for (int rq = 0; rq < 4; ++rq) { const f32x4 e = *(const LAS f32x4*)(sm_ea + tt * 32 + 8 * rq + 4 * hh); y[4 * rq] *= e.x; y[4 * rq + 1] *= e.y; y[4 * rq + 2] *= e.z; y[4 * rq + 3] *= e.w; }
            const int tidx = tt * 32 + l31;
            const float at = sm_acum[tidx];
#pragma unroll 1
            for (int st = 0; st <= tt; ++st) {
                f32x16 s;
#pragma unroll
                for (int i = 0; i < 16; ++i) s[i] = 0.f;
                const int bbase = L_BN + (st * 32 + l31) * RS + 16 * hh;
#pragma unroll
                for (int ks = 0; ks < 8; ++ks) { const bf16x8 afr = *(const LAS bf16x8*)(lds + bbase + ks * 32); s = mfma32(afr, cf[ks], s); }
#pragma unroll
                for (int rq = 0; rq < 4; ++rq) {
                    const int sb0 = st * 32 + 8 * rq + 4 * hh;
                    const f32x4 asv = *(const LAS f32x4*)(sm_acum + sb0), dsv = *(const LAS f32x4*)(sm_dt + sb0);
#pragma unroll
                    for (int i = 0; i < 4; ++i) {
                        float e = at - asv[i];
                        if (sb0 + i > tidx) e = -INFINITY;
                        s[4 * rq + i] *= __expf(e) * dsv[i];
                    }
                }
#pragma unroll
                for (int k2 = 0; k2 < 2; ++k2) {
                    u32x4 au; au.x = cvt_pk_bf16(s[8 * k2], s[8 * k2 + 1]); au.y = cvt_pk_bf16(s[8 * k2 + 2], s[8 * k2 + 3]); au.z = cvt_pk_bf16(s[8 * k2 + 4], s[8 * k2 + 5]); au.w = cvt_pk_bf16(s[8 * k2 + 6], s[8 * k2 + 7]);
                    const int sbase = st * 32 + 16 * k2 + 4 * hh;
                    const u32x2 lo = *(const LAS u32x2*)(lds + xt_addr(pt * 32 + l31, sbase)), hi = *(const LAS u32x2*)(lds + xt_addr(pt * 32 + l31, sbase + 8));
                    u32x4 bu; bu.x = lo.x; bu.y = lo.y; bu.z = hi.x; bu.w = hi.y;
                    y = mfma32(__builtin_bit_cast(bf16x8, au), __builtin_bit_cast(bf16x8, bu), y);
                }
            }
        }
        {
            int ln = tid0 & 63; OPQ(ln);
            const int l31 = ln & 31, hh = ln >> 5;
            const unsigned oy = (unsigned)((rowbase + t0 + tt * 32 + 4 * hh) * 2048 + h * 64 + pt * 32 + l31) * 2u;
#pragma unroll
            for (int rq = 0; rq < 4; ++rq) {
                const u32x2 xv = *(const LAS u32x2*)(lds + xt_addr(pt * 32 + l31, tt * 32 + 8 * rq + 4 * hh));
                const float xs[4] = {bf_lo(xv.x), bf_hi(xv.x), bf_lo(xv.y), bf_hi(xv.y)};
#pragma unroll
                for (int i = 0; i < 4; ++i) {
                    const int rg = 4 * rq + i;
                    const float yv = y[rg] + Dh * xs[i];
                    const float gv = yv * silu_f(bf2f(zr[rg]));
                    *(bf16_t*)(ygc + (oy + (unsigned)(8 * rq + i) * 4096u)) = (bf16_t)(cvt_pk_bf16(gv, 0.f) & 0xffffu);
                }
            }
        }
        if (c + 1 < 16) acum_stage((c + 1) & 1);
        __syncthreads();
        {
            int ln = tid0 & 63; OPQ(ln);
            const int l31 = ln & 31, hh = ln >> 5;
#pragma unroll
            for (int rg = 0; rg < 16; ++rg) {
                const int pr = hp * 32 + (rg & 3) + 8 * (rg >> 2) + 4 * hh;
                *(LAS bf16_t*)(lds + L_HB + pr * RS + (hn * 32 + l31) * 2) = (bf16_t)(cvt_pk_bf16(hacc[rg], 0.f) & 0xffffu);
            }
        }
    }
    {
        int ln = tid0 & 63; OPQ(ln);
        const int l31 = ln & 31, hh = ln >> 5;
        float* so = p.out + O_SSM_P + ((size_t)(j * 8 + b) * 32 + h) * 8192;
#pragma unroll
        for (int rg = 0; rg < 16; ++rg) {
            const int pr = hp * 32 + (rg & 3) + 8 * (rg >> 2) + 4 * hh;
            so[pr * 128 + hn * 32 + l31] = hacc[rg];
        }
    }
}

__device__ void ssd_sample_all(const Params& p, int j, LAS unsigned char* lds) {
    const int tid = otid();
    const bf16_t* zx = (const bf16_t*)(p.ws + WS_ZX);
    const float* dtraw = (const float*)(p.ws + WS_DTRAW);
    bf16_t* yg = (bf16_t*)(p.ws + WS_YG);
    LAS float* sx = (LAS float*)lds;
    LAS float* sB = sx + 2048;
    LAS float* sC = sB + 1024;
    LAS float* sdt = sC + 1024;
    LAS float* sdec = sdt + 32;
    const int pp = tid >> 3, nl = (tid & 7) * 4;
    int item = (int)blockIdx.x;
    f32x4 hs[4][4];
    if (item < 1024) {
        const float* st = p.in[2] + ((size_t)(j * 128 + (item >> 3)) * 32 + (item & 7) * 4) * 8192;
#pragma unroll
        for (int r = 0; r < 4; ++r)
#pragma unroll
            for (int q = 0; q < 4; ++q) hs[r][q] = *(const f32x4*)(st + r * 8192 + pp * 128 + nl + 32 * q);
    }
#pragma unroll 1
    for (; item < 1024; item += (int)gridDim.x) {
        const int b = item >> 3, g = item & 7;
        __syncthreads();
        {
            const int cc = tid < 256 ? g * 256 + tid : (tid < 384 ? 2048 + g * 128 + (tid - 256) : 3072 + g * 128 + (tid - 384));
            float raw[11];
#pragma unroll
            for (int k = 0; k < 3; ++k) raw[k] = p.in[3][((size_t)(j * 128 + b) * 3 + k) * 4096 + cc];
#pragma unroll
            for (int t = 0; t < 8; ++t) raw[3 + t] = bf2f(zx[(size_t)(MP + b * 8 + t) * ZXW + 2048 + cc]);
            const float w0 = p.in[11][((size_t)j * 4 + 0) * 4096 + cc], w1 = p.in[11][((size_t)j * 4 + 1) * 4096 + cc];
            const float w2 = p.in[11][((size_t)j * 4 + 2) * 4096 + cc], w3 = p.in[11][((size_t)j * 4 + 3) * 4096 + cc];
            const float bs = p.in[12][(size_t)j * 4096 + cc];
            LAS float* dst = tid < 256 ? sx + tid : (tid < 384 ? sB + (tid - 256) : sC + (tid - 384));
            const int dstride = tid < 256 ? 256 : 128;
#pragma unroll
            for (int t = 0; t < 8; ++t) dst[t * dstride] = silu_f(bs + w0 * raw[t] + w1 * raw[t + 1] + w2 * raw[t + 2] + w3 * raw[t + 3]);
            if (tid < 32) {
                const int t = tid >> 2, r = tid & 3, hd = g * 4 + r;
                const float dtv = softplus_f(dtraw[(size_t)(MP + b * 8 + t) * 32 + hd] + p.in[13][j * 32 + hd]);
                sdt[tid] = dtv; sdec[tid] = __expf(-dtv * __expf(p.in[14][j * 32 + hd]));
            }
        }
        const int tsel = tid & 7;
        const size_t row = (size_t)(MP + b * 8 + tsel);
        bf16_t zv[4];
#pragma unroll
        for (int r = 0; r < 4; ++r) zv[r] = zx[row * ZXW + g * 256 + r * 64 + pp];
        const int nitem = item + (int)gridDim.x;
        f32x4 hn[4][4];
        if (nitem < 1024) {
            const float* st = p.in[2] + ((size_t)(j * 128 + (nitem >> 3)) * 32 + (nitem & 7) * 4) * 8192;
#pragma unroll
            for (int r = 0; r < 4; ++r)
#pragma unroll
                for (int q = 0; q < 4; ++q) hn[r][q] = *(const f32x4*)(st + r * 8192 + pp * 128 + nl + 32 * q);
        }
        __syncthreads();
        float ysel[4] = {0.f, 0.f, 0.f, 0.f};
#pragma unroll
        for (int t = 0; t < 8; ++t) {
            const f32x4 dt4 = *(const LAS f32x4*)(sdt + t * 4), dc4 = *(const LAS f32x4*)(sdec + t * 4);
            const float dx[4] = {dt4.x * sx[t * 256 + pp], dt4.y * sx[t * 256 + 64 + pp], dt4.z * sx[t * 256 + 128 + pp], dt4.w * sx[t * 256 + 192 + pp]};
            const float dc[4] = {dc4.x, dc4.y, dc4.z, dc4.w};
            float yp[4] = {0.f, 0.f, 0.f, 0.f};
#pragma unroll
            for (int q = 0; q < 4; ++q) {
                const f32x4 B4 = *(const LAS f32x4*)(sB + t * 128 + nl + 32 * q), C4 = *(const LAS f32x4*)(sC + t * 128 + nl + 32 * q);
#pragma unroll
                for (int r = 0; r < 4; ++r) {
                    hs[r][q] = hs[r][q] * dc[r] + B4 * dx[r];
                    yp[r] += (hs[r][q].x * C4.x + hs[r][q].y * C4.y) + (hs[r][q].z * C4.z + hs[r][q].w * C4.w);
                }
            }
#pragma unroll
            for (int r = 0; r < 4; ++r) {
                float v = yp[r];
                v += __shfl_xor(v, 1); v += __shfl_xor(v, 2); v += __shfl_xor(v, 4);
                if (tsel == t) ysel[r] = v;
            }
        }
        float* so = p.out + O_SSM_S + ((size_t)(j * 128 + b) * 32 + g * 4) * 8192;
#pragma unroll
        for (int r = 0; r < 4; ++r) {
            const int ch = g * 256 + r * 64 + pp;
            const float yv = ysel[r] + p.in[15][j * 32 + g * 4 + r] * sx[tsel * 256 + r * 64 + pp];
            const float gv = yv * silu_f(bf2f(zv[r]));
            yg[row * 2048 + ch] = (bf16_t)(cvt_pk_bf16(gv, 0.f) & 0xffffu);
#pragma unroll
            for (int q = 0; q < 4; ++q) *(f32x4*)(so + r * 8192 + pp * 128 + nl + 32 * q) = hs[r][q];
        }
        if (nitem < 1024) {
#pragma unroll
            for (int r = 0; r < 4; ++r)
#pragma unroll
                for (int q = 0; q < 4; ++q) hs[r][q] = hn[r][q];
        }
    }
}

__device__ void phase_scan(const Params& p, int j, LAS unsigned char* lds) {
    for (int item = blockIdx.x; item < 256; item += gridDim.x) {
        const int g = item & 7, k = item >> 3, b = k >> 2, r = k & 3;
        for (int rep = 0; rep < REP_PROMPT; ++rep) ssd_prompt_item(p, j, b, g * 4 + r, lds);
    }
    ssd_sample_all(p, j, lds);
    const bf16_t* zx = (const bf16_t*)(p.ws + WS_ZX);
    const int gt = blockIdx.x * 512 + otid(), nth = gridDim.x * 512;
    for (int i = gt; i < 136 * 3 * 512; i += nth) {
        const int ch = (i & 511) * 8, k = (i >> 9) % 3, sq = (i >> 9) / 3;
        const size_t row = sq < 8 ? (size_t)(sq * 2048 + 2045 + k) : (size_t)(MP + (sq - 8) * 8 + 5 + k);
        float* dst = sq < 8 ? p.out + O_CONV_P + ((size_t)(j * 8 + sq) * 3 + k) * 4096 + ch : p.out + O_CONV_S + ((size_t)(j * 128 + (sq - 8)) * 3 + k) * 4096 + ch;
        const u32x4 v = *(const u32x4*)(zx + row * ZXW + 2048 + ch);
        *(f32x4*)dst = (f32x4){bf_lo(v.x), bf_hi(v.x), bf_lo(v.y), bf_hi(v.y)}; *(f32x4*)(dst + 4) = (f32x4){bf_lo(v.z), bf_hi(v.z), bf_lo(v.w), bf_hi(v.w)};
    }
}

#define XB_TMO      128
#define XB_XCNT(j)  (256  + 64 * (j))
#define XB_XSUB(j)  (1280 + 64 * (j))
#define XB_XGEN(j)  (2304 + 64 * (j))
#define XB_TOP      3328
#define XB_TOPGEN   3392
#define XCD_BAR_WORDS 3456
#define XB_SPIN_CAP (1u << 22)
__device__ __forceinline__ unsigned xb_ld(unsigned* p)              { return __hip_atomic_load(p, __ATOMIC_RELAXED, __HIP_MEMORY_SCOPE_AGENT); }
__device__ __forceinline__ unsigned xb_add(unsigned* p, unsigned v) { return __hip_atomic_fetch_add(p, v, __ATOMIC_RELAXED, __HIP_MEMORY_SCOPE_AGENT); }
__device__ __forceinline__ unsigned xb_xcc_id() { return (unsigned)__builtin_amdgcn_s_getreg((3 << 11) | 20) & 0xFu; }
#define XB_SPIN(cond, bar) do { unsigned _sp = 0; while (cond) { __builtin_amdgcn_s_sleep(1); \
    if ((++_sp & 255u) == 0u) { if (xb_ld(&(bar)[XB_TMO])) break; if (_sp > XB_SPIN_CAP) { atomicAdd(&(bar)[XB_TMO], 1u); break; } } } } while (0)
struct XcdBarrier { unsigned* bar; unsigned x; volatile LAS unsigned* st; };
__device__ __forceinline__ XcdBarrier xcd_barrier_post(unsigned* bar, volatile LAS unsigned* st) {
    XcdBarrier b; b.bar = bar; b.x = xb_xcc_id(); b.st = st;
    if (threadIdx.x == 0) (void)xb_add(&bar[XB_XCNT(b.x)], 1u);
    return b;
}
__device__ __forceinline__ void xcd_barrier_complete(unsigned* bar, unsigned x, unsigned& nloc, unsigned& nx) {
    const unsigned G = gridDim.x * gridDim.y * gridDim.z;
    unsigned sum, cnt, mine, sp = 0u;
    for (;;) {
        sum = 0u; cnt = 0u; mine = 0u;
#pragma unroll
        for (unsigned j = 0; j < 16; ++j) { const unsigned c = xb_ld(&bar[XB_XCNT(j)]); sum += c; cnt += (c > 0u) ? 1u : 0u; mine = (j == x) ? c : mine; }
        if (sum == G) break;
        __builtin_amdgcn_s_sleep(1);
        if ((++sp & 255u) == 0u) { if (xb_ld(&bar[XB_TMO])) break; if (sp > XB_SPIN_CAP) { atomicAdd(&bar[XB_TMO], 1u); break; } }
    }
    nloc = mine > 0u ? mine : 1u; nx = cnt > 0u ? cnt : 1u;
}
__device__ __forceinline__ void xcd_barrier(const XcdBarrier& b) {
    asm volatile("s_waitcnt vmcnt(0)" ::: "memory");
    __syncthreads();
    if (threadIdx.x == 0) {
        unsigned* bar = b.bar;
        __builtin_amdgcn_s_waitcnt(0);
        unsigned nloc = b.st[0], nx = b.st[1];
        if (nloc == 0u) { xcd_barrier_complete(bar, b.x, nloc, nx); b.st[0] = nloc; b.st[1] = nx; }
        const unsigned old = xb_add(&bar[XB_XSUB(b.x)], 1u);
        const unsigned gen = old / nloc;
        if (old + 1u == (gen + 1u) * nloc) {
            __builtin_amdgcn_fence(__ATOMIC_RELEASE, "agent");
            asm volatile("s_waitcnt vmcnt(0)" ::: "memory");
            const unsigned og = xb_add(&bar[XB_TOP], 1u);
            const unsigned tg = og / nx;
            if (og + 1u == (tg + 1u) * nx) xb_add(&bar[XB_TOPGEN], 1u);
            else XB_SPIN(xb_ld(&bar[XB_TOPGEN]) == tg, bar);
            __builtin_amdgcn_fence(__ATOMIC_ACQUIRE, "agent");
            xb_add(&bar[XB_XGEN(b.x)], 1u);
            asm volatile("s_waitcnt vmcnt(0)" ::: "memory");
        } else {
            XB_SPIN(xb_ld(&bar[XB_XGEN(b.x)]) == gen, bar);
            __builtin_amdgcn_fence(__ATOMIC_ACQUIRE, "agent");
            asm volatile("s_waitcnt vmcnt(0)" ::: "memory");
        }
    }
    __syncthreads();
}

#ifndef REP_PREP0
#define REP_PREP0 1
#endif
#ifndef REP_SMALL
#define REP_SMALL 1
#endif
#ifndef REP_GGRP
#define REP_GGRP 1
#endif
#ifndef REP_GGRP
#define REP_GGRP 1
#endif
#ifndef REP_SYNC
#define REP_SYNC 1
#endif
#ifndef REP_SCAN
#define REP_SCAN 1
#endif
#ifndef REP_GIN
#define REP_GIN 1
#endif
#ifndef REP_GOUT
#define REP_GOUT 1
#endif
#ifndef REP_ELEM
#define REP_ELEM 1
#endif
#define GSYNC() do { for (int _r = 0; _r < REP_SYNC; ++_r) xcd_barrier(xb); } while (0)
__global__ __launch_bounds__(512, 2) void hybrid_fwd(const float* i0, const float* i1, const float* i2, const float* i3, const float* i4, const float* i5, const float* i6, const float* i7,
        const float* i8, const float* i9, const float* i10, const float* i11, const float* i12, const float* i13, const float* i14, const float* i15, const float* i16, const float* i17,
        const float* i18, const float* i19, const float* i20, const float* i21, const float* i22, float* outp, unsigned char* wsp, WTab wt) {
    Params p;
    p.in[0] = i0; p.in[1] = i1; p.in[2] = i2; p.in[3] = i3; p.in[4] = i4; p.in[5] = i5; p.in[6] = i6; p.in[7] = i7; p.in[8] = i8; p.in[9] = i9; p.in[10] = i10; p.in[11] = i11;
    p.in[12] = i12; p.in[13] = i13; p.in[14] = i14; p.in[15] = i15; p.in[16] = i16; p.in[17] = i17; p.in[18] = i18; p.in[19] = i19; p.in[20] = i20; p.in[21] = i21; p.in[22] = i22;
    p.out = outp; p.ws = wsp;
    extern __shared__ __attribute__((aligned(16))) unsigned char smem[];
    LAS unsigned char* lds = (LAS unsigned char*)smem;
    cg::grid_group grid = cg::this_grid();
    unsigned char* ws = p.ws;
    volatile LAS unsigned* xst = (volatile LAS unsigned*)(lds + LDS_XB);
    if (threadIdx.x == 0) { xst[0] = 0u; xst[1] = 0u; }
    __syncthreads();
    const XcdBarrier xb = xcd_barrier_post((unsigned*)(ws + WS_BAR), xst);

    phase_prep0(p, wt, lds, 0, wt.wj[8].tile_begin, 0, true);
    if (wt.wtiles < 0) grid.sync();
    xcd_barrier(xb);
#pragma unroll 1
    for (int mode_ = 0; mode_ < 2 * REP_SMALL; ++mode_) {
        const int mode = mode_ % 2;
        pg8::SmallSched S; S.mode = mode; S.G = (int)gridDim.x; S.c = (int)blockIdx.x; S.lda = 1024; S.ldb = 1024; S.K = 1024;
        S.A0 = (const char*)(ws + (mode == 0 ? WS_AC : WS_SHIFTA)); S.ada = (const char*)(ws + WS_WT_ADA); S.ssd_in = (const char*)(ws + WS_WT_SSD_IN); S.pool_in = (const char*)(ws + WS_WT_POOL_IN);
        EpiSmall E; E.mode = mode; E.mod = (float*)(ws + WS_MOD); E.ada_b = p.in[8]; E.shiftA = (bf16_t*)(ws + WS_SHIFTA); E.sb = (float*)(ws + WS_SB);
#ifndef NO_GSMALL
        pg8::gemm_phase<EpiSmall, pg8::SmallSched>(lds, S, E);
#endif
        if (mode == 0) phase_prep0(p, wt, lds, wt.wj[8].tile_begin, wt.wtiles, 48, false);
        else phase_xprep(p, 82);
        GSYNC();
    }
    unsigned* tailw = (unsigned*)(ws + WS_BAR) + 3584;
    unsigned* tmow = (unsigned*)(ws + WS_BAR) + XB_TMO;
#pragma unroll 1
    for (int layer = 0; layer < 4; ++layer) {
        const int j = layer >> 1; const bool ssd = (layer & 1) == 0;
        {
            pg8::InSched S;
            S.init(ssd ? 6400 : 4096, ws + WS_APRIME, ssd ? ws + WS_WT_SSD_IN + (size_t)j * 6400 * 1024 * 2 : ws + WS_WT_POOL_IN + (size_t)j * 4096 * 1024 * 2, layer > 0 ? tailw + 64 * (layer - 1) : nullptr, tmow);
            EpiIn E; E.ssq = (const float*)(ws + WS_SSQ) + (size_t)layer * 17408; E.sb = (const float*)(ws + WS_SB) + (size_t)layer * 136 * 6400; E.out = (bf16_t*)(ws + WS_ZX);
            E.ldo = ssd ? ZXW : 4096; E.nbf = ssd ? ZXW : 4096; E.dtraw = ssd ? (float*)(ws + WS_DTRAW) : nullptr;
            for (int rep = 0; rep < REP_GIN; ++rep) pg8::gemm_phase<EpiIn, pg8::InSched>(lds, S, E);
        }
        GSYNC();
        if (ssd) { for (int rep = 0; rep < REP_SCAN; ++rep) phase_scan(p, j, lds); } else { for (int rep = 0; rep < REP_ELEM; ++rep) phase_pool(p, j); }
        GSYNC();
        if (ssd) { for (int rep = 0; rep < REP_ELEM; ++rep) phase_ssdnorm(p, j); }
        else {
            pg8::MainSched S; S.init(MT, 2048, 512, 2048, 512, ws + WS_YG, ws + WS_WT_POOL_G + (size_t)j * 2048 * 512 * 2, 1);
            EpiGrp E; E.uz = (const bf16_t*)(ws + WS_ZX); E.chs = p.in[20] + (size_t)j * 2048; E.out = (bf16_t*)(ws + WS_A2);
            for (int rep = 0; rep < REP_GGRP; ++rep) pg8::gemm_phase<EpiGrp, pg8::MainSched>(lds, S, E);
        }
        GSYNC();
#pragma unroll 1
        for (int part = 0; part < 2; ++part) {
            pg8::MainSched S; S.init(part == 0 ? MP : MT, 1024, 2048, 2048, 2048, ws + WS_A2, ssd ? ws + WS_WT_SSD_OUT + (size_t)j * 1024 * 2048 * 2 : ws + WS_WT_POOL_OUT + (size_t)j * 1024 * 2048 * 2, 30, part);
            EpiOut E; float* xw = (float*)(ws + WS_XW);
            E.xin_p = layer == 0 ? p.in[0] : xw; E.xin_s = layer == 0 ? p.in[1] : xw + (size_t)MP * DM; E.xw = xw;
            E.modl = (const float*)(ws + WS_MOD) + (size_t)layer * 3072; E.ng_next = layer < 3 ? p.in[9] + (size_t)(layer + 1) * 1024 : nullptr;
            E.aprime = (bf16_t*)(ws + WS_APRIME); E.ssq = (float*)(ws + WS_SSQ) + (size_t)(layer + 1) * 17408;
            pg8::gemm_phase<EpiOut, pg8::MainSched>(lds, S, E);
            if (part == 0) GSYNC();
        }
        if (blockIdx.x < 16) {
            asm volatile("s_waitcnt vmcnt(0)" ::: "memory");
            __syncthreads();
            if (threadIdx.x == 0) { __builtin_amdgcn_fence(__ATOMIC_RELEASE, "agent"); asm volatile("s_waitcnt vmcnt(0)" ::: "memory"); __hip_atomic_fetch_add(tailw + 64 * layer, 1u, __ATOMIC_RELAXED, __HIP_MEMORY_SCOPE_AGENT); }
        }
    }
    phase_final(p, 0, MP, 16);
    GSYNC();
    phase_final(p, MP, MT, 0);
}

extern "C" void kernel_launch(void* const* d_in, const int* in_sizes, int n_in, void* d_out, int out_size, void* d_ws, size_t ws_size, hipStream_t stream) {
    static int grid = 0;
    if (grid == 0) {
        if (n_in != 23 || ws_size < WS_END) { fprintf(stderr, "kernel_launch: unexpected n_in %d or ws_size %zu (need %zu)\n", n_in, ws_size, (size_t)WS_END); grid = -1; return; }
        int dev = 0, cus = 0, per_cu = 0;
        hipGetDevice(&dev);
        hipDeviceGetAttribute(&cus, hipDeviceAttributeMultiprocessorCount, dev);
        if (hipFuncSetAttribute((const void*)hybrid_fwd, hipFuncAttributeMaxDynamicSharedMemorySize, LDS_BYTES) != hipSuccess) { fprintf(stderr, "kernel_launch: hipFuncSetAttribute failed\n"); grid = -1; return; }
        if (hipOccupancyMaxActiveBlocksPerMultiprocessor(&per_cu, (const void*)hybrid_fwd, 512, LDS_BYTES) != hipSuccess || per_cu < 1) { fprintf(stderr, "kernel_launch: occupancy query gave %d\n", per_cu); (void)hipGetLastError(); per_cu = 1; }
        if (cus < 256) { fprintf(stderr, "kernel_launch: needs a 256-CU device (got %d CUs)\n", cus); grid = -1; return; }
        grid = 256;
    }
    if (grid < 0) return;
    WTab wt{};
    unsigned char* ws = (unsigned char*)d_ws;
    int nj = 0, tb = 0;
    auto add = [&](int srci, long long soff, size_t dst_off, int K, int N, int Npad) {
        WJob& w = wt.wj[nj++]; w.src = (const float*)d_in[srci] + soff; w.doff = (long long)dst_off; w.K = K; w.N = N; w.tiles_n = Npad / 64; w.tile_begin = tb; tb += (K / 64) * (Npad / 64);
    };
    for (int i = 0; i < 4; ++i) add(7, (long long)i * 1024 * 3072, WS_WT_ADA + (size_t)i * 3072 * 1024 * 2, 1024, 3072, 3072);
    for (int j = 0; j < 2; ++j) add(10, (long long)j * 1024 * 6176, WS_WT_SSD_IN + (size_t)j * 6400 * 1024 * 2, 1024, 6176, 6400);
    for (int j = 0; j < 2; ++j) add(18, (long long)j * 1024 * 4096, WS_WT_POOL_IN + (size_t)j * 4096 * 1024 * 2, 1024, 4096, 4096);
    for (int j = 0; j < 2; ++j) add(17, (long long)j * 2048 * 1024, WS_WT_SSD_OUT + (size_t)j * 1024 * 2048 * 2, 2048, 1024, 1024);
    for (int j = 0; j < 2; ++j) add(21, (long long)j * 2048 * 1024, WS_WT_POOL_OUT + (size_t)j * 1024 * 2048 * 2, 2048, 1024, 1024);
    for (int q = 0; q < 8; ++q) add(19, (long long)q * 512 * 512, WS_WT_POOL_G + (size_t)q * 512 * 512 * 2, 512, 512, 512);
    wt.wtiles = tb;
    if (hipMemsetAsync(ws + WS_BAR, 0, 16384, stream) != hipSuccess) { fprintf(stderr, "kernel_launch: memset of the barrier words failed\n"); return; }
    const float* ip[23]; for (int i = 0; i < 23; ++i) ip[i] = (const float*)d_in[i];
    float* outp = (float*)d_out;
    void* args[26];
    for (int i = 0; i < 23; ++i) args[i] = (void*)&ip[i];
    args[23] = (void*)&outp; args[24] = (void*)&ws; args[25] = (void*)&wt;
    hipError_t e = hipLaunchCooperativeKernel((const void*)hybrid_fwd, dim3(grid), dim3(512), args, LDS_BYTES, stream);
    if (e != hipSuccess) fprintf(stderr, "cooperative launch failed: %s (grid %d)\n", hipGetErrorString(e), grid);
}
```

```cpp
#include <hip/hip_runtime.h>
#include <hip/hip_cooperative_groups.h>
#include <cstdio>
namespace cg = cooperative_groups;

#ifndef REP_PROMPT
#define REP_PROMPT 1
#endif
#define LAS __attribute__((address_space(3)))
typedef unsigned short bf16_t;
typedef short bf16x8 __attribute__((ext_vector_type(8)));
typedef float f32x4 __attribute__((ext_vector_type(4)));
typedef float f32x16 __attribute__((ext_vector_type(16)));
typedef unsigned u32x4 __attribute__((ext_vector_type(4)));
typedef unsigned u32x2 __attribute__((ext_vector_type(2)));
typedef float f32x2 __attribute__((ext_vector_type(2)));

constexpr int MP = 16384, MT = 17408, DM = 1024;
constexpr int ZXW = 6144;
constexpr size_t O_SSM_P = 17825792, O_CONV_P = 22020096, O_POOL_P = 22216704, O_SSM_S = 22708224, O_CONV_S = 89817088, O_POOL_S = 92962816;

constexpr size_t WS_WT_SSD_IN = 0;
constexpr size_t WS_WT_SSD_OUT = WS_WT_SSD_IN + 2ull * 6400 * 1024 * 2;
constexpr size_t WS_WT_POOL_IN = WS_WT_SSD_OUT + 2ull * 1024 * 2048 * 2;
constexpr size_t WS_WT_POOL_G = WS_WT_POOL_IN + 2ull * 4096 * 1024 * 2;
constexpr size_t WS_WT_POOL_OUT = WS_WT_POOL_G + 2ull * 2048 * 512 * 2;
constexpr size_t WS_WT_ADA = WS_WT_POOL_OUT + 2ull * 1024 * 2048 * 2;
constexpr size_t WS_AC = WS_WT_ADA + 12288ull * 1024 * 2;
constexpr size_t WS_SHIFTA = WS_AC + 256ull * 1024 * 2;
constexpr size_t WS_MOD = WS_SHIFTA + 4ull * 256 * 1024 * 2;
constexpr size_t WS_SB = WS_MOD + 136ull * 12288 * 4;
constexpr size_t WS_APRIME = WS_SB + 4ull * 136 * 6400 * 4;
constexpr size_t WS_SSQ = WS_APRIME + 17408ull * 1024 * 2;
constexpr size_t WS_XW = WS_SSQ + 17408ull * 16 * 4;
constexpr size_t WS_ZX = WS_XW + 17408ull * 1024 * 4;
constexpr size_t WS_DTRAW = WS_ZX + 17408ull * 6144 * 2;
constexpr size_t WS_YG = WS_DTRAW + 17408ull * 32 * 4;
constexpr size_t WS_A2 = WS_YG + 17408ull * 2048 * 2;
constexpr size_t WS_BAR = WS_A2 + 17408ull * 2048 * 2;
constexpr size_t WS_END = WS_BAR + 16384;

constexpr int LDS_XB = 149760;
constexpr int LDS_BYTES = 149776;

struct WJob { const float* src; long long doff; int K, N, tiles_n, tile_begin; };
struct WTab { WJob wj[20]; int wtiles; int pad0; };
constexpr int NWJ = 20;
struct Params {
    const float* in[23];
    float* out;
    unsigned char* ws;
};

__device__ __forceinline__ unsigned cvt_pk_bf16(float lo, float hi) { unsigned r; asm("v_cvt_pk_bf16_f32 %0, %1, %2" : "=v"(r) : "v"(lo), "v"(hi)); return r; }
__device__ __forceinline__ float bf_lo(unsigned u) { return __uint_as_float(u << 16); }
__device__ __forceinline__ float bf_hi(unsigned u) { return __uint_as_float(u & 0xffff0000u); }
__device__ __forceinline__ float bf2f(bf16_t b) { return __uint_as_float(((unsigned)b) << 16); }
__device__ __forceinline__ float silu_f(float v) { return v * __builtin_amdgcn_rcpf(1.f + __expf(-v)); }
__device__ __forceinline__ f32x2 silu2(f32x2 v) { const f32x2 e = v * (-1.44269504f); f32x2 d; d.x = __builtin_amdgcn_exp2f(e.x); d.y = __builtin_amdgcn_exp2f(e.y); d = d + 1.f; f32x2 r; r.x = __builtin_amdgcn_rcpf(d.x); r.y = __builtin_amdgcn_rcpf(d.y); return v * r; }
__device__ __forceinline__ float softplus_f(float v) { return v > 20.f ? v : log1pf(__expf(v)); }
__device__ __forceinline__ int otid() { int t = threadIdx.x; asm volatile("" : "+v"(t)); return t; }
__device__ __forceinline__ int row_b(int r) { return r < MP ? (r >> 11) : 8 + ((r - MP) >> 3); }
__device__ __forceinline__ u32x4 pack8(f32x4 a, f32x4 b) { u32x4 r; r.x = cvt_pk_bf16(a.x, a.y); r.y = cvt_pk_bf16(a.z, a.w); r.z = cvt_pk_bf16(b.x, b.y); r.w = cvt_pk_bf16(b.z, b.w); return r; }

namespace pg8 {
constexpr int BM = 256, BK = 64, HALF = 128, HTB = HALF * BK * 2, STAGE_BYTES = 8 * HTB, NXCD = 8, WGM = 8;
__device__ __forceinline__ int lds_byte(int r, int c) { const int st = (r >> 4) * 2 + (c >> 5), rr = r & 15, cc = c & 31, ob = rr * 64 + cc * 2; return st * 1024 + (ob ^ (((ob >> 9) & 1) << 5)); }
__device__ __forceinline__ void stage_rc(int b, int& R, int& C) { const int st = b / 1024, sb = b % 1024, swz = sb ^ (((sb >> 9) & 1) << 5); R = (st >> 1) * 16 + swz / 64; C = (st & 1) * 32 + (swz % 64) / 2; }
__device__ __forceinline__ int perm32(int rho) { const int n = rho >> 4, i = rho & 15; return 8 * (i >> 2) + 4 * n + (i & 3); }

struct Unit { int pm, pn, q; const char* A; const char* B; };

__device__ __forceinline__ void static_unit(int L, int nM, int nN, int& pm, int& pn) {
    const int nwg = nM * nN;
    int wgid = L; { const int q = nwg / NXCD, r = nwg % NXCD, xcd = wgid % NXCD, off = wgid / NXCD; wgid = (xcd < r ? xcd * (q + 1) : r * (q + 1) + (xcd - r) * q) + off; }
    const int nig = WGM * nN, gid = wgid / nig, fm = gid * WGM, gsz = (nM - fm) < WGM ? (nM - fm) : WGM;
    pm = fm + ((wgid % nig) % gsz); pn = (wgid % nig) / gsz;
}
struct MainSched {
    int nM, nN, nwg, G, c, lda, ldb, K, gsh, single;
    const char* A; const char* Bt;
    __device__ void init(int M, int N, int K_, int lda_, int ldb_, const void* A_, const void* Bt_, int gsh_, int single_ = 0) {
        nM = M / BM; nN = N / BM; nwg = nM * nN; G = (int)gridDim.x; c = (int)blockIdx.x; lda = lda_; ldb = ldb_; K = K_; A = (const char*)A_; Bt = (const char*)Bt_; gsh = gsh_; single = single_;
    }
    __device__ bool next(int i, Unit& u) const {
        if (single) { if (i > 0 || c >= 16) return false; u.pm = 64 + (c >> 2); u.pn = c & 3; }
        else { const long L = (long)i * G + c; if (L >= nwg) return false; static_unit((int)L, nM, nN, u.pm, u.pn); }
        u.q = 0;
        u.A = A + ((size_t)u.pm * BM * lda + (size_t)(u.pn >> gsh) * 512) * 2;
        u.B = Bt + (size_t)u.pn * BM * ldb * 2;
        return true;
    }
    __device__ __forceinline__ void a_ready(const Unit&) const {}
};
struct InSched {
    int nN, nP, E, nskip, c, r0, cnt, lda, ldb, K;
    const char* A; const char* Bt; unsigned* tail; unsigned* tmo;
    __device__ void init(int N, const void* A_, const void* Bt_, unsigned* tail_, unsigned* tmo_) {
        nN = N / BM; nP = 64 * nN; c = (int)blockIdx.x; lda = 1024; ldb = 1024; K = 1024; A = (const char*)A_; Bt = (const char*)Bt_; tail = tail_; tmo = tmo_;
        nskip = tail_ != nullptr ? 32 : 0; E = nskip + 4 * nN; r0 = (tail_ != nullptr && c < 16) ? 2 : 0;
        const int tot = (nP - c + 255) / 256; cnt = tot - r0 > 0 ? tot - r0 : 0;
    }
    __device__ bool next(int i, Unit& u) const {
        if (i < cnt) static_unit((i + r0) * 256 + c, 64, nN, u.pm, u.pn);
        else {
            if (c < 16) return false;
            const int e = 255 - c + 240 * (i - cnt); if (e >= E) return false;
            if (e < nskip) static_unit(e < 16 ? e : 256 + (e - 16), 64, nN, u.pm, u.pn);
            else { const int sidx = e - nskip; u.pm = 64 + sidx / nN; u.pn = sidx - (sidx / nN) * nN; }
        }
        u.q = 0;
        u.A = A + (size_t)u.pm * BM * 1024 * 2; u.B = Bt + (size_t)u.pn * BM * 1024 * 2;
        return true;
    }
    __device__ __forceinline__ void a_ready(const Unit& u) const {
        if (tail == nullptr || u.pm < 64) return;
        if (threadIdx.x < 64) {
            unsigned polls = 0;
            while ((unsigned)__builtin_amdgcn_readfirstlane(__hip_atomic_load(tail, __ATOMIC_RELAXED, __HIP_MEMORY_SCOPE_AGENT)) < 16u) {
                __builtin_amdgcn_s_sleep(2);
                if ((++polls & 255u) == 0u) { if (__builtin_amdgcn_readfirstlane(__hip_atomic_load(tmo, __ATOMIC_RELAXED, __HIP_MEMORY_SCOPE_AGENT)) != 0u) break; if (polls > (1u << 22)) { if (threadIdx.x == 0) atomicAdd(tmo, 1u); break; } }
            }
            __builtin_amdgcn_fence(__ATOMIC_ACQUIRE, "agent");
            asm volatile("s_waitcnt vmcnt(0)" ::: "memory");
        }
        asm volatile("" ::: "memory"); __builtin_amdgcn_s_barrier(); asm volatile("" ::: "memory");
    }
};
struct SmallSched {
    int mode, G, c, lda, ldb, K;
    const char* A0; const char* ada; const char* ssd_in; const char* pool_in;
    __device__ bool next(int i, Unit& u) const {
        const long L = (long)i * G + c;
        u.pm = 0;
        if (mode == 0) { if (L >= 48) return false; u.pn = (int)L; u.q = 0; u.A = A0; u.B = ada + (size_t)u.pn * BM * 1024 * 2; return true; }
        if (L >= 82) return false;
        int l = (int)L, q, pn;
        if (l < 25) { q = 0; pn = l; } else if (l < 41) { q = 1; pn = l - 25; } else if (l < 66) { q = 2; pn = l - 41; } else { q = 3; pn = l - 66; }
        u.q = q; u.pn = pn; u.A = A0 + (size_t)q * 256 * 1024 * 2;
        u.B = ((q & 1) ? pool_in + (size_t)(q >> 1) * 4096 * 1024 * 2 : ssd_in + (size_t)(q >> 1) * 6400 * 1024 * 2) + (size_t)pn * BM * 1024 * 2;
        return true;
    }
    __device__ __forceinline__ void a_ready(const Unit&) const {}
};

template <class Epi, class Sched>
__device__ __forceinline__ void gemm_phase(LAS unsigned char* lds, const Sched& S, const Epi& E) {
    const int tid = otid(), wid = __builtin_amdgcn_readfirstlane(tid >> 6), lane = tid & 63, wr = wid >> 2, wc = wid & 3, fr = lane & 15, fq = lane >> 4;
    const int K = S.K, nt = K / BK;
    unsigned voffA[2], voffB[2];
#pragma unroll
    for (int i = 0; i < 2; ++i) { int R, C; stage_rc(tid * 16 + i * 8192, R, C); const int Rb = Epi::PERM ? ((R & ~31) + perm32(R & 31)) : R;
        voffA[i] = (unsigned)(R * S.lda + C) * 2u; voffB[i] = (unsigned)(Rb * S.ldb + C) * 2u; }
    const size_t kstep = (size_t)(BK * 2);
    const size_t hstepA = (size_t)HALF * S.lda * 2, hstepB = (size_t)HALF * S.ldb * 2;
    const unsigned ldsw = (unsigned)wid * 1024u;
    const int aoff = lds_byte(wr * 64 + fr, fq * 8), boff = lds_byte(wc * 32 + fr, fq * 8);
#define PG8_SA(b, h) (((b) * 2 + (h)) * HTB)
#define PG8_SB(b, h) ((4 + (b) * 2 + (h)) * HTB)
#define PG8_STAGE(bufoff, gbase, voff) do { _Pragma("unroll") for (int _i = 0; _i < 2; ++_i) \
        __builtin_amdgcn_global_load_lds((const unsigned*)((const char*)(gbase) + (voff)[_i]), (LAS unsigned*)(lds + (bufoff) + ldsw + _i * 8192), 16, 0, 0); } while (0)
#define PG8_LDA(dst, b, h) do { _Pragma("unroll") for (int m = 0; m < 4; ++m) _Pragma("unroll") for (int k = 0; k < 2; ++k) dst[m][k] = *(const LAS bf16x8*)(lds + PG8_SA(b, h) + aoff + m * 2048 + k * 1024); } while (0)
#define PG8_LDB(dst, b, h) do { _Pragma("unroll") for (int n = 0; n < 2; ++n) _Pragma("unroll") for (int k = 0; k < 2; ++k) dst[n][k] = *(const LAS bf16x8*)(lds + PG8_SB(b, h) + boff + n * 2048 + k * 1024); } while (0)
#define PG8_MMA(ai, bj, At, Bt) do { __builtin_amdgcn_s_setprio(1); _Pragma("unroll") for (int m = 0; m < 4; ++m) _Pragma("unroll") for (int n = 0; n < 2; ++n) _Pragma("unroll") for (int k = 0; k < 2; ++k) \
        acc[ai][bj][m][n] = __builtin_amdgcn_mfma_f32_16x16x32_bf16(Bt[n][k], At[m][k], acc[ai][bj][m][n], 0, 0, 0); __builtin_amdgcn_s_setprio(0); } while (0)
#define PG8_WAIT_V(n) asm volatile("s_waitcnt vmcnt(" #n ")" ::: "memory")
#define PG8_WAIT_L(n) asm volatile("s_waitcnt lgkmcnt(" #n ")" ::: "memory")
#define PG8_BAR __builtin_amdgcn_s_barrier()
#define PG8_SCHED __builtin_amdgcn_sched_barrier(0)
    Unit cur, nxt; int ui = 0;
    if (!S.next(0, cur)) return;
    f32x4 acc[2][2][4][2];
#pragma unroll
    for (int a = 0; a < 2; ++a)
#pragma unroll
        for (int b = 0; b < 2; ++b)
#pragma unroll
            for (int m = 0; m < 4; ++m)
#pragma unroll
                for (int n = 0; n < 2; ++n) acc[a][b][m][n] = (f32x4){0.f, 0.f, 0.f, 0.f};
    bf16x8 At[4][2], B0[2][2], B1[2][2];
    const char* cA = cur.A; const char* cB = cur.B;
    S.a_ready(cur);
    PG8_STAGE(PG8_SB(0, 0), cB, voffB); PG8_STAGE(PG8_SA(0, 0), cA, voffA); PG8_STAGE(PG8_SB(0, 1), cB + hstepB, voffB); PG8_STAGE(PG8_SA(0, 1), cA + hstepA, voffA);
    if (wr == 1) PG8_BAR;
    PG8_WAIT_V(4); PG8_BAR;
    PG8_STAGE(PG8_SB(1, 0), cB + kstep, voffB); PG8_STAGE(PG8_SA(1, 0), cA + kstep, voffA); PG8_STAGE(PG8_SB(1, 1), cB + hstepB + kstep, voffB);
    PG8_WAIT_V(6); PG8_BAR;
    for (;;) {
        const bool has_next = S.next(ui + 1, nxt);
        const char* nA = has_next ? nxt.A : cA; const char* nB = has_next ? nxt.B : cB;
        for (int t = 0; t < nt; t += 2) {
            const bool last = (t == nt - 2);
            const char* a1 = cA + (size_t)(t + 1) * kstep;
            const char* a2 = last ? nA : cA + (size_t)(t + 2) * kstep; const char* b2 = last ? nB : cB + (size_t)(t + 2) * kstep;
            const char* a3 = a2 + kstep; const char* b3 = b2 + kstep;
            if (last && has_next) S.a_ready(nxt);
            PG8_LDB(B0, 0, 0); PG8_SCHED; PG8_LDA(At, 0, 0); PG8_STAGE(PG8_SA(1, 1), a1 + hstepA, voffA);
            PG8_WAIT_L(8); PG8_BAR; PG8_WAIT_L(0); PG8_MMA(0, 0, At, B0); PG8_BAR; PG8_SCHED;
            PG8_LDB(B1, 0, 1); PG8_STAGE(PG8_SB(0, 0), b2, voffB);
            PG8_BAR; PG8_WAIT_L(0); PG8_MMA(0, 1, At, B1); PG8_BAR;
            PG8_LDA(At, 0, 1); PG8_STAGE(PG8_SA(0, 0), a2, voffA);
            PG8_BAR; PG8_WAIT_L(0); PG8_MMA(1, 0, At, B0); PG8_BAR; PG8_SCHED;
            PG8_STAGE(PG8_SB(0, 1), b2 + hstepB, voffB);
            PG8_WAIT_V(6); PG8_BAR; PG8_MMA(1, 1, At, B1); PG8_BAR;
            PG8_LDB(B0, 1, 0); PG8_SCHED; PG8_LDA(At, 1, 0); PG8_STAGE(PG8_SA(0, 1), a2 + hstepA, voffA);
            PG8_WAIT_L(8); PG8_BAR; PG8_WAIT_L(0); PG8_MMA(0, 0, At, B0); PG8_BAR; PG8_SCHED;
            PG8_LDB(B1, 1, 1); PG8_STAGE(PG8_SB(1, 0), b3, voffB);
            PG8_BAR; PG8_WAIT_L(0); PG8_MMA(0, 1, At, B1); PG8_BAR;
            PG8_LDA(At, 1, 1); PG8_STAGE(PG8_SA(1, 0), a3, voffA);
            PG8_BAR; PG8_WAIT_L(0); PG8_MMA(1, 0, At, B0); PG8_BAR; PG8_SCHED;
            PG8_STAGE(PG8_SB(1, 1), b3 + hstepB, voffB);
            PG8_WAIT_V(6); PG8_BAR; PG8_MMA(1, 1, At, B1); PG8_BAR;
        }
        E(acc, cur, wr, wc, fr, fq);
        if (!has_next) break;
#pragma unroll
        for (int a = 0; a < 2; ++a)
#pragma unroll
            for (int b = 0; b < 2; ++b)
#pragma unroll
                for (int m = 0; m < 4; ++m)
#pragma unroll
                    for (int n = 0; n < 2; ++n) acc[a][b][m][n] = (f32x4){0.f, 0.f, 0.f, 0.f};
        cur = nxt; cA = nA; cB = nB; ++ui;
    }
    PG8_WAIT_V(0);
    if (wr == 0) PG8_BAR;
    PG8_BAR;
#undef PG8_SA
#undef PG8_SB
#undef PG8_STAGE
#undef PG8_LDA
#undef PG8_LDB
#undef PG8_MMA
#undef PG8_WAIT_V
#undef PG8_WAIT_L
#undef PG8_BAR
#undef PG8_SCHED
}
}
using pg8::Unit;

struct EpiIn {
    static constexpr bool PERM = true;
    const float* ssq; const float* sb; bf16_t* out; int ldo, nbf; float* dtraw;
    template <bool UNI>
    __device__ __forceinline__ void body(const f32x4 (&acc)[2][2][4][2], const Unit& u, int wr, int wc, int fr, int fq) const {
        const int row0 = u.pm * 256 + wr * 64 + fr, colt = u.pn * 256 + wc * 32 + 8 * fq;
        f32x4 ub[2][2];
        if (UNI) {
            const float* sbr = sb + (size_t)(u.pm >> 3) * 6400;
#pragma unroll
            for (int bj = 0; bj < 2; ++bj) { const int c = colt + bj * 128; if (c < nbf + 32) { ub[bj][0] = *(const f32x4*)(sbr + c); ub[bj][1] = *(const f32x4*)(sbr + c + 4); } }
        }
        float rsv[2][4];
#pragma unroll
        for (int ai = 0; ai < 2; ++ai)
#pragma unroll
            for (int m = 0; m < 4; ++m) rsv[ai][m] = ssq[row0 + ai * 128 + m * 16];
#pragma unroll
        for (int ai = 0; ai < 2; ++ai) {
            f32x4 nb[4][2][2];
            if (!UNI) {
#pragma unroll
                for (int m = 0; m < 4; ++m) {
                    const float* sbr = sb + (size_t)row_b(row0 + ai * 128 + m * 16) * 6400;
#pragma unroll
                    for (int bj = 0; bj < 2; ++bj) { const int c = colt + bj * 128; if (c < nbf + 32) { nb[m][bj][0] = *(const f32x4*)(sbr + c); nb[m][bj][1] = *(const f32x4*)(sbr + c + 4); } }
                }
            }
#pragma unroll
            for (int m = 0; m < 4; ++m) {
                const int r = row0 + ai * 128 + m * 16;
                const float rstd = rsqrtf(rsv[ai][m] * (1.f / 1024.f) + 1e-6f);
#pragma unroll
                for (int bj = 0; bj < 2; ++bj) {
                    const int c = colt + bj * 128;
                    if (c < nbf + 32) {
                        f32x4 b0, b1;
                        if (UNI) { b0 = ub[bj][0]; b1 = ub[bj][1]; } else { b0 = nb[m][bj][0]; b1 = nb[m][bj][1]; }
                        const f32x4 v0 = acc[ai][bj][m][0] * rstd + b0, v1 = acc[ai][bj][m][1] * rstd + b1;
                        if (c < nbf) *(u32x4*)(out + (size_t)r * ldo + c) = pack8(v0, v1);
                        else if (dtraw != nullptr) { float* dp = dtraw + (size_t)r * 32 + (c - nbf); *(f32x4*)dp = v0; *(f32x4*)(dp + 4) = v1; }
                    }
                }
            }
        }
    }
    __device__ __forceinline__ void operator()(const f32x4 (&acc)[2][2][4][2], const Unit& u, int wr, int wc, int fr, int fq) const {
        asm volatile("" : "+v"(fr), "+v"(fq));
        if (u.pm < 64) body<true>(acc, u, wr, wc, fr, fq); else body<false>(acc, u, wr, wc, fr, fq);
    }
};
struct EpiOut {
    static constexpr bool PERM = true;
    bf16_t* xw; const float* modl; const float* ng_next; bf16_t* aprime; float* ssq;
    template <bool UNI>
    __device__ __forceinline__ void body(const f32x4 (&acc)[2][2][4][2], const Unit& u, int wr, int wc, int fr, int fq) const {
        const int row0 = u.pm * 256 + wr * 64 + fr, colt = u.pn * 256 + wc * 32 + 8 * fq;
        const bool has_next = ng_next != nullptr;
        f32x4 ug[2][2], us[2][2], uw[2][2];
#pragma unroll
        for (int bj = 0; bj < 2; ++bj) {
            const int c = colt + bj * 128;
            if (has_next) { uw[bj][0] = *(const f32x4*)(ng_next + c); uw[bj][1] = *(const f32x4*)(ng_next + c + 4); }
            if (UNI) {
                const float* mb = modl + (size_t)(u.pm >> 3) * 12288;
                ug[bj][0] = *(const f32x4*)(mb + 2048 + c) + 1.f; ug[bj][1] = *(const f32x4*)(mb + 2048 + c + 4) + 1.f;
                if (has_next) { us[bj][0] = (*(const f32x4*)(mb + 4096 + c) + 1.f) * uw[bj][0]; us[bj][1] = (*(const f32x4*)(mb + 4096 + c + 4) + 1.f) * uw[bj][1]; }
            }
        }
#pragma unroll
        for (int aim = 0; aim < 4; ++aim) {
            const int ai = aim >> 1, mp = aim & 1;
            u32x4 xv[2][2];
#pragma unroll
            for (int mm = 0; mm < 2; ++mm)
#pragma unroll
                for (int bj = 0; bj < 2; ++bj) xv[mm][bj] = *(const u32x4*)(xw + (size_t)(row0 + ai * 128 + (mp * 2 + mm) * 16) * DM + colt + bj * 128);
#pragma unroll
            for (int mm = 0; mm < 2; ++mm) {
                const int m = mp * 2 + mm;
                const int r = row0 + ai * 128 + m * 16;
                const float* mb = modl + (size_t)row_b(r) * 12288;
                float ss = 0.f;
#pragma unroll
                for (int bj = 0; bj < 2; ++bj) {
                    const int c = colt + bj * 128;
                    f32x4 g0, g1;
                    if (UNI) { g0 = ug[bj][0]; g1 = ug[bj][1]; } else { g0 = *(const f32x4*)(mb + 2048 + c) + 1.f; g1 = *(const f32x4*)(mb + 2048 + c + 4) + 1.f; }
                    const u32x4 xo = xv[mm][bj];
                    const f32x4 x0 = {bf_lo(xo.x), bf_hi(xo.x), bf_lo(xo.y), bf_hi(xo.y)}, x1 = {bf_lo(xo.z), bf_hi(xo.z), bf_lo(xo.w), bf_hi(xo.w)};
                    const f32x4 n0 = x0 + g0 * acc[ai][bj][m][0], n1 = x1 + g1 * acc[ai][bj][m][1];
                    *(u32x4*)(xw + (size_t)r * DM + c) = pack8(n0, n1);
                    ss += (n0.x * n0.x + n0.y * n0.y) + (n0.z * n0.z + n0.w * n0.w) + (n1.x * n1.x + n1.y * n1.y) + (n1.z * n1.z + n1.w * n1.w);
                    if (has_next) {
                        f32x4 s0, s1;
                        if (UNI) { s0 = us[bj][0]; s1 = us[bj][1]; } else { s0 = (*(const f32x4*)(mb + 4096 + c) + 1.f) * uw[bj][0]; s1 = (*(const f32x4*)(mb + 4096 + c + 4) + 1.f) * uw[bj][1]; }
                        *(u32x4*)(aprime + (size_t)r * DM + c) = pack8(n0 * s0, n1 * s1);
                    }
                }
                ss += __shfl_xor(ss, 16); ss += __shfl_xor(ss, 32);
                if (fq == 0) atomicAdd(ssq + r, ss);
            }
        }
    }
    __device__ __forceinline__ void operator()(const f32x4 (&acc)[2][2][4][2], const Unit& u, int wr, int wc, int fr, int fq) const {
        asm volatile("" : "+v"(fr), "+v"(fq));
        if (u.pm < 64) body<true>(acc, u, wr, wc, fr, fq); else body<false>(acc, u, wr, wc, fr, fq);
    }
};
struct EpiGrp {
    static constexpr bool PERM = true;
    const bf16_t* uz; const float* chs; bf16_t* out;
    __device__ __forceinline__ void operator()(const f32x4 (&acc)[2][2][4][2], const Unit& u, int wr, int wc, int fr, int fq) const {
        asm volatile("" : "+v"(fr), "+v"(fq));
        const int row0 = u.pm * 256 + wr * 64 + fr, colt = u.pn * 256 + wc * 32 + 8 * fq;
        f32x4 cs[2][2];
#pragma unroll
        for (int bj = 0; bj < 2; ++bj) { cs[bj][0] = *(const f32x4*)(chs + colt + bj * 128); cs[bj][1] = *(const f32x4*)(chs + colt + bj * 128 + 4); }
#pragma unroll
        for (int ai = 0; ai < 2; ++ai) {
            u32x4 zz[4][2];
#pragma unroll
            for (int m = 0; m < 4; ++m)
#pragma unroll
                for (int bj = 0; bj < 2; ++bj) zz[m][bj] = *(const u32x4*)(uz + (size_t)(row0 + ai * 128 + m * 16) * 4096 + 2048 + colt + bj * 128);
#pragma unroll
            for (int m = 0; m < 4; ++m) {
                const int r = row0 + ai * 128 + m * 16;
#pragma unroll
                for (int bj = 0; bj < 2; ++bj) {
                    const int c = colt + bj * 128;
                    const u32x4 z = zz[m][bj];
                    const f32x2 a = silu2((f32x2){bf_lo(z.x), bf_hi(z.x)}), b = silu2((f32x2){bf_lo(z.y), bf_hi(z.y)}), cc = silu2((f32x2){bf_lo(z.z), bf_hi(z.z)}), d = silu2((f32x2){bf_lo(z.w), bf_hi(z.w)});
                    const f32x4 z0 = {a.x, a.y, b.x, b.y}, z1 = {cc.x, cc.y, d.x, d.y};
                    *(u32x4*)(out + (size_t)r * 2048 + c) = pack8(acc[ai][bj][m][0] * cs[bj][0] * z0, acc[ai][bj][m][1] * cs[bj][1] * z1);
                }
            }
        }
    }
};
struct EpiSmall {
    static constexpr bool PERM = true;
    int mode; float* mod; const float* ada_b; bf16_t* shiftA; float* sb;
    __device__ __forceinline__ void operator()(const f32x4 (&acc)[2][2][4][2], const Unit& u, int wr, int wc, int fr, int fq) const {
        asm volatile("" : "+v"(fr), "+v"(fq));
        const int row0 = wr * 64 + fr, colt = u.pn * 256 + wc * 32 + 8 * fq;
#pragma unroll
        for (int ai = 0; ai < 2; ++ai)
#pragma unroll
            for (int m = 0; m < 4; ++m) {
                const int r = row0 + ai * 128 + m * 16;
                if (r < 136) {
#pragma unroll
                    for (int bj = 0; bj < 2; ++bj) {
                        const int c = colt + bj * 128;
                        if (mode == 0) {
                            const f32x4 v0 = acc[ai][bj][m][0] + *(const f32x4*)(ada_b + c), v1 = acc[ai][bj][m][1] + *(const f32x4*)(ada_b + c + 4);
                            *(f32x4*)(mod + (size_t)r * 12288 + c) = v0; *(f32x4*)(mod + (size_t)r * 12288 + c + 4) = v1;
                            const int li = c / 3072, cc = c - li * 3072;
                            if (cc < 1024) *(u32x4*)(shiftA + ((size_t)li * 256 + r) * 1024 + cc) = pack8(v0, v1);
                        } else {
                            float* sp = sb + ((size_t)u.q * 136 + r) * 6400 + c;
                            *(f32x4*)sp = acc[ai][bj][m][0]; *(f32x4*)(sp + 4) = acc[ai][bj][m][1];
                        }
                    }
                }
            }
    }
};

__device__ void phase_prep0(const Params& p, const WTab& wt, LAS unsigned char* lds, int tile_lo, int tile_hi, int blk0, bool misc) {
    if ((int)blockIdx.x < blk0) return;
    LAS float* tl = (LAS float*)lds;
    const int tid = otid();
    for (int tile = tile_lo + ((int)blockIdx.x - blk0); tile < tile_hi; tile += (int)gridDim.x - blk0) {
        int j = 0;
#pragma unroll 1
        for (int q = 1; q < NWJ; ++q) if (tile >= wt.wj[q].tile_begin) j = q;
        const WJob job = wt.wj[j];
        bf16_t* jdst = (bf16_t*)(p.ws + job.doff);
        const int lt = tile - job.tile_begin, tk = lt / job.tiles_n, tn = lt - tk * job.tiles_n, k0 = tk * 64, n0 = tn * 64;
        {
            const int kk = tid >> 3, nn = (tid & 7) * 8;
            f32x4 a = (f32x4){0.f, 0.f, 0.f, 0.f}, b = a;
            if (n0 + nn < job.N) { const __attribute__((address_space(1))) f32x4* sp = (const __attribute__((address_space(1))) f32x4*)(job.src + (size_t)(k0 + kk) * job.N + n0 + nn); a = sp[0]; b = sp[1]; }
            LAS float* d = tl + kk * 65 + nn;
            d[0] = a.x; d[1] = a.y; d[2] = a.z; d[3] = a.w; d[4] = b.x; d[5] = b.y; d[6] = b.z; d[7] = b.w;
        }
        __syncthreads();
        {
            const int n = tid >> 3, k8 = (tid & 7) * 8;
            const LAS float* s = tl + k8 * 65 + n;
            u32x4 o; o.x = cvt_pk_bf16(s[0], s[65]); o.y = cvt_pk_bf16(s[130], s[195]); o.z = cvt_pk_bf16(s[260], s[325]); o.w = cvt_pk_bf16(s[390], s[455]);
            *(u32x4*)(jdst + (size_t)(n0 + n) * job.K + k0 + k8) = o;
        }
        __syncthreads();
    }
    if (!misc) return;
    bf16_t* ac = (bf16_t*)(p.ws + WS_AC);
    const int gt = blockIdx.x * 512 + tid, nth = gridDim.x * 512;
    for (int i = gt; i < 256 * 1024 / 8; i += nth) {
        const int r = i >> 7, c = (i & 127) * 8;
        u32x4 o = (u32x4){0u, 0u, 0u, 0u};
        if (r < 136) {
            const float* cp = r < 8 ? p.in[5] + (size_t)r * 1024 + c : p.in[6] + (size_t)(r - 8) * 1024 + c;
            const f32x4 a = *(const f32x4*)cp, b = *(const f32x4*)(cp + 4);
            o.x = cvt_pk_bf16(silu_f(a.x), silu_f(a.y)); o.y = cvt_pk_bf16(silu_f(a.z), silu_f(a.w)); o.z = cvt_pk_bf16(silu_f(b.x), silu_f(b.y)); o.w = cvt_pk_bf16(silu_f(b.z), silu_f(b.w));
        }
        *(u32x4*)(ac + (size_t)i * 8) = o;
    }
    { u32x4* sq = (u32x4*)(p.ws + WS_SSQ + 17408ull * 4); for (int i = gt; i < 4 * 17408 / 4; i += nth) sq[i] = (u32x4){0u, 0u, 0u, 0u}; }
    u32x4* sh = (u32x4*)(p.ws + WS_SHIFTA);
    for (int i = gt; i < 4 * 256 * 1024 / 8; i += nth) sh[i] = (u32x4){0u, 0u, 0u, 0u};
}

__device__ void phase_xprep(const Params& p, int blk0) {
    if ((int)blockIdx.x < blk0) return;
    const int tid_ = otid(), lane = tid_ & 63, wv = ((int)blockIdx.x - blk0) * 8 + (tid_ >> 6), nw = ((int)gridDim.x - blk0) * 8;
    const float* mod = (const float*)(p.ws + WS_MOD);
    bf16_t* ap = (bf16_t*)(p.ws + WS_APRIME);
    bf16_t* xwb = (bf16_t*)(p.ws + WS_XW);
    float* ssq = (float*)(p.ws + WS_SSQ);
    const float* ng = p.in[9];
    for (int r0 = wv * 2; r0 < MT; r0 += nw * 2) {
        f32x4 x[2][4];
#pragma unroll
        for (int h = 0; h < 2; ++h) {
            const int r = r0 + h;
            const float* xr = r < MP ? p.in[0] + (size_t)r * DM : p.in[1] + (size_t)(r - MP) * DM;
#pragma unroll
            for (int q = 0; q < 4; ++q) x[h][q] = *(const f32x4*)(xr + q * 256 + lane * 4);
        }
#pragma unroll
        for (int h = 0; h < 2; ++h) {
            const int r = r0 + h;
            const float* mb = mod + (size_t)row_b(r) * 12288 + 1024;
            float ss = 0.f;
#pragma unroll
            for (int q = 0; q < 4; ++q) {
                const int c = q * 256 + lane * 4;
                const f32x4 xv = x[h][q], sv = *(const f32x4*)(mb + c), g = *(const f32x4*)(ng + c);
                ss += (xv.x * xv.x + xv.y * xv.y) + (xv.z * xv.z + xv.w * xv.w);
                const f32x4 a = xv * g * (sv + 1.f);
                u32x2 o; o.x = cvt_pk_bf16(a.x, a.y); o.y = cvt_pk_bf16(a.z, a.w);
                *(u32x2*)(ap + (size_t)r * DM + c) = o;
                u32x2 ox; ox.x = cvt_pk_bf16(xv.x, xv.y); ox.y = cvt_pk_bf16(xv.z, xv.w);
                *(u32x2*)(xwb + (size_t)r * DM + c) = ox;
            }
#pragma unroll
            for (int o = 1; o < 64; o <<= 1) ss += __shfl_xor(ss, o);
            if (lane == 0) ssq[r] = ss;
        }
    }
}

__device__ void phase_final(const Params& p, int r_begin, int r_end, int blk0) {
    if ((int)blockIdx.x < blk0) return;
    const int tid_ = otid(), lane = tid_ & 63, wv = ((int)blockIdx.x - blk0) * 8 + (tid_ >> 6), nw = ((int)gridDim.x - blk0) * 8;
    const bf16_t* xw = (const bf16_t*)(p.ws + WS_XW);
    const float* ssq = (const float*)(p.ws + WS_SSQ) + 4 * 17408;
    const float* fg = p.in[22];
    for (int r0 = r_begin + wv * 2; r0 < r_end; r0 += nw * 2) {
        f32x4 x[2][4];
#pragma unroll
        for (int h = 0; h < 2; ++h)
#pragma unroll
            for (int q = 0; q < 4; ++q) { const u32x2 v = *(const u32x2*)(xw + (size_t)(r0 + h) * DM + q * 256 + lane * 4); x[h][q] = (f32x4){bf_lo(v.x), bf_hi(v.x), bf_lo(v.y), bf_hi(v.y)}; }
#pragma unroll
        for (int h = 0; h < 2; ++h) {
            const int r = r0 + h;
            const float rstd = rsqrtf(ssq[r] * (1.f / 1024.f) + 1e-6f);
#pragma unroll
            for (int q = 0; q < 4; ++q) {
                const int c = q * 256 + lane * 4;
                const f32x4 g = *(const f32x4*)(fg + c);
                *(f32x4*)(p.out + (size_t)r * DM + c) = x[h][q] * rstd * g;
            }
        }
    }
}

__device__ void phase_ssdnorm(const Params& p, int j) {
    const int tid_ = otid(), lane = tid_ & 63, wv = blockIdx.x * 8 + (tid_ >> 6), nw = gridDim.x * 8;
    const bf16_t* yg = (const bf16_t*)(p.ws + WS_YG);
    bf16_t* a2 = (bf16_t*)(p.ws + WS_A2);
    const float* ng = p.in[16] + (size_t)j * 2048;
    for (int r0 = wv * 2; r0 < MT; r0 += nw * 2) {
        u32x4 vv[2][4];
#pragma unroll
        for (int h = 0; h < 2; ++h)
#pragma unroll
            for (int q = 0; q < 4; ++q) vv[h][q] = *(const u32x4*)(yg + (size_t)(r0 + h) * 2048 + q * 512 + lane * 8);
#pragma unroll
        for (int h = 0; h < 2; ++h)
#pragma unroll
            for (int q = 0; q < 4; ++q) {
                const int c = q * 512 + lane * 8;
                const u32x4 v = vv[h][q];
                f32x4 a, b;
                a.x = bf_lo(v.x); a.y = bf_hi(v.x); a.z = bf_lo(v.y); a.w = bf_hi(v.y); b.x = bf_lo(v.z); b.y = bf_hi(v.z); b.z = bf_lo(v.w); b.w = bf_hi(v.w);
                float ss = (a.x * a.x + a.y * a.y) + (a.z * a.z + a.w * a.w) + (b.x * b.x + b.y * b.y) + (b.z * b.z + b.w * b.w);
#pragma unroll
                for (int o = 1; o < 32; o <<= 1) ss += __shfl_xor(ss, o);
                const float rstd = rsqrtf(ss * (1.f / 256.f) + 1e-6f);
                const f32x4 g0 = *(const f32x4*)(ng + c), g1 = *(const f32x4*)(ng + c + 4);
                *(u32x4*)(a2 + (size_t)(r0 + h) * 2048 + c) = pack8(a * rstd * g0, b * rstd * g1);
            }
    }
}

__device__ void phase_pool(const Params& p, int j) {
    const bf16_t* uz = (const bf16_t*)(p.ws + WS_ZX);
    bf16_t* pooled = (bf16_t*)(p.ws + WS_YG);
    const int gt = blockIdx.x * 512 + otid(), nth = gridDim.x * 512;
    for (int u = gt; u < 131072 + 32768; u += nth) {
        int cv, row0, t0, R; const float* prev = nullptr; bool prompt;
        if (u < 131072) { cv = u & 255; const int run = (u >> 8) & 63, b = u >> 14; row0 = b * 2048; t0 = run * 32; R = 32; prompt = true; }
        else { const int v = u - 131072; cv = v & 255; const int b = v >> 8; row0 = MP + b * 8; t0 = 0; R = 8; prompt = false; prev = p.in[4] + ((size_t)(j * 128 + b) * 15) * 2048; }
        const int c = cv * 8, w = 2 << (c >> 9);
        float s[8];
#pragma unroll
        for (int i = 0; i < 8; ++i) s[i] = 0.f;
        auto getu = [&](int tt, float (&o)[8]) {
            if (tt >= 0) {
                const u32x4 v = *(const u32x4*)(uz + (size_t)(row0 + tt) * 4096 + c);
                o[0] = bf_lo(v.x); o[1] = bf_hi(v.x); o[2] = bf_lo(v.y); o[3] = bf_hi(v.y); o[4] = bf_lo(v.z); o[5] = bf_hi(v.z); o[6] = bf_lo(v.w); o[7] = bf_hi(v.w);
            } else if (!prompt) {
                const float* pp = prev + (size_t)(15 + tt) * 2048 + c;
                const f32x4 a = *(const f32x4*)pp, b = *(const f32x4*)(pp + 4);
                o[0] = a.x; o[1] = a.y; o[2] = a.z; o[3] = a.w; o[4] = b.x; o[5] = b.y; o[6] = b.z; o[7] = b.w;
            } else {
#pragma unroll
                for (int i = 0; i < 8; ++i) o[i] = 0.f;
            }
        };
        for (int i = 1; i < w; ++i) {
            float o[8]; getu(t0 - i, o);
#pragma unroll
            for (int k = 0; k < 8; ++k) s[k] += o[k];
        }
        for (int tb = t0; tb < t0 + R; tb += 4) {
            float cur[4][8], old[4][8];
#pragma unroll
            for (int k = 0; k < 4; ++k) { getu(tb + k, cur[k]); getu(tb + k - w + 1, old[k]); }
#pragma unroll
            for (int k = 0; k < 4; ++k) {
                const int t = tb + k;
                const float inv = 1.f / (float)(prompt ? min(w, t + 1) : w);
                f32x4 a, b;
#pragma unroll
                for (int i = 0; i < 8; ++i) s[i] += cur[k][i];
                a.x = s[0] * inv - cur[k][0]; a.y = s[1] * inv - cur[k][1]; a.z = s[2] * inv - cur[k][2]; a.w = s[3] * inv - cur[k][3];
                b.x = s[4] * inv - cur[k][4]; b.y = s[5] * inv - cur[k][5]; b.z = s[6] * inv - cur[k][6]; b.w = s[7] * inv - cur[k][7];
                *(u32x4*)(pooled + (size_t)(row0 + t) * 2048 + c) = pack8(a, b);
#pragma unroll
                for (int i = 0; i < 8; ++i) s[i] -= old[k][i];
            }
        }
    }
    for (int i = gt; i < (8 + 128) * 15 * 256; i += nth) {
        const int cv = i & 255, k = (i >> 8) % 15, sq = (i >> 8) / 15, ch = cv * 8;
        f32x4 a, b2;
        float* dst;
        bool from_state = false; size_t urow = 0;
        if (sq < 8) { urow = (size_t)(sq * 2048 + 2033 + k); dst = p.out + O_POOL_P + ((size_t)(j * 8 + sq) * 15 + k) * 2048 + ch; }
        else { const int bb = sq - 8; dst = p.out + O_POOL_S + ((size_t)(j * 128 + bb) * 15 + k) * 2048 + ch; if (k < 7) from_state = true; else urow = (size_t)(MP + bb * 8 + k - 7); }
        if (from_state) { const float* sp = p.in[4] + ((size_t)(j * 128 + (sq - 8)) * 15 + 8 + k) * 2048 + ch; a = *(const f32x4*)sp; b2 = *(const f32x4*)(sp + 4); }
        else { const u32x4 v = *(const u32x4*)(uz + urow * 4096 + ch); a = (f32x4){bf_lo(v.x), bf_hi(v.x), bf_lo(v.y), bf_hi(v.y)}; b2 = (f32x4){bf_lo(v.z), bf_hi(v.z), bf_lo(v.w), bf_hi(v.w)}; }
        *(f32x4*)dst = a; *(f32x4*)(dst + 4) = b2;
    }
}

constexpr int RS = 272;
constexpr int L_XT = 0, L_BN = 17408, L_BT = 52224, L_CN = 87040, L_HB = 121856, L_SM = 139264, L_CW = 143360;
__device__ __forceinline__ int xt_addr(int pr, int t) { return L_XT + pr * RS + ((((t >> 3) ^ (pr >> 1)) & 15) << 4) + (t & 7) * 2; }
__device__ __forceinline__ int bt_addr(int n, int t) { return L_BT + n * RS + ((((t >> 3) ^ (n >> 3)) & 15) << 4) + (t & 7) * 2; }
__device__ __forceinline__ f32x16 mfma32(bf16x8 a, bf16x8 b, f32x16 c) { return __builtin_amdgcn_mfma_f32_32x32x16_bf16(a, b, c, 0, 0, 0); }

#define OPQ(x) asm volatile("" : "+v"(x))
__device__ void ssd_prompt_item(const Params& p, int j, int b, int h, LAS unsigned char* lds) {
    const int tid0 = otid(), wid = __builtin_amdgcn_readfirstlane(tid0 >> 6), g = h >> 2;
    const char* zxc = (const char*)(p.ws + WS_ZX);
    const char* dtc = (const char*)(p.ws + WS_DTRAW);
    char* ygc = (char*)(p.ws + WS_YG);
    const int rowbase = b * 2048;
    LAS float* cw = (LAS float*)(lds + L_CW);
    const float Ah = -__expf(p.in[14][j * 32 + h]), Dh = p.in[15][j * 32 + h], dtb = p.in[13][j * 32 + h];
    const bool roleB = wid < 4;
    const int qq = wid >> 1, tt = qq ^ (qq >> 1), pt = wid & 1, hp = wid & 1, hn = wid >> 1;

    __syncthreads();
    if (tid0 < 320) {
        const int ch = tid0 < 64 ? h * 64 + tid0 : (tid0 < 192 ? 2048 + g * 128 + (tid0 - 64) : 3072 + g * 128 + (tid0 - 192));
#pragma unroll
        for (int k = 0; k < 4; ++k) cw[k * 320 + tid0] = p.in[11][((size_t)j * 4 + k) * 4096 + ch];
        cw[4 * 320 + tid0] = p.in[12][(size_t)j * 4096 + ch];
    }
    for (int i = tid0; i < 17408 / 4; i += 512) *(LAS unsigned*)(lds + L_HB + i * 4) = 0u;

    u32x4 rawBC[11]; unsigned rawX[11]; float dtp0 = 0.f, dtp1 = 0.f;
    auto prefetch = [&](int t0) {
        int tid = tid0; OPQ(tid);
        const int bt_ = tid & 255, tqb = bt_ >> 4, cg8 = bt_ & 15, tqx = tid >> 5, cp = tid & 31, lane = tid & 63;
        const int colBC = (roleB ? 4096 : 5120) + g * 128 + cg8 * 8, colX = 2048 + h * 64 + cp * 2;
        const int rB = t0 + tqb * 8 - 3, rX = t0 + tqx * 8 - 3;
        const unsigned oB = (unsigned)((rowbase + rB) * ZXW + colBC) * 2u, oX = (unsigned)((rowbase + rX) * ZXW + colX) * 2u;
#pragma unroll
        for (int i = 0; i < 11; ++i) {
            rawBC[i] = (rB + i >= 0) ? *(const u32x4*)(zxc + (oB + (unsigned)i * 12288u)) : (u32x4){0u, 0u, 0u, 0u};
            rawX[i] = (rX + i >= 0) ? *(const unsigned*)(zxc + (oX + (unsigned)i * 12288u)) : 0u;
        }
        if (wid == 0) { const unsigned od = (unsigned)((rowbase + t0 + 2 * lane) * 32 + h) * 4u; dtp0 = *(const float*)(dtc + od); dtp1 = *(const float*)(dtc + (od + 128u)); }
    };
    prefetch(0);

    auto acum_stage = [&](int par) {
        if (wid == 0) {
            LAS float* sm_acum = (LAS float*)(lds + L_SM + par * 2048);
            LAS float* sm_dt = sm_acum + 128;
            LAS float* sm_w = sm_acum + 256;
            LAS float* sm_ea = sm_acum + 384;
            int lane = tid0 & 63; OPQ(lane);
            const float d0 = softplus_f(dtp0 + dtb), d1 = softplus_f(dtp1 + dtb);
            const float a0 = d0 * Ah, a1 = a0 + d1 * Ah;
            float sc = a1;
#pragma unroll
            for (int o = 1; o < 64; o <<= 1) { const float v = __shfl_up(sc, o); if (lane >= o) sc += v; }
            const float c1 = sc, c0 = sc - a1 + a0;
            const float last = __shfl(sc, 63);
            sm_acum[2 * lane] = c0; sm_acum[2 * lane + 1] = c1;
            sm_dt[2 * lane] = d0; sm_dt[2 * lane + 1] = d1;
            sm_w[2 * lane] = __expf(last - c0) * d0; sm_w[2 * lane + 1] = __expf(last - c1) * d1;
            sm_ea[2 * lane] = __expf(c0); sm_ea[2 * lane + 1] = __expf(c1);
        }
    };
    acum_stage(0);
    __syncthreads();

    f32x16 hacc;
#pragma unroll
    for (int i = 0; i < 16; ++i) hacc[i] = 0.f;

#pragma unroll 1
    for (int c = 0; c < 16; ++c) {
        const int t0 = c * 128;
        LAS float* sm_acum = (LAS float*)(lds + L_SM + (c & 1) * 2048);
        LAS float* sm_dt = sm_acum + 128;
        LAS float* sm_w = sm_acum + 256;
        LAS float* sm_ea = sm_acum + 384;
        {
            int tid = tid0; OPQ(tid);
            const int bt_ = tid & 255, tqb = bt_ >> 4, cg8 = bt_ & 15;
            const int lcBC = (roleB ? 64 : 192) + cg8 * 8;
            const f32x4 wv0 = *(const LAS f32x4*)(sm_w + tqb * 8), wv1 = *(const LAS f32x4*)(sm_w + tqb * 8 + 4);
            const float wt[8] = {wv0.x, wv0.y, wv0.z, wv0.w, wv1.x, wv1.y, wv1.z, wv1.w};
            const int natbase = (roleB ? L_BN : L_CN) + (tqb * 8) * RS + cg8 * 16;
#pragma unroll
            for (int half = 0; half < 2; ++half) {
                u32x2 nat[8]; u32x4 tr[4];
#pragma unroll
                for (int ipp = 0; ipp < 2; ++ipp) {
                    const int ip = half * 2 + ipp;
                    const float k0a = cw[0 * 320 + lcBC + 2 * ip], k0b = cw[0 * 320 + lcBC + 2 * ip + 1];
                    const float k1a = cw[1 * 320 + lcBC + 2 * ip], k1b = cw[1 * 320 + lcBC + 2 * ip + 1];
                    const float k2a = cw[2 * 320 + lcBC + 2 * ip], k2b = cw[2 * 320 + lcBC + 2 * ip + 1];
                    const float k3a = cw[3 * 320 + lcBC + 2 * ip], k3b = cw[3 * 320 + lcBC + 2 * ip + 1];
                    const float bba = cw[4 * 320 + lcBC + 2 * ip], bbb = cw[4 * 320 + lcBC + 2 * ip + 1];
                    f32x2 rr[11];
#pragma unroll
                    for (int i = 0; i < 11; ++i) { const unsigned v = rawBC[i][ip]; rr[i] = (f32x2){bf_lo(v), bf_hi(v)}; }
                    const f32x2 K0 = {k0a, k0b}, K1 = {k1a, k1b}, K2 = {k2a, k2b}, K3 = {k3a, k3b}, BB = {bba, bbb};
                    float va[8], vb[8];
#pragma unroll
                    for (int t = 0; t < 8; ++t) {
                        const f32x2 v = silu2(BB + K0 * rr[t] + K1 * rr[t + 1] + K2 * rr[t + 2] + K3 * rr[t + 3]);
                        va[t] = v.x; vb[t] = v.y;
                        nat[t][ipp] = cvt_pk_bf16(v.x, v.y);
                    }
                    if (roleB) {
#pragma unroll
                        for (int tp = 0; tp < 4; ++tp) {
                            tr[2 * ipp][tp] = cvt_pk_bf16(va[2 * tp] * wt[2 * tp], va[2 * tp + 1] * wt[2 * tp + 1]);
                            tr[2 * ipp + 1][tp] = cvt_pk_bf16(vb[2 * tp] * wt[2 * tp], vb[2 * tp + 1] * wt[2 * tp + 1]);
                        }
                    }
                }
#pragma unroll
                for (int t = 0; t < 8; ++t) *(LAS u32x2*)(lds + natbase + t * RS + half * 8) = nat[t];
                if (roleB) {
#pragma unroll
                    for (int i = 0; i < 4; ++i) *(LAS u32x4*)(lds + bt_addr(cg8 * 8 + half * 4 + i, tqb * 8)) = tr[i];
                }
                __builtin_amdgcn_sched_barrier(0);
            }
        }
        {
            int tid = tid0; OPQ(tid);
            const int tqx = tid >> 5, cp = tid & 31, lcX = cp * 2;
            const float k0a = cw[0 * 320 + lcX], k0b = cw[0 * 320 + lcX + 1], k1a = cw[1 * 320 + lcX], k1b = cw[1 * 320 + lcX + 1];
            const float k2a = cw[2 * 320 + lcX], k2b = cw[2 * 320 + lcX + 1], k3a = cw[3 * 320 + lcX], k3b = cw[3 * 320 + lcX + 1];
            const float bba = cw[4 * 320 + lcX], bbb = cw[4 * 320 + lcX + 1];
            f32x2 rr[11];
#pragma unroll
            for (int i = 0; i < 11; ++i) rr[i] = (f32x2){bf_lo(rawX[i]), bf_hi(rawX[i])};
            const f32x2 K0 = {k0a, k0b}, K1 = {k1a, k1b}, K2 = {k2a, k2b}, K3 = {k3a, k3b}, BB = {bba, bbb};
            float va[8], vb[8];
#pragma unroll
            for (int t = 0; t < 8; ++t) { const f32x2 v = silu2(BB + K0 * rr[t] + K1 * rr[t + 1] + K2 * rr[t + 2] + K3 * rr[t + 3]); va[t] = v.x; vb[t] = v.y; }
            u32x4 xa, xb;
            xa.x = cvt_pk_bf16(va[0], va[1]); xa.y = cvt_pk_bf16(va[2], va[3]); xa.z = cvt_pk_bf16(va[4], va[5]); xa.w = cvt_pk_bf16(va[6], va[7]);
            xb.x = cvt_pk_bf16(vb[0], vb[1]); xb.y = cvt_pk_bf16(vb[2], vb[3]); xb.z = cvt_pk_bf16(vb[4], vb[5]); xb.w = cvt_pk_bf16(vb[6], vb[7]);
            *(LAS u32x4*)(lds + xt_addr(cp * 2, tqx * 8)) = xa;
            *(LAS u32x4*)(lds + xt_addr(cp * 2 + 1, tqx * 8)) = xb;
        }
        if (c + 1 < 16) prefetch(t0 + 128);
        bf16_t zr[16];
        {
            int ln = tid0 & 63; OPQ(ln);
            const int l31 = ln & 31, hh = ln >> 5;
            const unsigned oz = (unsigned)((rowbase + t0 + tt * 32 + 4 * hh) * ZXW + h * 64 + pt * 32 + l31) * 2u;
#pragma unroll
            for (int rg = 0; rg < 16; ++rg) zr[rg] = *(const bf16_t*)(zxc + (oz + (unsigned)((rg & 3) + 8 * (rg >> 2)) * 12288u));
        }
        __syncthreads();
        f32x16 y;
        {
            int ln = tid0 & 63; OPQ(ln);
            const int l31 = ln & 31, hh = ln >> 5;
            const int cbase = L_CN + (tt * 32 + l31) * RS + 16 * hh, hbase = L_HB + (pt * 32 + l31) * RS + 16 * hh;
#pragma unroll
            for (int i = 0; i < 16; ++i) y[i] = 0.f;
            {
                const float dec = sm_ea[127];
#pragma unroll
                for (int i = 0; i < 16; ++i) hacc[i] *= dec;
            }
            bf16x8 cf[8];
#pragma unroll
            for (int ks = 0; ks < 8; ++ks) {
                cf[ks] = *(const LAS bf16x8*)(lds + cbase + ks * 32);
                const bf16x8 bfr = *(const LAS bf16x8*)(lds + hbase + ks * 32);
                const bf16x8 a = *(const LAS bf16x8*)(lds + xt_addr(hp * 32 + l31, ks * 16 + 8 * hh));
                const bf16x8 bb = *(const LAS bf16x8*)(lds + bt_addr(hn * 32 + l31, ks * 16 + 8 * hh));
                y = mfma32(cf[ks], bfr, y);
                hacc = mfma32(a, bb, hacc);
            }
#pragma unroll
            for (int rq = 0; rq < 4; ++rq) { const f32x4 e = *(const LAS f32x4*)(sm_ea + tt * 32 + 8 * rq + 4 * hh); y[4 * rq] *= e.x; y[4 * rq + 1] *= e.y; y[4 * rq + 2] *= e.z; y[4 * rq + 3] *= e.w; }
            const int tidx = tt * 32 + l31;
            const float at = sm_acum[tidx];
#pragma unroll 1
            for (int st = 0; st <= tt; ++st) {
                f32x16 s;
#pragma unroll
                for (int i = 0; i < 16; ++i) s[i] = 0.f;
                const int bbase = L_BN + (st * 32 + l31) * RS + 16 * hh;
#pragma unroll
                for (int ks = 0; ks < 8; ++ks) { const bf16x8 afr = *(const LAS bf16x8*)(lds + bbase + ks * 32); s = mfma32(afr, cf[ks], s); }
#pragma unroll
                for (int rq = 0; rq < 4; ++rq) {
                    const int sb0 = st * 32 + 8 * rq + 4 * hh;
                    const f32x4 asv = *(const LAS f32x4*)(sm_acum + sb0), dsv = *(const LAS f32x4*)(sm_dt + sb0);
#pragma unroll
                    for (int i = 0; i < 4; ++i) {
                        float e = at - asv[i];
                        if (sb0 + i > tidx) e = -INFINITY;
                        s[4 * rq + i] *= __expf(e) * dsv[i];
                    }
                }
#pragma unroll
                for (int k2 = 0; k2 < 2; ++k2) {
                    u32x4 au; au.x = cvt_pk_bf16(s[8 * k2], s[8 * k2 + 1]); au.y = cvt_pk_bf16(s[8 * k2 + 2], s[8 * k2 + 3]); au.z = cvt_pk_bf16(s[8 * k2 + 4], s[8 * k2 + 5]); au.w = cvt_pk_bf16(s[8 * k2 + 6], s[8 * k2 + 7]);
                    const int sbase = st * 32 + 16 * k2 + 4 * hh;
                    const u32x2 lo = *(const LAS u32x2*)(lds + xt_addr(pt * 32 + l31, sbase)), hi = *(const LAS u32x2*)(lds + xt_addr(pt * 32 + l31, sbase + 8));
                    u32x4 bu; bu.x = lo.x; bu.y = lo.y; bu.z = hi.x; bu.w = hi.y;
                    y = mfma32(__builtin_bit_cast(bf16x8, au), __builtin_bit_cast(bf16x8, bu), y);
                }
            }
        }
        {
            int ln = tid0 & 63; OPQ(ln);
            const int l31 = ln & 31, hh = ln >> 5;
            const unsigned oy = (unsigned)((rowbase + t0 + tt * 32 + 4 * hh) * 2048 + h * 64 + pt * 32 + l31) * 2u;
#pragma unroll
            for (int rq = 0; rq < 4; ++rq) {
                const u32x2 xv = *(const LAS u32x2*)(lds + xt_addr(pt * 32 + l31, tt * 32 + 8 * rq + 4 * hh));
                const float xs[4] = {bf_lo(xv.x), bf_hi(xv.x), bf_lo(xv.y), bf_hi(xv.y)};
#pragma unroll
                for (int i = 0; i < 4; ++i) {
                    const int rg = 4 * rq + i;
                    const float yv = y[rg] + Dh * xs[i];
                    const float gv = yv * silu_f(bf2f(zr[rg]));
                    *(bf16_t*)(ygc + (oy + (unsigned)(8 * rq + i) * 4096u)) = (bf16_t)(cvt_pk_bf16(gv, 0.f) & 0xffffu);
                }
            }
        }
        if (c + 1 < 16) acum_stage((c + 1) & 1);
        __syncthreads();
        {
            int ln = tid0 & 63; OPQ(ln);
            const int l31 = ln & 31, hh = ln >> 5;
#pragma unroll
            for (int rg = 0; rg < 16; ++rg) {
                const int pr = hp * 32 + (rg & 3) + 8 * (rg >> 2) + 4 * hh;
                *(LAS bf16_t*)(lds + L_HB + pr * RS + (hn * 32 + l31) * 2) = (bf16_t)(cvt_pk_bf16(hacc[rg], 0.f) & 0xffffu);
            }
        }
    }
    {
        int ln = tid0 & 63; OPQ(ln);
        const int l31 = ln & 31, hh = ln >> 5;
        float* so = p.out + O_SSM_P + ((size_t)(j * 8 + b) * 32 + h) * 8192;
#pragma unroll
        for (int rg = 0; rg < 16; ++rg) {
            const int pr = hp * 32 + (rg & 3) + 8 * (rg >> 2) + 4 * hh;
            so[pr * 128 + hn * 32 + l31] = hacc[rg];
        }
    }
}

__device__ void ssd_sample_all(const Params& p, int j, LAS unsigned char* lds) {
    const int tid = otid();
    const bf16_t* zx = (const bf16_t*)(p.ws + WS_ZX);
    const float* dtraw = (const float*)(p.ws + WS_DTRAW);
    bf16_t* yg = (bf16_t*)(p.ws + WS_YG);
    LAS float* sx = (LAS float*)lds;
    LAS float* sB = sx + 2048;
    LAS float* sC = sB + 1024;
    LAS float* sdt = sC + 1024;
    LAS float* sdec = sdt + 32;
    const int pp = tid >> 3, nl = (tid & 7) * 4;
    int item = (int)blockIdx.x;
    f32x4 hs[4][4];
    if (item < 1024) {
        const float* st = p.in[2] + ((size_t)(j * 128 + (item >> 3)) * 32 + (item & 7) * 4) * 8192;
#pragma unroll
        for (int r = 0; r < 4; ++r)
#pragma unroll
            for (int q = 0; q < 4; ++q) hs[r][q] = *(const f32x4*)(st + r * 8192 + pp * 128 + nl + 32 * q);
    }
#pragma unroll 1
    for (; item < 1024; item += (int)gridDim.x) {
        const int b = item >> 3, g = item & 7;
        __syncthreads();
        {
            const int cc = tid < 256 ? g * 256 + tid : (tid < 384 ? 2048 + g * 128 + (tid - 256) : 3072 + g * 128 + (tid - 384));
            float raw[11];
#pragma unroll
            for (int k = 0; k < 3; ++k) raw[k] = p.in[3][((size_t)(j * 128 + b) * 3 + k) * 4096 + cc];
#pragma unroll
            for (int t = 0; t < 8; ++t) raw[3 + t] = bf2f(zx[(size_t)(MP + b * 8 + t) * ZXW + 2048 + cc]);
            const float w0 = p.in[11][((size_t)j * 4 + 0) * 4096 + cc], w1 = p.in[11][((size_t)j * 4 + 1) * 4096 + cc];
            const float w2 = p.in[11][((size_t)j * 4 + 2) * 4096 + cc], w3 = p.in[11][((size_t)j * 4 + 3) * 4096 + cc];
            const float bs = p.in[12][(size_t)j * 4096 + cc];
            LAS float* dst = tid < 256 ? sx + tid : (tid < 384 ? sB + (tid - 256) : sC + (tid - 384));
            const int dstride = tid < 256 ? 256 : 128;
#pragma unroll
            for (int t = 0; t < 8; ++t) dst[t * dstride] = silu_f(bs + w0 * raw[t] + w1 * raw[t + 1] + w2 * raw[t + 2] + w3 * raw[t + 3]);
            if (tid < 32) {
                const int t = tid >> 2, r = tid & 3, hd = g * 4 + r;
                const float dtv = softplus_f(dtraw[(size_t)(MP + b * 8 + t) * 32 + hd] + p.in[13][j * 32 + hd]);
                sdt[tid] = dtv; sdec[tid] = __expf(-dtv * __expf(p.in[14][j * 32 + hd]));
            }
        }
        const int tsel = tid & 7;
        const size_t row = (size_t)(MP + b * 8 + tsel);
        bf16_t zv[4];
#pragma unroll
        for (int r = 0; r < 4; ++r) zv[r] = zx[row * ZXW + g * 256 + r * 64 + pp];
        const int nitem = item + (int)gridDim.x;
        f32x4 hn[4][4];
        if (nitem < 1024) {
            const float* st = p.in[2] + ((size_t)(j * 128 + (nitem >> 3)) * 32 + (nitem & 7) * 4) * 8192;
#pragma unroll
            for (int r = 0; r < 4; ++r)
#pragma unroll
                for (int q = 0; q < 4; ++q) hn[r][q] = *(const f32x4*)(st + r * 8192 + pp * 128 + nl + 32 * q);
        }
        __syncthreads();
        float ysel[4] = {0.f, 0.f, 0.f, 0.f};
#pragma unroll
        for (int t = 0; t < 8; ++t) {
            const f32x4 dt4 = *(const LAS f32x4*)(sdt + t * 4), dc4 = *(const LAS f32x4*)(sdec + t * 4);
            const float dx[4] = {dt4.x * sx[t * 256 + pp], dt4.y * sx[t * 256 + 64 + pp], dt4.z * sx[t * 256 + 128 + pp], dt4.w * sx[t * 256 + 192 + pp]};
            const float dc[4] = {dc4.x, dc4.y, dc4.z, dc4.w};
            float yp[4] = {0.f, 0.f, 0.f, 0.f};
#pragma unroll
            for (int q = 0; q < 4; ++q) {
                const f32x4 B4 = *(const LAS f32x4*)(sB + t * 128 + nl + 32 * q), C4 = *(const LAS f32x4*)(sC + t * 128 + nl + 32 * q);
#pragma unroll
                for (int r = 0; r < 4; ++r) {
                    hs[r][q] = hs[r][q] * dc[r] + B4 * dx[r];
                    yp[r] += (hs[r][q].x * C4.x + hs[r][q].y * C4.y) + (hs[r][q].z * C4.z + hs[r][q].w * C4.w);
                }
            }
#pragma unroll
            for (int r = 0; r < 4; ++r) {
                float v = yp[r];
                v += __shfl_xor(v, 1); v += __shfl_xor(v, 2); v += __shfl_xor(v, 4);
                if (tsel == t) ysel[r] = v;
            }
        }
        float* so = p.out + O_SSM_S + ((size_t)(j * 128 + b) * 32 + g * 4) * 8192;
#pragma unroll
        for (int r = 0; r < 4; ++r) {
            const int ch = g * 256 + r * 64 + pp;
            const float yv = ysel[r] + p.in[15][j * 32 + g * 4 + r] * sx[tsel * 256 + r * 64 + pp];
            const float gv = yv * silu_f(bf2f(zv[r]));
            yg[row * 2048 + ch] = (bf16_t)(cvt_pk_bf16(gv, 0.f) & 0xffffu);
#pragma unroll
            for (int q = 0; q < 4; ++q) *(f32x4*)(so + r * 8192 + pp * 128 + nl + 32 * q) = hs[r][q];
        }
        if (nitem < 1024) {
#pragma unroll
            for (int r = 0; r < 4; ++r)
#pragma unroll
                for (int q = 0; q < 4; ++q) hs[r][q] = hn[r][q];
        }
    }
}

__device__ void phase_scan(const Params& p, int j, LAS unsigned char* lds) {
    for (int item = blockIdx.x; item < 256; item += gridDim.x) {
        const int g = item & 7, k = item >> 3, b = k >> 2, r = k & 3;
        for (int rep = 0; rep < REP_PROMPT; ++rep) ssd_prompt_item(p, j, b, g * 4 + r, lds);
    }
    ssd_sample_all(p, j, lds);
    const bf16_t* zx = (const bf16_t*)(p.ws + WS_ZX);
    const int gt = blockIdx.x * 512 + otid(), nth = gridDim.x * 512;
    for (int i = gt; i < 136 * 3 * 512; i += nth) {
        const int ch = (i & 511) * 8, k = (i >> 9) % 3, sq = (i >> 9) / 3;
        const size_t row = sq < 8 ? (size_t)(sq * 2048 + 2045 + k) : (size_t)(MP + (sq - 8) * 8 + 5 + k);
        float* dst = sq < 8 ? p.out + O_CONV_P + ((size_t)(j * 8 + sq) * 3 + k) * 4096 + ch : p.out + O_CONV_S + ((size_t)(j * 128 + (sq - 8)) * 3 + k) * 4096 + ch;
        const u32x4 v = *(const u32x4*)(zx + row * ZXW + 2048 + ch);
        *(f32x4*)dst = (f32x4){bf_lo(v.x), bf_hi(v.x), bf_lo(v.y), bf_hi(v.y)}; *(f32x4*)(dst + 4) = (f32x4){bf_lo(v.z), bf_hi(v.z), bf_lo(v.w), bf_hi(v.w)};
    }
}

#define XB_TMO      128
#define XB_XCNT(j)  (256  + 64 * (j))
#define XB_XSUB(j)  (1280 + 64 * (j))
#define XB_XGEN(j)  (2304 + 64 * (j))
#define XB_TOP      3328
#define XB_TOPGEN   3392
#define XCD_BAR_WORDS 3456
#define XB_SPIN_CAP (1u << 22)
__device__ __forceinline__ unsigned xb_ld(unsigned* p)              { return __hip_atomic_load(p, __ATOMIC_RELAXED, __HIP_MEMORY_SCOPE_AGENT); }
__device__ __forceinline__ unsigned xb_add(unsigned* p, unsigned v) { return __hip_atomic_fetch_add(p, v, __ATOMIC_RELAXED, __HIP_MEMORY_SCOPE_AGENT); }
__device__ __forceinline__ unsigned xb_xcc_id() { return (unsigned)__builtin_amdgcn_s_getreg((3 << 11) | 20) & 0xFu; }
#define XB_SPIN(cond, bar) do { unsigned _sp = 0; while (cond) { __builtin_amdgcn_s_sleep(1); \
    if ((++_sp & 255u) == 0u) { if (xb_ld(&(bar)[XB_TMO])) break; if (_sp > XB_SPIN_CAP) { atomicAdd(&(bar)[XB_TMO], 1u); break; } } } } while (0)
struct XcdBarrier { unsigned* bar; unsigned x; volatile LAS unsigned* st; };
__device__ __forceinline__ XcdBarrier xcd_barrier_post(unsigned* bar, volatile LAS unsigned* st) {
    XcdBarrier b; b.bar = bar; b.x = xb_xcc_id(); b.st = st;
    if (threadIdx.x == 0) (void)xb_add(&bar[XB_XCNT(b.x)], 1u);
    return b;
}
__device__ __forceinline__ void xcd_barrier_complete(unsigned* bar, unsigned x, unsigned& nloc, unsigned& nx) {
    const unsigned G = gridDim.x * gridDim.y * gridDim.z;
    unsigned sum, cnt, mine, sp = 0u;
    for (;;) {
        sum = 0u; cnt = 0u; mine = 0u;
#pragma unroll
        for (unsigned j = 0; j < 16; ++j) { const unsigned c = xb_ld(&bar[XB_XCNT(j)]); sum += c; cnt += (c > 0u) ? 1u : 0u; mine = (j == x) ? c : mine; }
        if (sum == G) break;
        __builtin_amdgcn_s_sleep(1);
        if ((++sp & 255u) == 0u) { if (xb_ld(&bar[XB_TMO])) break; if (sp > XB_SPIN_CAP) { atomicAdd(&bar[XB_TMO], 1u); break; } }
    }
    nloc = mine > 0u ? mine : 1u; nx = cnt > 0u ? cnt : 1u;
}
__device__ __forceinline__ void xcd_barrier(const XcdBarrier& b) {
    asm volatile("s_waitcnt vmcnt(0)" ::: "memory");
    __syncthreads();
    if (threadIdx.x == 0) {
        unsigned* bar = b.bar;
        __builtin_amdgcn_s_waitcnt(0);
        unsigned nloc = b.st[0], nx = b.st[1];
        if (nloc == 0u) { xcd_barrier_complete(bar, b.x, nloc, nx); b.st[0] = nloc; b.st[1] = nx; }
        const unsigned old = xb_add(&bar[XB_XSUB(b.x)], 1u);
        const unsigned gen = old / nloc;
        if (old + 1u == (gen + 1u) * nloc) {
            __builtin_amdgcn_fence(__ATOMIC_RELEASE, "agent");
            asm volatile("s_waitcnt vmcnt(0)" ::: "memory");
            const unsigned og = xb_add(&bar[XB_TOP], 1u);
            const unsigned tg = og / nx;
            if (og + 1u == (tg + 1u) * nx) xb_add(&bar[XB_TOPGEN], 1u);
            else XB_SPIN(xb_ld(&bar[XB_TOPGEN]) == tg, bar);
            __builtin_amdgcn_fence(__ATOMIC_ACQUIRE, "agent");
            xb_add(&bar[XB_XGEN(b.x)], 1u);
            asm volatile("s_waitcnt vmcnt(0)" ::: "memory");
        } else {
            XB_SPIN(xb_ld(&bar[XB_XGEN(b.x)]) == gen, bar);
            __builtin_amdgcn_fence(__ATOMIC_ACQUIRE, "agent");
            asm volatile("s_waitcnt vmcnt(0)" ::: "memory");
        }
    }
    __syncthreads();
}

#ifndef REP_PREP0
#define REP_PREP0 1
#endif
#ifndef REP_SMALL
#define REP_SMALL 1
#endif
#ifndef REP_GGRP
#define REP_GGRP 1
#endif
#ifndef REP_GGRP
#define REP_GGRP 1
#endif
#ifndef REP_SYNC
#define REP_SYNC 1
#endif
#ifndef REP_SCAN
#define REP_SCAN 1
#endif
#ifndef REP_GIN
#define REP_GIN 1
#endif
#ifndef REP_GOUT
#define REP_GOUT 1
#endif
#ifndef REP_ELEM
#define REP_ELEM 1
#endif
#define GSYNC() do { for (int _r = 0; _r < REP_SYNC; ++_r) xcd_barrier(xb); } while (0)
__global__ __launch_bounds__(512, 2) void hybrid_fwd(const float* i0, const float* i1, const float* i2, const float* i3, const float* i4, const float* i5, const float* i6, const float* i7,
        const float* i8, const float* i9, const float* i10, const float* i11, const float* i12, const float* i13, const float* i14, const float* i15, const float* i16, const float* i17,
        const float* i18, const float* i19, const float* i20, const float* i21, const float* i22, float* outp, unsigned char* wsp, WTab wt) {
    Params p;
    p.in[0] = i0; p.in[1] = i1; p.in[2] = i2; p.in[3] = i3; p.in[4] = i4; p.in[5] = i5; p.in[6] = i6; p.in[7] = i7; p.in[8] = i8; p.in[9] = i9; p.in[10] = i10; p.in[11] = i11;
    p.in[12] = i12; p.in[13] = i13; p.in[14] = i14; p.in[15] = i15; p.in[16] = i16; p.in[17] = i17; p.in[18] = i18; p.in[19] = i19; p.in[20] = i20; p.in[21] = i21; p.in[22] = i22;
    p.out = outp; p.ws = wsp;
    extern __shared__ __attribute__((aligned(16))) unsigned char smem[];
    LAS unsigned char* lds = (LAS unsigned char*)smem;
    cg::grid_group grid = cg::this_grid();
    unsigned char* ws = p.ws;
    volatile LAS unsigned* xst = (volatile LAS unsigned*)(lds + LDS_XB);
    if (threadIdx.x == 0) { xst[0] = 0u; xst[1] = 0u; }
    __syncthreads();
    const XcdBarrier xb = xcd_barrier_post((unsigned*)(ws + WS_BAR), xst);

    phase_prep0(p, wt, lds, 0, wt.wj[8].tile_begin, 0, true);
    if (wt.wtiles < 0) grid.sync();
    xcd_barrier(xb);
#pragma unroll 1
    for (int mode_ = 0; mode_ < 2 * REP_SMALL; ++mode_) {
        const int mode = mode_ % 2;
        pg8::SmallSched S; S.mode = mode; S.G = (int)gridDim.x; S.c = (int)blockIdx.x; S.lda = 1024; S.ldb = 1024; S.K = 1024;
        S.A0 = (const char*)(ws + (mode == 0 ? WS_AC : WS_SHIFTA)); S.ada = (const char*)(ws + WS_WT_ADA); S.ssd_in = (const char*)(ws + WS_WT_SSD_IN); S.pool_in = (const char*)(ws + WS_WT_POOL_IN);
        EpiSmall E; E.mode = mode; E.mod = (float*)(ws + WS_MOD); E.ada_b = p.in[8]; E.shiftA = (bf16_t*)(ws + WS_SHIFTA); E.sb = (float*)(ws + WS_SB);
#ifndef NO_GSMALL
        pg8::gemm_phase<EpiSmall, pg8::SmallSched>(lds, S, E);
#endif
        if (mode == 0) phase_prep0(p, wt, lds, wt.wj[8].tile_begin, wt.wtiles, 48, false);
        else phase_xprep(p, 82);
        GSYNC();
    }
    unsigned* tailw = (unsigned*)(ws + WS_BAR) + 3584;
    unsigned* tmow = (unsigned*)(ws + WS_BAR) + XB_TMO;
#pragma unroll 1
    for (int layer = 0; layer < 4; ++layer) {
        const int j = layer >> 1; const bool ssd = (layer & 1) == 0;
        {
            pg8::InSched S;
            S.init(ssd ? 6400 : 4096, ws + WS_APRIME, ssd ? ws + WS_WT_SSD_IN + (size_t)j * 6400 * 1024 * 2 : ws + WS_WT_POOL_IN + (size_t)j * 4096 * 1024 * 2, layer > 0 ? tailw + 64 * (layer - 1) : nullptr, tmow);
            EpiIn E; E.ssq = (const float*)(ws + WS_SSQ) + (size_t)layer * 17408; E.sb = (const float*)(ws + WS_SB) + (size_t)layer * 136 * 6400; E.out = (bf16_t*)(ws + WS_ZX);
            E.ldo = ssd ? ZXW : 4096; E.nbf = ssd ? ZXW : 4096; E.dtraw = ssd ? (float*)(ws + WS_DTRAW) : nullptr;
            for (int rep = 0; rep < REP_GIN; ++rep) pg8::gemm_phase<EpiIn, pg8::InSched>(lds, S, E);
        }
        GSYNC();
        if (ssd) { for (int rep = 0; rep < REP_SCAN; ++rep) phase_scan(p, j, lds); } else { for (int rep = 0; rep < REP_ELEM; ++rep) phase_pool(p, j); }
        GSYNC();
        if (ssd) { for (int rep = 0; rep < REP_ELEM; ++rep) phase_ssdnorm(p, j); }
        else {
            pg8::MainSched S; S.init(MT, 2048, 512, 2048, 512, ws + WS_YG, ws + WS_WT_POOL_G + (size_t)j * 2048 * 512 * 2, 1);
            EpiGrp E; E.uz = (const bf16_t*)(ws + WS_ZX); E.chs = p.in[20] + (size_t)j * 2048; E.out = (bf16_t*)(ws + WS_A2);
            for (int rep = 0; rep < REP_GGRP; ++rep) pg8::gemm_phase<EpiGrp, pg8::MainSched>(lds, S, E);
        }
        GSYNC();
#pragma unroll 1
        for (int part = 0; part < 2; ++part) {
            pg8::MainSched S; S.init(part == 0 ? MP : MT, 1024, 2048, 2048, 2048, ws + WS_A2, ssd ? ws + WS_WT_SSD_OUT + (size_t)j * 1024 * 2048 * 2 : ws + WS_WT_POOL_OUT + (size_t)j * 1024 * 2048 * 2, 30, part);
            EpiOut E; E.xw = (bf16_t*)(ws + WS_XW);
            E.modl = (const float*)(ws + WS_MOD) + (size_t)layer * 3072; E.ng_next = layer < 3 ? p.in[9] + (size_t)(layer + 1) * 1024 : nullptr;
            E.aprime = (bf16_t*)(ws + WS_APRIME); E.ssq = (float*)(ws + WS_SSQ) + (size_t)(layer + 1) * 17408;
            pg8::gemm_phase<EpiOut, pg8::MainSched>(lds, S, E);
            if (part == 0) GSYNC();
        }
        if (blockIdx.x < 16) {
            asm volatile("s_waitcnt vmcnt(0)" ::: "memory");
            __syncthreads();
            if (threadIdx.x == 0) { __builtin_amdgcn_fence(__ATOMIC_RELEASE, "agent"); asm volatile("s_waitcnt vmcnt(0)" ::: "memory"); __hip_atomic_fetch_add(tailw + 64 * layer, 1u, __ATOMIC_RELAXED, __HIP_MEMORY_SCOPE_AGENT); }
        }
    }
    phase_final(p, 0, MP, 16);
    GSYNC();
    phase_final(p, MP, MT, 0);
}

extern "C" void kernel_launch(void* const* d_in, const int* in_sizes, int n_in, void* d_out, int out_size, void* d_ws, size_t ws_size, hipStream_t stream) {
    static int grid = 0;
    if (grid == 0) {
        if (n_in != 23 || ws_size < WS_END) { fprintf(stderr, "kernel_launch: unexpected n_in %d or ws_size %zu (need %zu)\n", n_in, ws_size, (size_t)WS_END); grid = -1; return; }
        int dev = 0, cus = 0, per_cu = 0;
        hipGetDevice(&dev);
        hipDeviceGetAttribute(&cus, hipDeviceAttributeMultiprocessorCount, dev);
        if (hipFuncSetAttribute((const void*)hybrid_fwd, hipFuncAttributeMaxDynamicSharedMemorySize, LDS_BYTES) != hipSuccess) { fprintf(stderr, "kernel_launch: hipFuncSetAttribute failed\n"); grid = -1; return; }
        if (hipOccupancyMaxActiveBlocksPerMultiprocessor(&per_cu, (const void*)hybrid_fwd, 512, LDS_BYTES) != hipSuccess || per_cu < 1) { fprintf(stderr, "kernel_launch: occupancy query gave %d\n", per_cu); (void)hipGetLastError(); per_cu = 1; }
        if (cus < 256) { fprintf(stderr, "kernel_launch: needs a 256-CU device (got %d CUs)\n", cus); grid = -1; return; }
        grid = 256;
    }
    if (grid < 0) return;
    WTab wt{};
    unsigned char* ws = (unsigned char*)d_ws;
    int nj = 0, tb = 0;
    auto add = [&](int srci, long long soff, size_t dst_off, int K, int N, int Npad) {
        WJob& w = wt.wj[nj++]; w.src = (const float*)d_in[srci] + soff; w.doff = (long long)dst_off; w.K = K; w.N = N; w.tiles_n = Npad / 64; w.tile_begin = tb; tb += (K / 64) * (Npad / 64);
    };
    for (int i = 0; i < 4; ++i) add(7, (long long)i * 1024 * 3072, WS_WT_ADA + (size_t)i * 3072 * 1024 * 2, 1024, 3072, 3072);
    for (int j = 0; j < 2; ++j) add(10, (long long)j * 1024 * 6176, WS_WT_SSD_IN + (size_t)j * 6400 * 1024 * 2, 1024, 6176, 6400);
    for (int j = 0; j < 2; ++j) add(18, (long long)j * 1024 * 4096, WS_WT_POOL_IN + (size_t)j * 4096 * 1024 * 2, 1024, 4096, 4096);
    for (int j = 0; j < 2; ++j) add(17, (long long)j * 2048 * 1024, WS_WT_SSD_OUT + (size_t)j * 1024 * 2048 * 2, 2048, 1024, 1024);
    for (int j = 0; j < 2; ++j) add(21, (long long)j * 2048 * 1024, WS_WT_POOL_OUT + (size_t)j * 1024 * 2048 * 2, 2048, 1024, 1024);
    for (int q = 0; q < 8; ++q) add(19, (long long)q * 512 * 512, WS_WT_POOL_G + (size_t)q * 512 * 512 * 2, 512, 512, 512);
    wt.wtiles = tb;
    if (hipMemsetAsync(ws + WS_BAR, 0, 16384, stream) != hipSuccess) { fprintf(stderr, "kernel_launch: memset of the barrier words failed\n"); return; }
    const float* ip[23]; for (int i = 0; i < 23; ++i) ip[i] = (const float*)d_in[i];
    float* outp = (float*)d_out;
    void* args[26];
    for (int i = 0; i < 23; ++i) args[i] = (void*)&ip[i];
    args[23] = (void*)&outp; args[24] = (void*)&ws; args[25] = (void*)&wt;
    hipError_t e = hipLaunchCooperativeKernel((const void*)hybrid_fwd, dim3(grid), dim3(512), args, LDS_BYTES, stream);
    if (e != hipSuccess) fprintf(stderr, "cooperative launch failed: %s (grid %d)\n", hipGetErrorString(e), grid);
}
```

```cpp
#include <hip/hip_runtime.h>
#include <hip/hip_cooperative_groups.h>
#include <cstdio>
namespace cg = cooperative_groups;

#ifndef REP_PROMPT
#define REP_PROMPT 1
#endif
#define LAS __attribute__((address_space(3)))
typedef unsigned short bf16_t;
typedef short bf16x8 __attribute__((ext_vector_type(8)));
typedef float f32x4 __attribute__((ext_vector_type(4)));
typedef float f32x16 __attribute__((ext_vector_type(16)));
typedef unsigned u32x4 __attribute__((ext_vector_type(4)));
typedef unsigned u32x2 __attribute__((ext_vector_type(2)));
typedef float f32x2 __attribute__((ext_vector_type(2)));

constexpr int MP = 16384, MT = 17408, DM = 1024;
constexpr int ZXW = 6144;
constexpr size_t O_SSM_P = 17825792, O_CONV_P = 22020096, O_POOL_P = 22216704, O_SSM_S = 22708224, O_CONV_S = 89817088, O_POOL_S = 92962816;

constexpr size_t WS_WT_SSD_IN = 0;
constexpr size_t WS_WT_SSD_OUT = WS_WT_SSD_IN + 2ull * 6400 * 1024 * 2;
constexpr size_t WS_WT_POOL_IN = WS_WT_SSD_OUT + 2ull * 1024 * 2048 * 2;
constexpr size_t WS_WT_POOL_G = WS_WT_POOL_IN + 2ull * 4096 * 1024 * 2;
constexpr size_t WS_WT_POOL_OUT = WS_WT_POOL_G + 2ull * 2048 * 512 * 2;
constexpr size_t WS_WT_ADA = WS_WT_POOL_OUT + 2ull * 1024 * 2048 * 2;
constexpr size_t WS_AC = WS_WT_ADA + 12288ull * 1024 * 2;
constexpr size_t WS_SHIFTA = WS_AC + 256ull * 1024 * 2;
constexpr size_t WS_MOD = WS_SHIFTA + 4ull * 256 * 1024 * 2;
constexpr size_t WS_SB = WS_MOD + 136ull * 12288 * 4;
constexpr size_t WS_APRIME = WS_SB + 4ull * 136 * 6400 * 4;
constexpr size_t WS_SSQ = WS_APRIME + 17408ull * 1024 * 2;
constexpr size_t WS_XW = WS_SSQ + 17408ull * 16 * 4;
constexpr size_t WS_ZX = WS_XW + 17408ull * 1024 * 4;
constexpr size_t WS_DTRAW = WS_ZX + 17408ull * 6144 * 2;
constexpr size_t WS_YG = WS_DTRAW + 17408ull * 32 * 4;
constexpr size_t WS_A2 = WS_YG + 17408ull * 2048 * 2;
constexpr size_t WS_BAR = WS_A2 + 17408ull * 2048 * 2;
constexpr size_t WS_PART = WS_BAR + 16384;
constexpr size_t WS_END = WS_PART + 2ull * 1024 * 1024 * 4;

constexpr int LDS_XB = 149760;
constexpr int LDS_BYTES = 149776;

struct WJob { const float* src; long long doff; int K, N, tiles_n, tile_begin; };
struct WTab { WJob wj[20]; int wtiles; int pad0; };
constexpr int NWJ = 20;
struct Params {
    const float* in[23];
    float* out;
    unsigned char* ws;
};

__device__ __forceinline__ unsigned cvt_pk_bf16(float lo, float hi) { unsigned r; asm("v_cvt_pk_bf16_f32 %0, %1, %2" : "=v"(r) : "v"(lo), "v"(hi)); return r; }
__device__ __forceinline__ float bf_lo(unsigned u) { return __uint_as_float(u << 16); }
__device__ __forceinline__ float bf_hi(unsigned u) { return __uint_as_float(u & 0xffff0000u); }
__device__ __forceinline__ float bf2f(bf16_t b) { return __uint_as_float(((unsigned)b) << 16); }
__device__ __forceinline__ float silu_f(float v) { return v * __builtin_amdgcn_rcpf(1.f + __expf(-v)); }
__device__ __forceinline__ f32x2 silu2(f32x2 v) { const f32x2 e = v * (-1.44269504f); f32x2 d; d.x = __builtin_amdgcn_exp2f(e.x); d.y = __builtin_amdgcn_exp2f(e.y); d = d + 1.f; f32x2 r; r.x = __builtin_amdgcn_rcpf(d.x); r.y = __builtin_amdgcn_rcpf(d.y); return v * r; }
__device__ __forceinline__ float softplus_f(float v) { return v > 20.f ? v : log1pf(__expf(v)); }
__device__ __forceinline__ int otid() { int t = threadIdx.x; asm volatile("" : "+v"(t)); return t; }
__device__ __forceinline__ int row_b(int r) { return r < MP ? (r >> 11) : 8 + ((r - MP) >> 3); }
__device__ __forceinline__ u32x4 pack8(f32x4 a, f32x4 b) { u32x4 r; r.x = cvt_pk_bf16(a.x, a.y); r.y = cvt_pk_bf16(a.z, a.w); r.z = cvt_pk_bf16(b.x, b.y); r.w = cvt_pk_bf16(b.z, b.w); return r; }

namespace pg8 {
constexpr int BM = 256, BK = 64, HALF = 128, HTB = HALF * BK * 2, STAGE_BYTES = 8 * HTB, NXCD = 8, WGM = 8;
__device__ __forceinline__ int lds_byte(int r, int c) { const int st = (r >> 4) * 2 + (c >> 5), rr = r & 15, cc = c & 31, ob = rr * 64 + cc * 2; return st * 1024 + (ob ^ (((ob >> 9) & 1) << 5)); }
__device__ __forceinline__ void stage_rc(int b, int& R, int& C) { const int st = b / 1024, sb = b % 1024, swz = sb ^ (((sb >> 9) & 1) << 5); R = (st >> 1) * 16 + swz / 64; C = (st & 1) * 32 + (swz % 64) / 2; }
__device__ __forceinline__ int perm32(int rho) { const int n = rho >> 4, i = rho & 15; return 8 * (i >> 2) + 4 * n + (i & 3); }

struct Unit { int pm, pn, q; const char* A; const char* B; };

__device__ __forceinline__ void static_unit(int L, int nM, int nN, int& pm, int& pn) {
    const int nwg = nM * nN;
    int wgid = L; { const int q = nwg / NXCD, r = nwg % NXCD, xcd = wgid % NXCD, off = wgid / NXCD; wgid = (xcd < r ? xcd * (q + 1) : r * (q + 1) + (xcd - r) * q) + off; }
    const int nig = WGM * nN, gid = wgid / nig, fm = gid * WGM, gsz = (nM - fm) < WGM ? (nM - fm) : WGM;
    pm = fm + ((wgid % nig) % gsz); pn = (wgid % nig) / gsz;
}
struct MainSched {
    int nM, nN, nwg, G, c, lda, ldb, K, gsh, single;
    const char* A; const char* Bt;
    __device__ void init(int M, int N, int K_, int lda_, int ldb_, const void* A_, const void* Bt_, int gsh_, int single_ = 0) {
        nM = M / BM; nN = N / BM; nwg = nM * nN; G = (int)gridDim.x; c = (int)blockIdx.x; lda = lda_; ldb = ldb_; K = K_; A = (const char*)A_; Bt = (const char*)Bt_; gsh = gsh_; single = single_;
    }
    __device__ bool next(int i, Unit& u) const {
        int koff = 0;
        if (single == 1) { if (i > 0 || c >= 16) return false; u.pm = 64 + (c >> 2); u.pn = c & 3; }
        else if (single == 2) { if (i > 0 || c >= 32) return false; u.pm = 64 + (c >> 3); u.pn = (c >> 1) & 3; koff = (c & 1) * K; }
        else { const long L = (long)i * G + c; if (L >= nwg) return false; static_unit((int)L, nM, nN, u.pm, u.pn); }
        u.q = single == 2 ? (c & 1) : 0;
        u.A = A + ((size_t)u.pm * BM * lda + (size_t)(u.pn >> gsh) * 512 + koff) * 2;
        u.B = Bt + ((size_t)u.pn * BM * ldb + koff) * 2;
        return true;
    }
    __device__ __forceinline__ void a_ready(const Unit&) const {}
};
struct InSched {
    int nN, nP, E, nskip, c, r0, cnt, lda, ldb, K;
    const char* A; const char* Bt; unsigned* tail; unsigned* tmo;
    __device__ void init(int N, const void* A_, const void* Bt_, unsigned* tail_, unsigned* tmo_) {
        nN = N / BM; nP = 64 * nN; c = (int)blockIdx.x; lda = 1024; ldb = 1024; K = 1024; A = (const char*)A_; Bt = (const char*)Bt_; tail = tail_; tmo = tmo_;
        nskip = tail_ != nullptr ? 32 : 0; E = nskip + 4 * nN; r0 = (tail_ != nullptr && c < 16) ? 2 : 0;
        const int tot = (nP - c + 255) / 256; cnt = tot - r0 > 0 ? tot - r0 : 0;
    }
    __device__ bool next(int i, Unit& u) const {
        if (i < cnt) static_unit((i + r0) * 256 + c, 64, nN, u.pm, u.pn);
        else {
            if (c < 16) return false;
            const int e = 255 - c + 240 * (i - cnt); if (e >= E) return false;
            if (e < nskip) static_unit(e < 16 ? e : 256 + (e - 16), 64, nN, u.pm, u.pn);
            else { const int sidx = e - nskip; u.pm = 64 + sidx / nN; u.pn = sidx - (sidx / nN) * nN; }
        }
        u.q = 0;
        u.A = A + (size_t)u.pm * BM * 1024 * 2; u.B = Bt + (size_t)u.pn * BM * 1024 * 2;
        return true;
    }
    __device__ __forceinline__ void a_ready(const Unit& u) const {
        if (tail == nullptr || u.pm < 64) return;
        if (threadIdx.x < 64) {
            unsigned polls = 0;
            while ((unsigned)__builtin_amdgcn_readfirstlane(__hip_atomic_load(tail, __ATOMIC_RELAXED, __HIP_MEMORY_SCOPE_AGENT)) < 16u) {
                __builtin_amdgcn_s_sleep(2);
                if ((++polls & 255u) == 0u) { if (__builtin_amdgcn_readfirstlane(__hip_atomic_load(tmo, __ATOMIC_RELAXED, __HIP_MEMORY_SCOPE_AGENT)) != 0u) break; if (polls > (1u << 22)) { if (threadIdx.x == 0) atomicAdd(tmo, 1u); break; } }
            }
            __builtin_amdgcn_fence(__ATOMIC_ACQUIRE, "agent");
            asm volatile("s_waitcnt vmcnt(0)" ::: "memory");
        }
        asm volatile("" ::: "memory"); __builtin_amdgcn_s_barrier(); asm volatile("" ::: "memory");
    }
};
struct SmallSched {
    int mode, G, c, lda, ldb, K;
    const char* A0; const char* ada; const char* ssd_in; const char* pool_in;
    __device__ bool next(int i, Unit& u) const {
        const long L = (long)i * G + c;
        u.pm = 0;
        if (mode == 0) { if (L >= 48) return false; u.pn = (int)L; u.q = 0; u.A = A0; u.B = ada + (size_t)u.pn * BM * 1024 * 2; return true; }
        if (L >= 82) return false;
        int l = (int)L, q, pn;
        if (l < 25) { q = 0; pn = l; } else if (l < 41) { q = 1; pn = l - 25; } else if (l < 66) { q = 2; pn = l - 41; } else { q = 3; pn = l - 66; }
        u.q = q; u.pn = pn; u.A = A0 + (size_t)q * 256 * 1024 * 2;
        u.B = ((q & 1) ? pool_in + (size_t)(q >> 1) * 4096 * 1024 * 2 : ssd_in + (size_t)(q >> 1) * 6400 * 1024 * 2) + (size_t)pn * BM * 1024 * 2;
        return true;
    }
    __device__ __forceinline__ void a_ready(const Unit&) const {}
};

template <class Epi, class Sched>
__device__ __forceinline__ void gemm_phase(LAS unsigned char* lds, const Sched& S, const Epi& E) {
    const int tid = otid(), wid = __builtin_amdgcn_readfirstlane(tid >> 6), lane = tid & 63, wr = wid >> 2, wc = wid & 3, fr = lane & 15, fq = lane >> 4;
    const int K = S.K, nt = K / BK;
    unsigned voffA[2], voffB[2];
#pragma unroll
    for (int i = 0; i < 2; ++i) { int R, C; stage_rc(tid * 16 + i * 8192, R, C); const int Rb = Epi::PERM ? ((R & ~31) + perm32(R & 31)) : R;
        voffA[i] = (unsigned)(R * S.lda + C) * 2u; voffB[i] = (unsigned)(Rb * S.ldb + C) * 2u; }
    const size_t kstep = (size_t)(BK * 2);
    const size_t hstepA = (size_t)HALF * S.lda * 2, hstepB = (size_t)HALF * S.ldb * 2;
    const unsigned ldsw = (unsigned)wid * 1024u;
    const int aoff = lds_byte(wr * 64 + fr, fq * 8), boff = lds_byte(wc * 32 + fr, fq * 8);
#define PG8_SA(b, h) (((b) * 2 + (h)) * HTB)
#define PG8_SB(b, h) ((4 + (b) * 2 + (h)) * HTB)
#define PG8_STAGE(bufoff, gbase, voff) do { _Pragma("unroll") for (int _i = 0; _i < 2; ++_i) \
        __builtin_amdgcn_global_load_lds((const unsigned*)((const char*)(gbase) + (voff)[_i]), (LAS unsigned*)(lds + (bufoff) + ldsw + _i * 8192), 16, 0, 0); } while (0)
#define PG8_LDA(dst, b, h) do { _Pragma("unroll") for (int m = 0; m < 4; ++m) _Pragma("unroll") for (int k = 0; k < 2; ++k) dst[m][k] = *(const LAS bf16x8*)(lds + PG8_SA(b, h) + aoff + m * 2048 + k * 1024); } while (0)
#define PG8_LDB(dst, b, h) do { _Pragma("unroll") for (int n = 0; n < 2; ++n) _Pragma("unroll") for (int k = 0; k < 2; ++k) dst[n][k] = *(const LAS bf16x8*)(lds + PG8_SB(b, h) + boff + n * 2048 + k * 1024); } while (0)
#define PG8_MMA(ai, bj, At, Bt) do { __builtin_amdgcn_s_setprio(1); _Pragma("unroll") for (int m = 0; m < 4; ++m) _Pragma("unroll") for (int n = 0; n < 2; ++n) _Pragma("unroll") for (int k = 0; k < 2; ++k) \
        acc[ai][bj][m][n] = __builtin_amdgcn_mfma_f32_16x16x32_bf16(Bt[n][k], At[m][k], acc[ai][bj][m][n], 0, 0, 0); __builtin_amdgcn_s_setprio(0); } while (0)
#define PG8_WAIT_V(n) asm volatile("s_waitcnt vmcnt(" #n ")" ::: "memory")
#define PG8_WAIT_L(n) asm volatile("s_waitcnt lgkmcnt(" #n ")" ::: "memory")
#define PG8_BAR __builtin_amdgcn_s_barrier()
#define PG8_SCHED __builtin_amdgcn_sched_barrier(0)
    Unit cur, nxt; int ui = 0;
    if (!S.next(0, cur)) return;
    f32x4 acc[2][2][4][2];
#pragma unroll
    for (int a = 0; a < 2; ++a)
#pragma unroll
        for (int b = 0; b < 2; ++b)
#pragma unroll
            for (int m = 0; m < 4; ++m)
#pragma unroll
                for (int n = 0; n < 2; ++n) acc[a][b][m][n] = (f32x4){0.f, 0.f, 0.f, 0.f};
    bf16x8 At[4][2], B0[2][2], B1[2][2];
    const char* cA = cur.A; const char* cB = cur.B;
    S.a_ready(cur);
    PG8_STAGE(PG8_SB(0, 0), cB, voffB); PG8_STAGE(PG8_SA(0, 0), cA, voffA); PG8_STAGE(PG8_SB(0, 1), cB + hstepB, voffB); PG8_STAGE(PG8_SA(0, 1), cA + hstepA, voffA);
    if (wr == 1) PG8_BAR;
    PG8_WAIT_V(4); PG8_BAR;
    PG8_STAGE(PG8_SB(1, 0), cB + kstep, voffB); PG8_STAGE(PG8_SA(1, 0), cA + kstep, voffA); PG8_STAGE(PG8_SB(1, 1), cB + hstepB + kstep, voffB);
    PG8_WAIT_V(6); PG8_BAR;
    for (;;) {
        const bool has_next = S.next(ui + 1, nxt);
        const char* nA = has_next ? nxt.A : cA; const char* nB = has_next ? nxt.B : cB;
        for (int t = 0; t < nt; t += 2) {
            const bool last = (t == nt - 2);
            const char* a1 = cA + (size_t)(t + 1) * kstep;
            const char* a2 = last ? nA : cA + (size_t)(t + 2) * kstep; const char* b2 = last ? nB : cB + (size_t)(t + 2) * kstep;
            const char* a3 = a2 + kstep; const char* b3 = b2 + kstep;
            if (last && has_next) S.a_ready(nxt);
            PG8_LDB(B0, 0, 0); PG8_SCHED; PG8_LDA(At, 0, 0); PG8_STAGE(PG8_SA(1, 1), a1 + hstepA, voffA);
            PG8_WAIT_L(8); PG8_BAR; PG8_WAIT_L(0); PG8_MMA(0, 0, At, B0); PG8_BAR; PG8_SCHED;
            PG8_LDB(B1, 0, 1); PG8_STAGE(PG8_SB(0, 0), b2, voffB);
            PG8_BAR; PG8_WAIT_L(0); PG8_MMA(0, 1, At, B1); PG8_BAR;
            PG8_LDA(At, 0, 1); PG8_STAGE(PG8_SA(0, 0), a2, voffA);
            PG8_BAR; PG8_WAIT_L(0); PG8_MMA(1, 0, At, B0); PG8_BAR; PG8_SCHED;
            PG8_STAGE(PG8_SB(0, 1), b2 + hstepB, voffB);
            PG8_WAIT_V(6); PG8_BAR; PG8_MMA(1, 1, At, B1); PG8_BAR;
            PG8_LDB(B0, 1, 0); PG8_SCHED; PG8_LDA(At, 1, 0); PG8_STAGE(PG8_SA(0, 1), a2 + hstepA, voffA);
            PG8_WAIT_L(8); PG8_BAR; PG8_WAIT_L(0); PG8_MMA(0, 0, At, B0); PG8_BAR; PG8_SCHED;
            PG8_LDB(B1, 1, 1); PG8_STAGE(PG8_SB(1, 0), b3, voffB);
            PG8_BAR; PG8_WAIT_L(0); PG8_MMA(0, 1, At, B1); PG8_BAR;
            PG8_LDA(At, 1, 1); PG8_STAGE(PG8_SA(1, 0), a3, voffA);
            PG8_BAR; PG8_WAIT_L(0); PG8_MMA(1, 0, At, B0); PG8_BAR; PG8_SCHED;
            PG8_STAGE(PG8_SB(1, 1), b3 + hstepB, voffB);
            PG8_WAIT_V(6); PG8_BAR; PG8_MMA(1, 1, At, B1); PG8_BAR;
        }
        E(acc, cur, wr, wc, fr, fq);
        if (!has_next) break;
#pragma unroll
        for (int a = 0; a < 2; ++a)
#pragma unroll
            for (int b = 0; b < 2; ++b)
#pragma unroll
                for (int m = 0; m < 4; ++m)
#pragma unroll
                    for (int n = 0; n < 2; ++n) acc[a][b][m][n] = (f32x4){0.f, 0.f, 0.f, 0.f};
        cur = nxt; cA = nA; cB = nB; ++ui;
    }
    PG8_WAIT_V(0);
    if (wr == 0) PG8_BAR;
    PG8_BAR;
#undef PG8_SA
#undef PG8_SB
#undef PG8_STAGE
#undef PG8_LDA
#undef PG8_LDB
#undef PG8_MMA
#undef PG8_WAIT_V
#undef PG8_WAIT_L
#undef PG8_BAR
#undef PG8_SCHED
}
}
using pg8::Unit;

struct EpiIn {
    static constexpr bool PERM = true;
    const float* ssq; const float* sb; bf16_t* out; int ldo, nbf; float* dtraw;
    template <bool UNI>
    __device__ __forceinline__ void body(const f32x4 (&acc)[2][2][4][2], const Unit& u, int wr, int wc, int fr, int fq) const {
        const int row0 = u.pm * 256 + wr * 64 + fr, colt = u.pn * 256 + wc * 32 + 8 * fq;
        f32x4 ub[2][2];
        if (UNI) {
            const float* sbr = sb + (size_t)(u.pm >> 3) * 6400;
#pragma unroll
            for (int bj = 0; bj < 2; ++bj) { const int c = colt + bj * 128; if (c < nbf + 32) { ub[bj][0] = *(const f32x4*)(sbr + c); ub[bj][1] = *(const f32x4*)(sbr + c + 4); } }
        }
        float rsv[2][4];
#pragma unroll
        for (int ai = 0; ai < 2; ++ai)
#pragma unroll
            for (int m = 0; m < 4; ++m) rsv[ai][m] = ssq[row0 + ai * 128 + m * 16];
#pragma unroll
        for (int ai = 0; ai < 2; ++ai) {
            f32x4 nb[4][2][2];
            if (!UNI) {
#pragma unroll
                for (int m = 0; m < 4; ++m) {
                    const float* sbr = sb + (size_t)row_b(row0 + ai * 128 + m * 16) * 6400;
#pragma unroll
                    for (int bj = 0; bj < 2; ++bj) { const int c = colt + bj * 128; if (c < nbf + 32) { nb[m][bj][0] = *(const f32x4*)(sbr + c); nb[m][bj][1] = *(const f32x4*)(sbr + c + 4); } }
                }
            }
#pragma unroll
            for (int m = 0; m < 4; ++m) {
                const int r = row0 + ai * 128 + m * 16;
                const float rstd = rsqrtf(rsv[ai][m] * (1.f / 1024.f) + 1e-6f);
#pragma unroll
                for (int bj = 0; bj < 2; ++bj) {
                    const int c = colt + bj * 128;
                    if (c < nbf + 32) {
                        f32x4 b0, b1;
                        if (UNI) { b0 = ub[bj][0]; b1 = ub[bj][1]; } else { b0 = nb[m][bj][0]; b1 = nb[m][bj][1]; }
                        const f32x4 v0 = acc[ai][bj][m][0] * rstd + b0, v1 = acc[ai][bj][m][1] * rstd + b1;
                        if (c < nbf) *(u32x4*)(out + (size_t)r * ldo + c) = pack8(v0, v1);
                        else if (dtraw != nullptr) { float* dp = dtraw + (size_t)r * 32 + (c - nbf); *(f32x4*)dp = v0; *(f32x4*)(dp + 4) = v1; }
                    }
                }
            }
        }
    }
    __device__ __forceinline__ void operator()(const f32x4 (&acc)[2][2][4][2], const Unit& u, int wr, int wc, int fr, int fq) const {
        asm volatile("" : "+v"(fr), "+v"(fq));
        if (u.pm < 64) body<true>(acc, u, wr, wc, fr, fq); else body<false>(acc, u, wr, wc, fr, fq);
    }
};
struct EpiOut {
    static constexpr bool PERM = true;
    bf16_t* xw; const float* modl; const float* ng_next; bf16_t* aprime; float* ssq; float* part;
    template <bool UNI>
    __device__ __forceinline__ void body(const f32x4 (&acc)[2][2][4][2], const Unit& u, int wr, int wc, int fr, int fq) const {
        const int row0 = u.pm * 256 + wr * 64 + fr, colt = u.pn * 256 + wc * 32 + 8 * fq;
        const bool has_next = ng_next != nullptr;
        f32x4 ug[2][2], us[2][2], uw[2][2];
#pragma unroll
        for (int bj = 0; bj < 2; ++bj) {
            const int c = colt + bj * 128;
            if (has_next) { uw[bj][0] = *(const f32x4*)(ng_next + c); uw[bj][1] = *(const f32x4*)(ng_next + c + 4); }
            if (UNI) {
                const float* mb = modl + (size_t)(u.pm >> 3) * 12288;
                ug[bj][0] = *(const f32x4*)(mb + 2048 + c) + 1.f; ug[bj][1] = *(const f32x4*)(mb + 2048 + c + 4) + 1.f;
                if (has_next) { us[bj][0] = (*(const f32x4*)(mb + 4096 + c) + 1.f) * uw[bj][0]; us[bj][1] = (*(const f32x4*)(mb + 4096 + c + 4) + 1.f) * uw[bj][1]; }
            }
        }
#pragma unroll
        for (int aim = 0; aim < 4; ++aim) {
            const int ai = aim >> 1, mp = aim & 1;
            u32x4 xv[2][2];
#pragma unroll
            for (int mm = 0; mm < 2; ++mm)
#pragma unroll
                for (int bj = 0; bj < 2; ++bj) xv[mm][bj] = *(const u32x4*)(xw + (size_t)(row0 + ai * 128 + (mp * 2 + mm) * 16) * DM + colt + bj * 128);
#pragma unroll
            for (int mm = 0; mm < 2; ++mm) {
                const int m = mp * 2 + mm;
                const int r = row0 + ai * 128 + m * 16;
                const float* mb = modl + (size_t)row_b(r) * 12288;
                float ss = 0.f;
#pragma unroll
                for (int bj = 0; bj < 2; ++bj) {
                    const int c = colt + bj * 128;
                    f32x4 g0, g1;
                    if (UNI) { g0 = ug[bj][0]; g1 = ug[bj][1]; } else { g0 = *(const f32x4*)(mb + 2048 + c) + 1.f; g1 = *(const f32x4*)(mb + 2048 + c + 4) + 1.f; }
                    const u32x4 xo = xv[mm][bj];
                    const f32x4 x0 = {bf_lo(xo.x), bf_hi(xo.x), bf_lo(xo.y), bf_hi(xo.y)}, x1 = {bf_lo(xo.z), bf_hi(xo.z), bf_lo(xo.w), bf_hi(xo.w)};
                    const f32x4 n0 = x0 + g0 * acc[ai][bj][m][0], n1 = x1 + g1 * acc[ai][bj][m][1];
                    *(u32x4*)(xw + (size_t)r * DM + c) = pack8(n0, n1);
                    ss += (n0.x * n0.x + n0.y * n0.y) + (n0.z * n0.z + n0.w * n0.w) + (n1.x * n1.x + n1.y * n1.y) + (n1.z * n1.z + n1.w * n1.w);
                    if (has_next) {
                        f32x4 s0, s1;
                        if (UNI) { s0 = us[bj][0]; s1 = us[bj][1]; } else { s0 = (*(const f32x4*)(mb + 4096 + c) + 1.f) * uw[bj][0]; s1 = (*(const f32x4*)(mb + 4096 + c + 4) + 1.f) * uw[bj][1]; }
                        *(u32x4*)(aprime + (size_t)r * DM + c) = pack8(n0 * s0, n1 * s1);
                    }
                }
                ss += __shfl_xor(ss, 16); ss += __shfl_xor(ss, 32);
                if (fq == 0) atomicAdd(ssq + r, ss);
            }
        }
    }
    __device__ __forceinline__ void operator()(const f32x4 (&acc)[2][2][4][2], const Unit& u, int wr, int wc, int fr, int fq) const {
        asm volatile("" : "+v"(fr), "+v"(fq));
        if (part != nullptr) {
            float* pb = part + (size_t)u.q * 1024 * 1024;
            const int row0 = (u.pm - 64) * 256 + wr * 64 + fr, colt = u.pn * 256 + wc * 32 + 8 * fq;
#pragma unroll
            for (int ai = 0; ai < 2; ++ai)
#pragma unroll
                for (int m = 0; m < 4; ++m)
#pragma unroll
                    for (int bj = 0; bj < 2; ++bj) {
                        float* dp = pb + (size_t)(row0 + ai * 128 + m * 16) * 1024 + colt + bj * 128;
                        *(f32x4*)dp = acc[ai][bj][m][0]; *(f32x4*)(dp + 4) = acc[ai][bj][m][1];
                    }
            return;
        }
        if (u.pm < 64) body<true>(acc, u, wr, wc, fr, fq); else body<false>(acc, u, wr, wc, fr, fq);
    }
};
struct EpiGrp {
    static constexpr bool PERM = true;
    const bf16_t* uz; const float* chs; bf16_t* out;
    __device__ __forceinline__ void operator()(const f32x4 (&acc)[2][2][4][2], const Unit& u, int wr, int wc, int fr, int fq) const {
        asm volatile("" : "+v"(fr), "+v"(fq));
        const int row0 = u.pm * 256 + wr * 64 + fr, colt = u.pn * 256 + wc * 32 + 8 * fq;
        f32x4 cs[2][2];
#pragma unroll
        for (int bj = 0; bj < 2; ++bj) { cs[bj][0] = *(const f32x4*)(chs + colt + bj * 128); cs[bj][1] = *(const f32x4*)(chs + colt + bj * 128 + 4); }
#pragma unroll
        for (int ai = 0; ai < 2; ++ai) {
            u32x4 zz[4][2];
#pragma unroll
            for (int m = 0; m < 4; ++m)
#pragma unroll
                for (int bj = 0; bj < 2; ++bj) zz[m][bj] = *(const u32x4*)(uz + (size_t)(row0 + ai * 128 + m * 16) * 4096 + 2048 + colt + bj * 128);
#pragma unroll
            for (int m = 0; m < 4; ++m) {
                const int r = row0 + ai * 128 + m * 16;
#pragma unroll
                for (int bj = 0; bj < 2; ++bj) {
                    const int c = colt + bj * 128;
                    const u32x4 z = zz[m][bj];
                    const f32x2 a = silu2((f32x2){bf_lo(z.x), bf_hi(z.x)}), b = silu2((f32x2){bf_lo(z.y), bf_hi(z.y)}), cc = silu2((f32x2){bf_lo(z.z), bf_hi(z.z)}), d = silu2((f32x2){bf_lo(z.w), bf_hi(z.w)});
                    const f32x4 z0 = {a.x, a.y, b.x, b.y}, z1 = {cc.x, cc.y, d.x, d.y};
                    *(u32x4*)(out + (size_t)r * 2048 + c) = pack8(acc[ai][bj][m][0] * cs[bj][0] * z0, acc[ai][bj][m][1] * cs[bj][1] * z1);
                }
            }
        }
    }
};
struct EpiSmall {
    static constexpr bool PERM = true;
    int mode; float* mod; const float* ada_b; bf16_t* shiftA; float* sb;
    __device__ __forceinline__ void operator()(const f32x4 (&acc)[2][2][4][2], const Unit& u, int wr, int wc, int fr, int fq) const {
        asm volatile("" : "+v"(fr), "+v"(fq));
        const int row0 = wr * 64 + fr, colt = u.pn * 256 + wc * 32 + 8 * fq;
#pragma unroll
        for (int ai = 0; ai < 2; ++ai)
#pragma unroll
            for (int m = 0; m < 4; ++m) {
                const int r = row0 + ai * 128 + m * 16;
                if (r < 136) {
#pragma unroll
                    for (int bj = 0; bj < 2; ++bj) {
                        const int c = colt + bj * 128;
                        if (mode == 0) {
                            const f32x4 v0 = acc[ai][bj][m][0] + *(const f32x4*)(ada_b + c), v1 = acc[ai][bj][m][1] + *(const f32x4*)(ada_b + c + 4);
                            *(f32x4*)(mod + (size_t)r * 12288 + c) = v0; *(f32x4*)(mod + (size_t)r * 12288 + c + 4) = v1;
                            const int li = c / 3072, cc = c - li * 3072;
                            if (cc < 1024) *(u32x4*)(shiftA + ((size_t)li * 256 + r) * 1024 + cc) = pack8(v0, v1);
                        } else {
                            float* sp = sb + ((size_t)u.q * 136 + r) * 6400 + c;
                            *(f32x4*)sp = acc[ai][bj][m][0]; *(f32x4*)(sp + 4) = acc[ai][bj][m][1];
                        }
                    }
                }
            }
    }
};

__device__ void phase_prep0(const Params& p, const WTab& wt, LAS unsigned char* lds, int tile_lo, int tile_hi, int blk0, bool misc) {
    if ((int)blockIdx.x < blk0) return;
    LAS float* tl = (LAS float*)lds;
    const int tid = otid();
    for (int tile = tile_lo + ((int)blockIdx.x - blk0); tile < tile_hi; tile += (int)gridDim.x - blk0) {
        int j = 0;
#pragma unroll 1
        for (int q = 1; q < NWJ; ++q) if (tile >= wt.wj[q].tile_begin) j = q;
        const WJob job = wt.wj[j];
        bf16_t* jdst = (bf16_t*)(p.ws + job.doff);
        const int lt = tile - job.tile_begin, tk = lt / job.tiles_n, tn = lt - tk * job.tiles_n, k0 = tk * 64, n0 = tn * 64;
        {
            const int kk = tid >> 3, nn = (tid & 7) * 8;
            f32x4 a = (f32x4){0.f, 0.f, 0.f, 0.f}, b = a;
            if (n0 + nn < job.N) { const __attribute__((address_space(1))) f32x4* sp = (const __attribute__((address_space(1))) f32x4*)(job.src + (size_t)(k0 + kk) * job.N + n0 + nn); a = sp[0]; b = sp[1]; }
            LAS float* d = tl + kk * 65 + nn;
            d[0] = a.x; d[1] = a.y; d[2] = a.z; d[3] = a.w; d[4] = b.x; d[5] = b.y; d[6] = b.z; d[7] = b.w;
        }
        __syncthreads();
        {
            const int n = tid >> 3, k8 = (tid & 7) * 8;
            const LAS float* s = tl + k8 * 65 + n;
            u32x4 o; o.x = cvt_pk_bf16(s[0], s[65]); o.y = cvt_pk_bf16(s[130], s[195]); o.z = cvt_pk_bf16(s[260], s[325]); o.w = cvt_pk_bf16(s[390], s[455]);
            *(u32x4*)(jdst + (size_t)(n0 + n) * job.K + k0 + k8) = o;
        }
        __syncthreads();
    }
    if (!misc) return;
    bf16_t* ac = (bf16_t*)(p.ws + WS_AC);
    const int gt = blockIdx.x * 512 + tid, nth = gridDim.x * 512;
    for (int i = gt; i < 256 * 1024 / 8; i += nth) {
        const int r = i >> 7, c = (i & 127) * 8;
        u32x4 o = (u32x4){0u, 0u, 0u, 0u};
        if (r < 136) {
            const float* cp = r < 8 ? p.in[5] + (size_t)r * 1024 + c : p.in[6] + (size_t)(r - 8) * 1024 + c;
            const f32x4 a = *(const f32x4*)cp, b = *(const f32x4*)(cp + 4);
            o.x = cvt_pk_bf16(silu_f(a.x), silu_f(a.y)); o.y = cvt_pk_bf16(silu_f(a.z), silu_f(a.w)); o.z = cvt_pk_bf16(silu_f(b.x), silu_f(b.y)); o.w = cvt_pk_bf16(silu_f(b.z), silu_f(b.w));
        }
        *(u32x4*)(ac + (size_t)i * 8) = o;
    }
    { u32x4* sq = (u32x4*)(p.ws + WS_SSQ + 17408ull * 4); for (int i = gt; i < 4 * 17408 / 4; i += nth) sq[i] = (u32x4){0u, 0u, 0u, 0u}; }
    u32x4* sh = (u32x4*)(p.ws + WS_SHIFTA);
    for (int i = gt; i < 4 * 256 * 1024 / 8; i += nth) sh[i] = (u32x4){0u, 0u, 0u, 0u};
}

__device__ void phase_xprep(const Params& p, int blk0) {
    if ((int)blockIdx.x < blk0) return;
    const int tid_ = otid(), lane = tid_ & 63, wv = ((int)blockIdx.x - blk0) * 8 + (tid_ >> 6), nw = ((int)gridDim.x - blk0) * 8;
    const float* mod = (const float*)(p.ws + WS_MOD);
    bf16_t* ap = (bf16_t*)(p.ws + WS_APRIME);
    bf16_t* xwb = (bf16_t*)(p.ws + WS_XW);
    float* ssq = (float*)(p.ws + WS_SSQ);
    const float* ng = p.in[9];
    for (int r0 = wv * 2; r0 < MT; r0 += nw * 2) {
        f32x4 x[2][4];
#pragma unroll
        for (int h = 0; h < 2; ++h) {
            const int r = r0 + h;
            const float* xr = r < MP ? p.in[0] + (size_t)r * DM : p.in[1] + (size_t)(r - MP) * DM;
#pragma unroll
            for (int q = 0; q < 4; ++q) x[h][q] = *(const f32x4*)(xr + q * 256 + lane * 4);
        }
#pragma unroll
        for (int h = 0; h < 2; ++h) {
            const int r = r0 + h;
            const float* mb = mod + (size_t)row_b(r) * 12288 + 1024;
            float ss = 0.f;
#pragma unroll
            for (int q = 0; q < 4; ++q) {
                const int c = q * 256 + lane * 4;
                const f32x4 xv = x[h][q], sv = *(const f32x4*)(mb + c), g = *(const f32x4*)(ng + c);
                ss += (xv.x * xv.x + xv.y * xv.y) + (xv.z * xv.z + xv.w * xv.w);
                const f32x4 a = xv * g * (sv + 1.f);
                u32x2 o; o.x = cvt_pk_bf16(a.x, a.y); o.y = cvt_pk_bf16(a.z, a.w);
                *(u32x2*)(ap + (size_t)r * DM + c) = o;
                u32x2 ox; ox.x = cvt_pk_bf16(xv.x, xv.y); ox.y = cvt_pk_bf16(xv.z, xv.w);
                *(u32x2*)(xwb + (size_t)r * DM + c) = ox;
            }
#pragma unroll
            for (int o = 1; o < 64; o <<= 1) ss += __shfl_xor(ss, o);
            if (lane == 0) ssq[r] = ss;
        }
    }
}

__device__ void phase_final(const Params& p, int r_begin, int r_end, int blk0, bool fold) {
    if ((int)blockIdx.x < blk0) return;
    const int tid_ = otid(), lane = tid_ & 63, wv = ((int)blockIdx.x - blk0) * 8 + (tid_ >> 6), nw = ((int)gridDim.x - blk0) * 8;
    const bf16_t* xw = (const bf16_t*)(p.ws + WS_XW);
    const float* ssq = (const float*)(p.ws + WS_SSQ) + 4 * 17408;
    const float* fg = p.in[22];
    for (int r0 = r_begin + wv * 2; r0 < r_end; r0 += nw * 2) {
        f32x4 x[2][4];
#pragma unroll
        for (int h = 0; h < 2; ++h)
#pragma unroll
            for (int q = 0; q < 4; ++q) { const u32x2 v = *(const u32x2*)(xw + (size_t)(r0 + h) * DM + q * 256 + lane * 4); x[h][q] = (f32x4){bf_lo(v.x), bf_hi(v.x), bf_lo(v.y), bf_hi(v.y)}; }
#pragma unroll
        for (int h = 0; h < 2; ++h) {
            const int r = r0 + h;
            float sq = ssq[r];
            if (fold) {
                const float* p0 = (const float*)(p.ws + WS_PART) + (size_t)(r - MP) * 1024, *p1 = p0 + (size_t)1024 * 1024;
                const float* gt = (const float*)(p.ws + WS_MOD) + (size_t)row_b(r) * 12288 + 3 * 3072 + 2048;
                sq = 0.f;
#pragma unroll
                for (int q = 0; q < 4; ++q) {
                    const int c = q * 256 + lane * 4;
                    const f32x4 a = *(const f32x4*)(p0 + c) + *(const f32x4*)(p1 + c), gg = *(const f32x4*)(gt + c) + 1.f;
                    x[h][q] = x[h][q] + gg * a;
                    sq += (x[h][q].x * x[h][q].x + x[h][q].y * x[h][q].y) + (x[h][q].z * x[h][q].z + x[h][q].w * x[h][q].w);
                }
#pragma unroll
                for (int o = 1; o < 64; o <<= 1) sq += __shfl_xor(sq, o);
            }
            const float rstd = rsqrtf(sq * (1.f / 1024.f) + 1e-6f);
#pragma unroll
            for (int q = 0; q < 4; ++q) {
                const int c = q * 256 + lane * 4;
                const f32x4 g = *(const f32x4*)(fg + c);
                *(f32x4*)(p.out + (size_t)r * DM + c) = x[h][q] * rstd * g;
            }
        }
    }
}

__device__ void phase_ssdnorm(const Params& p, int j) {
    const int tid_ = otid(), lane = tid_ & 63, wv = blockIdx.x * 8 + (tid_ >> 6), nw = gridDim.x * 8;
    const bf16_t* yg = (const bf16_t*)(p.ws + WS_YG);
    bf16_t* a2 = (bf16_t*)(p.ws + WS_A2);
    const float* ng = p.in[16] + (size_t)j * 2048;
    for (int r0 = wv * 2; r0 < MT; r0 += nw * 2) {
        u32x4 vv[2][4];
#pragma unroll
        for (int h = 0; h < 2; ++h)
#pragma unroll
            for (int q = 0; q < 4; ++q) vv[h][q] = *(const u32x4*)(yg + (size_t)(r0 + h) * 2048 + q * 512 + lane * 8);
#pragma unroll
        for (int h = 0; h < 2; ++h)
#pragma unroll
            for (int q = 0; q < 4; ++q) {
                const int c = q * 512 + lane * 8;
                const u32x4 v = vv[h][q];
                f32x4 a, b;
                a.x = bf_lo(v.x); a.y = bf_hi(v.x); a.z = bf_lo(v.y); a.w = bf_hi(v.y); b.x = bf_lo(v.z); b.y = bf_hi(v.z); b.z = bf_lo(v.w); b.w = bf_hi(v.w);
                float ss = (a.x * a.x + a.y * a.y) + (a.z * a.z + a.w * a.w) + (b.x * b.x + b.y * b.y) + (b.z * b.z + b.w * b.w);
#pragma unroll
                for (int o = 1; o < 32; o <<= 1) ss += __shfl_xor(ss, o);
                const float rstd = rsqrtf(ss * (1.f / 256.f) + 1e-6f);
                const f32x4 g0 = *(const f32x4*)(ng + c), g1 = *(const f32x4*)(ng + c + 4);
                *(u32x4*)(a2 + (size_t)(r0 + h) * 2048 + c) = pack8(a * rstd * g0, b * rstd * g1);
            }
    }
}

__device__ void phase_pool(const Params& p, int j) {
    const bf16_t* uz = (const bf16_t*)(p.ws + WS_ZX);
    bf16_t* pooled = (bf16_t*)(p.ws + WS_YG);
    const int gt = blockIdx.x * 512 + otid(), nth = gridDim.x * 512;
    for (int u = gt; u < 131072 + 32768; u += nth) {
        int cv, row0, t0, R; const float* prev = nullptr; bool prompt;
        if (u < 131072) { cv = u & 255; const int run = (u >> 8) & 63, b = u >> 14; row0 = b * 2048; t0 = run * 32; R = 32; prompt = true; }
        else { const int v = u - 131072; cv = v & 255; const int b = v >> 8; row0 = MP + b * 8; t0 = 0; R = 8; prompt = false; prev = p.in[4] + ((size_t)(j * 128 + b) * 15) * 2048; }
        const int c = cv * 8, w = 2 << (c >> 9);
        float s[8];
#pragma unroll
        for (int i = 0; i < 8; ++i) s[i] = 0.f;
        auto getu = [&](int tt, float (&o)[8]) {
            if (tt >= 0) {
                const u32x4 v = *(const u32x4*)(uz + (size_t)(row0 + tt) * 4096 + c);
                o[0] = bf_lo(v.x); o[1] = bf_hi(v.x); o[2] = bf_lo(v.y); o[3] = bf_hi(v.y); o[4] = bf_lo(v.z); o[5] = bf_hi(v.z); o[6] = bf_lo(v.w); o[7] = bf_hi(v.w);
            } else if (!prompt) {
                const float* pp = prev + (size_t)(15 + tt) * 2048 + c;
                const f32x4 a = *(const f32x4*)pp, b = *(const f32x4*)(pp + 4);
                o[0] = a.x; o[1] = a.y; o[2] = a.z; o[3] = a.w; o[4] = b.x; o[5] = b.y; o[6] = b.z; o[7] = b.w;
            } else {
#pragma unroll
                for (int i = 0; i < 8; ++i) o[i] = 0.f;
            }
        };
        for (int i = 1; i < w; ++i) {
            float o[8]; getu(t0 - i, o);
#pragma unroll
            for (int k = 0; k < 8; ++k) s[k] += o[k];
        }
        for (int tb = t0; tb < t0 + R; tb += 4) {
            float cur[4][8], old[4][8];
#pragma unroll
            for (int k = 0; k < 4; ++k) { getu(tb + k, cur[k]); getu(tb + k - w + 1, old[k]); }
#pragma unroll
            for (int k = 0; k < 4; ++k) {
                const int t = tb + k;
                const float inv = 1.f / (float)(prompt ? min(w, t + 1) : w);
                f32x4 a, b;
#pragma unroll
                for (int i = 0; i < 8; ++i) s[i] += cur[k][i];
                a.x = s[0] * inv - cur[k][0]; a.y = s[1] * inv - cur[k][1]; a.z = s[2] * inv - cur[k][2]; a.w = s[3] * inv - cur[k][3];
                b.x = s[4] * inv - cur[k][4]; b.y = s[5] * inv - cur[k][5]; b.z = s[6] * inv - cur[k][6]; b.w = s[7] * inv - cur[k][7];
                *(u32x4*)(pooled + (size_t)(row0 + t) * 2048 + c) = pack8(a, b);
#pragma unroll
                for (int i = 0; i < 8; ++i) s[i] -= old[k][i];
            }
        }
    }
    for (int i = gt; i < (8 + 128) * 15 * 256; i += nth) {
        const int cv = i & 255, k = (i >> 8) % 15, sq = (i >> 8) / 15, ch = cv * 8;
        f32x4 a, b2;
        float* dst;
        bool from_state = false; size_t urow = 0;
        if (sq < 8) { urow = (size_t)(sq * 2048 + 2033 + k); dst = p.out + O_POOL_P + ((size_t)(j * 8 + sq) * 15 + k) * 2048 + ch; }
        else { const int bb = sq - 8; dst = p.out + O_POOL_S + ((size_t)(j * 128 + bb) * 15 + k) * 2048 + ch; if (k < 7) from_state = true; else urow = (size_t)(MP + bb * 8 + k - 7); }
        if (from_state) { const float* sp = p.in[4] + ((size_t)(j * 128 + (sq - 8)) * 15 + 8 + k) * 2048 + ch; a = *(const f32x4*)sp; b2 = *(const f32x4*)(sp + 4); }
        else { const u32x4 v = *(const u32x4*)(uz + urow * 4096 + ch); a = (f32x4){bf_lo(v.x), bf_hi(v.x), bf_lo(v.y), bf_hi(v.y)}; b2 = (f32x4){bf_lo(v.z), bf_hi(v.z), bf_lo(v.w), bf_hi(v.w)}; }
        *(f32x4*)dst = a; *(f32x4*)(dst + 4) = b2;
    }
}

constexpr int RS = 272;
constexpr int L_XT = 0, L_BN = 17408, L_BT = 52224, L_CN = 87040, L_HB = 121856, L_SM = 139264, L_CW = 143360;
__device__ __forceinline__ int xt_addr(int pr, int t) { return L_XT + pr * RS + ((((t >> 3) ^ (pr >> 1)) & 15) << 4) + (t & 7) * 2; }
__device__ __forceinline__ int bt_addr(int n, int t) { return L_BT + n * RS + ((((t >> 3) ^ (n >> 3)) & 15) << 4) + (t & 7) * 2; }
__device__ __forceinline__ f32x16 mfma32(bf16x8 a, bf16x8 b, f32x16 c) { return __builtin_amdgcn_mfma_f32_32x32x16_bf16(a, b, c, 0, 0, 0); }

#define OPQ(x) asm volatile("" : "+v"(x))
__device__ void ssd_prompt_item(const Params& p, int j, int b, int h, LAS unsigned char* lds) {
    const int tid0 = otid(), wid = __builtin_amdgcn_readfirstlane(tid0 >> 6), g = h >> 2;
    const char* zxc = (const char*)(p.ws + WS_ZX);
    const char* dtc = (const char*)(p.ws + WS_DTRAW);
    char* ygc = (char*)(p.ws + WS_YG);
    const int rowbase = b * 2048;
    LAS float* cw = (LAS float*)(lds + L_CW);
    const float Ah = -__expf(p.in[14][j * 32 + h]), Dh = p.in[15][j * 32 + h], dtb = p.in[13][j * 32 + h];
    const bool roleB = wid < 4;
    const int qq = wid >> 1, tt = qq ^ (qq >> 1), pt = wid & 1, hp = wid & 1, hn = wid >> 1;

    __syncthreads();
    if (tid0 < 320) {
        const int ch = tid0 < 64 ? h * 64 + tid0 : (tid0 < 192 ? 2048 + g * 128 + (tid0 - 64) : 3072 + g * 128 + (tid0 - 192));
#pragma unroll
        for (int k = 0; k < 4; ++k) cw[k * 320 + tid0] = p.in[11][((size_t)j * 4 + k) * 4096 + ch];
        cw[4 * 320 + tid0] = p.in[12][(size_t)j * 4096 + ch];
    }
    for (int i = tid0; i < 17408 / 4; i += 512) *(LAS unsigned*)(lds + L_HB + i * 4) = 0u;

    u32x4 rawBC[11]; unsigned rawX[11]; float dtp0 = 0.f, dtp1 = 0.f;
    auto prefetch = [&](int t0) {
        int tid = tid0; OPQ(tid);
        const int bt_ = tid & 255, tqb = bt_ >> 4, cg8 = bt_ & 15, tqx = tid >> 5, cp = tid & 31, lane = tid & 63;
        const int colBC = (roleB ? 4096 : 5120) + g * 128 + cg8 * 8, colX = 2048 + h * 64 + cp * 2;
        const int rB = t0 + tqb * 8 - 3, rX = t0 + tqx * 8 - 3;
        const unsigned oB = (unsigned)((rowbase + rB) * ZXW + colBC) * 2u, oX = (unsigned)((rowbase + rX) * ZXW + colX) * 2u;
#pragma unroll
        for (int i = 0; i < 11; ++i) {
            rawBC[i] = (rB + i >= 0) ? *(const u32x4*)(zxc + (oB + (unsigned)i * 12288u)) : (u32x4){0u, 0u, 0u, 0u};
            rawX[i] = (rX + i >= 0) ? *(const unsigned*)(zxc + (oX + (unsigned)i * 12288u)) : 0u;
        }
        if (wid == 0) { const unsigned od = (unsigned)((rowbase + t0 + 2 * lane) * 32 + h) * 4u; dtp0 = *(const float*)(dtc + od); dtp1 = *(const float*)(dtc + (od + 128u)); }
    };
    prefetch(0);

    auto acum_stage = [&](int par) {
        if (wid == 0) {
            LAS float* sm_acum = (LAS float*)(lds + L_SM + par * 2048);
            LAS float* sm_dt = sm_acum + 128;
            LAS float* sm_w = sm_acum + 256;
            LAS float* sm_ea = sm_acum + 384;
            int lane = tid0 & 63; OPQ(lane);
            const float d0 = softplus_f(dtp0 + dtb), d1 = softplus_f(dtp1 + dtb);
            const float a0 = d0 * Ah, a1 = a0 + d1 * Ah;
            float sc = a1;
#pragma unroll
            for (int o = 1; o < 64; o <<= 1) { const float v = __shfl_up(sc, o); if (lane >= o) sc += v; }
            const float c1 = sc, c0 = sc - a1 + a0;
            const float last = __shfl(sc, 63);
            sm_acum[2 * lane] = c0; sm_acum[2 * lane + 1] = c1;
            sm_dt[2 * lane] = d0; sm_dt[2 * lane + 1] = d1;
            sm_w[2 * lane] = __expf(last - c0) * d0; sm_w[2 * lane + 1] = __expf(last - c1) * d1;
            sm_ea[2 * lane] = __expf(c0); sm_ea[2 * lane + 1] = __expf(c1);
        }
    };
    acum_stage(0);
    __syncthreads();

    f32x16 hacc;
#pragma unroll
    for (int i = 0; i < 16; ++i) hacc[i] = 0.f;

#pragma unroll 1
    for (int c = 0; c < 16; ++c) {
        const int t0 = c * 128;
        LAS float* sm_acum = (LAS float*)(lds + L_SM + (c & 1) * 2048);
        LAS float* sm_dt = sm_acum + 128;
        LAS float* sm_w = sm_acum + 256;
        LAS float* sm_ea = sm_acum + 384;
        {
            int tid = tid0; OPQ(tid);
            const int bt_ = tid & 255, tqb = bt_ >> 4, cg8 = bt_ & 15;
            const int lcBC = (roleB ? 64 : 192) + cg8 * 8;
            const f32x4 wv0 = *(const LAS f32x4*)(sm_w + tqb * 8), wv1 = *(const LAS f32x4*)(sm_w + tqb * 8 + 4);
            const float wt[8] = {wv0.x, wv0.y, wv0.z, wv0.w, wv1.x, wv1.y, wv1.z, wv1.w};
            const int natbase = (roleB ? L_BN : L_CN) + (tqb * 8) * RS + cg8 * 16;
#pragma unroll
            for (int half = 0; half < 2; ++half) {
                u32x2 nat[8]; u32x4 tr[4];
#pragma unroll
                for (int ipp = 0; ipp < 2; ++ipp) {
                    const int ip = half * 2 + ipp;
                    const float k0a = cw[0 * 320 + lcBC + 2 * ip], k0b = cw[0 * 320 + lcBC + 2 * ip + 1];
                    const float k1a = cw[1 * 320 + lcBC + 2 * ip], k1b = cw[1 * 320 + lcBC + 2 * ip + 1];
                    const float k2a = cw[2 * 320 + lcBC + 2 * ip], k2b = cw[2 * 320 + lcBC + 2 * ip + 1];
                    const float k3a = cw[3 * 320 + lcBC + 2 * ip], k3b = cw[3 * 320 + lcBC + 2 * ip + 1];
                    const float bba = cw[4 * 320 + lcBC + 2 * ip], bbb = cw[4 * 320 + lcBC + 2 * ip + 1];
                    f32x2 rr[11];
#pragma unroll
                    for (int i = 0; i < 11; ++i) { const unsigned v = rawBC[i][ip]; rr[i] = (f32x2){bf_lo(v), bf_hi(v)}; }
                    const f32x2 K0 = {k0a, k0b}, K1 = {k1a, k1b}, K2 = {k2a, k2b}, K3 = {k3a, k3b}, BB = {bba, bbb};
                    float va[8], vb[8];
#pragma unroll
                    for (int t = 0; t < 8; ++t) {
                        const f32x2 v = silu2(BB + K0 * rr[t] + K1 * rr[t + 1] + K2 * rr[t + 2] + K3 * rr[t + 3]);
                        va[t] = v.x; vb[t] = v.y;
                        nat[t][ipp] = cvt_pk_bf16(v.x, v.y);
                    }
                    if (roleB) {
#pragma unroll
                        for (int tp = 0; tp < 4; ++tp) {
                            tr[2 * ipp][tp] = cvt_pk_bf16(va[2 * tp] * wt[2 * tp], va[2 * tp + 1] * wt[2 * tp + 1]);
                            tr[2 * ipp + 1][tp] = cvt_pk_bf16(vb[2 * tp] * wt[2 * tp], vb[2 * tp + 1] * wt[2 * tp + 1]);
                        }
                    }
                }
#pragma unroll
                for (int t = 0; t < 8; ++t) *(LAS u32x2*)(lds + natbase + t * RS + half * 8) = nat[t];
                if (roleB) {
#pragma unroll
                    for (int i = 0; i < 4; ++i) *(LAS u32x4*)(lds + bt_addr(cg8 * 8 + half * 4 + i, tqb * 8)) = tr[i];
                }
                __builtin_amdgcn_sched_barrier(0);
            }
        }
        {
            int tid = tid0; OPQ(tid);
            const int tqx = tid >> 5, cp = tid & 31, lcX = cp * 2;
            const float k0a = cw[0 * 320 + lcX], k0b = cw[0 * 320 + lcX + 1], k1a = cw[1 * 320 + lcX], k1b = cw[1 * 320 + lcX + 1];
            const float k2a = cw[2 * 320 + lcX], k2b = cw[2 * 320 + lcX + 1], k3a = cw[3 * 320 + lcX], k3b = cw[3 * 320 + lcX + 1];
            const float bba = cw[4 * 320 + lcX], bbb = cw[4 * 320 + lcX + 1];
            f32x2 rr[11];
#pragma unroll
            for (int i = 0; i < 11; ++i) rr[i] = (f32x2){bf_lo(rawX[i]), bf_hi(rawX[i])};
            const f32x2 K0 = {k0a, k0b}, K1 = {k1a, k1b}, K2 = {k2a, k2b}, K3 = {k3a, k3b}, BB = {bba, bbb};
            float va[8], vb[8];
#pragma unroll
            for (int t = 0; t < 8; ++t) { const f32x2 v = silu2(BB + K0 * rr[t] + K1 * rr[t + 1] + K2 * rr[t + 2] + K3 * rr[t + 3]); va[t] = v.x; vb[t] = v.y; }
            u32x4 xa, xb;
            xa.x = cvt_pk_bf16(va[0], va[1]); xa.y = cvt_pk_bf16(va[2], va[3]); xa.z = cvt_pk_bf16(va[4], va[5]); xa.w = cvt_pk_bf16(va[6], va[7]);
            xb.x = cvt_pk_bf16(vb[0], vb[1]); xb.y = cvt_pk_bf16(vb[2], vb[3]); xb.z = cvt_pk_bf16(vb[4], vb[5]); xb.w = cvt_pk_bf16(vb[6], vb[7]);
            *(LAS u32x4*)(lds + xt_addr(cp * 2, tqx * 8)) = xa;
            *(LAS u32x4*)(lds + xt_addr(cp * 2 + 1, tqx * 8)) = xb;
        }
        if (c + 1 < 16) prefetch(t0 + 128);
        bf16_t zr[16];
        {
            int ln = tid0 & 63; OPQ(ln);
            const int l31 = ln & 31, hh = ln >> 5;
            const unsigned oz = (unsigned)((rowbase + t0 + tt * 32 + 4 * hh) * ZXW + h * 64 + pt * 32 + l31) * 2u;
#pragma unroll
            for (int rg = 0; rg < 16; ++rg) zr[rg] = *(const bf16_t*)(zxc + (oz + (unsigned)((rg & 3) + 8 * (rg >> 2)) * 12288u));
        }
        __syncthreads();
        f32x16 y;
        {
            int ln = tid0 & 63; OPQ(ln);
            const int l31 = ln & 31, hh = ln >> 5;
            const int cbase = L_CN + (tt * 32 + l31) * RS + 16 * hh, hbase = L_HB + (pt * 32 + l31) * RS + 16 * hh;
#pragma unroll
            for (int i = 0; i < 16; ++i) y[i] = 0.f;
            {
                const float dec = sm_ea[127];
#pragma unroll
                for (int i = 0; i < 16; ++i) hacc[i] *= dec;
            }
            bf16x8 cf[8];
#pragma unroll
            for (int ks = 0; ks < 8; ++ks) {
                cf[ks] = *(const LAS bf16x8*)(lds + cbase + ks * 32);
                const bf16x8 bfr = *(const LAS bf16x8*)(lds + hbase + ks * 32);
                const bf16x8 a = *(const LAS bf16x8*)(lds + xt_addr(hp * 32 + l31, ks * 16 + 8 * hh));
                const bf16x8 bb = *(const LAS bf16x8*)(lds + bt_addr(hn * 32 + l31, ks * 16 + 8 * hh));
                y = mfma32(cf[ks], bfr, y);
                hacc = mfma32(a, bb, hacc);
            }
#pragma unroll
            for (int rq = 0; rq < 4; ++rq) { const f32x4 e = *(const LAS f32x4*)(sm_ea + tt * 32 + 8 * rq + 4 * hh); y[4 * rq] *= e.x; y[4 * rq + 1] *= e.y; y[4 * rq + 2] *= e.z; y[4 * rq + 3] *= e.w; }
            const int tidx = tt * 32 + l31;
            const float at = sm_acum[tidx];
#pragma unroll 1
            for (int st = 0; st <= tt; ++st) {
                f32x16 s;
#pragma unroll
                for (int i = 0; i < 16; ++i) s[i] = 0.f;
                const int bbase = L_BN + (st * 32 + l31) * RS + 16 * hh;
#pragma unroll
                for (int ks = 0; ks < 8; ++ks) { const bf16x8 afr = *(const LAS bf16x8*)(lds + bbase + ks * 32); s = mfma32(afr, cf[ks], s); }
#pragma unroll
                for (int rq = 0; rq < 4; ++rq) {
                    const int sb0 = st * 32 + 8 * rq + 4 * hh;
                    const f32x4 asv = *(const LAS f32x4*)(sm_acum + sb0), dsv = *(const LAS f32x4*)(sm_dt + sb0);
#pragma unroll
                    for (int i = 0; i < 4; ++i) {
                        float e = at - asv[i];
                        if (sb0 + i > tidx) e = -INFINITY;
                        s[4 * rq + i] *= __expf(e) * dsv[i];
                    }
                }
#pragma unroll
                for (int k2 = 0; k2 < 2; ++k2) {
                    u32x4 au; au.x = cvt_pk_bf16(s[8 * k2], s[8 * k2 + 1]); au.y = cvt_pk_bf16(s[8 * k2 + 2], s[8 * k2 + 3]); au.z = cvt_pk_bf16(s[8 * k2 + 4], s[8 * k2 + 5]); au.w = cvt_pk_bf16(s[8 * k2 + 6], s[8 * k2 + 7]);
                    const int sbase = st * 32 + 16 * k2 + 4 * hh;
                    const u32x2 lo = *(const LAS u32x2*)(lds + xt_addr(pt * 32 + l31, sbase)), hi = *(const LAS u32x2*)(lds + xt_addr(pt * 32 + l31, sbase + 8));
                    u32x4 bu; bu.x = lo.x; bu.y = lo.y; bu.z = hi.x; bu.w = hi.y;
                    y = mfma32(__builtin_bit_cast(bf16x8, au), __builtin_bit_cast(bf16x8, bu), y);
                }
            }
        }
        {
            int ln = tid0 & 63; OPQ(ln);
            const int l31 = ln & 31, hh = ln >> 5;
            const unsigned oy = (unsigned)((rowbase + t0 + tt * 32 + 4 * hh) * 2048 + h * 64 + pt * 32 + l31) * 2u;
#pragma unroll
            for (int rq = 0; rq < 4; ++rq) {
                const u32x2 xv = *(const LAS u32x2*)(lds + xt_addr(pt * 32 + l31, tt * 32 + 8 * rq + 4 * hh));
                const float xs[4] = {bf_lo(xv.x), bf_hi(xv.x), bf_lo(xv.y), bf_hi(xv.y)};
#pragma unroll
                for (int i = 0; i < 4; ++i) {
                    const int rg = 4 * rq + i;
                    const float yv = y[rg] + Dh * xs[i];
                    const float gv = yv * silu_f(bf2f(zr[rg]));
                    *(bf16_t*)(ygc + (oy + (unsigned)(8 * rq + i) * 4096u)) = (bf16_t)(cvt_pk_bf16(gv, 0.f) & 0xffffu);
                }
            }
        }
        if (c + 1 < 16) acum_stage((c + 1) & 1);
        __syncthreads();
        {
            int ln = tid0 & 63; OPQ(ln);
            const int l31 = ln & 31, hh = ln >> 5;
#pragma unroll
            for (int rg = 0; rg < 16; ++rg) {
                const int pr = hp * 32 + (rg & 3) + 8 * (rg >> 2) + 4 * hh;
                *(LAS bf16_t*)(lds + L_HB + pr * RS + (hn * 32 + l31) * 2) = (bf16_t)(cvt_pk_bf16(hacc[rg], 0.f) & 0xffffu);
            }
        }
    }
    {
        int ln = tid0 & 63; OPQ(ln);
        const int l31 = ln & 31, hh = ln >> 5;
        float* so = p.out + O_SSM_P + ((size_t)(j * 8 + b) * 32 + h) * 8192;
#pragma unroll
        for (int rg = 0; rg < 16; ++rg) {
            const int pr = hp * 32 + (rg & 3) + 8 * (rg >> 2) + 4 * hh;
            so[pr * 128 + hn * 32 + l31] = hacc[rg];
        }
    }
}

__device__ void ssd_sample_all(const Params& p, int j, LAS unsigned char* lds) {
    const int tid = otid();
    const bf16_t* zx = (const bf16_t*)(p.ws + WS_ZX);
    const float* dtraw = (const float*)(p.ws + WS_DTRAW);
    bf16_t* yg = (bf16_t*)(p.ws + WS_YG);
    LAS float* sx = (LAS float*)lds;
    LAS float* sB = sx + 2048;
    LAS float* sC = sB + 1024;
    LAS float* sdt = sC + 1024;
    LAS float* sdec = sdt + 32;
    const int pp = tid >> 3, nl = (tid & 7) * 4;
    int item = (int)blockIdx.x;
    f32x4 hs[4][4];
    if (item < 1024) {
        const float* st = p.in[2] + ((size_t)(j * 128 + (item >> 3)) * 32 + (item & 7) * 4) * 8192;
#pragma unroll
        for (int r = 0; r < 4; ++r)
#pragma unroll
            for (int q = 0; q < 4; ++q) hs[r][q] = *(const f32x4*)(st + r * 8192 + pp * 128 + nl + 32 * q);
    }
#pragma unroll 1
    for (; item < 1024; item += (int)gridDim.x) {
        const int b = item >> 3, g = item & 7;
        __syncthreads();
        {
            const int cc = tid < 256 ? g * 256 + tid : (tid < 384 ? 2048 + g * 128 + (tid - 256) : 3072 + g * 128 + (tid - 384));
            float raw[11];
#pragma unroll
            for (int k = 0; k < 3; ++k) raw[k] = p.in[3][((size_t)(j * 128 + b) * 3 + k) * 4096 + cc];
#pragma unroll
            for (int t = 0; t < 8; ++t) raw[3 + t] = bf2f(zx[(size_t)(MP + b * 8 + t) * ZXW + 2048 + cc]);
            const float w0 = p.in[11][((size_t)j * 4 + 0) * 4096 + cc], w1 = p.in[11][((size_t)j * 4 + 1) * 4096 + cc];
            const float w2 = p.in[11][((size_t)j * 4 + 2) * 4096 + cc], w3 = p.in[11][((size_t)j * 4 + 3) * 4096 + cc];
            const float bs = p.in[12][(size_t)j * 4096 + cc];
            LAS float* dst = tid < 256 ? sx + tid : (tid < 384 ? sB + (tid - 256) : sC + (tid - 384));
            const int dstride = tid < 256 ? 256 : 128;
#pragma unroll
            for (int t = 0; t < 8; ++t) dst[t * dstride] = silu_f(bs + w0 * raw[t] + w1 * raw[t + 1] + w2 * raw[t + 2] + w3 * raw[t + 3]);
            if (tid < 32) {
                const int t = tid >> 2, r = tid & 3, hd = g * 4 + r;
                const float dtv = softplus_f(dtraw[(size_t)(MP + b * 8 + t) * 32 + hd] + p.in[13][j * 32 + hd]);
                sdt[tid] = dtv; sdec[tid] = __expf(-dtv * __expf(p.in[14][j * 32 + hd]));
            }
        }
        const int tsel = tid & 7;
        const size_t row = (size_t)(MP + b * 8 + tsel);
        bf16_t zv[4];
#pragma unroll
        for (int r = 0; r < 4; ++r) zv[r] = zx[row * ZXW + g * 256 + r * 64 + pp];
        const int nitem = item + (int)gridDim.x;
        f32x4 hn[4][4];
        if (nitem < 1024) {
            const float* st = p.in[2] + ((size_t)(j * 128 + (nitem >> 3)) * 32 + (nitem & 7) * 4) * 8192;
#pragma unroll
            for (int r = 0; r < 4; ++r)
#pragma unroll
                for (int q = 0; q < 4; ++q) hn[r][q] = *(const f32x4*)(st + r * 8192 + pp * 128 + nl + 32 * q);
        }
        __syncthreads();
        float ysel[4] = {0.f, 0.f, 0.f, 0.f};
#pragma unroll
        for (int t = 0; t < 8; ++t) {
            const f32x4 dt4 = *(const LAS f32x4*)(sdt + t * 4), dc4 = *(const LAS f32x4*)(sdec + t * 4);
            const float dx[4] = {dt4.x * sx[t * 256 + pp], dt4.y * sx[t * 256 + 64 + pp], dt4.z * sx[t * 256 + 128 + pp], dt4.w * sx[t * 256 + 192 + pp]};
            const float dc[4] = {dc4.x, dc4.y, dc4.z, dc4.w};
            float yp[4] = {0.f, 0.f, 0.f, 0.f};
#pragma unroll
            for (int q = 0; q < 4; ++q) {
                const f32x4 B4 = *(const LAS f32x4*)(sB + t * 128 + nl + 32 * q), C4 = *(const LAS f32x4*)(sC + t * 128 + nl + 32 * q);
#pragma unroll
                for (int r = 0; r < 4; ++r) {
                    hs[r][q] = hs[r][q] * dc[r] + B4 * dx[r];
                    yp[r] += (hs[r][q].x * C4.x + hs[r][q].y * C4.y) + (hs[r][q].z * C4.z + hs[r][q].w * C4.w);
                }
            }
#pragma unroll
            for (int r = 0; r < 4; ++r) {
                float v = yp[r];
                v += __shfl_xor(v, 1); v += __shfl_xor(v, 2); v += __shfl_xor(v, 4);
                if (tsel == t) ysel[r] = v;
            }
        }
        float* so = p.out + O_SSM_S + ((size_t)(j * 128 + b) * 32 + g * 4) * 8192;
#pragma unroll
        for (int r = 0; r < 4; ++r) {
            const int ch = g * 256 + r * 64 + pp;
            const float yv = ysel[r] + p.in[15][j * 32 + g * 4 + r] * sx[tsel * 256 + r * 64 + pp];
            const float gv = yv * silu_f(bf2f(zv[r]));
            yg[row * 2048 + ch] = (bf16_t)(cvt_pk_bf16(gv, 0.f) & 0xffffu);
#pragma unroll
            for (int q = 0; q < 4; ++q) *(f32x4*)(so + r * 8192 + pp * 128 + nl + 32 * q) = hs[r][q];
        }
        if (nitem < 1024) {
#pragma unroll
            for (int r = 0; r < 4; ++r)
#pragma unroll
                for (int q = 0; q < 4; ++q) hs[r][q] = hn[r][q];
        }
    }
}

__device__ void phase_scan(const Params& p, int j, LAS unsigned char* lds) {
    for (int item = blockIdx.x; item < 256; item += gridDim.x) {
        const int g = item & 7, k = item >> 3, b = k >> 2, r = k & 3;
        for (int rep = 0; rep < REP_PROMPT; ++rep) ssd_prompt_item(p, j, b, g * 4 + r, lds);
    }
    ssd_sample_all(p, j, lds);
    const bf16_t* zx = (const bf16_t*)(p.ws + WS_ZX);
    const int gt = blockIdx.x * 512 + otid(), nth = gridDim.x * 512;
    for (int i = gt; i < 136 * 3 * 512; i += nth) {
        const int ch = (i & 511) * 8, k = (i >> 9) % 3, sq = (i >> 9) / 3;
        const size_t row = sq < 8 ? (size_t)(sq * 2048 + 2045 + k) : (size_t)(MP + (sq - 8) * 8 + 5 + k);
        float* dst = sq < 8 ? p.out + O_CONV_P + ((size_t)(j * 8 + sq) * 3 + k) * 4096 + ch : p.out + O_CONV_S + ((size_t)(j * 128 + (sq - 8)) * 3 + k) * 4096 + ch;
        const u32x4 v = *(const u32x4*)(zx + row * ZXW + 2048 + ch);
        *(f32x4*)dst = (f32x4){bf_lo(v.x), bf_hi(v.x), bf_lo(v.y), bf_hi(v.y)}; *(f32x4*)(dst + 4) = (f32x4){bf_lo(v.z), bf_hi(v.z), bf_lo(v.w), bf_hi(v.w)};
    }
}

#define XB_TMO      128
#define XB_XCNT(j)  (256  + 64 * (j))
#define XB_XSUB(j)  (1280 + 64 * (j))
#define XB_XGEN(j)  (2304 + 64 * (j))
#define XB_TOP      3328
#define XB_TOPGEN   3392
#define XCD_BAR_WORDS 3456
#define XB_SPIN_CAP (1u << 22)
__device__ __forceinline__ unsigned xb_ld(unsigned* p)              { return __hip_atomic_load(p, __ATOMIC_RELAXED, __HIP_MEMORY_SCOPE_AGENT); }
__device__ __forceinline__ unsigned xb_add(unsigned* p, unsigned v) { return __hip_atomic_fetch_add(p, v, __ATOMIC_RELAXED, __HIP_MEMORY_SCOPE_AGENT); }
__device__ __forceinline__ unsigned xb_xcc_id() { return (unsigned)__builtin_amdgcn_s_getreg((3 << 11) | 20) & 0xFu; }
#define XB_SPIN(cond, bar) do { unsigned _sp = 0; while (cond) { __builtin_amdgcn_s_sleep(1); \
    if ((++_sp & 255u) == 0u) { if (xb_ld(&(bar)[XB_TMO])) break; if (_sp > XB_SPIN_CAP) { atomicAdd(&(bar)[XB_TMO], 1u); break; } } } } while (0)
struct XcdBarrier { unsigned* bar; unsigned x; volatile LAS unsigned* st; };
__device__ __forceinline__ XcdBarrier xcd_barrier_post(unsigned* bar, volatile LAS unsigned* st) {
    XcdBarrier b; b.bar = bar; b.x = xb_xcc_id(); b.st = st;
    if (threadIdx.x == 0) (void)xb_add(&bar[XB_XCNT(b.x)], 1u);
    return b;
}
__device__ __forceinline__ void xcd_barrier_complete(unsigned* bar, unsigned x, unsigned& nloc, unsigned& nx) {
    const unsigned G = gridDim.x * gridDim.y * gridDim.z;
    unsigned sum, cnt, mine, sp = 0u;
    for (;;) {
        sum = 0u; cnt = 0u; mine = 0u;
#pragma unroll
        for (unsigned j = 0; j < 16; ++j) { const unsigned c = xb_ld(&bar[XB_XCNT(j)]); sum += c; cnt += (c > 0u) ? 1u : 0u; mine = (j == x) ? c : mine; }
        if (sum == G) break;
        __builtin_amdgcn_s_sleep(1);
        if ((++sp & 255u) == 0u) { if (xb_ld(&bar[XB_TMO])) break; if (sp > XB_SPIN_CAP) { atomicAdd(&bar[XB_TMO], 1u); break; } }
    }
    nloc = mine > 0u ? mine : 1u; nx = cnt > 0u ? cnt : 1u;
}
__device__ __forceinline__ void xcd_barrier(const XcdBarrier& b) {
    asm volatile("s_waitcnt vmcnt(0)" ::: "memory");
    __syncthreads();
    if (threadIdx.x == 0) {
        unsigned* bar = b.bar;
        __builtin_amdgcn_s_waitcnt(0);
        unsigned nloc = b.st[0], nx = b.st[1];
        if (nloc == 0u) { xcd_barrier_complete(bar, b.x, nloc, nx); b.st[0] = nloc; b.st[1] = nx; }
        const unsigned old = xb_add(&bar[XB_XSUB(b.x)], 1u);
        const unsigned gen = old / nloc;
        if (old + 1u == (gen + 1u) * nloc) {
            __builtin_amdgcn_fence(__ATOMIC_RELEASE, "agent");
            asm volatile("s_waitcnt vmcnt(0)" ::: "memory");
            const unsigned og = xb_add(&bar[XB_TOP], 1u);
            const unsigned tg = og / nx;
            if (og + 1u == (tg + 1u) * nx) xb_add(&bar[XB_TOPGEN], 1u);
            else XB_SPIN(xb_ld(&bar[XB_TOPGEN]) == tg, bar);
            __builtin_amdgcn_fence(__ATOMIC_ACQUIRE, "agent");
            xb_add(&bar[XB_XGEN(b.x)], 1u);
            asm volatile("s_waitcnt vmcnt(0)" ::: "memory");
        } else {
            XB_SPIN(xb_ld(&bar[XB_XGEN(b.x)]) == gen, bar);
            __builtin_amdgcn_fence(__ATOMIC_ACQUIRE, "agent");
            asm volatile("s_waitcnt vmcnt(0)" ::: "memory");
        }
    }
    __syncthreads();
}

#ifndef REP_PREP0
#define REP_PREP0 1
#endif
#ifndef REP_SMALL
#define REP_SMALL 1
#endif
#ifndef REP_GGRP
#define REP_GGRP 1
#endif
#ifndef REP_GGRP
#define REP_GGRP 1
#endif
#ifndef REP_SYNC
#define REP_SYNC 1
#endif
#ifndef REP_SCAN
#define REP_SCAN 1
#endif
#ifndef REP_GIN
#define REP_GIN 1
#endif
#ifndef REP_GOUT
#define REP_GOUT 1
#endif
#ifndef REP_ELEM
#define REP_ELEM 1
#endif
#define GSYNC() do { for (int _r = 0; _r < REP_SYNC; ++_r) xcd_barrier(xb); } while (0)
__global__ __launch_bounds__(512, 2) void hybrid_fwd(const float* i0, const float* i1, const float* i2, const float* i3, const float* i4, const float* i5, const float* i6, const float* i7,
        const float* i8, const float* i9, const float* i10, const float* i11, const float* i12, const float* i13, const float* i14, const float* i15, const float* i16, const float* i17,
        const float* i18, const float* i19, const float* i20, const float* i21, const float* i22, float* outp, unsigned char* wsp, WTab wt) {
    Params p;
    p.in[0] = i0; p.in[1] = i1; p.in[2] = i2; p.in[3] = i3; p.in[4] = i4; p.in[5] = i5; p.in[6] = i6; p.in[7] = i7; p.in[8] = i8; p.in[9] = i9; p.in[10] = i10; p.in[11] = i11;
    p.in[12] = i12; p.in[13] = i13; p.in[14] = i14; p.in[15] = i15; p.in[16] = i16; p.in[17] = i17; p.in[18] = i18; p.in[19] = i19; p.in[20] = i20; p.in[21] = i21; p.in[22] = i22;
    p.out = outp; p.ws = wsp;
    extern __shared__ __attribute__((aligned(16))) unsigned char smem[];
    LAS unsigned char* lds = (LAS unsigned char*)smem;
    cg::grid_group grid = cg::this_grid();
    unsigned char* ws = p.ws;
    volatile LAS unsigned* xst = (volatile LAS unsigned*)(lds + LDS_XB);
    if (threadIdx.x == 0) { xst[0] = 0u; xst[1] = 0u; }
    __syncthreads();
    const XcdBarrier xb = xcd_barrier_post((unsigned*)(ws + WS_BAR), xst);

    phase_prep0(p, wt, lds, 0, wt.wj[8].tile_begin, 0, true);
    if (wt.wtiles < 0) grid.sync();
    xcd_barrier(xb);
#pragma unroll 1
    for (int mode_ = 0; mode_ < 2 * REP_SMALL; ++mode_) {
        const int mode = mode_ % 2;
        pg8::SmallSched S; S.mode = mode; S.G = (int)gridDim.x; S.c = (int)blockIdx.x; S.lda = 1024; S.ldb = 1024; S.K = 1024;
        S.A0 = (const char*)(ws + (mode == 0 ? WS_AC : WS_SHIFTA)); S.ada = (const char*)(ws + WS_WT_ADA); S.ssd_in = (const char*)(ws + WS_WT_SSD_IN); S.pool_in = (const char*)(ws + WS_WT_POOL_IN);
        EpiSmall E; E.mode = mode; E.mod = (float*)(ws + WS_MOD); E.ada_b = p.in[8]; E.shiftA = (bf16_t*)(ws + WS_SHIFTA); E.sb = (float*)(ws + WS_SB);
#ifndef NO_GSMALL
        pg8::gemm_phase<EpiSmall, pg8::SmallSched>(lds, S, E);
#endif
        if (mode == 0) phase_prep0(p, wt, lds, wt.wj[8].tile_begin, wt.wtiles, 48, false);
        else phase_xprep(p, 82);
        GSYNC();
    }
    unsigned* tailw = (unsigned*)(ws + WS_BAR) + 3584;
    unsigned* tmow = (unsigned*)(ws + WS_BAR) + XB_TMO;
#pragma unroll 1
    for (int layer = 0; layer < 4; ++layer) {
        const int j = layer >> 1; const bool ssd = (layer & 1) == 0;
        {
            pg8::InSched S;
            S.init(ssd ? 6400 : 4096, ws + WS_APRIME, ssd ? ws + WS_WT_SSD_IN + (size_t)j * 6400 * 1024 * 2 : ws + WS_WT_POOL_IN + (size_t)j * 4096 * 1024 * 2, layer > 0 ? tailw + 64 * (layer - 1) : nullptr, tmow);
            EpiIn E; E.ssq = (const float*)(ws + WS_SSQ) + (size_t)layer * 17408; E.sb = (const float*)(ws + WS_SB) + (size_t)layer * 136 * 6400; E.out = (bf16_t*)(ws + WS_ZX);
            E.ldo = ssd ? ZXW : 4096; E.nbf = ssd ? ZXW : 4096; E.dtraw = ssd ? (float*)(ws + WS_DTRAW) : nullptr;
            for (int rep = 0; rep < REP_GIN; ++rep) pg8::gemm_phase<EpiIn, pg8::InSched>(lds, S, E);
        }
        GSYNC();
        if (ssd) { for (int rep = 0; rep < REP_SCAN; ++rep) phase_scan(p, j, lds); } else { for (int rep = 0; rep < REP_ELEM; ++rep) phase_pool(p, j); }
        GSYNC();
        if (ssd) { for (int rep = 0; rep < REP_ELEM; ++rep) phase_ssdnorm(p, j); }
        else {
            pg8::MainSched S; S.init(MT, 2048, 512, 2048, 512, ws + WS_YG, ws + WS_WT_POOL_G + (size_t)j * 2048 * 512 * 2, 1);
            EpiGrp E; E.uz = (const bf16_t*)(ws + WS_ZX); E.chs = p.in[20] + (size_t)j * 2048; E.out = (bf16_t*)(ws + WS_A2);
            for (int rep = 0; rep < REP_GGRP; ++rep) pg8::gemm_phase<EpiGrp, pg8::MainSched>(lds, S, E);
        }
        GSYNC();
#pragma unroll 1
        for (int part = 0; part < 2; ++part) {
            const bool splitk = (part == 1 && layer == 3);
            pg8::MainSched S; S.init(part == 0 ? MP : MT, 1024, splitk ? 1024 : 2048, 2048, 2048, ws + WS_A2, ssd ? ws + WS_WT_SSD_OUT + (size_t)j * 1024 * 2048 * 2 : ws + WS_WT_POOL_OUT + (size_t)j * 1024 * 2048 * 2, 30, splitk ? 2 : part);
            EpiOut E; E.xw = (bf16_t*)(ws + WS_XW);
            E.modl = (const float*)(ws + WS_MOD) + (size_t)layer * 3072; E.ng_next = layer < 3 ? p.in[9] + (size_t)(layer + 1) * 1024 : nullptr;
            E.aprime = (bf16_t*)(ws + WS_APRIME); E.ssq = (float*)(ws + WS_SSQ) + (size_t)(layer + 1) * 17408;
            E.part = splitk ? (float*)(ws + WS_PART) : nullptr;
            pg8::gemm_phase<EpiOut, pg8::MainSched>(lds, S, E);
            if (part == 0) GSYNC();
        }
        if (blockIdx.x < 16) {
            asm volatile("s_waitcnt vmcnt(0)" ::: "memory");
            __syncthreads();
            if (threadIdx.x == 0) { __builtin_amdgcn_fence(__ATOMIC_RELEASE, "agent"); asm volatile("s_waitcnt vmcnt(0)" ::: "memory"); __hip_atomic_fetch_add(tailw + 64 * layer, 1u, __ATOMIC_RELAXED, __HIP_MEMORY_SCOPE_AGENT); }
        }
    }
    phase_final(p, 0, MP, 32, false);
    GSYNC();
    phase_final(p, MP, MT, 0, true);
}

extern "C" void kernel_launch(void* const* d_in, const int* in_sizes, int n_in, void* d_out, int out_size, void* d_ws, size_t ws_size, hipStream_t stream) {
    static int grid = 0;
    if (grid == 0) {
        if (n_in != 23 || ws_size < WS_END) { fprintf(stderr, "kernel_launch: unexpected n_in %d or ws_size %zu (need %zu)\n", n_in, ws_size, (size_t)WS_END); grid = -1; return; }
        int dev = 0, cus = 0, per_cu = 0;
        hipGetDevice(&dev);
        hipDeviceGetAttribute(&cus, hipDeviceAttributeMultiprocessorCount, dev);
        if (hipFuncSetAttribute((const void*)hybrid_fwd, hipFuncAttributeMaxDynamicSharedMemorySize, LDS_BYTES) != hipSuccess) { fprintf(stderr, "kernel_launch: hipFuncSetAttribute failed\n"); grid = -1; return; }
        if (hipOccupancyMaxActiveBlocksPerMultiprocessor(&per_cu, (const void*)hybrid_fwd, 512, LDS_BYTES) != hipSuccess || per_cu < 1) { fprintf(stderr, "kernel_launch: occupancy query gave %d\n", per_cu); (void)hipGetLastError(); per_cu = 1; }
        if (cus < 256) { fprintf(stderr, "kernel_launch: needs a 256-CU device (got %d CUs)\n", cus); grid = -1; return; }
        grid = 256;
    }
    if (grid < 0) return;
    WTab wt{};
    unsigned char* ws = (unsigned char*)d_ws;
    int nj = 0, tb = 0;
    auto add = [&](int srci, long long soff, size_t dst_off, int K, int N, int Npad) {
        WJob& w = wt.wj[nj++]; w.src = (const float*)d_in[srci] + soff; w.doff = (long long)dst_off; w.K = K; w.N = N; w.tiles_n = Npad / 64; w.tile_begin = tb; tb += (K / 64) * (Npad / 64);
    };
    for (int i = 0; i < 4; ++i) add(7, (long long)i * 1024 * 3072, WS_WT_ADA + (size_t)i * 3072 * 1024 * 2, 1024, 3072, 3072);
    for (int j = 0; j < 2; ++j) add(10, (long long)j * 1024 * 6176, WS_WT_SSD_IN + (size_t)j * 6400 * 1024 * 2, 1024, 6176, 6400);
    for (int j = 0; j < 2; ++j) add(18, (long long)j * 1024 * 4096, WS_WT_POOL_IN + (size_t)j * 4096 * 1024 * 2, 1024, 4096, 4096);
    for (int j = 0; j < 2; ++j) add(17, (long long)j * 2048 * 1024, WS_WT_SSD_OUT + (size_t)j * 1024 * 2048 * 2, 2048, 1024, 1024);
    for (int j = 0; j < 2; ++j) add(21, (long long)j * 2048 * 1024, WS_WT_POOL_OUT + (size_t)j * 1024 * 2048 * 2, 2048, 1024, 1024);
    for (int q = 0; q < 8; ++q) add(19, (long long)q * 512 * 512, WS_WT_POOL_G + (size_t)q * 512 * 512 * 2, 512, 512, 512);
    wt.wtiles = tb;
    if (hipMemsetAsync(ws + WS_BAR, 0, 16384, stream) != hipSuccess) { fprintf(stderr, "kernel_launch: memset of the barrier words failed\n"); return; }
    const float* ip[23]; for (int i = 0; i < 23; ++i) ip[i] = (const float*)d_in[i];
    float* outp = (float*)d_out;
    void* args[26];
    for (int i = 0; i < 23; ++i) args[i] = (void*)&ip[i];
    args[23] = (void*)&outp; args[24] = (void*)&ws; args[25] = (void*)&wt;
    hipError_t e = hipLaunchCooperativeKernel((const void*)hybrid_fwd, dim3(grid), dim3(512), args, LDS_BYTES, stream);
    if (e != hipSuccess) fprintf(stderr, "cooperative launch failed: %s (grid %d)\n", hipGetErrorString(e), grid);
}
```

```cpp
#include <hip/hip_runtime.h>
#include <hip/hip_cooperative_groups.h>
#include <cstdio>
namespace cg = cooperative_groups;

#ifndef REP_PROMPT
#define REP_PROMPT 1
#endif
#define LAS __attribute__((address_space(3)))
typedef unsigned short bf16_t;
typedef short bf16x8 __attribute__((ext_vector_type(8)));
typedef float f32x4 __attribute__((ext_vector_type(4)));
typedef float f32x16 __attribute__((ext_vector_type(16)));
typedef unsigned u32x4 __attribute__((ext_vector_type(4)));
typedef unsigned u32x2 __attribute__((ext_vector_type(2)));
typedef float f32x2 __attribute__((ext_vector_type(2)));

constexpr int MP = 16384, MT = 17408, DM = 1024;
constexpr int ZXW = 6144;
constexpr size_t O_SSM_P = 17825792, O_CONV_P = 22020096, O_POOL_P = 22216704, O_SSM_S = 22708224, O_CONV_S = 89817088, O_POOL_S = 92962816;

constexpr size_t WS_WT_SSD_IN = 0;
constexpr size_t WS_WT_SSD_OUT = WS_WT_SSD_IN + 2ull * 6400 * 1024 * 2;
constexpr size_t WS_WT_POOL_IN = WS_WT_SSD_OUT + 2ull * 1024 * 2048 * 2;
constexpr size_t WS_WT_POOL_G = WS_WT_POOL_IN + 2ull * 4096 * 1024 * 2;
constexpr size_t WS_WT_POOL_OUT = WS_WT_POOL_G + 2ull * 2048 * 512 * 2;
constexpr size_t WS_WT_ADA = WS_WT_POOL_OUT + 2ull * 1024 * 2048 * 2;
constexpr size_t WS_AC = WS_WT_ADA + 12288ull * 1024 * 2;
constexpr size_t WS_SHIFTA = WS_AC + 256ull * 1024 * 2;
constexpr size_t WS_MOD = WS_SHIFTA + 4ull * 256 * 1024 * 2;
constexpr size_t WS_SB = WS_MOD + 136ull * 12288 * 4;
constexpr size_t WS_APRIME = WS_SB + 4ull * 136 * 6400 * 4;
constexpr size_t WS_SSQ = WS_APRIME + 17408ull * 1024 * 2;
constexpr size_t WS_XW = WS_SSQ + 17408ull * 16 * 4;
constexpr size_t WS_ZX = WS_XW + 17408ull * 1024 * 4;
constexpr size_t WS_DTRAW = WS_ZX + 17408ull * 6144 * 2;
constexpr size_t WS_YG = WS_DTRAW + 17408ull * 32 * 4;
constexpr size_t WS_A2 = WS_YG + 17408ull * 2048 * 2;
constexpr size_t WS_BAR = WS_A2 + 17408ull * 2048 * 2;
constexpr size_t WS_PART = WS_BAR + 16384;
constexpr size_t WS_UZ = WS_PART + 2ull * 1024 * 1024 * 4;
constexpr size_t WS_END = WS_UZ + 17408ull * 4096 * 2;

constexpr int LDS_XB = 149760;
constexpr int LDS_BYTES = 149776;

struct WJob { const float* src; long long doff; int K, N, tiles_n, tile_begin; };
struct WTab { WJob wj[20]; int wtiles; int pad0; };
constexpr int NWJ = 20;
struct Params {
    const float* in[23];
    float* out;
    unsigned char* ws;
};

__device__ __forceinline__ unsigned cvt_pk_bf16(float lo, float hi) { unsigned r; asm("v_cvt_pk_bf16_f32 %0, %1, %2" : "=v"(r) : "v"(lo), "v"(hi)); return r; }
__device__ __forceinline__ float bf_lo(unsigned u) { return __uint_as_float(u << 16); }
__device__ __forceinline__ float bf_hi(unsigned u) { return __uint_as_float(u & 0xffff0000u); }
__device__ __forceinline__ float bf2f(bf16_t b) { return __uint_as_float(((unsigned)b) << 16); }
__device__ __forceinline__ float silu_f(float v) { return v * __builtin_amdgcn_rcpf(1.f + __expf(-v)); }
__device__ __forceinline__ f32x2 silu2(f32x2 v) { const f32x2 e = v * (-1.44269504f); f32x2 d; d.x = __builtin_amdgcn_exp2f(e.x); d.y = __builtin_amdgcn_exp2f(e.y); d = d + 1.f; f32x2 r; r.x = __builtin_amdgcn_rcpf(d.x); r.y = __builtin_amdgcn_rcpf(d.y); return v * r; }
__device__ __forceinline__ float softplus_f(float v) { return v > 20.f ? v : log1pf(__expf(v)); }
__device__ __forceinline__ int otid() { int t = threadIdx.x; asm volatile("" : "+v"(t)); return t; }
__device__ __forceinline__ int row_b(int r) { return r < MP ? (r >> 11) : 8 + ((r - MP) >> 3); }
__device__ __forceinline__ u32x4 pack8(f32x4 a, f32x4 b) { u32x4 r; r.x = cvt_pk_bf16(a.x, a.y); r.y = cvt_pk_bf16(a.z, a.w); r.z = cvt_pk_bf16(b.x, b.y); r.w = cvt_pk_bf16(b.z, b.w); return r; }

namespace pg8 {
constexpr int BM = 256, BK = 64, HALF = 128, HTB = HALF * BK * 2, STAGE_BYTES = 8 * HTB, NXCD = 8, WGM = 8;
__device__ __forceinline__ int lds_byte(int r, int c) { const int st = (r >> 4) * 2 + (c >> 5), rr = r & 15, cc = c & 31, ob = rr * 64 + cc * 2; return st * 1024 + (ob ^ (((ob >> 9) & 1) << 5)); }
__device__ __forceinline__ void stage_rc(int b, int& R, int& C) { const int st = b / 1024, sb = b % 1024, swz = sb ^ (((sb >> 9) & 1) << 5); R = (st >> 1) * 16 + swz / 64; C = (st & 1) * 32 + (swz % 64) / 2; }
__device__ __forceinline__ int perm32(int rho) { const int n = rho >> 4, i = rho & 15; return 8 * (i >> 2) + 4 * n + (i & 3); }

struct Unit { int pm, pn, q; const char* A; const char* B; };

__device__ __forceinline__ void static_unit(int L, int nM, int nN, int& pm, int& pn) {
    const int nwg = nM * nN;
    int wgid = L; { const int q = nwg / NXCD, r = nwg % NXCD, xcd = wgid % NXCD, off = wgid / NXCD; wgid = (xcd < r ? xcd * (q + 1) : r * (q + 1) + (xcd - r) * q) + off; }
    const int nig = WGM * nN, gid = wgid / nig, fm = gid * WGM, gsz = (nM - fm) < WGM ? (nM - fm) : WGM;
    pm = fm + ((wgid % nig) % gsz); pn = (wgid % nig) / gsz;
}
struct MainSched {
    int nM, nN, nwg, G, c, lda, ldb, K, gsh, single, ntail;
    const char* A; const char* Bt;
    __device__ void init(int M, int N, int K_, int lda_, int ldb_, const void* A_, const void* Bt_, int gsh_, int single_ = 0) {
        nM = M / BM; nN = N / BM; nwg = nM * nN; G = (int)gridDim.x; c = (int)blockIdx.x; lda = lda_; ldb = ldb_; K = K_; A = (const char*)A_; Bt = (const char*)Bt_; gsh = gsh_; single = single_; ntail = 16;
    }
    __device__ bool next(int i, Unit& u) const {
        int koff = 0;
        if (single == 1) { if (i > 0 || c >= 16) return false; u.pm = 64 + (c >> 2); u.pn = c & 3; }
        else if (single == 3) { const int per = 32 / ntail; if (c >= ntail || i >= per) return false; const int sx_ = c * per + i; u.pm = 64 + (sx_ >> 3); u.pn = sx_ & 7; }
        else if (single == 2) { if (i > 0 || c >= 32) return false; u.pm = 64 + (c >> 3); u.pn = (c >> 1) & 3; koff = (c & 1) * K; }
        else { const long L = (long)i * G + c; if (L >= nwg) return false; static_unit((int)L, nM, nN, u.pm, u.pn); }
        u.q = single == 2 ? (c & 1) : 0;
        u.A = A + ((size_t)u.pm * BM * lda + (size_t)(u.pn >> gsh) * 512 + koff) * 2;
        u.B = Bt + ((size_t)u.pn * BM * ldb + koff) * 2;
        return true;
    }
    __device__ __forceinline__ void a_ready(const Unit&) const {}
};
struct InSched {
    int nN, nP, E, nskip, c, r0, cnt, lda, ldb, K;
    const char* A; const char* Bt; unsigned* tail; unsigned* tmo;
    __device__ void init(int N, const void* A_, const void* Bt_, unsigned* tail_, unsigned* tmo_, int skip_rounds = 2) {
        nN = N / BM; nP = 64 * nN; c = (int)blockIdx.x; lda = 1024; ldb = 1024; K = 1024; A = (const char*)A_; Bt = (const char*)Bt_; tail = tail_; tmo = tmo_;
        nskip = tail_ != nullptr ? 16 * skip_rounds : 0; E = nskip + 4 * nN; r0 = (tail_ != nullptr && c < 16) ? skip_rounds : 0;
        const int tot = (nP - c + 255) / 256; cnt = tot - r0 > 0 ? tot - r0 : 0;
    }
    __device__ bool next(int i, Unit& u) const {
        if (i < cnt) static_unit((i + r0) * 256 + c, 64, nN, u.pm, u.pn);
        else {
            if (c < 16) return false;
            const int e = 255 - c + 240 * (i - cnt); if (e >= E) return false;
            if (e < nskip) static_unit((e >> 4) * 256 + (e & 15), 64, nN, u.pm, u.pn);
            else { const int sidx = e - nskip; u.pm = 64 + sidx / nN; u.pn = sidx - (sidx / nN) * nN; }
        }
        u.q = 0;
        u.A = A + (size_t)u.pm * BM * 1024 * 2; u.B = Bt + (size_t)u.pn * BM * 1024 * 2;
        return true;
    }
    __device__ __forceinline__ void a_ready(const Unit& u) const {
        if (tail == nullptr || u.pm < 64) return;
        if (threadIdx.x < 64) {
            unsigned polls = 0;
            while ((unsigned)__builtin_amdgcn_readfirstlane(__hip_atomic_load(tail, __ATOMIC_RELAXED, __HIP_MEMORY_SCOPE_AGENT)) < 16u) {
                __builtin_amdgcn_s_sleep(2);
                if ((++polls & 255u) == 0u) { if (__builtin_amdgcn_readfirstlane(__hip_atomic_load(tmo, __ATOMIC_RELAXED, __HIP_MEMORY_SCOPE_AGENT)) != 0u) break; if (polls > (1u << 22)) { if (threadIdx.x == 0) atomicAdd(tmo, 1u); break; } }
            }
            __builtin_amdgcn_fence(__ATOMIC_ACQUIRE, "agent");
            asm volatile("s_waitcnt vmcnt(0)" ::: "memory");
        }
        asm volatile("" ::: "memory"); __builtin_amdgcn_s_barrier(); asm volatile("" ::: "memory");
    }
};
struct SmallSched {
    int mode, G, c, lda, ldb, K;
    const char* A0; const char* ada; const char* ssd_in; const char* pool_in;
    __device__ bool next(int i, Unit& u) const {
        const long L = (long)i * G + c;
        u.pm = 0;
        if (mode == 0) { if (L >= 48) return false; u.pn = (int)L; u.q = 0; u.A = A0; u.B = ada + (size_t)u.pn * BM * 1024 * 2; return true; }
        if (L >= 82) return false;
        int l = (int)L, q, pn;
        if (l < 25) { q = 0; pn = l; } else if (l < 41) { q = 1; pn = l - 25; } else if (l < 66) { q = 2; pn = l - 41; } else { q = 3; pn = l - 66; }
        u.q = q; u.pn = pn; u.A = A0 + (size_t)q * 256 * 1024 * 2;
        u.B = ((q & 1) ? pool_in + (size_t)(q >> 1) * 4096 * 1024 * 2 : ssd_in + (size_t)(q >> 1) * 6400 * 1024 * 2) + (size_t)pn * BM * 1024 * 2;
        return true;
    }
    __device__ __forceinline__ void a_ready(const Unit&) const {}
};

template <class Epi, class Sched>
__device__ __forceinline__ void gemm_phase(LAS unsigned char* lds, const Sched& S, const Epi& E) {
    const int tid = otid(), wid = __builtin_amdgcn_readfirstlane(tid >> 6), lane = tid & 63, wr = wid >> 2, wc = wid & 3, fr = lane & 15, fq = lane >> 4;
    const int K = S.K, nt = K / BK;
    unsigned voffA[2], voffB[2];
#pragma unroll
    for (int i = 0; i < 2; ++i) { int R, C; stage_rc(tid * 16 + i * 8192, R, C); const int Rb = Epi::PERM ? ((R & ~31) + perm32(R & 31)) : R;
        voffA[i] = (unsigned)(R * S.lda + C) * 2u; voffB[i] = (unsigned)(Rb * S.ldb + C) * 2u; }
    const size_t kstep = (size_t)(BK * 2);
    const size_t hstepA = (size_t)HALF * S.lda * 2, hstepB = (size_t)HALF * S.ldb * 2;
    const unsigned ldsw = (unsigned)wid * 1024u;
    const int aoff = lds_byte(wr * 64 + fr, fq * 8), boff = lds_byte(wc * 32 + fr, fq * 8);
#define PG8_SA(b, h) (((b) * 2 + (h)) * HTB)
#define PG8_SB(b, h) ((4 + (b) * 2 + (h)) * HTB)
#define PG8_STAGE(bufoff, gbase, voff) do { _Pragma("unroll") for (int _i = 0; _i < 2; ++_i) \
        __builtin_amdgcn_global_load_lds((const unsigned*)((const char*)(gbase) + (voff)[_i]), (LAS unsigned*)(lds + (bufoff) + ldsw + _i * 8192), 16, 0, 0); } while (0)
#define PG8_LDA(dst, b, h) do { _Pragma("unroll") for (int m = 0; m < 4; ++m) _Pragma("unroll") for (int k = 0; k < 2; ++k) dst[m][k] = *(const LAS bf16x8*)(lds + PG8_SA(b, h) + aoff + m * 2048 + k * 1024); } while (0)
#define PG8_LDB(dst, b, h) do { _Pragma("unroll") for (int n = 0; n < 2; ++n) _Pragma("unroll") for (int k = 0; k < 2; ++k) dst[n][k] = *(const LAS bf16x8*)(lds + PG8_SB(b, h) + boff + n * 2048 + k * 1024); } while (0)
#define PG8_MMA(ai, bj, At, Bt) do { __builtin_amdgcn_s_setprio(1); _Pragma("unroll") for (int m = 0; m < 4; ++m) _Pragma("unroll") for (int n = 0; n < 2; ++n) _Pragma("unroll") for (int k = 0; k < 2; ++k) \
        acc[ai][bj][m][n] = __builtin_amdgcn_mfma_f32_16x16x32_bf16(Bt[n][k], At[m][k], acc[ai][bj][m][n], 0, 0, 0); __builtin_amdgcn_s_setprio(0); } while (0)
#define PG8_WAIT_V(n) asm volatile("s_waitcnt vmcnt(" #n ")" ::: "memory")
#define PG8_WAIT_L(n) asm volatile("s_waitcnt lgkmcnt(" #n ")" ::: "memory")
#define PG8_BAR __builtin_amdgcn_s_barrier()
#define PG8_SCHED __builtin_amdgcn_sched_barrier(0)
    Unit cur, nxt; int ui = 0;
    if (!S.next(0, cur)) return;
    f32x4 acc[2][2][4][2];
#pragma unroll
    for (int a = 0; a < 2; ++a)
#pragma unroll
        for (int b = 0; b < 2; ++b)
#pragma unroll
            for (int m = 0; m < 4; ++m)
#pragma unroll
                for (int n = 0; n < 2; ++n) acc[a][b][m][n] = (f32x4){0.f, 0.f, 0.f, 0.f};
    bf16x8 At[4][2], B0[2][2], B1[2][2];
    const char* cA = cur.A; const char* cB = cur.B;
    S.a_ready(cur);
    PG8_STAGE(PG8_SB(0, 0), cB, voffB); PG8_STAGE(PG8_SA(0, 0), cA, voffA); PG8_STAGE(PG8_SB(0, 1), cB + hstepB, voffB); PG8_STAGE(PG8_SA(0, 1), cA + hstepA, voffA);
    if (wr == 1) PG8_BAR;
    PG8_WAIT_V(4); PG8_BAR;
    PG8_STAGE(PG8_SB(1, 0), cB + kstep, voffB); PG8_STAGE(PG8_SA(1, 0), cA + kstep, voffA); PG8_STAGE(PG8_SB(1, 1), cB + hstepB + kstep, voffB);
    PG8_WAIT_V(6); PG8_BAR;
    for (;;) {
        const bool has_next = S.next(ui + 1, nxt);
        const char* nA = has_next ? nxt.A : cA; const char* nB = has_next ? nxt.B : cB;
        for (int t = 0; t < nt; t += 2) {
            const bool last = (t == nt - 2);
            const char* a1 = cA + (size_t)(t + 1) * kstep;
            const char* a2 = last ? nA : cA + (size_t)(t + 2) * kstep; const char* b2 = last ? nB : cB + (size_t)(t + 2) * kstep;
            const char* a3 = a2 + kstep; const char* b3 = b2 + kstep;
            if (last && has_next) S.a_ready(nxt);
            PG8_LDB(B0, 0, 0); PG8_SCHED; PG8_LDA(At, 0, 0); PG8_STAGE(PG8_SA(1, 1), a1 + hstepA, voffA);
            PG8_WAIT_L(8); PG8_BAR; PG8_WAIT_L(0); PG8_MMA(0, 0, At, B0); PG8_BAR; PG8_SCHED;
            PG8_LDB(B1, 0, 1); PG8_STAGE(PG8_SB(0, 0), b2, voffB);
            PG8_BAR; PG8_WAIT_L(0); PG8_MMA(0, 1, At, B1); PG8_BAR;
            PG8_LDA(At, 0, 1); PG8_STAGE(PG8_SA(0, 0), a2, voffA);
            PG8_BAR; PG8_WAIT_L(0); PG8_MMA(1, 0, At, B0); PG8_BAR; PG8_SCHED;
            PG8_STAGE(PG8_SB(0, 1), b2 + hstepB, voffB);
            PG8_WAIT_V(6); PG8_BAR; PG8_MMA(1, 1, At, B1); PG8_BAR;
            PG8_LDB(B0, 1, 0); PG8_SCHED; PG8_LDA(At, 1, 0); PG8_STAGE(PG8_SA(0, 1), a2 + hstepA, voffA);
            PG8_WAIT_L(8); PG8_BAR; PG8_WAIT_L(0); PG8_MMA(0, 0, At, B0); PG8_BAR; PG8_SCHED;
            PG8_LDB(B1, 1, 1); PG8_STAGE(PG8_SB(1, 0), b3, voffB);
            PG8_BAR; PG8_WAIT_L(0); PG8_MMA(0, 1, At, B1); PG8_BAR;
            PG8_LDA(At, 1, 1); PG8_STAGE(PG8_SA(1, 0), a3, voffA);
            PG8_BAR; PG8_WAIT_L(0); PG8_MMA(1, 0, At, B0); PG8_BAR; PG8_SCHED;
            PG8_STAGE(PG8_SB(1, 1), b3 + hstepB, voffB);
            PG8_WAIT_V(6); PG8_BAR; PG8_MMA(1, 1, At, B1); PG8_BAR;
        }
        E(acc, cur, wr, wc, fr, fq);
        if (!has_next) break;
#pragma unroll
        for (int a = 0; a < 2; ++a)
#pragma unroll
            for (int b = 0; b < 2; ++b)
#pragma unroll
                for (int m = 0; m < 4; ++m)
#pragma unroll
                    for (int n = 0; n < 2; ++n) acc[a][b][m][n] = (f32x4){0.f, 0.f, 0.f, 0.f};
        cur = nxt; cA = nA; cB = nB; ++ui;
    }
    PG8_WAIT_V(0);
    if (wr == 0) PG8_BAR;
    PG8_BAR;
#undef PG8_SA
#undef PG8_SB
#undef PG8_STAGE
#undef PG8_LDA
#undef PG8_LDB
#undef PG8_MMA
#undef PG8_WAIT_V
#undef PG8_WAIT_L
#undef PG8_BAR
#undef PG8_SCHED
}
}
using pg8::Unit;

struct EpiIn {
    static constexpr bool PERM = true;
    const float* ssq; const float* sb; bf16_t* out; int ldo, nbf; float* dtraw;
    template <bool UNI>
    __device__ __forceinline__ void body(const f32x4 (&acc)[2][2][4][2], const Unit& u, int wr, int wc, int fr, int fq) const {
        const int row0 = u.pm * 256 + wr * 64 + fr, colt = u.pn * 256 + wc * 32 + 8 * fq;
        f32x4 ub[2][2];
        if (UNI) {
            const float* sbr = sb + (size_t)(u.pm >> 3) * 6400;
#pragma unroll
            for (int bj = 0; bj < 2; ++bj) { const int c = colt + bj * 128; if (c < nbf + 32) { ub[bj][0] = *(const f32x4*)(sbr + c); ub[bj][1] = *(const f32x4*)(sbr + c + 4); } }
        }
        float rsv[2][4];
#pragma unroll
        for (int ai = 0; ai < 2; ++ai)
#pragma unroll
            for (int m = 0; m < 4; ++m) rsv[ai][m] = ssq[row0 + ai * 128 + m * 16];
#pragma unroll
        for (int ai = 0; ai < 2; ++ai) {
            f32x4 nb[4][2][2];
            if (!UNI) {
#pragma unroll
                for (int m = 0; m < 4; ++m) {
                    const float* sbr = sb + (size_t)row_b(row0 + ai * 128 + m * 16) * 6400;
#pragma unroll
                    for (int bj = 0; bj < 2; ++bj) { const int c = colt + bj * 128; if (c < nbf + 32) { nb[m][bj][0] = *(const f32x4*)(sbr + c); nb[m][bj][1] = *(const f32x4*)(sbr + c + 4); } }
                }
            }
#pragma unroll
            for (int m = 0; m < 4; ++m) {
                const int r = row0 + ai * 128 + m * 16;
                const float rstd = rsqrtf(rsv[ai][m] * (1.f / 1024.f) + 1e-6f);
#pragma unroll
                for (int bj = 0; bj < 2; ++bj) {
                    const int c = colt + bj * 128;
                    if (c < nbf + 32) {
                        f32x4 b0, b1;
                        if (UNI) { b0 = ub[bj][0]; b1 = ub[bj][1]; } else { b0 = nb[m][bj][0]; b1 = nb[m][bj][1]; }
                        const f32x4 v0 = acc[ai][bj][m][0] * rstd + b0, v1 = acc[ai][bj][m][1] * rstd + b1;
                        if (c < nbf) *(u32x4*)(out + (size_t)r * ldo + c) = pack8(v0, v1);
                        else if (dtraw != nullptr) { float* dp = dtraw + (size_t)r * 32 + (c - nbf); *(f32x4*)dp = v0; *(f32x4*)(dp + 4) = v1; }
                    }
                }
            }
        }
    }
    __device__ __forceinline__ void operator()(const f32x4 (&acc)[2][2][4][2], const Unit& u, int wr, int wc, int fr, int fq) const {
        asm volatile("" : "+v"(fr), "+v"(fq));
        if (u.pm < 64) body<true>(acc, u, wr, wc, fr, fq); else body<false>(acc, u, wr, wc, fr, fq);
    }
};
struct EpiOut {
    static constexpr bool PERM = true;
    bf16_t* xw; const float* modl; const float* ng_next; bf16_t* aprime; float* ssq; float* part;
    template <bool UNI>
    __device__ __forceinline__ void body(const f32x4 (&acc)[2][2][4][2], const Unit& u, int wr, int wc, int fr, int fq) const {
        const int row0 = u.pm * 256 + wr * 64 + fr, colt = u.pn * 256 + wc * 32 + 8 * fq;
        const bool has_next = ng_next != nullptr;
        f32x4 ug[2][2], us[2][2], uw[2][2];
#pragma unroll
        for (int bj = 0; bj < 2; ++bj) {
            const int c = colt + bj * 128;
            if (has_next) { uw[bj][0] = *(const f32x4*)(ng_next + c); uw[bj][1] = *(const f32x4*)(ng_next + c + 4); }
            if (UNI) {
                const float* mb = modl + (size_t)(u.pm >> 3) * 12288;
                ug[bj][0] = *(const f32x4*)(mb + 2048 + c) + 1.f; ug[bj][1] = *(const f32x4*)(mb + 2048 + c + 4) + 1.f;
                if (has_next) { us[bj][0] = (*(const f32x4*)(mb + 4096 + c) + 1.f) * uw[bj][0]; us[bj][1] = (*(const f32x4*)(mb + 4096 + c + 4) + 1.f) * uw[bj][1]; }
            }
        }
#pragma unroll
        for (int aim = 0; aim < 4; ++aim) {
            const int ai = aim >> 1, mp = aim & 1;
            u32x4 xv[2][2];
#pragma unroll
            for (int mm = 0; mm < 2; ++mm)
#pragma unroll
                for (int bj = 0; bj < 2; ++bj) xv[mm][bj] = *(const u32x4*)(xw + (size_t)(row0 + ai * 128 + (mp * 2 + mm) * 16) * DM + colt + bj * 128);
#pragma unroll
            for (int mm = 0; mm < 2; ++mm) {
                const int m = mp * 2 + mm;
                const int r = row0 + ai * 128 + m * 16;
                const float* mb = modl + (size_t)row_b(r) * 12288;
                float ss = 0.f;
#pragma unroll
                for (int bj = 0; bj < 2; ++bj) {
                    const int c = colt + bj * 128;
                    f32x4 g0, g1;
                    if (UNI) { g0 = ug[bj][0]; g1 = ug[bj][1]; } else { g0 = *(const f32x4*)(mb + 2048 + c) + 1.f; g1 = *(const f32x4*)(mb + 2048 + c + 4) + 1.f; }
                    const u32x4 xo = xv[mm][bj];
                    const f32x4 x0 = {bf_lo(xo.x), bf_hi(xo.x), bf_lo(xo.y), bf_hi(xo.y)}, x1 = {bf_lo(xo.z), bf_hi(xo.z), bf_lo(xo.w), bf_hi(xo.w)};
                    const f32x4 n0 = x0 + g0 * acc[ai][bj][m][0], n1 = x1 + g1 * acc[ai][bj][m][1];
                    *(u32x4*)(xw + (size_t)r * DM + c) = pack8(n0, n1);
                    ss += (n0.x * n0.x + n0.y * n0.y) + (n0.z * n0.z + n0.w * n0.w) + (n1.x * n1.x + n1.y * n1.y) + (n1.z * n1.z + n1.w * n1.w);
                    if (has_next) {
                        f32x4 s0, s1;
                        if (UNI) { s0 = us[bj][0]; s1 = us[bj][1]; } else { s0 = (*(const f32x4*)(mb + 4096 + c) + 1.f) * uw[bj][0]; s1 = (*(const f32x4*)(mb + 4096 + c + 4) + 1.f) * uw[bj][1]; }
                        *(u32x4*)(aprime + (size_t)r * DM + c) = pack8(n0 * s0, n1 * s1);
                    }
                }
                ss += __shfl_xor(ss, 16); ss += __shfl_xor(ss, 32);
                if (fq == 0) atomicAdd(ssq + r, ss);
            }
        }
    }
    __device__ __forceinline__ void operator()(const f32x4 (&acc)[2][2][4][2], const Unit& u, int wr, int wc, int fr, int fq) const {
        asm volatile("" : "+v"(fr), "+v"(fq));
        if (part != nullptr) {
            float* pb = part + (size_t)u.q * 1024 * 1024;
            const int row0 = (u.pm - 64) * 256 + wr * 64 + fr, colt = u.pn * 256 + wc * 32 + 8 * fq;
#pragma unroll
            for (int ai = 0; ai < 2; ++ai)
#pragma unroll
                for (int m = 0; m < 4; ++m)
#pragma unroll
                    for (int bj = 0; bj < 2; ++bj) {
                        float* dp = pb + (size_t)(row0 + ai * 128 + m * 16) * 1024 + colt + bj * 128;
                        *(f32x4*)dp = acc[ai][bj][m][0]; *(f32x4*)(dp + 4) = acc[ai][bj][m][1];
                    }
            return;
        }
        if (u.pm < 64) body<true>(acc, u, wr, wc, fr, fq); else body<false>(acc, u, wr, wc, fr, fq);
    }
};
struct EpiGrp {
    static constexpr bool PERM = true;
    const bf16_t* uz; const float* chs; bf16_t* out;
    __device__ __forceinline__ void operator()(const f32x4 (&acc)[2][2][4][2], const Unit& u, int wr, int wc, int fr, int fq) const {
        asm volatile("" : "+v"(fr), "+v"(fq));
        const int row0 = u.pm * 256 + wr * 64 + fr, colt = u.pn * 256 + wc * 32 + 8 * fq;
        f32x4 cs[2][2];
#pragma unroll
        for (int bj = 0; bj < 2; ++bj) { cs[bj][0] = *(const f32x4*)(chs + colt + bj * 128); cs[bj][1] = *(const f32x4*)(chs + colt + bj * 128 + 4); }
#pragma unroll
        for (int ai = 0; ai < 2; ++ai) {
            u32x4 zz[4][2];
#pragma unroll
            for (int m = 0; m < 4; ++m)
#pragma unroll
                for (int bj = 0; bj < 2; ++bj) zz[m][bj] = *(const u32x4*)(uz + (size_t)(row0 + ai * 128 + m * 16) * 4096 + 2048 + colt + bj * 128);
#pragma unroll
            for (int m = 0; m < 4; ++m) {
                const int r = row0 + ai * 128 + m * 16;
#pragma unroll
                for (int bj = 0; bj < 2; ++bj) {
                    const int c = colt + bj * 128;
                    const u32x4 z = zz[m][bj];
                    const f32x2 a = silu2((f32x2){bf_lo(z.x), bf_hi(z.x)}), b = silu2((f32x2){bf_lo(z.y), bf_hi(z.y)}), cc = silu2((f32x2){bf_lo(z.z), bf_hi(z.z)}), d = silu2((f32x2){bf_lo(z.w), bf_hi(z.w)});
                    const f32x4 z0 = {a.x, a.y, b.x, b.y}, z1 = {cc.x, cc.y, d.x, d.y};
                    *(u32x4*)(out + (size_t)r * 2048 + c) = pack8(acc[ai][bj][m][0] * cs[bj][0] * z0, acc[ai][bj][m][1] * cs[bj][1] * z1);
                }
            }
        }
    }
};
struct EpiSmall {
    static constexpr bool PERM = true;
    int mode; float* mod; const float* ada_b; bf16_t* shiftA; float* sb;
    __device__ __forceinline__ void operator()(const f32x4 (&acc)[2][2][4][2], const Unit& u, int wr, int wc, int fr, int fq) const {
        asm volatile("" : "+v"(fr), "+v"(fq));
        const int row0 = wr * 64 + fr, colt = u.pn * 256 + wc * 32 + 8 * fq;
#pragma unroll
        for (int ai = 0; ai < 2; ++ai)
#pragma unroll
            for (int m = 0; m < 4; ++m) {
                const int r = row0 + ai * 128 + m * 16;
                if (r < 136) {
#pragma unroll
                    for (int bj = 0; bj < 2; ++bj) {
                        const int c = colt + bj * 128;
                        if (mode == 0) {
                            const f32x4 v0 = acc[ai][bj][m][0] + *(const f32x4*)(ada_b + c), v1 = acc[ai][bj][m][1] + *(const f32x4*)(ada_b + c + 4);
                            *(f32x4*)(mod + (size_t)r * 12288 + c) = v0; *(f32x4*)(mod + (size_t)r * 12288 + c + 4) = v1;
                            const int li = c / 3072, cc = c - li * 3072;
                            if (cc < 1024) *(u32x4*)(shiftA + ((size_t)li * 256 + r) * 1024 + cc) = pack8(v0, v1);
                        } else {
                            float* sp = sb + ((size_t)u.q * 136 + r) * 6400 + c;
                            *(f32x4*)sp = acc[ai][bj][m][0]; *(f32x4*)(sp + 4) = acc[ai][bj][m][1];
                        }
                    }
                }
            }
    }
};

__device__ void phase_prep0(const Params& p, const WTab& wt, LAS unsigned char* lds, int tile_lo, int tile_hi, int blk0, bool misc) {
    if ((int)blockIdx.x < blk0) return;
    LAS float* tl = (LAS float*)lds;
    const int tid = otid();
    for (int tile = tile_lo + ((int)blockIdx.x - blk0); tile < tile_hi; tile += (int)gridDim.x - blk0) {
        int j = 0;
#pragma unroll 1
        for (int q = 1; q < NWJ; ++q) if (tile >= wt.wj[q].tile_begin) j = q;
        const WJob job = wt.wj[j];
        bf16_t* jdst = (bf16_t*)(p.ws + job.doff);
        const int lt = tile - job.tile_begin, tk = lt / job.tiles_n, tn = lt - tk * job.tiles_n, k0 = tk * 64, n0 = tn * 64;
        {
            const int kk = tid >> 3, nn = (tid & 7) * 8;
            f32x4 a = (f32x4){0.f, 0.f, 0.f, 0.f}, b = a;
            if (n0 + nn < job.N) { const __attribute__((address_space(1))) f32x4* sp = (const __attribute__((address_space(1))) f32x4*)(job.src + (size_t)(k0 + kk) * job.N + n0 + nn); a = sp[0]; b = sp[1]; }
            LAS float* d = tl + kk * 65 + nn;
            d[0] = a.x; d[1] = a.y; d[2] = a.z; d[3] = a.w; d[4] = b.x; d[5] = b.y; d[6] = b.z; d[7] = b.w;
        }
        __syncthreads();
        {
            const int n = tid >> 3, k8 = (tid & 7) * 8;
            const LAS float* s = tl + k8 * 65 + n;
            u32x4 o; o.x = cvt_pk_bf16(s[0], s[65]); o.y = cvt_pk_bf16(s[130], s[195]); o.z = cvt_pk_bf16(s[260], s[325]); o.w = cvt_pk_bf16(s[390], s[455]);
            *(u32x4*)(jdst + (size_t)(n0 + n) * job.K + k0 + k8) = o;
        }
        __syncthreads();
    }
    if (!misc) return;
    bf16_t* ac = (bf16_t*)(p.ws + WS_AC);
    const int gt = blockIdx.x * 512 + tid, nth = gridDim.x * 512;
    for (int i = gt; i < 256 * 1024 / 8; i += nth) {
        const int r = i >> 7, c = (i & 127) * 8;
        u32x4 o = (u32x4){0u, 0u, 0u, 0u};
        if (r < 136) {
            const float* cp = r < 8 ? p.in[5] + (size_t)r * 1024 + c : p.in[6] + (size_t)(r - 8) * 1024 + c;
            const f32x4 a = *(const f32x4*)cp, b = *(const f32x4*)(cp + 4);
            o.x = cvt_pk_bf16(silu_f(a.x), silu_f(a.y)); o.y = cvt_pk_bf16(silu_f(a.z), silu_f(a.w)); o.z = cvt_pk_bf16(silu_f(b.x), silu_f(b.y)); o.w = cvt_pk_bf16(silu_f(b.z), silu_f(b.w));
        }
        *(u32x4*)(ac + (size_t)i * 8) = o;
    }
    { u32x4* sq = (u32x4*)(p.ws + WS_SSQ + 17408ull * 4); for (int i = gt; i < 4 * 17408 / 4; i += nth) sq[i] = (u32x4){0u, 0u, 0u, 0u}; }
    u32x4* sh = (u32x4*)(p.ws + WS_SHIFTA);
    for (int i = gt; i < 4 * 256 * 1024 / 8; i += nth) sh[i] = (u32x4){0u, 0u, 0u, 0u};
}

__device__ void phase_xprep(const Params& p, int blk0) {
    if ((int)blockIdx.x < blk0) return;
    const int tid_ = otid(), lane = tid_ & 63, wv = ((int)blockIdx.x - blk0) * 8 + (tid_ >> 6), nw = ((int)gridDim.x - blk0) * 8;
    const float* mod = (const float*)(p.ws + WS_MOD);
    bf16_t* ap = (bf16_t*)(p.ws + WS_APRIME);
    bf16_t* xwb = (bf16_t*)(p.ws + WS_XW);
    float* ssq = (float*)(p.ws + WS_SSQ);
    const float* ng = p.in[9];
    for (int r0 = wv * 2; r0 < MT; r0 += nw * 2) {
        f32x4 x[2][4];
#pragma unroll
        for (int h = 0; h < 2; ++h) {
            const int r = r0 + h;
            const float* xr = r < MP ? p.in[0] + (size_t)r * DM : p.in[1] + (size_t)(r - MP) * DM;
#pragma unroll
            for (int q = 0; q < 4; ++q) x[h][q] = *(const f32x4*)(xr + q * 256 + lane * 4);
        }
#pragma unroll
        for (int h = 0; h < 2; ++h) {
            const int r = r0 + h;
            const float* mb = mod + (size_t)row_b(r) * 12288 + 1024;
            float ss = 0.f;
#pragma unroll
            for (int q = 0; q < 4; ++q) {
                const int c = q * 256 + lane * 4;
                const f32x4 xv = x[h][q], sv = *(const f32x4*)(mb + c), g = *(const f32x4*)(ng + c);
                ss += (xv.x * xv.x + xv.y * xv.y) + (xv.z * xv.z + xv.w * xv.w);
                const f32x4 a = xv * g * (sv + 1.f);
                u32x2 o; o.x = cvt_pk_bf16(a.x, a.y); o.y = cvt_pk_bf16(a.z, a.w);
                *(u32x2*)(ap + (size_t)r * DM + c) = o;
                u32x2 ox; ox.x = cvt_pk_bf16(xv.x, xv.y); ox.y = cvt_pk_bf16(xv.z, xv.w);
                *(u32x2*)(xwb + (size_t)r * DM + c) = ox;
            }
#pragma unroll
            for (int o = 1; o < 64; o <<= 1) ss += __shfl_xor(ss, o);
            if (lane == 0) ssq[r] = ss;
        }
    }
}

__device__ void phase_final(const Params& p, int r_begin, int r_end, int blk0, bool fold) {
    if ((int)blockIdx.x < blk0) return;
    const int tid_ = otid(), lane = tid_ & 63, wv = ((int)blockIdx.x - blk0) * 8 + (tid_ >> 6), nw = ((int)gridDim.x - blk0) * 8;
    const bf16_t* xw = (const bf16_t*)(p.ws + WS_XW);
    const float* ssq = (const float*)(p.ws + WS_SSQ) + 4 * 17408;
    const float* fg = p.in[22];
    for (int r0 = r_begin + wv * 2; r0 < r_end; r0 += nw * 2) {
        f32x4 x[2][4];
#pragma unroll
        for (int h = 0; h < 2; ++h)
#pragma unroll
            for (int q = 0; q < 4; ++q) { const u32x2 v = *(const u32x2*)(xw + (size_t)(r0 + h) * DM + q * 256 + lane * 4); x[h][q] = (f32x4){bf_lo(v.x), bf_hi(v.x), bf_lo(v.y), bf_hi(v.y)}; }
#pragma unroll
        for (int h = 0; h < 2; ++h) {
            const int r = r0 + h;
            float sq = ssq[r];
            if (fold) {
                const float* p0 = (const float*)(p.ws + WS_PART) + (size_t)(r - MP) * 1024, *p1 = p0 + (size_t)1024 * 1024;
                const float* gt = (const float*)(p.ws + WS_MOD) + (size_t)row_b(r) * 12288 + 3 * 3072 + 2048;
                sq = 0.f;
#pragma unroll
                for (int q = 0; q < 4; ++q) {
                    const int c = q * 256 + lane * 4;
                    const f32x4 a = *(const f32x4*)(p0 + c) + *(const f32x4*)(p1 + c), gg = *(const f32x4*)(gt + c) + 1.f;
                    x[h][q] = x[h][q] + gg * a;
                    sq += (x[h][q].x * x[h][q].x + x[h][q].y * x[h][q].y) + (x[h][q].z * x[h][q].z + x[h][q].w * x[h][q].w);
                }
#pragma unroll
                for (int o = 1; o < 64; o <<= 1) sq += __shfl_xor(sq, o);
            }
            const float rstd = rsqrtf(sq * (1.f / 1024.f) + 1e-6f);
#pragma unroll
            for (int q = 0; q < 4; ++q) {
                const int c = q * 256 + lane * 4;
                const f32x4 g = *(const f32x4*)(fg + c);
                *(f32x4*)(p.out + (size_t)r * DM + c) = x[h][q] * rstd * g;
            }
        }
    }
}

__device__ void phase_ssdnorm(const Params& p, int j) {
    const int tid_ = otid(), lane = tid_ & 63, wv = blockIdx.x * 8 + (tid_ >> 6), nw = gridDim.x * 8;
    const bf16_t* yg = (const bf16_t*)(p.ws + WS_YG);
    bf16_t* a2 = (bf16_t*)(p.ws + WS_A2);
    const float* ng = p.in[16] + (size_t)j * 2048;
    for (int r0 = wv * 2; r0 < MT; r0 += nw * 2) {
        u32x4 vv[2][4];
#pragma unroll
        for (int h = 0; h < 2; ++h)
#pragma unroll
            for (int q = 0; q < 4; ++q) vv[h][q] = *(const u32x4*)(yg + (size_t)(r0 + h) * 2048 + q * 512 + lane * 8);
#pragma unroll
        for (int h = 0; h < 2; ++h)
#pragma unroll
            for (int q = 0; q < 4; ++q) {
                const int c = q * 512 + lane * 8;
                const u32x4 v = vv[h][q];
                f32x4 a, b;
                a.x = bf_lo(v.x); a.y = bf_hi(v.x); a.z = bf_lo(v.y); a.w = bf_hi(v.y); b.x = bf_lo(v.z); b.y = bf_hi(v.z); b.z = bf_lo(v.w); b.w = bf_hi(v.w);
                float ss = (a.x * a.x + a.y * a.y) + (a.z * a.z + a.w * a.w) + (b.x * b.x + b.y * b.y) + (b.z * b.z + b.w * b.w);
#pragma unroll
                for (int o = 1; o < 32; o <<= 1) ss += __shfl_xor(ss, o);
                const float rstd = rsqrtf(ss * (1.f / 256.f) + 1e-6f);
                const f32x4 g0 = *(const f32x4*)(ng + c), g1 = *(const f32x4*)(ng + c + 4);
                *(u32x4*)(a2 + (size_t)(r0 + h) * 2048 + c) = pack8(a * rstd * g0, b * rstd * g1);
            }
    }
}

__device__ void phase_pool(const Params& p, int j) {
    const bf16_t* uz = (const bf16_t*)(p.ws + WS_UZ);
    bf16_t* pooled = (bf16_t*)(p.ws + WS_YG);
    const int gt = blockIdx.x * 512 + otid(), nth = gridDim.x * 512;
    for (int u = gt; u < 131072 + 32768; u += nth) {
        int cv, row0, t0, R; const float* prev = nullptr; bool prompt;
        if (u < 131072) { cv = u & 255; const int run = (u >> 8) & 63, b = u >> 14; row0 = b * 2048; t0 = run * 32; R = 32; prompt = true; }
        else { const int v = u - 131072; cv = v & 255; const int b = v >> 8; row0 = MP + b * 8; t0 = 0; R = 8; prompt = false; prev = p.in[4] + ((size_t)(j * 128 + b) * 15) * 2048; }
        const int c = cv * 8, w = 2 << (c >> 9);
        float s[8];
#pragma unroll
        for (int i = 0; i < 8; ++i) s[i] = 0.f;
        auto getu = [&](int tt, float (&o)[8]) {
            if (tt >= 0) {
                const u32x4 v = *(const u32x4*)(uz + (size_t)(row0 + tt) * 4096 + c);
                o[0] = bf_lo(v.x); o[1] = bf_hi(v.x); o[2] = bf_lo(v.y); o[3] = bf_hi(v.y); o[4] = bf_lo(v.z); o[5] = bf_hi(v.z); o[6] = bf_lo(v.w); o[7] = bf_hi(v.w);
            } else if (!prompt) {
                const float* pp = prev + (size_t)(15 + tt) * 2048 + c;
                const f32x4 a = *(const f32x4*)pp, b = *(const f32x4*)(pp + 4);
                o[0] = a.x; o[1] = a.y; o[2] = a.z; o[3] = a.w; o[4] = b.x; o[5] = b.y; o[6] = b.z; o[7] = b.w;
            } else {
#pragma unroll
                for (int i = 0; i < 8; ++i) o[i] = 0.f;
            }
        };
        for (int i = 1; i < w; ++i) {
            float o[8]; getu(t0 - i, o);
#pragma unroll
            for (int k = 0; k < 8; ++k) s[k] += o[k];
        }
        for (int tb = t0; tb < t0 + R; tb += 4) {
            float cur[4][8], old[4][8];
#pragma unroll
            for (int k = 0; k < 4; ++k) { getu(tb + k, cur[k]); getu(tb + k - w + 1, old[k]); }
#pragma unroll
            for (int k = 0; k < 4; ++k) {
                const int t = tb + k;
                const float inv = 1.f / (float)(prompt ? min(w, t + 1) : w);
                f32x4 a, b;
#pragma unroll
                for (int i = 0; i < 8; ++i) s[i] += cur[k][i];
                a.x = s[0] * inv - cur[k][0]; a.y = s[1] * inv - cur[k][1]; a.z = s[2] * inv - cur[k][2]; a.w = s[3] * inv - cur[k][3];
                b.x = s[4] * inv - cur[k][4]; b.y = s[5] * inv - cur[k][5]; b.z = s[6] * inv - cur[k][6]; b.w = s[7] * inv - cur[k][7];
                *(u32x4*)(pooled + (size_t)(row0 + t) * 2048 + c) = pack8(a, b);
#pragma unroll
                for (int i = 0; i < 8; ++i) s[i] -= old[k][i];
            }
        }
    }
    for (int i = gt; i < (8 + 128) * 15 * 256; i += nth) {
        const int cv = i & 255, k = (i >> 8) % 15, sq = (i >> 8) / 15, ch = cv * 8;
        f32x4 a, b2;
        float* dst;
        bool from_state = false; size_t urow = 0;
        if (sq < 8) { urow = (size_t)(sq * 2048 + 2033 + k); dst = p.out + O_POOL_P + ((size_t)(j * 8 + sq) * 15 + k) * 2048 + ch; }
        else { const int bb = sq - 8; dst = p.out + O_POOL_S + ((size_t)(j * 128 + bb) * 15 + k) * 2048 + ch; if (k < 7) from_state = true; else urow = (size_t)(MP + bb * 8 + k - 7); }
        if (from_state) { const float* sp = p.in[4] + ((size_t)(j * 128 + (sq - 8)) * 15 + 8 + k) * 2048 + ch; a = *(const f32x4*)sp; b2 = *(const f32x4*)(sp + 4); }
        else { const u32x4 v = *(const u32x4*)(uz + urow * 4096 + ch); a = (f32x4){bf_lo(v.x), bf_hi(v.x), bf_lo(v.y), bf_hi(v.y)}; b2 = (f32x4){bf_lo(v.z), bf_hi(v.z), bf_lo(v.w), bf_hi(v.w)}; }
        *(f32x4*)dst = a; *(f32x4*)(dst + 4) = b2;
    }
}

constexpr int RS = 272;
constexpr int L_XT = 0, L_BN = 17408, L_BT = 52224, L_CN = 87040, L_HB = 121856, L_SM = 139264, L_CW = 143360;
__device__ __forceinline__ int xt_addr(int pr, int t) { return L_XT + pr * RS + ((((t >> 3) ^ (pr >> 1)) & 15) << 4) + (t & 7) * 2; }
__device__ __forceinline__ int bt_addr(int n, int t) { return L_BT + n * RS + ((((t >> 3) ^ (n >> 3)) & 15) << 4) + (t & 7) * 2; }
__device__ __forceinline__ f32x16 mfma32(bf16x8 a, bf16x8 b, f32x16 c) { return __builtin_amdgcn_mfma_f32_32x32x16_bf16(a, b, c, 0, 0, 0); }

#define OPQ(x) asm volatile("" : "+v"(x))
__device__ void ssd_prompt_item(const Params& p, int j, int b, int h, LAS unsigned char* lds) {
    const int tid0 = otid(), wid = __builtin_amdgcn_readfirstlane(tid0 >> 6), g = h >> 2;
    const char* zxc = (const char*)(p.ws + WS_ZX);
    const char* dtc = (const char*)(p.ws + WS_DTRAW);
    char* ygc = (char*)(p.ws + WS_YG);
    const int rowbase = b * 2048;
    LAS float* cw = (LAS float*)(lds + L_CW);
    const float Ah = -__expf(p.in[14][j * 32 + h]), Dh = p.in[15][j * 32 + h], dtb = p.in[13][j * 32 + h];
    const bool roleB = wid < 4;
    const int qq = wid >> 1, tt = qq ^ (qq >> 1), pt = wid & 1, hp = wid & 1, hn = wid >> 1;

    __syncthreads();
    if (tid0 < 320) {
        const int ch = tid0 < 64 ? h * 64 + tid0 : (tid0 < 192 ? 2048 + g * 128 + (tid0 - 64) : 3072 + g * 128 + (tid0 - 192));
#pragma unroll
        for (int k = 0; k < 4; ++k) cw[k * 320 + tid0] = p.in[11][((size_t)j * 4 + k) * 4096 + ch];
        cw[4 * 320 + tid0] = p.in[12][(size_t)j * 4096 + ch];
    }
    for (int i = tid0; i < 17408 / 4; i += 512) *(LAS unsigned*)(lds + L_HB + i * 4) = 0u;

    u32x4 rawBC[11]; unsigned rawX[11]; float dtp0 = 0.f, dtp1 = 0.f;
    auto prefetch = [&](int t0) {
        int tid = tid0; OPQ(tid);
        const int bt_ = tid & 255, tqb = bt_ >> 4, cg8 = bt_ & 15, tqx = tid >> 5, cp = tid & 31, lane = tid & 63;
        const int colBC = (roleB ? 4096 : 5120) + g * 128 + cg8 * 8, colX = 2048 + h * 64 + cp * 2;
        const int rB = t0 + tqb * 8 - 3, rX = t0 + tqx * 8 - 3;
        const unsigned oB = (unsigned)((rowbase + rB) * ZXW + colBC) * 2u, oX = (unsigned)((rowbase + rX) * ZXW + colX) * 2u;
#pragma unroll
        for (int i = 0; i < 11; ++i) {
            rawBC[i] = (rB + i >= 0) ? *(const u32x4*)(zxc + (oB + (unsigned)i * 12288u)) : (u32x4){0u, 0u, 0u, 0u};
            rawX[i] = (rX + i >= 0) ? *(const unsigned*)(zxc + (oX + (unsigned)i * 12288u)) : 0u;
        }
        if (wid == 0) { const unsigned od = (unsigned)((rowbase + t0 + 2 * lane) * 32 + h) * 4u; dtp0 = *(const float*)(dtc + od); dtp1 = *(const float*)(dtc + (od + 128u)); }
    };
    prefetch(0);

    auto acum_stage = [&](int par) {
        if (wid == 0) {
            LAS float* sm_acum = (LAS float*)(lds + L_SM + par * 2048);
            LAS float* sm_dt = sm_acum + 128;
            LAS float* sm_w = sm_acum + 256;
            LAS float* sm_ea = sm_acum + 384;
            int lane = tid0 & 63; OPQ(lane);
            const float d0 = softplus_f(dtp0 + dtb), d1 = softplus_f(dtp1 + dtb);
            const float a0 = d0 * Ah, a1 = a0 + d1 * Ah;
            float sc = a1;
#pragma unroll
            for (int o = 1; o < 64; o <<= 1) { const float v = __shfl_up(sc, o); if (lane >= o) sc += v; }
            const float c1 = sc, c0 = sc - a1 + a0;
            const float last = __shfl(sc, 63);
            sm_acum[2 * lane] = c0; sm_acum[2 * lane + 1] = c1;
            sm_dt[2 * lane] = d0; sm_dt[2 * lane + 1] = d1;
            sm_w[2 * lane] = __expf(last - c0) * d0; sm_w[2 * lane + 1] = __expf(last - c1) * d1;
            sm_ea[2 * lane] = __expf(c0); sm_ea[2 * lane + 1] = __expf(c1);
        }
    };
    acum_stage(0);
    __syncthreads();

    f32x16 hacc;
#pragma unroll
    for (int i = 0; i < 16; ++i) hacc[i] = 0.f;

#pragma unroll 1
    for (int c = 0; c < 16; ++c) {
        const int t0 = c * 128;
        LAS float* sm_acum = (LAS float*)(lds + L_SM + (c & 1) * 2048);
        LAS float* sm_dt = sm_acum + 128;
        LAS float* sm_w = sm_acum + 256;
        LAS float* sm_ea = sm_acum + 384;
        {
            int tid = tid0; OPQ(tid);
            const int bt_ = tid & 255, tqb = bt_ >> 4, cg8 = bt_ & 15;
            const int lcBC = (roleB ? 64 : 192) + cg8 * 8;
            const f32x4 wv0 = *(const LAS f32x4*)(sm_w + tqb * 8), wv1 = *(const LAS f32x4*)(sm_w + tqb * 8 + 4);
            const float wt[8] = {wv0.x, wv0.y, wv0.z, wv0.w, wv1.x, wv1.y, wv1.z, wv1.w};
            const int natbase = (roleB ? L_BN : L_CN) + (tqb * 8) * RS + cg8 * 16;
#pragma unroll
            for (int half = 0; half < 2; ++half) {
                u32x2 nat[8]; u32x4 tr[4];
#pragma unroll
                for (int ipp = 0; ipp < 2; ++ipp) {
                    const int ip = half * 2 + ipp;
                    const float k0a = cw[0 * 320 + lcBC + 2 * ip], k0b = cw[0 * 320 + lcBC + 2 * ip + 1];
                    const float k1a = cw[1 * 320 + lcBC + 2 * ip], k1b = cw[1 * 320 + lcBC + 2 * ip + 1];
                    const float k2a = cw[2 * 320 + lcBC + 2 * ip], k2b = cw[2 * 320 + lcBC + 2 * ip + 1];
                    const float k3a = cw[3 * 320 + lcBC + 2 * ip], k3b = cw[3 * 320 + lcBC + 2 * ip + 1];
                    const float bba = cw[4 * 320 + lcBC + 2 * ip], bbb = cw[4 * 320 + lcBC + 2 * ip + 1];
                    f32x2 rr[11];
#pragma unroll
                    for (int i = 0; i < 11; ++i) { const unsigned v = rawBC[i][ip]; rr[i] = (f32x2){bf_lo(v), bf_hi(v)}; }
                    const f32x2 K0 = {k0a, k0b}, K1 = {k1a, k1b}, K2 = {k2a, k2b}, K3 = {k3a, k3b}, BB = {bba, bbb};
                    float va[8], vb[8];
#pragma unroll
                    for (int t = 0; t < 8; ++t) {
                        const f32x2 v = silu2(BB + K0 * rr[t] + K1 * rr[t + 1] + K2 * rr[t + 2] + K3 * rr[t + 3]);
                        va[t] = v.x; vb[t] = v.y;
                        nat[t][ipp] = cvt_pk_bf16(v.x, v.y);
                    }
                    if (roleB) {
#pragma unroll
                        for (int tp = 0; tp < 4; ++tp) {
                            tr[2 * ipp][tp] = cvt_pk_bf16(va[2 * tp] * wt[2 * tp], va[2 * tp + 1] * wt[2 * tp + 1]);
                            tr[2 * ipp + 1][tp] = cvt_pk_bf16(vb[2 * tp] * wt[2 * tp], vb[2 * tp + 1] * wt[2 * tp + 1]);
                        }
                    }
                }
#pragma unroll
                for (int t = 0; t < 8; ++t) *(LAS u32x2*)(lds + natbase + t * RS + half * 8) = nat[t];
                if (roleB) {
#pragma unroll
                    for (int i = 0; i < 4; ++i) *(LAS u32x4*)(lds + bt_addr(cg8 * 8 + half * 4 + i, tqb * 8)) = tr[i];
                }
                __builtin_amdgcn_sched_barrier(0);
            }
        }
        {
            int tid = tid0; OPQ(tid);
            const int tqx = tid >> 5, cp = tid & 31, lcX = cp * 2;
            const float k0a = cw[0 * 320 + lcX], k0b = cw[0 * 320 + lcX + 1], k1a = cw[1 * 320 + lcX], k1b = cw[1 * 320 + lcX + 1];
            const float k2a = cw[2 * 320 + lcX], k2b = cw[2 * 320 + lcX + 1], k3a = cw[3 * 320 + lcX], k3b = cw[3 * 320 + lcX + 1];
            const float bba = cw[4 * 320 + lcX], bbb = cw[4 * 320 + lcX + 1];
            f32x2 rr[11];
#pragma unroll
            for (int i = 0; i < 11; ++i) rr[i] = (f32x2){bf_lo(rawX[i]), bf_hi(rawX[i])};
            const f32x2 K0 = {k0a, k0b}, K1 = {k1a, k1b}, K2 = {k2a, k2b}, K3 = {k3a, k3b}, BB = {bba, bbb};
            float va[8], vb[8];
#pragma unroll
            for (int t = 0; t < 8; ++t) { const f32x2 v = silu2(BB + K0 * rr[t] + K1 * rr[t + 1] + K2 * rr[t + 2] + K3 * rr[t + 3]); va[t] = v.x; vb[t] = v.y; }
            u32x4 xa, xb;
            xa.x = cvt_pk_bf16(va[0], va[1]); xa.y = cvt_pk_bf16(va[2], va[3]); xa.z = cvt_pk_bf16(va[4], va[5]); xa.w = cvt_pk_bf16(va[6], va[7]);
            xb.x = cvt_pk_bf16(vb[0], vb[1]); xb.y = cvt_pk_bf16(vb[2], vb[3]); xb.z = cvt_pk_bf16(vb[4], vb[5]); xb.w = cvt_pk_bf16(vb[6], vb[7]);
            *(LAS u32x4*)(lds + xt_addr(cp * 2, tqx * 8)) = xa;
            *(LAS u32x4*)(lds + xt_addr(cp * 2 + 1, tqx * 8)) = xb;
        }
        if (c + 1 < 16) prefetch(t0 + 128);
        bf16_t zr[16];
        {
            int ln = tid0 & 63; OPQ(ln);
            const int l31 = ln & 31, hh = ln >> 5;
            const unsigned oz = (unsigned)((rowbase + t0 + tt * 32 + 4 * hh) * ZXW + h * 64 + pt * 32 + l31) * 2u;
#pragma unroll
            for (int rg = 0; rg < 16; ++rg) zr[rg] = *(const bf16_t*)(zxc + (oz + (unsigned)((rg & 3) + 8 * (rg >> 2)) * 12288u));
        }
        __syncthreads();
        f32x16 y;
        {
            int ln = tid0 & 63; OPQ(ln);
            const int l31 = ln & 31, hh = ln >> 5;
            const int cbase = L_CN + (tt * 32 + l31) * RS + 16 * hh, hbase = L_HB + (pt * 32 + l31) * RS + 16 * hh;
#pragma unroll
            for (int i = 0; i < 16; ++i) y[i] = 0.f;
            {
                const float dec = sm_ea[127];
#pragma unroll
                for (int i = 0; i < 16; ++i) hacc[i] *= dec;
            }
            bf16x8 cf[8];
#pragma unroll
            for (int ks = 0; ks < 8; ++ks) {
                cf[ks] = *(const LAS bf16x8*)(lds + cbase + ks * 32);
                const bf16x8 bfr = *(const LAS bf16x8*)(lds + hbase + ks * 32);
                const bf16x8 a = *(const LAS bf16x8*)(lds + xt_addr(hp * 32 + l31, ks * 16 + 8 * hh));
                const bf16x8 bb = *(const LAS bf16x8*)(lds + bt_addr(hn * 32 + l31, ks * 16 + 8 * hh));
                y = mfma32(cf[ks], bfr, y);
                hacc = mfma32(a, bb, hacc);
            }
#pragma unroll
            for (int rq = 0; rq < 4; ++rq) { const f32x4 e = *(const LAS f32x4*)(sm_ea + tt * 32 + 8 * rq + 4 * hh); y[4 * rq] *= e.x; y[4 * rq + 1] *= e.y; y[4 * rq + 2] *= e.z; y[4 * rq + 3] *= e.w; }
            const int tidx = tt * 32 + l31;
            const float at = sm_acum[tidx];
#pragma unroll 1
            for (int st = 0; st <= tt; ++st) {
                f32x16 s;
#pragma unroll
                for (int i = 0; i < 16; ++i) s[i] = 0.f;
                const int bbase = L_BN + (st * 32 + l31) * RS + 16 * hh;
#pragma unroll
                for (int ks = 0; ks < 8; ++ks) { const bf16x8 afr = *(const LAS bf16x8*)(lds + bbase + ks * 32); s = mfma32(afr, cf[ks], s); }
#pragma unroll
                for (int rq = 0; rq < 4; ++rq) {
                    const int sb0 = st * 32 + 8 * rq + 4 * hh;
                    const f32x4 asv = *(const LAS f32x4*)(sm_acum + sb0), dsv = *(const LAS f32x4*)(sm_dt + sb0);
#pragma unroll
                    for (int i = 0; i < 4; ++i) {
                        float e = at - asv[i];
                        if (sb0 + i > tidx) e = -INFINITY;
                        s[4 * rq + i] *= __expf(e) * dsv[i];
                    }
                }
#pragma unroll
                for (int k2 = 0; k2 < 2; ++k2) {
                    u32x4 au; au.x = cvt_pk_bf16(s[8 * k2], s[8 * k2 + 1]); au.y = cvt_pk_bf16(s[8 * k2 + 2], s[8 * k2 + 3]); au.z = cvt_pk_bf16(s[8 * k2 + 4], s[8 * k2 + 5]); au.w = cvt_pk_bf16(s[8 * k2 + 6], s[8 * k2 + 7]);
                    const int sbase = st * 32 + 16 * k2 + 4 * hh;
                    const u32x2 lo = *(const LAS u32x2*)(lds + xt_addr(pt * 32 + l31, sbase)), hi = *(const LAS u32x2*)(lds + xt_addr(pt * 32 + l31, sbase + 8));
                    u32x4 bu; bu.x = lo.x; bu.y = lo.y; bu.z = hi.x; bu.w = hi.y;
                    y = mfma32(__builtin_bit_cast(bf16x8, au), __builtin_bit_cast(bf16x8, bu), y);
                }
            }
        }
        {
            int ln = tid0 & 63; OPQ(ln);
            const int l31 = ln & 31, hh = ln >> 5;
            const unsigned oy = (unsigned)((rowbase + t0 + tt * 32 + 4 * hh) * 2048 + h * 64 + pt * 32 + l31) * 2u;
#pragma unroll
            for (int rq = 0; rq < 4; ++rq) {
                const u32x2 xv = *(const LAS u32x2*)(lds + xt_addr(pt * 32 + l31, tt * 32 + 8 * rq + 4 * hh));
                const float xs[4] = {bf_lo(xv.x), bf_hi(xv.x), bf_lo(xv.y), bf_hi(xv.y)};
#pragma unroll
                for (int i = 0; i < 4; ++i) {
                    const int rg = 4 * rq + i;
                    const float yv = y[rg] + Dh * xs[i];
                    const float gv = yv * silu_f(bf2f(zr[rg]));
                    *(bf16_t*)(ygc + (oy + (unsigned)(8 * rq + i) * 4096u)) = (bf16_t)(cvt_pk_bf16(gv, 0.f) & 0xffffu);
                }
            }
        }
        if (c + 1 < 16) acum_stage((c + 1) & 1);
        __syncthreads();
        {
            int ln = tid0 & 63; OPQ(ln);
            const int l31 = ln & 31, hh = ln >> 5;
#pragma unroll
            for (int rg = 0; rg < 16; ++rg) {
                const int pr = hp * 32 + (rg & 3) + 8 * (rg >> 2) + 4 * hh;
                *(LAS bf16_t*)(lds + L_HB + pr * RS + (hn * 32 + l31) * 2) = (bf16_t)(cvt_pk_bf16(hacc[rg], 0.f) & 0xffffu);
            }
        }
    }
    {
        int ln = tid0 & 63; OPQ(ln);
        const int l31 = ln & 31, hh = ln >> 5;
        float* so = p.out + O_SSM_P + ((size_t)(j * 8 + b) * 32 + h) * 8192;
#pragma unroll
        for (int rg = 0; rg < 16; ++rg) {
            const int pr = hp * 32 + (rg & 3) + 8 * (rg >> 2) + 4 * hh;
            so[pr * 128 + hn * 32 + l31] = hacc[rg];
        }
    }
}

__device__ void ssd_sample_all(const Params& p, int j, LAS unsigned char* lds) {
    const int tid = otid();
    const bf16_t* zx = (const bf16_t*)(p.ws + WS_ZX);
    const float* dtraw = (const float*)(p.ws + WS_DTRAW);
    bf16_t* yg = (bf16_t*)(p.ws + WS_YG);
    LAS float* sx = (LAS float*)lds;
    LAS float* sB = sx + 2048;
    LAS float* sC = sB + 1024;
    LAS float* sdt = sC + 1024;
    LAS float* sdec = sdt + 32;
    const int pp = tid >> 3, nl = (tid & 7) * 4;
    int item = (int)blockIdx.x;
    f32x4 hs[4][4];
    if (item < 1024) {
        const float* st = p.in[2] + ((size_t)(j * 128 + (item >> 3)) * 32 + (item & 7) * 4) * 8192;
#pragma unroll
        for (int r = 0; r < 4; ++r)
#pragma unroll
            for (int q = 0; q < 4; ++q) hs[r][q] = *(const f32x4*)(st + r * 8192 + pp * 128 + nl + 32 * q);
    }
#pragma unroll 1
    for (; item < 1024; item += (int)gridDim.x) {
        const int b = item >> 3, g = item & 7;
        __syncthreads();
        {
            const int cc = tid < 256 ? g * 256 + tid : (tid < 384 ? 2048 + g * 128 + (tid - 256) : 3072 + g * 128 + (tid - 384));
            float raw[11];
#pragma unroll
            for (int k = 0; k < 3; ++k) raw[k] = p.in[3][((size_t)(j * 128 + b) * 3 + k) * 4096 + cc];
#pragma unroll
            for (int t = 0; t < 8; ++t) raw[3 + t] = bf2f(zx[(size_t)(MP + b * 8 + t) * ZXW + 2048 + cc]);
            const float w0 = p.in[11][((size_t)j * 4 + 0) * 4096 + cc], w1 = p.in[11][((size_t)j * 4 + 1) * 4096 + cc];
            const float w2 = p.in[11][((size_t)j * 4 + 2) * 4096 + cc], w3 = p.in[11][((size_t)j * 4 + 3) * 4096 + cc];
            const float bs = p.in[12][(size_t)j * 4096 + cc];
            LAS float* dst = tid < 256 ? sx + tid : (tid < 384 ? sB + (tid - 256) : sC + (tid - 384));
            const int dstride = tid < 256 ? 256 : 128;
#pragma unroll
            for (int t = 0; t < 8; ++t) dst[t * dstride] = silu_f(bs + w0 * raw[t] + w1 * raw[t + 1] + w2 * raw[t + 2] + w3 * raw[t + 3]);
            if (tid < 32) {
                const int t = tid >> 2, r = tid & 3, hd = g * 4 + r;
                const float dtv = softplus_f(dtraw[(size_t)(MP + b * 8 + t) * 32 + hd] + p.in[13][j * 32 + hd]);
                sdt[tid] = dtv; sdec[tid] = __expf(-dtv * __expf(p.in[14][j * 32 + hd]));
            }
        }
        const int tsel = tid & 7;
        const size_t row = (size_t)(MP + b * 8 + tsel);
        bf16_t zv[4];
#pragma unroll
        for (int r = 0; r < 4; ++r) zv[r] = zx[row * ZXW + g * 256 + r * 64 + pp];
        const int nitem = item + (int)gridDim.x;
        f32x4 hn[4][4];
        if (nitem < 1024) {
            const float* st = p.in[2] + ((size_t)(j * 128 + (nitem >> 3)) * 32 + (nitem & 7) * 4) * 8192;
#pragma unroll
            for (int r = 0; r < 4; ++r)
#pragma unroll
                for (int q = 0; q < 4; ++q) hn[r][q] = *(const f32x4*)(st + r * 8192 + pp * 128 + nl + 32 * q);
        }
        __syncthreads();
        float ysel[4] = {0.f, 0.f, 0.f, 0.f};
#pragma unroll
        for (int t = 0; t < 8; ++t) {
            const f32x4 dt4 = *(const LAS f32x4*)(sdt + t * 4), dc4 = *(const LAS f32x4*)(sdec + t * 4);
            const float dx[4] = {dt4.x * sx[t * 256 + pp], dt4.y * sx[t * 256 + 64 + pp], dt4.z * sx[t * 256 + 128 + pp], dt4.w * sx[t * 256 + 192 + pp]};
            const float dc[4] = {dc4.x, dc4.y, dc4.z, dc4.w};
            float yp[4] = {0.f, 0.f, 0.f, 0.f};
#pragma unroll
            for (int q = 0; q < 4; ++q) {
                const f32x4 B4 = *(const LAS f32x4*)(sB + t * 128 + nl + 32 * q), C4 = *(const LAS f32x4*)(sC + t * 128 + nl + 32 * q);
#pragma unroll
                for (int r = 0; r < 4; ++r) {
                    hs[r][q] = hs[r][q] * dc[r] + B4 * dx[r];
                    yp[r] += (hs[r][q].x * C4.x + hs[r][q].y * C4.y) + (hs[r][q].z * C4.z + hs[r][q].w * C4.w);
                }
            }
#pragma unroll
            for (int r = 0; r < 4; ++r) {
                float v = yp[r];
                v += __shfl_xor(v, 1); v += __shfl_xor(v, 2); v += __shfl_xor(v, 4);
                if (tsel == t) ysel[r] = v;
            }
        }
        float* so = p.out + O_SSM_S + ((size_t)(j * 128 + b) * 32 + g * 4) * 8192;
#pragma unroll
        for (int r = 0; r < 4; ++r) {
            const int ch = g * 256 + r * 64 + pp;
            const float yv = ysel[r] + p.in[15][j * 32 + g * 4 + r] * sx[tsel * 256 + r * 64 + pp];
            const float gv = yv * silu_f(bf2f(zv[r]));
            yg[row * 2048 + ch] = (bf16_t)(cvt_pk_bf16(gv, 0.f) & 0xffffu);
#pragma unroll
            for (int q = 0; q < 4; ++q) *(f32x4*)(so + r * 8192 + pp * 128 + nl + 32 * q) = hs[r][q];
        }
        if (nitem < 1024) {
#pragma unroll
            for (int r = 0; r < 4; ++r)
#pragma unroll
                for (int q = 0; q < 4; ++q) hs[r][q] = hn[r][q];
        }
    }
}

__device__ void phase_scan(const Params& p, int j, LAS unsigned char* lds) {
    for (int item = blockIdx.x; item < 256; item += gridDim.x) {
        const int g = item & 7, k = item >> 3, b = k >> 2, r = k & 3;
        for (int rep = 0; rep < REP_PROMPT; ++rep) ssd_prompt_item(p, j, b, g * 4 + r, lds);
    }
    ssd_sample_all(p, j, lds);
    const bf16_t* zx = (const bf16_t*)(p.ws + WS_ZX);
    const int gt = blockIdx.x * 512 + otid(), nth = gridDim.x * 512;
    for (int i = gt; i < 136 * 3 * 512; i += nth) {
        const int ch = (i & 511) * 8, k = (i >> 9) % 3, sq = (i >> 9) / 3;
        const size_t row = sq < 8 ? (size_t)(sq * 2048 + 2045 + k) : (size_t)(MP + (sq - 8) * 8 + 5 + k);
        float* dst = sq < 8 ? p.out + O_CONV_P + ((size_t)(j * 8 + sq) * 3 + k) * 4096 + ch : p.out + O_CONV_S + ((size_t)(j * 128 + (sq - 8)) * 3 + k) * 4096 + ch;
        const u32x4 v = *(const u32x4*)(zx + row * ZXW + 2048 + ch);
        *(f32x4*)dst = (f32x4){bf_lo(v.x), bf_hi(v.x), bf_lo(v.y), bf_hi(v.y)}; *(f32x4*)(dst + 4) = (f32x4){bf_lo(v.z), bf_hi(v.z), bf_lo(v.w), bf_hi(v.w)};
    }
}

#define XB_TMO      128
#define XB_XCNT(j)  (256  + 64 * (j))
#define XB_XSUB(j)  (1280 + 64 * (j))
#define XB_XGEN(j)  (2304 + 64 * (j))
#define XB_TOP      3328
#define XB_TOPGEN   3392
#define XCD_BAR_WORDS 3456
#define XB_SPIN_CAP (1u << 22)
__device__ __forceinline__ unsigned xb_ld(unsigned* p)              { return __hip_atomic_load(p, __ATOMIC_RELAXED, __HIP_MEMORY_SCOPE_AGENT); }
__device__ __forceinline__ unsigned xb_add(unsigned* p, unsigned v) { return __hip_atomic_fetch_add(p, v, __ATOMIC_RELAXED, __HIP_MEMORY_SCOPE_AGENT); }
__device__ __forceinline__ unsigned xb_xcc_id() { return (unsigned)__builtin_amdgcn_s_getreg((3 << 11) | 20) & 0xFu; }
#define XB_SPIN(cond, bar) do { unsigned _sp = 0; while (cond) { __builtin_amdgcn_s_sleep(1); \
    if ((++_sp & 255u) == 0u) { if (xb_ld(&(bar)[XB_TMO])) break; if (_sp > XB_SPIN_CAP) { atomicAdd(&(bar)[XB_TMO], 1u); break; } } } } while (0)
struct XcdBarrier { unsigned* bar; unsigned x; volatile LAS unsigned* st; };
__device__ __forceinline__ XcdBarrier xcd_barrier_post(unsigned* bar, volatile LAS unsigned* st) {
    XcdBarrier b; b.bar = bar; b.x = xb_xcc_id(); b.st = st;
    if (threadIdx.x == 0) (void)xb_add(&bar[XB_XCNT(b.x)], 1u);
    return b;
}
__device__ __forceinline__ void xcd_barrier_complete(unsigned* bar, unsigned x, unsigned& nloc, unsigned& nx) {
    const unsigned G = gridDim.x * gridDim.y * gridDim.z;
    unsigned sum, cnt, mine, sp = 0u;
    for (;;) {
        sum = 0u; cnt = 0u; mine = 0u;
#pragma unroll
        for (unsigned j = 0; j < 16; ++j) { const unsigned c = xb_ld(&bar[XB_XCNT(j)]); sum += c; cnt += (c > 0u) ? 1u : 0u; mine = (j == x) ? c : mine; }
        if (sum == G) break;
        __builtin_amdgcn_s_sleep(1);
        if ((++sp & 255u) == 0u) { if (xb_ld(&bar[XB_TMO])) break; if (sp > XB_SPIN_CAP) { atomicAdd(&bar[XB_TMO], 1u); break; } }
    }
    nloc = mine > 0u ? mine : 1u; nx = cnt > 0u ? cnt : 1u;
}
__device__ __forceinline__ void xcd_barrier(const XcdBarrier& b) {
    asm volatile("s_waitcnt vmcnt(0)" ::: "memory");
    __syncthreads();
    if (threadIdx.x == 0) {
        unsigned* bar = b.bar;
        __builtin_amdgcn_s_waitcnt(0);
        unsigned nloc = b.st[0], nx = b.st[1];
        if (nloc == 0u) { xcd_barrier_complete(bar, b.x, nloc, nx); b.st[0] = nloc; b.st[1] = nx; }
        const unsigned old = xb_add(&bar[XB_XSUB(b.x)], 1u);
        const unsigned gen = old / nloc;
        if (old + 1u == (gen + 1u) * nloc) {
            __builtin_amdgcn_fence(__ATOMIC_RELEASE, "agent");
            asm volatile("s_waitcnt vmcnt(0)" ::: "memory");
            const unsigned og = xb_add(&bar[XB_TOP], 1u);
            const unsigned tg = og / nx;
            if (og + 1u == (tg + 1u) * nx) xb_add(&bar[XB_TOPGEN], 1u);
            else XB_SPIN(xb_ld(&bar[XB_TOPGEN]) == tg, bar);
            __builtin_amdgcn_fence(__ATOMIC_ACQUIRE, "agent");
            xb_add(&bar[XB_XGEN(b.x)], 1u);
            asm volatile("s_waitcnt vmcnt(0)" ::: "memory");
        } else {
            XB_SPIN(xb_ld(&bar[XB_XGEN(b.x)]) == gen, bar);
            __builtin_amdgcn_fence(__ATOMIC_ACQUIRE, "agent");
            asm volatile("s_waitcnt vmcnt(0)" ::: "memory");
        }
    }
    __syncthreads();
}

#ifndef REP_PREP0
#define REP_PREP0 1
#endif
#ifndef REP_SMALL
#define REP_SMALL 1
#endif
#ifndef REP_GGRP
#define REP_GGRP 1
#endif
#ifndef REP_GGRP
#define REP_GGRP 1
#endif
#ifndef REP_SYNC
#define REP_SYNC 1
#endif
#ifndef REP_SCAN
#define REP_SCAN 1
#endif
#ifndef REP_GIN
#define REP_GIN 1
#endif
#ifndef REP_GOUT
#define REP_GOUT 1
#endif
#ifndef REP_ELEM
#define REP_ELEM 1
#endif
#define GSYNC() do { for (int _r = 0; _r < REP_SYNC; ++_r) xcd_barrier(xb); } while (0)
__global__ __launch_bounds__(512, 2) void hybrid_fwd(const float* i0, const float* i1, const float* i2, const float* i3, const float* i4, const float* i5, const float* i6, const float* i7,
        const float* i8, const float* i9, const float* i10, const float* i11, const float* i12, const float* i13, const float* i14, const float* i15, const float* i16, const float* i17,
        const float* i18, const float* i19, const float* i20, const float* i21, const float* i22, float* outp, unsigned char* wsp, WTab wt) {
    Params p;
    p.in[0] = i0; p.in[1] = i1; p.in[2] = i2; p.in[3] = i3; p.in[4] = i4; p.in[5] = i5; p.in[6] = i6; p.in[7] = i7; p.in[8] = i8; p.in[9] = i9; p.in[10] = i10; p.in[11] = i11;
    p.in[12] = i12; p.in[13] = i13; p.in[14] = i14; p.in[15] = i15; p.in[16] = i16; p.in[17] = i17; p.in[18] = i18; p.in[19] = i19; p.in[20] = i20; p.in[21] = i21; p.in[22] = i22;
    p.out = outp; p.ws = wsp;
    extern __shared__ __attribute__((aligned(16))) unsigned char smem[];
    LAS unsigned char* lds = (LAS unsigned char*)smem;
    cg::grid_group grid = cg::this_grid();
    unsigned char* ws = p.ws;
    volatile LAS unsigned* xst = (volatile LAS unsigned*)(lds + LDS_XB);
    if (threadIdx.x == 0) { xst[0] = 0u; xst[1] = 0u; }
    __syncthreads();
    const XcdBarrier xb = xcd_barrier_post((unsigned*)(ws + WS_BAR), xst);

    phase_prep0(p, wt, lds, 0, wt.wj[8].tile_begin, 0, true);
    if (wt.wtiles < 0) grid.sync();
    xcd_barrier(xb);
#pragma unroll 1
    for (int mode_ = 0; mode_ < 2 * REP_SMALL; ++mode_) {
        const int mode = mode_ % 2;
        pg8::SmallSched S; S.mode = mode; S.G = (int)gridDim.x; S.c = (int)blockIdx.x; S.lda = 1024; S.ldb = 1024; S.K = 1024;
        S.A0 = (const char*)(ws + (mode == 0 ? WS_AC : WS_SHIFTA)); S.ada = (const char*)(ws + WS_WT_ADA); S.ssd_in = (const char*)(ws + WS_WT_SSD_IN); S.pool_in = (const char*)(ws + WS_WT_POOL_IN);
        EpiSmall E; E.mode = mode; E.mod = (float*)(ws + WS_MOD); E.ada_b = p.in[8]; E.shiftA = (bf16_t*)(ws + WS_SHIFTA); E.sb = (float*)(ws + WS_SB);
#ifndef NO_GSMALL
        pg8::gemm_phase<EpiSmall, pg8::SmallSched>(lds, S, E);
#endif
        if (mode == 0) phase_prep0(p, wt, lds, wt.wj[8].tile_begin, wt.wtiles, 48, false);
        else phase_xprep(p, 82);
        GSYNC();
    }
    unsigned* tailw = (unsigned*)(ws + WS_BAR) + 3584;
    unsigned* tmow = (unsigned*)(ws + WS_BAR) + XB_TMO;
#pragma unroll 1
    for (int layer = 0; layer < 4; ++layer) {
        const int j = layer >> 1; const bool ssd = (layer & 1) == 0;
        {
            pg8::InSched S;
            S.init(ssd ? 6400 : 4096, ws + WS_APRIME, ssd ? ws + WS_WT_SSD_IN + (size_t)j * 6400 * 1024 * 2 : ws + WS_WT_POOL_IN + (size_t)j * 4096 * 1024 * 2, layer > 0 ? tailw + 64 * (layer - 1) : nullptr, tmow, layer == 2 ? 4 : 2);
            EpiIn E; E.ssq = (const float*)(ws + WS_SSQ) + (size_t)layer * 17408; E.sb = (const float*)(ws + WS_SB) + (size_t)layer * 136 * 6400; E.out = (bf16_t*)(ws + (ssd ? WS_ZX : WS_UZ));
            E.ldo = ssd ? ZXW : 4096; E.nbf = ssd ? ZXW : 4096; E.dtraw = ssd ? (float*)(ws + WS_DTRAW) : nullptr;
            for (int rep = 0; rep < REP_GIN; ++rep) pg8::gemm_phase<EpiIn, pg8::InSched>(lds, S, E);
        }
        GSYNC();
        if (ssd) { for (int rep = 0; rep < REP_SCAN; ++rep) phase_scan(p, j, lds); } else { for (int rep = 0; rep < REP_ELEM; ++rep) phase_pool(p, j); }
        GSYNC();
        if (ssd) { for (int rep = 0; rep < REP_ELEM; ++rep) phase_ssdnorm(p, j); GSYNC(); }
        const int ntail = layer == 3 ? 32 : 16;
#pragma unroll 1
        for (int part = 0; part < 2; ++part) {
            if (!ssd) {
                pg8::MainSched S; S.init(part == 0 ? MP : MT, 2048, 512, 2048, 512, ws + WS_YG, ws + WS_WT_POOL_G + (size_t)j * 2048 * 512 * 2, 1, part == 0 ? 0 : 3); S.ntail = ntail;
                EpiGrp E; E.uz = (const bf16_t*)(ws + WS_UZ); E.chs = p.in[20] + (size_t)j * 2048; E.out = (bf16_t*)(ws + WS_A2);
                pg8::gemm_phase<EpiGrp, pg8::MainSched>(lds, S, E);
                if (part == 0) GSYNC();
                else if ((int)blockIdx.x < ntail) {
                    unsigned* gc = tailw + 64 * (4 + layer);
                    asm volatile("s_waitcnt vmcnt(0)" ::: "memory");
                    __syncthreads();
                    if (threadIdx.x == 0) {
                        __builtin_amdgcn_fence(__ATOMIC_RELEASE, "agent"); asm volatile("s_waitcnt vmcnt(0)" ::: "memory");
                        __hip_atomic_fetch_add(gc, 1u, __ATOMIC_RELAXED, __HIP_MEMORY_SCOPE_AGENT);
                        unsigned polls = 0;
                        while (__hip_atomic_load(gc, __ATOMIC_RELAXED, __HIP_MEMORY_SCOPE_AGENT) < (unsigned)ntail) {
                            __builtin_amdgcn_s_sleep(2);
                            if ((++polls & 255u) == 0u) { if (__hip_atomic_load(tmow, __ATOMIC_RELAXED, __HIP_MEMORY_SCOPE_AGENT) != 0u) break; if (polls > (1u << 22)) { atomicAdd(tmow, 1u); break; } }
                        }
                        __builtin_amdgcn_fence(__ATOMIC_ACQUIRE, "agent"); asm volatile("s_waitcnt vmcnt(0)" ::: "memory");
                    }
                    __syncthreads();
                }
            }
            const bool splitk = (part == 1 && layer == 3);
            pg8::MainSched S; S.init(part == 0 ? MP : MT, 1024, splitk ? 1024 : 2048, 2048, 2048, ws + WS_A2, ssd ? ws + WS_WT_SSD_OUT + (size_t)j * 1024 * 2048 * 2 : ws + WS_WT_POOL_OUT + (size_t)j * 1024 * 2048 * 2, 30, splitk ? 2 : part);
            EpiOut E; E.xw = (bf16_t*)(ws + WS_XW);
            E.modl = (const float*)(ws + WS_MOD) + (size_t)layer * 3072; E.ng_next = layer < 3 ? p.in[9] + (size_t)(layer + 1) * 1024 : nullptr;
            E.aprime = (bf16_t*)(ws + WS_APRIME); E.ssq = (float*)(ws + WS_SSQ) + (size_t)(layer + 1) * 17408;
            E.part = splitk ? (float*)(ws + WS_PART) : nullptr;
            pg8::gemm_phase<EpiOut, pg8::MainSched>(lds, S, E);
            if (part == 0) GSYNC();
        }
        if (blockIdx.x < 16) {
            asm volatile("s_waitcnt vmcnt(0)" ::: "memory");
            __syncthreads();
            if (threadIdx.x == 0) { __builtin_amdgcn_fence(__ATOMIC_RELEASE, "agent"); asm volatile("s_waitcnt vmcnt(0)" ::: "memory"); __hip_atomic_fetch_add(tailw + 64 * layer, 1u, __ATOMIC_RELAXED, __HIP_MEMORY_SCOPE_AGENT); }
        }
    }
    phase_final(p, 0, MP, 32, false);
    GSYNC();
    phase_final(p, MP, MT, 0, true);
}

extern "C" void kernel_launch(void* const* d_in, const int* in_sizes, int n_in, void* d_out, int out_size, void* d_ws, size_t ws_size, hipStream_t stream) {
    static int grid = 0;
    if (grid == 0) {
        if (n_in != 23 || ws_size < WS_END) { fprintf(stderr, "kernel_launch: unexpected n_in %d or ws_size %zu (need %zu)\n", n_in, ws_size, (size_t)WS_END); grid = -1; return; }
        int dev = 0, cus = 0, per_cu = 0;
        hipGetDevice(&dev);
        hipDeviceGetAttribute(&cus, hipDeviceAttributeMultiprocessorCount, dev);
        if (hipFuncSetAttribute((const void*)hybrid_fwd, hipFuncAttributeMaxDynamicSharedMemorySize, LDS_BYTES) != hipSuccess) { fprintf(stderr, "kernel_launch: hipFuncSetAttribute failed\n"); grid = -1; return; }
        if (hipOccupancyMaxActiveBlocksPerMultiprocessor(&per_cu, (const void*)hybrid_fwd, 512, LDS_BYTES) != hipSuccess || per_cu < 1) { fprintf(stderr, "kernel_launch: occupancy query gave %d\n", per_cu); (void)hipGetLastError(); per_cu = 1; }
        if (cus < 256) { fprintf(stderr, "kernel_launch: needs a 256-CU device (got %d CUs)\n", cus); grid = -1; return; }
        grid = 256;
    }
    if (grid < 0) return;
    WTab wt{};
    unsigned char* ws = (unsigned char*)d_ws;
    int nj = 0, tb = 0;
    auto add = [&](int srci, long long soff, size_t dst_off, int K, int N, int Npad) {
        WJob& w = wt.wj[nj++]; w.src = (const float*)d_in[srci] + soff; w.doff = (long long)dst_off; w.K = K; w.N = N; w.tiles_n = Npad / 64; w.tile_begin = tb; tb += (K / 64) * (Npad / 64);
    };
    for (int i = 0; i < 4; ++i) add(7, (long long)i * 1024 * 3072, WS_WT_ADA + (size_t)i * 3072 * 1024 * 2, 1024, 3072, 3072);
    for (int j = 0; j < 2; ++j) add(10, (long long)j * 1024 * 6176, WS_WT_SSD_IN + (size_t)j * 6400 * 1024 * 2, 1024, 6176, 6400);
    for (int j = 0; j < 2; ++j) add(18, (long long)j * 1024 * 4096, WS_WT_POOL_IN + (size_t)j * 4096 * 1024 * 2, 1024, 4096, 4096);
    for (int j = 0; j < 2; ++j) add(17, (long long)j * 2048 * 1024, WS_WT_SSD_OUT + (size_t)j * 1024 * 2048 * 2, 2048, 1024, 1024);
    for (int j = 0; j < 2; ++j) add(21, (long long)j * 2048 * 1024, WS_WT_POOL_OUT + (size_t)j * 1024 * 2048 * 2, 2048, 1024, 1024);
    for (int q = 0; q < 8; ++q) add(19, (long long)q * 512 * 512, WS_WT_POOL_G + (size_t)q * 512 * 512 * 2, 512, 512, 512);
    wt.wtiles = tb;
    if (hipMemsetAsync(ws + WS_BAR, 0, 16384, stream) != hipSuccess) { fprintf(stderr, "kernel_launch: memset of the barrier words failed\n"); return; }
    const float* ip[23]; for (int i = 0; i < 23; ++i) ip[i] = (const float*)d_in[i];
    float* outp = (float*)d_out;
    void* args[26];
    for (int i = 0; i < 23; ++i) args[i] = (void*)&ip[i];
    args[23] = (void*)&outp; args[24] = (void*)&ws; args[25] = (void*)&wt;
    hipError_t e = hipLaunchCooperativeKernel((const void*)hybrid_fwd, dim3(grid), dim3(512), args, LDS_BYTES, stream);
    if (e != hipSuccess) fprintf(stderr, "cooperative launch failed: %s (grid %d)\n", hipGetErrorString(e), grid);
}
```
